# Optimizing an MI355X kernel written in HIP

```python
import math
import jax, jax.numpy as jnp
from jax import lax
import numpy as np

D_MODEL = 1024
BATCH = 16
SEQ = 256
DEPTH = 4
DEC_BATCH = 2
DEC_SEQ = 1024
PAST_LEN = 256

GRID_W = 64
EPS = 1e-6
D_FF = 2816
N_MOD = 9
N_EVEN = (DEPTH + 1) // 2
N_ODD = DEPTH // 2
POOL_SIZES = (2, 4, 8, 16)
POOL_GROUPS = 4
POOL_CH = 64
A_W = POOL_GROUPS * POOL_CH
DN_HEADS = 6
DN_DK = 128
DN_DV = 128
DN_CONV = 3
DN_CHUNK = 64
QK_W = DN_HEADS * DN_DK
B_W = DN_HEADS * DN_DV
CONV_CH = 2 * QK_W + B_W
P_EVEN = A_W + CONV_CH + B_W + 4 * DN_HEADS
O_EVEN = A_W + B_W
SGU_CHUNK = 128
SGU_HEADS = 6
SGU_CH = 128
C_W = SGU_HEADS * SGU_CH
FN_GROUPS = 4
FN_CH = 64
F_W = FN_GROUPS * FN_CH
P_ODD = 2 * C_W + F_W
O_ODD = C_W + F_W

kernel_name = 'hybrid_prefix_diffusion_step'

F32 = jnp.float32


def _rms_norm(x, w):
    xf = x.astype(F32)
    y = xf * lax.rsqrt(jnp.mean(xf * xf, axis=-1, keepdims=True) + EPS)
    return (y * w.astype(F32)).astype(x.dtype)


def _modulate(h, shift, scale):
    return h * (1 + scale) + shift


def _swiglu(h, w_gate, w_up, w_down):
    return (jax.nn.silu(h @ w_gate) * (h @ w_up)) @ w_down


def _l2norm(x):
    return x * lax.rsqrt(jnp.sum(x * x, axis=-1, keepdims=True) + EPS)


def _grid_pos_embed(n_tok, dtype):
    rows = n_tok // GRID_W
    r = jnp.broadcast_to(jnp.arange(rows, dtype=F32)[:, None], (rows, GRID_W)).reshape(-1)
    col = jnp.broadcast_to(jnp.arange(GRID_W, dtype=F32)[None, :], (rows, GRID_W)).reshape(-1)
    quarter = D_MODEL // 4
    freq = jnp.exp(-math.log(10000.0) * jnp.arange(quarter, dtype=F32) / quarter)

    def emb(p):
        ang = p[:, None] * freq[None, :]
        return jnp.concatenate([jnp.sin(ang), jnp.cos(ang)], axis=-1)

    return jnp.concatenate([emb(r), emb(col)], axis=-1).astype(dtype)


def _pool_mixer(p, w, scale):
    bn, n, _ = p.shape
    pf = p.astype(F32).reshape(bn, n, POOL_GROUPS, POOL_CH)
    csum = jnp.concatenate([jnp.zeros_like(pf[:, :1]), jnp.cumsum(pf, axis=1)], axis=1)
    t = jnp.arange(n)
    outs = []
    for gi, size in enumerate(POOL_SIZES):
        lo = jnp.clip(t - size // 2, 0, n)
        hi = jnp.clip(t + size // 2, 0, n)
        cnt = (hi - lo).astype(F32)[None, :, None]
        cg = csum[:, :, gi]
        outs.append((cg[:, hi] - cg[:, lo]) / cnt - pf[:, :, gi])
    d = jnp.stack(outs, axis=2)
    y = jnp.einsum('blgc,gce->blge', d, w.astype(F32)).reshape(bn, n, A_W)
    return (y * scale.astype(F32)).astype(p.dtype)


def _short_conv(x, w):
    n = x.shape[1]
    pad = DN_CONV // 2
    xp = jnp.pad(x, ((0, 0), (pad, pad), (0, 0)))
    y = xp[:, 0:n] * w[0]
    for tap in range(1, DN_CONV):
        y = y + xp[:, tap:tap + n] * w[tap]
    return y


def _gated_delta_chunked(q, k, v, g, beta, s0):
    bn, n, nh, dk = q.shape
    dv = v.shape[-1]
    nc = n // DN_CHUNK
    cs = DN_CHUNK

    def chunks(t):
        t = t.reshape((bn, nc, cs, nh) + t.shape[3:])
        return jnp.moveaxis(t, 3, 1)

    q, k, v, g, beta = (chunks(t) for t in (q, k, v, g, beta))
    q = q * (dk ** -0.5)
    gc = jnp.cumsum(g, axis=-1)
    idx = jnp.arange(cs)
    lower = idx[:, None] >= idx[None, :]
    strict = idx[:, None] > idx[None, :]
    decay = jnp.exp(jnp.where(lower, gc[..., :, None] - gc[..., None, :], -jnp.inf))
    kb = k * beta[..., None]
    m = jnp.where(strict, jnp.einsum('bhnik,bhnjk->bhnij', kb, k) * decay, 0.0)
    eye = jnp.eye(cs, dtype=F32)
    tinv = lax.linalg.triangular_solve(eye + m, jnp.broadcast_to(eye, m.shape),
                                       left_side=True, lower=True)
    u = tinv @ (v * beta[..., None])
    w = tinv @ (kb * jnp.exp(gc)[..., None])
    a_intra = jnp.einsum('bhnik,bhnjk->bhnij', q, k) * decay
    q_dec = q * jnp.exp(gc)[..., None]
    k_dec = k * jnp.exp(gc[..., -1:] - gc)[..., None]
    g_last = jnp.exp(gc[..., -1])

    def step(s, inp):
        q_i, k_i, u_i, w_i, a_i, gl_i = inp
        v_new = u_i - w_i @ s
        o = q_i @ s + a_i @ v_new
        s = s * gl_i[..., None, None] + jnp.einsum('bhck,bhcv->bhkv', k_i, v_new)
        return s, o

    xs = tuple(jnp.moveaxis(t, 2, 0) for t in (q_dec, k_dec, u, w, a_intra, g_last))
    s_final, o = lax.scan(step, s0, xs)
    o = jnp.moveaxis(jnp.moveaxis(o, 0, 2), 1, 3).reshape(bn, n, nh, dv)
    return o, s_final


def _deltanet_mixer(qkv, z, b_f, b_b, a_f, a_b, conv_w, a_log, dt_bias, norm_w, s0):
    bn, n, _ = qkv.shape
    hq = jax.nn.silu(_short_conv(qkv.astype(F32), conv_w.astype(F32)))
    q, k, v = jnp.split(hq, [QK_W, 2 * QK_W], axis=-1)
    q = _l2norm(q.reshape(bn, n, DN_HEADS, DN_DK))
    k = _l2norm(k.reshape(bn, n, DN_HEADS, DN_DK))
    v = v.reshape(bn, n, DN_HEADS, DN_DV)
    a_log = a_log.astype(F32)
    dt_bias = dt_bias.astype(F32)
    s0 = s0.astype(F32)
    g_f = -jnp.exp(a_log[0]) * jax.nn.softplus(a_f.astype(F32) + dt_bias[0])
    g_b = -jnp.exp(a_log[1]) * jax.nn.softplus(a_b.astype(F32) + dt_bias[1])
    beta_f = jax.nn.sigmoid(b_f.astype(F32))
    beta_b = jax.nn.sigmoid(b_b.astype(F32))
    o_f, s_f = _gated_delta_chunked(q, k, v, g_f, beta_f, s0[:, 0])
    rev = lambda t: jnp.flip(t, axis=1)
    o_b, s_b = _gated_delta_chunked(rev(q), rev(k), rev(v), rev(g_b), rev(beta_b), s0[:, 1])
    o = o_f + rev(o_b)
    o = o * lax.rsqrt(jnp.mean(o * o, axis=-1, keepdims=True) + EPS) * norm_w.astype(F32)
    o = o * jax.nn.silu(z.astype(F32).reshape(bn, n, DN_HEADS, DN_DV))
    return o.reshape(bn, n, B_W).astype(qkv.dtype), jnp.stack([s_f, s_b], axis=1)


def _sgu_mixer(uv, norm_w, w_s, b_s):
    bn, n, _ = uv.shape
    u, v = jnp.split(jax.nn.gelu(uv), 2, axis=-1)
    vf = v.astype(F32)
    mu = jnp.mean(vf, axis=-1, keepdims=True)
    var = jnp.mean(jnp.square(vf - mu), axis=-1, keepdims=True)
    vn = (vf - mu) * lax.rsqrt(var + EPS) * norm_w.astype(F32)
    vn = vn.reshape(bn, n // SGU_CHUNK, SGU_CHUNK, SGU_HEADS, SGU_CH)
    mixed = jnp.einsum('hps,bnshc->bnphc', w_s.astype(F32), vn) + b_s.astype(F32).T[:, :, None]
    return u * mixed.reshape(bn, n, C_W).astype(u.dtype)


def _fourier_mixer(f, w):
    bn, n, _ = f.shape
    ff = f.astype(F32).reshape(bn, n, FN_GROUPS, FN_CH)
    spec = jnp.fft.fft2(ff, axes=(1, 3), norm='ortho').real
    y = jnp.einsum('blgc,gce->blge', spec, w.astype(F32)).reshape(bn, n, F_W)
    return y.astype(f.dtype)


def _trunk(x, cond, init_state, ffn1_norm, ffn1_w_gate, ffn1_w_up, ffn1_w_down, mix_norm,
           ffn2_norm, ffn2_w_gate, ffn2_w_up, ffn2_w_down, ada_w, ada_b, ev_w_in, ev_w_out,
           pool_w, pool_scale, dn_conv_w, dn_a_log, dn_dt_bias, dn_norm_w, od_w_in, od_w_out,
           sgu_norm, sgu_w, sgu_b, fnet_w, final_norm):
    ev_splits = [A_W, A_W + CONV_CH, A_W + CONV_CH + B_W, A_W + CONV_CH + B_W + DN_HEADS,
                 A_W + CONV_CH + B_W + 2 * DN_HEADS, A_W + CONV_CH + B_W + 3 * DN_HEADS]
    final_states = []
    for l in range(DEPTH):
        mod = (jax.nn.silu(cond) @ ada_w[l] + ada_b[l])[:, None, :]
        sh1, sc1, g1, sh2, sc2, g2, sh3, sc3, g3 = jnp.split(mod, N_MOD, axis=-1)
        h = _modulate(_rms_norm(x, ffn1_norm[l]), sh1, sc1)
        x = x + 0.5 * g1 * _swiglu(h, ffn1_w_gate[l], ffn1_w_up[l], ffn1_w_down[l])
        h = _modulate(_rms_norm(x, mix_norm[l]), sh2, sc2)
        if l % 2 == 0:
            e = l // 2
            p_a, qkv, z, b_f, b_b, a_f, a_b = jnp.split(h @ ev_w_in[e], ev_splits, axis=-1)
            y_a = _pool_mixer(p_a, pool_w[e], pool_scale[e])
            y_b, s_fin = _deltanet_mixer(qkv, z, b_f, b_b, a_f, a_b, dn_conv_w[e], dn_a_log[e],
                                         dn_dt_bias[e], dn_norm_w[e], init_state[:, e])
            final_states.append(s_fin)
            mix = jnp.concatenate([y_a, y_b], axis=-1) @ ev_w_out[e]
        else:
            j = l // 2
            uv, f = jnp.split(h @ od_w_in[j], [2 * C_W], axis=-1)
            y_c = _sgu_mixer(uv, sgu_norm[j], sgu_w[j], sgu_b[j])
            y_d = _fourier_mixer(f, fnet_w[j])
            mix = jnp.concatenate([y_c, y_d], axis=-1) @ od_w_out[j]
        x = x + g2 * mix
        h = _modulate(_rms_norm(x, ffn2_norm[l]), sh3, sc3)
        x = x + 0.5 * g3 * _swiglu(h, ffn2_w_gate[l], ffn2_w_up[l], ffn2_w_down[l])
    return _rms_norm(x, final_norm), jnp.stack(final_states, axis=1)


def setup_inputs(seed: int = 0) -> dict:
    key = jax.random.key(seed)
    ks = iter(jax.random.split(key, 40))

    def nrm(shape, scale):
        return jax.random.normal(next(ks), shape, F32) * scale

    def gain(shape):
        return 1.0 + 0.02 * jax.random.normal(next(ks), shape, F32)

    d = D_MODEL
    a_log = jnp.log(jax.random.uniform(next(ks), (N_EVEN, 2, DN_HEADS), F32, 1.0, 16.0))
    dt = jnp.exp(jax.random.uniform(next(ks), (N_EVEN, 2, DN_HEADS), F32)
                 * (math.log(0.1) - math.log(0.001)) + math.log(0.001))
    dt_bias = dt + jnp.log(-jnp.expm1(-dt))
    return {
        'x_prompt': nrm((BATCH, SEQ, d), 1.0),
        'x_sample': nrm((DEC_BATCH, DEC_SEQ, d), 1.0),
        'state_delta': nrm((DEC_BATCH, N_EVEN, 2, DN_HEADS, DN_DK, DN_DV), DN_DK ** -0.5),
        'c': nrm((DEC_BATCH, d), 1.0),
        'c_ctx': nrm((d,), 1.0),
        'ffn1_norm': gain((DEPTH, d)),
        'ffn1_w_gate': nrm((DEPTH, d, D_FF), d ** -0.5),
        'ffn1_w_up': nrm((DEPTH, d, D_FF), d ** -0.5),
        'ffn1_w_down': nrm((DEPTH, D_FF, d), D_FF ** -0.5),
        'mix_norm': gain((DEPTH, d)),
        'ffn2_norm': gain((DEPTH, d)),
        'ffn2_w_gate': nrm((DEPTH, d, D_FF), d ** -0.5),
        'ffn2_w_up': nrm((DEPTH, d, D_FF), d ** -0.5),
        'ffn2_w_down': nrm((DEPTH, D_FF, d), D_FF ** -0.5),
        'ada_w': nrm((DEPTH, d, N_MOD * d), 0.5 * d ** -0.5),
        'ada_b': nrm((DEPTH, N_MOD * d), 0.02),
        'ev_w_in': nrm((N_EVEN, d, P_EVEN), d ** -0.5),
        'ev_w_out': nrm((N_EVEN, O_EVEN, d), O_EVEN ** -0.5),
        'pool_w': nrm((N_EVEN, POOL_GROUPS, POOL_CH, POOL_CH), POOL_CH ** -0.5),
        'pool_scale': gain((N_EVEN, A_W)),
        'dn_conv_w': nrm((N_EVEN, DN_CONV, CONV_CH), DN_CONV ** -0.5),
        'dn_a_log': a_log,
        'dn_dt_bias': dt_bias,
        'dn_norm_w': gain((N_EVEN, DN_DV)),
        'od_w_in': nrm((N_ODD, d, P_ODD), d ** -0.5),
        'od_w_out': nrm((N_ODD, O_ODD, d), O_ODD ** -0.5),
        'sgu_norm': gain((N_ODD, C_W)),
        'sgu_w': nrm((N_ODD, SGU_HEADS, SGU_CHUNK, SGU_CHUNK), SGU_CHUNK ** -0.5),
        'sgu_b': nrm((N_ODD, SGU_HEADS, SGU_CHUNK), 0.02),
        'fnet_w': nrm((N_ODD, FN_GROUPS, FN_CH, FN_CH), FN_CH ** -0.5),
        'final_norm': gain((d,)),
    }


def reference(x_prompt, x_sample, state_delta, c, c_ctx, ffn1_norm, ffn1_w_gate, ffn1_w_up,
              ffn1_w_down, mix_norm, ffn2_norm, ffn2_w_gate, ffn2_w_up, ffn2_w_down, ada_w, ada_b,
              ev_w_in, ev_w_out, pool_w, pool_scale, dn_conv_w, dn_a_log, dn_dt_bias, dn_norm_w,
              od_w_in, od_w_out, sgu_norm, sgu_w, sgu_b, fnet_w, final_norm):
    weights = (ffn1_norm, ffn1_w_gate, ffn1_w_up, ffn1_w_down, mix_norm, ffn2_norm, ffn2_w_gate,
               ffn2_w_up, ffn2_w_down, ada_w, ada_b, ev_w_in, ev_w_out, pool_w, pool_scale,
               dn_conv_w, dn_a_log, dn_dt_bias, dn_norm_w, od_w_in, od_w_out, sgu_norm, sgu_w,
               sgu_b, fnet_w, final_norm)
    zero_state = jnp.zeros((x_prompt.shape[0], N_EVEN, 2, DN_HEADS, DN_DK, DN_DV), F32)
    y_prompt, new_state_delta = _trunk(x_prompt, c_ctx[None, :], zero_state, *weights)
    x_lat = x_sample + _grid_pos_embed(x_sample.shape[1], x_sample.dtype)[None]
    y_sample, _ = _trunk(x_lat, c, state_delta, *weights)
    return (y_prompt, y_sample, new_state_delta)
```

```cpp
#include <hip/hip_runtime.h>
#include <cstdio>
#include <cstdint>

#ifndef ONE_LAUNCH
#define ONE_LAUNCH 0
#endif

#define GAS __attribute__((address_space(1)))
#define LAS __attribute__((address_space(3)))
#define CAS __attribute__((address_space(4)))
typedef unsigned short bf16;
typedef float f32x4 __attribute__((ext_vector_type(4)));
typedef float f32x2 __attribute__((ext_vector_type(2)));
typedef short bf16x8 __attribute__((ext_vector_type(8)));
typedef unsigned u32x4 __attribute__((ext_vector_type(4)));
typedef unsigned u32x2 __attribute__((ext_vector_type(2)));

constexpr int D = 1024, NCTX = 4096, NLAT = 2048, M = 6144, FF = 2816, DEPTH = 4;
constexpr int CTX_B = 16, CTX_L = 256, LAT_B = 2, LAT_L = 1024;
constexpr int NUP = 2 * FF;
constexpr int P_EVEN = 3352, P_EVEN_PAD = 3584, P_ODD = 1792;
constexpr int LDP = 3584;
constexpr int NH = 6, DK = 128;
constexpr float EPS = 1e-6f;
constexpr int NSEQ = CTX_B + LAT_B;

constexpr size_t MiB = 1u << 20;
constexpr size_t WS_CTL = 0, CTL_BYTES = 1 * MiB;
constexpr size_t WS_MOD = 1 * MiB;
constexpr size_t WS_WUP = 2 * MiB, WUP_SZ = 11 * MiB;
constexpr size_t WS_WDN = 90 * MiB, WDN_SZ = 5632 * 1024;
constexpr size_t WS_EVIN = 134 * MiB, EVIN_SZ = 7 * MiB;
constexpr size_t WS_EVOUT = 148 * MiB, SQ_SZ = 2 * MiB;
constexpr size_t WS_ODIN = 152 * MiB, ODIN_SZ = 4 * MiB;
constexpr size_t WS_ODOUT = 160 * MiB;
constexpr size_t WS_X = 164 * MiB;
constexpr size_t WS_HN = 188 * MiB;
constexpr size_t WS_HH = 200 * MiB;
constexpr size_t WS_P = 233 * MiB;
constexpr size_t WS_Y = 317 * MiB;
constexpr size_t WS_QN = 329 * MiB, WS_KN = 347 * MiB, WS_VV = 365 * MiB, WS_OF = 383 * MiB, WS_OB = 401 * MiB;
constexpr size_t WS_AG = 419 * MiB, WS_BT = 420 * MiB;
constexpr size_t WS_ZR = 421 * MiB, WS_ZI = 427 * MiB, WS_SPEC = 433 * MiB;
constexpr size_t WS_END = 439 * MiB;

constexpr int CW_BAR = 4096;

constexpr int LDS_MAIN = 139264;
constexpr int LDS_MISC = LDS_MAIN;
constexpr int LDS_BYTES = LDS_MAIN + 1024;

__device__ __forceinline__ float wave_sum(float v) {
#pragma unroll
    for (int o = 1; o < 64; o <<= 1) v += __shfl_xor(v, o);
    return v;
}
__device__ __forceinline__ unsigned f2bf(float f) { unsigned u = __builtin_bit_cast(unsigned, f); return (u + 0x7fffu + ((u >> 16) & 1u)) >> 16; }
__device__ __forceinline__ unsigned pk2(float lo, float hi) { return f2bf(lo) | (f2bf(hi) << 16); }
__device__ __forceinline__ float silu_f(float x) { return x / (1.f + __expf(-x)); }
__device__ __forceinline__ float sigmoid_f(float x) { return 1.f / (1.f + __expf(-x)); }
__device__ __forceinline__ float gelu_tanh(float x) { const float u = 0.7978845608028654f * (x + 0.044715f * x * x * x); return 0.5f * x * (1.f + tanhf(u)); }
__device__ __forceinline__ float softplus_f(float x) { return x > 20.f ? x : log1pf(expf(x)); }
__device__ __forceinline__ int cond_of_row(int r) { return r < NCTX ? 0 : (r < NCTX + LAT_L ? 1 : 2); }
__device__ __forceinline__ void seq_of_row(int r, int& s0, int& L) { if (r < NCTX) { s0 = r & ~(CTX_L - 1); L = CTX_L; } else { s0 = NCTX + ((r - NCTX) & ~(LAT_L - 1)); L = LAT_L; } }

#define XB_TMO      128
#define XB_XCNT(j)  (256  + 64 * (j))
#define XB_XSUB(j)  (1280 + 64 * (j))
#define XB_XGEN(j)  (2304 + 64 * (j))
#define XB_TOP      3328
#define XB_TOPGEN   3392
#define XCD_BAR_WORDS 3456
#define XB_SPIN_CAP (1u << 18)
__device__ __forceinline__ unsigned xb_ld(unsigned* p)              { return __hip_atomic_load(p, __ATOMIC_RELAXED, __HIP_MEMORY_SCOPE_AGENT); }
__device__ __forceinline__ unsigned xb_add(unsigned* p, unsigned v) { return __hip_atomic_fetch_add(p, v, __ATOMIC_RELAXED, __HIP_MEMORY_SCOPE_AGENT); }
__device__ __forceinline__ unsigned xb_xcc_id() { return (unsigned)__builtin_amdgcn_s_getreg((3 << 11) | 20) & 0xFu; }
#define XB_SPIN(cond, bar) do { unsigned _sp = 0; while (cond) { __builtin_amdgcn_s_sleep(1); \
    if ((++_sp & 255u) == 0u) { if (xb_ld(&(bar)[XB_TMO])) break; if (_sp > XB_SPIN_CAP) { atomicAdd(&(bar)[XB_TMO], 1u); break; } } } } while (0)
struct XcdBarrier { unsigned* bar; unsigned x; volatile LAS unsigned* st; };
__device__ __forceinline__ XcdBarrier xcd_barrier_post(unsigned* bar, volatile LAS unsigned* st) {
    XcdBarrier b; b.bar = bar; b.x = xb_xcc_id(); b.st = st;
    if (threadIdx.x == 0) (void)xb_add(&bar[XB_XCNT(b.x)], 1u);
    return b;
}
__device__ __forceinline__ void xcd_barrier_complete(unsigned* bar, unsigned x, unsigned& nloc, unsigned& nx) {
    const unsigned G = gridDim.x * gridDim.y * gridDim.z;
    unsigned sum, cnt, mine, sp = 0u;
    for (;;) {
        sum = 0u; cnt = 0u; mine = 0u;
#pragma unroll
        for (unsigned j = 0; j < 16; ++j) { const unsigned c = xb_ld(&bar[XB_XCNT(j)]); sum += c; cnt += (c > 0u) ? 1u : 0u; mine = (j == x) ? c : mine; }
        if (sum == G) break;
        __builtin_amdgcn_s_sleep(1);
        if ((++sp & 255u) == 0u) { if (xb_ld(&bar[XB_TMO])) break; if (sp > XB_SPIN_CAP) { atomicAdd(&bar[XB_TMO], 1u); break; } }
    }
    nloc = mine > 0u ? mine : 1u; nx = cnt > 0u ? cnt : 1u;
}
__device__ __forceinline__ void xcd_barrier(const XcdBarrier& b) {
    asm volatile("s_waitcnt vmcnt(0)" ::: "memory");
    __syncthreads();
    if (threadIdx.x == 0) {
        unsigned* bar = b.bar;
        __builtin_amdgcn_s_waitcnt(0);
        unsigned nloc = b.st[0], nx = b.st[1];
        if (nloc == 0u) { xcd_barrier_complete(bar, b.x, nloc, nx); b.st[0] = nloc; b.st[1] = nx; }
        const unsigned old = xb_add(&bar[XB_XSUB(b.x)], 1u);
        const unsigned gen = old / nloc;
        if (old + 1u == (gen + 1u) * nloc) {
            __builtin_amdgcn_fence(__ATOMIC_RELEASE, "agent");
            asm volatile("s_waitcnt vmcnt(0)" ::: "memory");
            const unsigned og = xb_add(&bar[XB_TOP], 1u);
            const unsigned tg = og / nx;
            if (og + 1u == (tg + 1u) * nx) xb_add(&bar[XB_TOPGEN], 1u);
            else XB_SPIN(xb_ld(&bar[XB_TOPGEN]) == tg, bar);
            __builtin_amdgcn_fence(__ATOMIC_ACQUIRE, "agent");
            xb_add(&bar[XB_XGEN(b.x)], 1u);
            asm volatile("s_waitcnt vmcnt(0)" ::: "memory");
        } else {
            XB_SPIN(xb_ld(&bar[XB_XGEN(b.x)]) == gen, bar);
            __builtin_amdgcn_fence(__ATOMIC_ACQUIRE, "agent");
            asm volatile("s_waitcnt vmcnt(0)" ::: "memory");
        }
    }
    __syncthreads();
}

struct Args { const float* in[31]; float* out; unsigned char* ws; int ph_lo, ph_hi; };
enum { I_XP = 0, I_XS, I_STATE, I_C, I_CCTX, I_F1N, I_F1G, I_F1U, I_F1D, I_MIXN, I_F2N, I_F2G, I_F2U, I_F2D, I_ADAW, I_ADAB, I_EVIN, I_EVOUT,
       I_POOLW, I_POOLS, I_CONVW, I_ALOG, I_DTB, I_DNNW, I_ODIN, I_ODOUT, I_SGUN, I_SGUW, I_SGUB, I_FNETW, I_FINN };

struct Frame {
    LAS unsigned char* lds;
    int tid, lane, wave, vcu, G;
    const CAS Args* a;
};

template <int NFRAG, class Epi>
__device__ __forceinline__ void gemm_tile(LAS unsigned char* lds, const int tid, const bf16* A, const bf16* Bt, int K, int row0, int col0, const Epi& E) {
    constexpr int BN = 32 * NFRAG, NPB = BN / 8, A_BYTES = 192 * 128, B_BYTES = BN * 128, STAGE = A_BYTES + B_BYTES, NBI = (NPB + 7) / 8;
    static_assert(2 * STAGE <= LDS_MAIN, "LDS");
    const int lane = tid & 63, wid = __builtin_amdgcn_readfirstlane(tid >> 6), wm = wid >> 1, wn = wid & 1, fr = lane & 15, fq = lane >> 4;
    const int r = lane >> 3, slot = lane & 7;
    const int srow = wid * 8 + r;
    const int chunk = slot ^ ((srow >> 1) & 7);
    const char* gA = (const char*)(A + (size_t)(row0 + srow) * K) + chunk * 16;
    const char* gB = (const char*)(Bt + (size_t)(col0 + srow) * K) + chunk * 16;
    const size_t pstep = (size_t)64 * K * 2;
    const int nt = K / 64;
    const int rowA0 = wm * 48 + fr, rowB0 = wn * NFRAG * 16 + fr;
    int offA[2], offB[2];
#pragma unroll
    for (int kk = 0; kk < 2; ++kk) {
        offA[kk] = rowA0 * 128 + (((kk * 4 + fq) ^ ((rowA0 >> 1) & 7)) << 4);
        offB[kk] = A_BYTES + rowB0 * 128 + (((kk * 4 + fq) ^ ((rowB0 >> 1) & 7)) << 4);
    }
    f32x4 acc[3][NFRAG];
#pragma unroll
    for (int i = 0; i < 3; ++i)
#pragma unroll
        for (int j = 0; j < NFRAG; ++j) acc[i][j] = (f32x4){0.f, 0.f, 0.f, 0.f};

#define GEMM_STAGE(buf, t) do { LAS unsigned char* sA_ = lds + (buf) * STAGE + wid * 1024; \
        _Pragma("unroll") for (int i_ = 0; i_ < 3; ++i_) \
            __builtin_amdgcn_global_load_lds((const unsigned*)(gA + i_ * pstep + (size_t)(t) * 128), (LAS unsigned*)(sA_ + i_ * 8192), 16, 0, 0); \
        _Pragma("unroll") for (int i_ = 0; i_ < NBI; ++i_) if (wid + 8 * i_ < NPB) \
            __builtin_amdgcn_global_load_lds((const unsigned*)(gB + i_ * pstep + (size_t)(t) * 128), (LAS unsigned*)(sA_ + A_BYTES + i_ * 8192), 16, 0, 0); } while (0)

    GEMM_STAGE(0, 0);
    for (int t = 0; t < nt; ++t) {
        asm volatile("s_waitcnt vmcnt(0)" ::: "memory");
        __syncthreads();
        if (t + 1 < nt) GEMM_STAGE((t + 1) & 1, t + 1);
        LAS unsigned char* sb = lds + (t & 1) * STAGE;
#pragma unroll
        for (int kk = 0; kk < 2; ++kk) {
            bf16x8 af[3];
#pragma unroll
            for (int mf = 0; mf < 3; ++mf) af[mf] = *(const LAS bf16x8*)(sb + offA[kk] + mf * 2048);
#pragma unroll
            for (int nf = 0; nf < NFRAG; ++nf) {
                const bf16x8 bfr = *(const LAS bf16x8*)(sb + offB[kk] + nf * 2048);
#pragma unroll
                for (int mf = 0; mf < 3; ++mf) acc[mf][nf] = __builtin_amdgcn_mfma_f32_16x16x32_bf16(bfr, af[mf], acc[mf][nf], 0, 0, 0);
            }
        }
    }
#undef GEMM_STAGE
    E(acc, row0 + wm * 48 + fr, col0 + wn * NFRAG * 16 + fq * 4, fq);
    __syncthreads();
}

struct EpiUp {
    bf16* H;
    template <int NFRAG> __device__ __forceinline__ void operator()(f32x4 (&acc)[3][NFRAG], int row, int colq, int fq) const {
#pragma unroll
        for (int mf = 0; mf < 3; ++mf)
#pragma unroll
            for (int nf = 0; nf < NFRAG; ++nf) {
                f32x4 v = acc[mf][nf], o;
                o[0] = __shfl_xor(v[0], 16); o[1] = __shfl_xor(v[1], 16); o[2] = __shfl_xor(v[2], 16); o[3] = __shfl_xor(v[3], 16);
                if ((fq & 1) == 0) {
                    const int c = colq + nf * 16;
                    const int hid = (c >> 3) * 4;
                    u32x2 w; w.x = pk2(silu_f(v[0]) * o[0], silu_f(v[1]) * o[1]); w.y = pk2(silu_f(v[2]) * o[2], silu_f(v[3]) * o[3]);
                    *(u32x2*)(H + (size_t)(row + mf * 16) * FF + hid) = w;
                }
            }
    }
};
struct EpiRes {
    float* X; const float* mod; int layer, gidx; float scale;
    template <int NFRAG> __device__ __forceinline__ void operator()(f32x4 (&acc)[3][NFRAG], int row, int colq, int) const {
#pragma unroll
        for (int mf = 0; mf < 3; ++mf) {
            const int rr = row + mf * 16;
            const float* g = mod + ((size_t)(layer * 3 + cond_of_row(rr)) * 9 + gidx) * 1024;
#pragma unroll
            for (int nf = 0; nf < NFRAG; ++nf) {
                const int c = colq + nf * 16;
                const f32x4 gv = *(const f32x4*)(g + c);
                f32x4* xp = (f32x4*)(X + (size_t)rr * D + c);
                f32x4 xv = *xp;
                xv += acc[mf][nf] * gv * scale;
                *xp = xv;
            }
        }
    }
};
struct EpiStore {
    float* P; int ld;
    template <int NFRAG> __device__ __forceinline__ void operator()(f32x4 (&acc)[3][NFRAG], int row, int colq, int) const {
#pragma unroll
        for (int mf = 0; mf < 3; ++mf)
#pragma unroll
            for (int nf = 0; nf < NFRAG; ++nf) *(f32x4*)(P + (size_t)(row + mf * 16) * ld + colq + nf * 16) = acc[mf][nf];
    }
};

template <int NFRAG, class Epi>
__device__ __forceinline__ void gemm_phase(Frame& F, const bf16* A, const bf16* Bt, int K, int N, const Epi& E) {
    constexpr int BN = 32 * NFRAG;
    const int NT = N / BN, nitems = 32 * NT;
    for (int i = F.vcu; i < nitems; i += F.G) {
        const int panel = (i >> 3) & 31, ct = (i & 7) + 8 * (i >> 8);
        gemm_tile<NFRAG, Epi>(F.lds, F.tid, A, Bt, K, panel * 192, ct * BN, E);
    }
}

__device__ __forceinline__ void transpose_item(const float* W, int K, int N, bf16* WT, int mode, LAS float* scr, int item, int lane) {
    const int nblk = (N + 31) / 32, kb = item / nblk, nb = item % nblk, k0 = 64 * kb, n0 = 32 * nb;
    const int nn = n0 + (lane & 31);
#pragma unroll 8
    for (int i = 0; i < 32; ++i) { const int kk = 2 * i + (lane >> 5); scr[kk * 33 + (lane & 31)] = (nn < N) ? W[(size_t)(k0 + kk) * N + nn] : 0.f; }
    asm volatile("s_waitcnt lgkmcnt(0)" ::: "memory");
    const int c = lane & 7;
#pragma unroll
    for (int j = 0; j < 4; ++j) {
        const int nl = (lane >> 3) + 8 * j, n = n0 + nl; const LAS float* s = scr + (8 * c) * 33 + nl;
        u32x4 o; o.x = pk2(s[0 * 33], s[1 * 33]); o.y = pk2(s[2 * 33], s[3 * 33]); o.z = pk2(s[4 * 33], s[5 * 33]); o.w = pk2(s[6 * 33], s[7 * 33]);
        const int dr = (mode == 0) ? n : ((n >> 2) * 8 + (n & 3) + (mode == 2 ? 4 : 0));
        if (n < N) *(u32x4*)(WT + (size_t)dr * K + k0 + 8 * c) = o;
    }
    asm volatile("s_waitcnt lgkmcnt(0)" ::: "memory");
}

__device__ __forceinline__ void phase_setup(Frame& F) {
    const CAS Args& a = *F.a;
    unsigned char* ws = a.ws;
    {
        LAS float* sc = (LAS float*)F.lds;
        LAS float* red = sc + 3 * 1024;
        for (int i = F.tid; i < 3 * 1024; i += 512) { const int c = i >> 10, k = i & 1023; const float v = (c == 0) ? a.in[I_CCTX][k] : a.in[I_C][(c - 1) * 1024 + k]; sc[i] = silu_f(v); }
        __syncthreads();
        float* mod = (float*)(ws + WS_MOD);
        for (int it = F.vcu; it < 4 * 72; it += F.G) {
            const int l = it / 72, cb = it % 72, q = F.tid & 31, kg = F.tid >> 5;
            const float* W = a.in[I_ADAW] + (size_t)l * 1024 * 9216 + cb * 128 + q * 4;
            f32x4 s0 = {0, 0, 0, 0}, s1 = s0, s2 = s0;
#pragma unroll 4
            for (int k = kg * 64; k < kg * 64 + 64; ++k) {
                const f32x4 w = *(const f32x4*)(W + (size_t)k * 9216);
                s0 += w * sc[k]; s1 += w * sc[1024 + k]; s2 += w * sc[2048 + k];
            }
            LAS float* rp = red + (kg * 32 + q) * 12;
#pragma unroll
            for (int j = 0; j < 4; ++j) { rp[j] = s0[j]; rp[4 + j] = s1[j]; rp[8 + j] = s2[j]; }
            __syncthreads();
            if (F.tid < 384) {
                const int qq = F.tid / 12, v = F.tid % 12; float s = 0.f;
#pragma unroll
                for (int g = 0; g < 16; ++g) s += red[(g * 32 + qq) * 12 + v];
                const int c = v >> 2, j = v & 3, n = cb * 128 + qq * 4 + j;
                mod[(size_t)(l * 3 + c) * 9216 + n] = s + a.in[I_ADAB][l * 9216 + n];
            }
            __syncthreads();
        }
        __syncthreads();
    }
    {
        LAS float* scr = (LAS float*)(F.lds + F.wave * 16384);
        const int gw = F.vcu * 8 + F.wave, NGW = F.G * 8;
        constexpr int IT_G = 16 * 88, IT_D = 44 * 32, IT_EVIN = 16 * 105, IT_SQ = 16 * 32, IT_ODIN = 16 * 56;
        static_assert(IT_G == IT_D, "decode");
        constexpr int PER_FFN = 2 * IT_G + IT_D;
        constexpr int TOT = 8 * PER_FFN + 2 * (IT_EVIN + IT_SQ + IT_ODIN + IT_SQ);
        for (int it = gw; it < TOT; it += NGW) {
            int r = it; const float* W; bf16* WT; int K, N, mode;
            if (r < 8 * PER_FFN) {
                const int f = r / PER_FFN, l = f >> 1, s = f & 1; r -= f * PER_FFN;
                const int sub = r / IT_G; r -= sub * IT_G;
                const int idx = (sub == 0) ? (s ? I_F2G : I_F1G) : ((sub == 1) ? (s ? I_F2U : I_F1U) : (s ? I_F2D : I_F1D));
                W = a.in[idx] + (size_t)l * D * FF;
                WT = (sub == 2) ? (bf16*)(ws + WS_WDN + (size_t)f * WDN_SZ) : (bf16*)(ws + WS_WUP + (size_t)f * WUP_SZ);
                K = (sub == 2) ? FF : D; N = (sub == 2) ? D : FF; mode = (sub == 2) ? 0 : sub + 1;
            } else {
                r -= 8 * PER_FFN;
                constexpr int PER_E = IT_EVIN + IT_SQ + IT_ODIN + IT_SQ;
                const int e = r / PER_E; r -= e * PER_E;
                K = D; mode = 0;
                if (r < IT_EVIN) { W = a.in[I_EVIN] + (size_t)e * D * P_EVEN; N = P_EVEN; WT = (bf16*)(ws + WS_EVIN + (size_t)e * EVIN_SZ); }
                else if (r < IT_EVIN + IT_SQ) { r -= IT_EVIN; W = a.in[I_EVOUT] + (size_t)e * D * D; N = D; WT = (bf16*)(ws + WS_EVOUT + (size_t)e * SQ_SZ); }
                else if (r < IT_EVIN + IT_SQ + IT_ODIN) { r -= IT_EVIN + IT_SQ; W = a.in[I_ODIN] + (size_t)e * D * P_ODD; N = P_ODD; WT = (bf16*)(ws + WS_ODIN + (size_t)e * ODIN_SZ); }
                else { r -= IT_EVIN + IT_SQ + IT_ODIN; W = a.in[I_ODOUT] + (size_t)e * D * D; N = D; WT = (bf16*)(ws + WS_ODOUT + (size_t)e * SQ_SZ); }
            }
            transpose_item(W, K, N, WT, mode, scr, r, F.lane);
        }
        for (int it = gw; it < 2 * (P_EVEN_PAD - P_EVEN); it += NGW) {
            const int e = it / (P_EVEN_PAD - P_EVEN), rr = P_EVEN + it % (P_EVEN_PAD - P_EVEN);
            u32x4* p = (u32x4*)((bf16*)(ws + WS_EVIN + (size_t)e * EVIN_SZ) + (size_t)rr * D);
            p[F.lane] = (u32x4){0, 0, 0, 0}; p[64 + F.lane] = (u32x4){0, 0, 0, 0};
        }
        float* X = (float*)(ws + WS_X);
        for (int row = gw; row < M; row += NGW) {
            float* xo = X + (size_t)row * D;
            if (row < NCTX) {
                const f32x4* src = (const f32x4*)(a.in[I_XP] + (size_t)row * D);
#pragma unroll
                for (int j = 0; j < 4; ++j) ((f32x4*)xo)[j * 64 + F.lane] = src[j * 64 + F.lane];
            } else {
                const int t = (row - NCTX) & (LAT_L - 1); const float pr = (float)(t >> 6), pc = (float)(t & 63);
                const float* src = a.in[I_XS] + (size_t)(row - NCTX) * D;
#pragma unroll
                for (int j = 0; j < 16; ++j) {
                    const int ch = j * 64 + F.lane, seg = ch >> 8, i = ch & 255;
                    const float freq = expf(-9.210340371976184f * (float)i * (1.0f / 256.0f));
                    const float ang = ((seg < 2) ? pr : pc) * freq;
                    const float pe = (seg & 1) ? cosf(ang) : sinf(ang);
                    xo[ch] = src[ch] + pe;
                }
            }
        }
    }
}

__device__ __forceinline__ void phase_norm(Frame& F, int layer, int which) {
    const CAS Args& a = *F.a;
    const float* X = (const float*)(a.ws + WS_X); bf16* HN = (bf16*)(a.ws + WS_HN);
    const float* mod = (const float*)(a.ws + WS_MOD);
    const float* nw = a.in[which == 0 ? I_F1N : (which == 1 ? I_MIXN : I_F2N)] + layer * D;
    const int gw = F.vcu * 8 + F.wave, NGW = F.G * 8;
    for (int row = gw; row < M; row += NGW) {
        const f32x4* xr = (const f32x4*)(X + (size_t)row * D) + F.lane;
        f32x4 v[4]; float s = 0.f;
#pragma unroll
        for (int j = 0; j < 4; ++j) { v[j] = xr[64 * j]; s += v[j][0] * v[j][0] + v[j][1] * v[j][1] + v[j][2] * v[j][2] + v[j][3] * v[j][3]; }
        const float rstd = 1.0f / sqrtf(wave_sum(s) * (1.f / D) + EPS);
        const float* mb = mod + ((size_t)(layer * 3 + cond_of_row(row)) * 9 + which * 3) * 1024;
        u32x2* o = (u32x2*)(HN + (size_t)row * D) + F.lane;
#pragma unroll
        for (int j = 0; j < 4; ++j) {
            const int k = (64 * j + F.lane) * 4;
            const f32x4 w = *(const f32x4*)(nw + k), sh = *(const f32x4*)(mb + k), sc = *(const f32x4*)(mb + 1024 + k);
            const f32x4 h = (v[j] * rstd * w) * (sc + 1.0f) + sh;
            u32x2 pkd; pkd.x = pk2(h[0], h[1]); pkd.y = pk2(h[2], h[3]);
            o[64 * j] = pkd;
        }
    }
}

__device__ __forceinline__ void phase_final(Frame& F) {
    const CAS Args& a = *F.a;
    const float* X = (const float*)(a.ws + WS_X);
    const float* nw = a.in[I_FINN];
    const int gw = F.vcu * 8 + F.wave, NGW = F.G * 8;
    for (int row = gw; row < M; row += NGW) {
        const f32x4* xr = (const f32x4*)(X + (size_t)row * D) + F.lane;
        f32x4 v[4]; float s = 0.f;
#pragma unroll
        for (int j = 0; j < 4; ++j) { v[j] = xr[64 * j]; s += v[j][0] * v[j][0] + v[j][1] * v[j][1] + v[j][2] * v[j][2] + v[j][3] * v[j][3]; }
        const float rstd = 1.0f / sqrtf(wave_sum(s) * (1.f / D) + EPS);
        f32x4* o = (f32x4*)(a.out + (size_t)row * D) + F.lane;
#pragma unroll
        for (int j = 0; j < 4; ++j) { const f32x4 w = *(const f32x4*)(nw + (64 * j + F.lane) * 4); o[64 * j] = v[j] * rstd * w; }
    }
}

__device__ __forceinline__ float wave_matvec64(float d, const float* W, int lane) {
    float y = 0.f;
#pragma unroll
    for (int c = 0; c < 64; ++c) { const float dc = __builtin_bit_cast(float, __builtin_amdgcn_readlane(__builtin_bit_cast(int, d), c)); y += dc * W[c * 64 + lane]; }
    return y;
}

__device__ __forceinline__ void phase_even_pre(Frame& F, int e) {
    const CAS Args& a = *F.a;
    const float* P = (const float*)(a.ws + WS_P);
    float* QN = (float*)(a.ws + WS_QN); float* KN = (float*)(a.ws + WS_KN); float* VV = (float*)(a.ws + WS_VV);
    float* AG = (float*)(a.ws + WS_AG); float* BT = (float*)(a.ws + WS_BT);
    bf16* Y = (bf16*)(a.ws + WS_Y);
    const float* cw = a.in[I_CONVW] + (size_t)e * 3 * 2304;
    const int gw = F.vcu * 8 + F.wave, NGW = F.G * 8;
    for (int it = gw; it < M * NH; it += NGW) {
        const int row = it / NH, h = it % NH; int s0, L; seq_of_row(row, s0, L);
        const int t = row - s0; const bool hp = t > 0, hn = t < L - 1;
        const int c2 = F.lane * 2;
        float res[3][2];
#pragma unroll
        for (int part = 0; part < 3; ++part) {
            const int pc = 256 + part * 768 + h * 128 + c2, wc = part * 768 + h * 128 + c2;
            const f32x2 x1 = *(const f32x2*)(P + (size_t)row * LDP + pc);
            const f32x2 x0 = hp ? *(const f32x2*)(P + (size_t)(row - 1) * LDP + pc) : (f32x2){0.f, 0.f};
            const f32x2 x2 = hn ? *(const f32x2*)(P + (size_t)(row + 1) * LDP + pc) : (f32x2){0.f, 0.f};
            const f32x2 w0 = *(const f32x2*)(cw + wc), w1 = *(const f32x2*)(cw + 2304 + wc), w2 = *(const f32x2*)(cw + 4608 + wc);
            const f32x2 y = x0 * w0 + x1 * w1 + x2 * w2;
            res[part][0] = silu_f(y[0]); res[part][1] = silu_f(y[1]);
        }
        const float qs = wave_sum(res[0][0] * res[0][0] + res[0][1] * res[0][1]);
        const float ks = wave_sum(res[1][0] * res[1][0] + res[1][1] * res[1][1]);
        const float qr = (1.0f / sqrtf(qs + EPS)) * 0.08838834764831845f, kr = 1.0f / sqrtf(ks + EPS);
        const size_t o = (size_t)row * 768 + h * 128 + c2;
        *(f32x2*)(QN + o) = (f32x2){res[0][0] * qr, res[0][1] * qr};
        *(f32x2*)(KN + o) = (f32x2){res[1][0] * kr, res[1][1] * kr};
        *(f32x2*)(VV + o) = (f32x2){res[2][0], res[2][1]};
        if (F.lane < 2) {
            const int d = F.lane;
            const float braw = P[(size_t)row * LDP + 3328 + d * 6 + h], araw = P[(size_t)row * LDP + 3340 + d * 6 + h];
            const float al = a.in[I_ALOG][(e * 2 + d) * 6 + h], dtb = a.in[I_DTB][(e * 2 + d) * 6 + h];
            const float g = -expf(al) * softplus_f(araw + dtb);
            AG[(size_t)row * 12 + d * 6 + h] = expf(g);
            BT[(size_t)row * 12 + d * 6 + h] = sigmoid_f(braw);
        }
    }
    const float* pw = a.in[I_POOLW] + (size_t)e * 4 * 64 * 64; const float* ps = a.in[I_POOLS] + e * 256;
    for (int it = gw; it < M * 4; it += NGW) {
        const int row = it >> 2, g = it & 3; int s0, L; seq_of_row(row, s0, L);
        const int t = row - s0, half = 1 << g;
        const int lo = max(t - half, 0), hi = min(t + half, L);
        float sum = 0.f;
        for (int p = lo; p < hi; ++p) sum += P[(size_t)(s0 + p) * LDP + g * 64 + F.lane];
        const float d = sum / (float)(hi - lo) - P[(size_t)row * LDP + g * 64 + F.lane];
        const float y = wave_matvec64(d, pw + g * 4096, F.lane) * ps[g * 64 + F.lane];
        Y[(size_t)row * D + g * 64 + F.lane] = (bf16)f2bf(y);
    }
}

__device__ __forceinline__ void phase_dn_scan(Frame& F, int e) {
    const CAS Args& a = *F.a;
    const float* QN = (const float*)(a.ws + WS_QN); const float* KN = (const float*)(a.ws + WS_KN); const float* VV = (const float*)(a.ws + WS_VV);
    const float* AG = (const float*)(a.ws + WS_AG); const float* BT = (const float*)(a.ws + WS_BT);
    constexpr int TCH = 16;
    LAS float* sk = (LAS float*)F.lds;
    LAS float* sq = sk + TCH * 128;
    LAS float* sv = sq + TCH * 128;
    LAS float* sab = sv + TCH * 128;
    const int cl = F.lane & 15, rg = F.lane >> 4, col = F.wave * 16 + cl;
    for (int it = F.vcu; it < NSEQ * 2 * NH; it += F.G) {
        int seq, dir, h;
        if (it < LAT_B * 2 * NH) { seq = CTX_B + it / (2 * NH); dir = (it / NH) & 1; h = it % NH; }
        else { const int j = it - LAT_B * 2 * NH; seq = j / (2 * NH); dir = (j / NH) & 1; h = j % NH; }
        const bool lat = seq >= CTX_B;
        const int L = lat ? LAT_L : CTX_L, row0 = lat ? NCTX + (seq - CTX_B) * LAT_L : seq * CTX_L;
        float S[32];
        if (lat) {
            const float* s0 = a.in[I_STATE] + ((((size_t)(seq - CTX_B) * 2 + e) * 2 + dir) * NH + h) * 128 * 128;
#pragma unroll
            for (int i = 0; i < 32; ++i) S[i] = s0[(size_t)(rg * 32 + i) * 128 + col];
        } else {
#pragma unroll
            for (int i = 0; i < 32; ++i) S[i] = 0.f;
        }
        float* O = (float*)(a.ws + (dir ? WS_OB : WS_OF));
        for (int c0 = 0; c0 < L; c0 += TCH) {
            __syncthreads();
            for (int i = F.tid; i < TCH * 96; i += 512) {
                const int tt = i / 96, w = i % 96, part = w >> 5, c4 = (w & 31) * 4;
                const int step = c0 + tt, row = row0 + (dir ? (L - 1 - step) : step);
                const float* src = (part == 0 ? KN : (part == 1 ? QN : VV)) + (size_t)row * 768 + h * 128 + c4;
                LAS float* dst = (part == 0 ? sk : (part == 1 ? sq : sv)) + tt * 128 + c4;
                *(LAS f32x4*)dst = *(const f32x4*)src;
            }
            if (F.tid < TCH * 2) {
                const int tt = F.tid >> 1, w = F.tid & 1, step = c0 + tt, row = row0 + (dir ? (L - 1 - step) : step);
                sab[F.tid] = (w ? BT : AG)[(size_t)row * 12 + dir * 6 + h];
            }
            __syncthreads();
            for (int tt = 0; tt < TCH; ++tt) {
                const float av = sab[tt * 2], bv = sab[tt * 2 + 1];
                const LAS float* kp = sk + tt * 128 + rg * 32; const LAS float* qp = sq + tt * 128 + rg * 32;
                float kr[32];
#pragma unroll
                for (int i = 0; i < 32; i += 4) { const f32x4 k4 = *(const LAS f32x4*)(kp + i); kr[i] = k4[0]; kr[i + 1] = k4[1]; kr[i + 2] = k4[2]; kr[i + 3] = k4[3]; }
                float dot = 0.f;
#pragma unroll
                for (int i = 0; i < 32; ++i) dot += kr[i] * S[i];
                dot += __shfl_xor(dot, 16); dot += __shfl_xor(dot, 32);
                const float coef = bv * (sv[tt * 128 + col] - av * dot);
                float o = 0.f;
#pragma unroll
                for (int i = 0; i < 32; i += 4) {
                    const f32x4 q4 = *(const LAS f32x4*)(qp + i);
#pragma unroll
                    for (int j = 0; j < 4; ++j) { S[i + j] = av * S[i + j] + kr[i + j] * coef; o += q4[j] * S[i + j]; }
                }
                o += __shfl_xor(o, 16); o += __shfl_xor(o, 32);
                if (rg == 0) { const int step = c0 + tt, row = row0 + (dir ? (L - 1 - step) : step); O[(size_t)row * 768 + h * 128 + col] = o; }
            }
        }
        if (!lat) {
            float* so = a.out + (size_t)M * D + ((((size_t)seq * 2 + e) * 2 + dir) * NH + h) * 128 * 128;
#pragma unroll
            for (int i = 0; i < 32; ++i) so[(size_t)(rg * 32 + i) * 128 + col] = S[i];
        }
    }
}

__device__ __forceinline__ void phase_dn_fin(Frame& F, int e) {
    const CAS Args& a = *F.a;
    const float* P = (const float*)(a.ws + WS_P);
    const float* OF = (const float*)(a.ws + WS_OF); const float* OB = (const float*)(a.ws + WS_OB);
    bf16* Y = (bf16*)(a.ws + WS_Y);
    const float* nw = a.in[I_DNNW] + e * 128;
    const int gw = F.vcu * 8 + F.wave, NGW = F.G * 8;
    for (int it = gw; it < M * NH; it += NGW) {
        const int row = it / NH, h = it % NH, c2 = F.lane * 2;
        const size_t o = (size_t)row * 768 + h * 128 + c2;
        const f32x2 v = *(const f32x2*)(OF + o) + *(const f32x2*)(OB + o);
        const float ms = wave_sum(v[0] * v[0] + v[1] * v[1]) * (1.f / 128.f);
        const float rs = 1.0f / sqrtf(ms + EPS);
        const f32x2 z = *(const f32x2*)(P + (size_t)row * LDP + 2560 + h * 128 + c2);
        const f32x2 w = *(const f32x2*)(nw + c2);
        *(unsigned*)(Y + (size_t)row * D + 256 + h * 128 + c2) = pk2(v[0] * rs * w[0] * silu_f(z[0]), v[1] * rs * w[1] * silu_f(z[1]));
    }
}

__device__ __forceinline__ void phase_odd_a(Frame& F, int j) {
    const CAS Args& a = *F.a;
    const float* P = (const float*)(a.ws + WS_P);
    bf16* Y = (bf16*)(a.ws + WS_Y);
    {
        LAS float* tw = (LAS float*)(F.lds + LDS_MAIN - 1024);
        if (F.tid < 64) { tw[F.tid] = cospif((float)F.tid * (1.f / 32.f)); tw[64 + F.tid] = sinpif((float)F.tid * (1.f / 32.f)); }
        __syncthreads();
        float* ZR = (float*)(a.ws + WS_ZR); float* ZI = (float*)(a.ws + WS_ZI);
        const int gw = F.vcu * 8 + F.wave, NGW = F.G * 8;
        for (int it = gw; it < M * 4; it += NGW) {
            const int row = it >> 2, g = it & 3;
            const float x = P[(size_t)row * LDP + 1536 + g * 64 + F.lane];
            float zr = 0.f, zi = 0.f;
#pragma unroll
            for (int c = 0; c < 64; ++c) {
                const float xc = __builtin_bit_cast(float, __builtin_amdgcn_readlane(__builtin_bit_cast(int, x), c));
                const int idx = (F.lane * c) & 63;
                zr += xc * tw[idx]; zi -= xc * tw[64 + idx];
            }
            ZR[(size_t)row * 256 + g * 64 + F.lane] = zr; ZI[(size_t)row * 256 + g * 64 + F.lane] = zi;
        }
        __syncthreads();
    }
    {
        LAS float* Wl = (LAS float*)F.lds;
        LAS float* vn = Wl + 128 * 128;
        const float* nw = a.in[I_SGUN] + j * 768;
        for (int it = F.vcu; it < (M / 128) * NH; it += F.G) {
            const int ch = it / NH, h = it % NH, r0 = ch * 128;
            __syncthreads();
            for (int tt = 0; tt < 16; ++tt) {
                const int s = F.wave * 16 + tt; const float* pr = P + (size_t)(r0 + s) * LDP + 768;
                float g[12]; float sum = 0.f;
#pragma unroll
                for (int q = 0; q < 12; ++q) { g[q] = gelu_tanh(pr[q * 64 + F.lane]); sum += g[q]; }
                const float mu = wave_sum(sum) * (1.f / 768.f); float sq = 0.f;
#pragma unroll
                for (int q = 0; q < 12; ++q) { const float dd = g[q] - mu; sq += dd * dd; }
                const float rstd = 1.0f / sqrtf(wave_sum(sq) * (1.f / 768.f) + EPS);
#pragma unroll
                for (int q = 0; q < 12; ++q) if ((q >> 1) == h) { const int c = (q & 1) * 64 + F.lane; vn[s * 128 + c] = (g[q] - mu) * rstd * nw[h * 128 + c]; }
            }
            const float* Wg = a.in[I_SGUW] + ((size_t)j * NH + h) * 128 * 128;
            for (int i = F.tid; i < 128 * 32; i += 512) *(LAS f32x4*)(Wl + i * 4) = *(const f32x4*)(Wg + i * 4);
            __syncthreads();
            const int p0 = (F.tid >> 4) * 4, c0 = (F.tid & 15) * 8;
            float acc[4][8];
#pragma unroll
            for (int pp = 0; pp < 4; ++pp)
#pragma unroll
                for (int cc = 0; cc < 8; ++cc) acc[pp][cc] = 0.f;
            for (int s = 0; s < 128; ++s) {
                const f32x4 v0 = *(const LAS f32x4*)(vn + s * 128 + c0), v1 = *(const LAS f32x4*)(vn + s * 128 + c0 + 4);
#pragma unroll
                for (int pp = 0; pp < 4; ++pp) {
                    const float w = Wl[(p0 + pp) * 128 + s];
#pragma unroll
                    for (int cc = 0; cc < 4; ++cc) { acc[pp][cc] += w * v0[cc]; acc[pp][4 + cc] += w * v1[cc]; }
                }
            }
            const float* bs = a.in[I_SGUB] + ((size_t)j * NH + h) * 128;
#pragma unroll
            for (int pp = 0; pp < 4; ++pp) {
                const int row = r0 + p0 + pp; const float b = bs[p0 + pp];
                const float* ur = P + (size_t)row * LDP + h * 128 + c0;
                u32x4 o;
                o.x = pk2(gelu_tanh(ur[0]) * (acc[pp][0] + b), gelu_tanh(ur[1]) * (acc[pp][1] + b));
                o.y = pk2(gelu_tanh(ur[2]) * (acc[pp][2] + b), gelu_tanh(ur[3]) * (acc[pp][3] + b));
                o.z = pk2(gelu_tanh(ur[4]) * (acc[pp][4] + b), gelu_tanh(ur[5]) * (acc[pp][5] + b));
                o.w = pk2(gelu_tanh(ur[6]) * (acc[pp][6] + b), gelu_tanh(ur[7]) * (acc[pp][7] + b));
                *(u32x4*)(Y + (size_t)row * D + h * 128 + c0) = o;
            }
        }
        __syncthreads();
    }
}

__device__ __forceinline__ void phase_odd_b(Frame& F) {
    const CAS Args& a = *F.a;
    const float* ZR = (const float*)(a.ws + WS_ZR); const float* ZI = (const float*)(a.ws + WS_ZI); float* SP = (float*)(a.ws + WS_SPEC);
    LAS float* twc = (LAS float*)F.lds;
    LAS float* tws = twc + 1024;
    LAS float* red = tws + 1024;
    constexpr int LAT_ITEMS = LAT_B * (LAT_L / 8), CTX_ITEMS = CTX_B * (CTX_L / 8);
    int curN = 0;
    for (int it = F.vcu; it < LAT_ITEMS + CTX_ITEMS; it += F.G) {
        int row0, N, k0;
        if (it < LAT_ITEMS) { N = LAT_L; row0 = NCTX + (it / (LAT_L / 8)) * LAT_L; k0 = (it % (LAT_L / 8)) * 8; }
        else { const int q = it - LAT_ITEMS; N = CTX_L; row0 = (q / (CTX_L / 8)) * CTX_L; k0 = (q % (CTX_L / 8)) * 8; }
        __syncthreads();
        if (N != curN) {
            for (int i = F.tid; i < N; i += 512) { const float x = 2.0f * (float)i / (float)N; twc[i] = cospif(x); tws[i] = sinpif(x); }
            curN = N;
        }
        __syncthreads();
        const int col = F.tid & 255, nh = F.tid >> 8, nb = nh * (N / 2);
        float acc[8];
#pragma unroll
        for (int q = 0; q < 8; ++q) acc[q] = 0.f;
        for (int n = nb; n < nb + N / 2; ++n) {
            const float zr = ZR[(size_t)(row0 + n) * 256 + col], zi = ZI[(size_t)(row0 + n) * 256 + col];
#pragma unroll
            for (int q = 0; q < 8; ++q) { const int idx = ((k0 + q) * n) & (N - 1); acc[q] += twc[idx] * zr + tws[idx] * zi; }
        }
        if (nh == 1) {
#pragma unroll
            for (int q = 0; q < 8; ++q) red[col * 8 + q] = acc[q];
        }
        __syncthreads();
        if (nh == 0) {
            const float sc = 1.0f / sqrtf(64.0f * (float)N);
#pragma unroll
            for (int q = 0; q < 8; ++q) SP[(size_t)(row0 + k0 + q) * 256 + col] = (acc[q] + red[col * 8 + q]) * sc;
        }
    }
    __syncthreads();
}

__device__ __forceinline__ void phase_odd_c(Frame& F, int j) {
    const CAS Args& a = *F.a;
    const float* SP = (const float*)(a.ws + WS_SPEC); bf16* Y = (bf16*)(a.ws + WS_Y);
    const float* fw = a.in[I_FNETW] + (size_t)j * 4 * 4096;
    const int gw = F.vcu * 8 + F.wave, NGW = F.G * 8;
    for (int it = gw; it < M * 4; it += NGW) {
        const int row = it >> 2, g = it & 3;
        const float d = SP[(size_t)row * 256 + g * 64 + F.lane];
        const float y = wave_matvec64(d, fw + g * 4096, F.lane);
        Y[(size_t)row * D + 768 + g * 64 + F.lane] = (bf16)f2bf(y);
    }
}

constexpr int STEPS = 12, N_PHASES = 1 + DEPTH * STEPS + 1;
__device__ __forceinline__ void run_phase(Frame& F, int ph) {
    const CAS Args& a = *F.a; unsigned char* ws = a.ws;
    if (ph == 0) { phase_setup(F); return; }
    if (ph == N_PHASES - 1) { phase_final(F); return; }
    const int l = (ph - 1) / STEPS, st = (ph - 1) % STEPS, e = l >> 1;
    const bf16* HN = (const bf16*)(ws + WS_HN); bf16* HH = (bf16*)(ws + WS_HH); float* X = (float*)(ws + WS_X); float* P = (float*)(ws + WS_P);
    const bf16* Y = (const bf16*)(ws + WS_Y); const float* mod = (const float*)(ws + WS_MOD);
    switch (st) {
        case 0: phase_norm(F, l, 0); break;
        case 1: { EpiUp E{HH}; gemm_phase<11, EpiUp>(F, HN, (const bf16*)(ws + WS_WUP + (size_t)(l * 2) * WUP_SZ), D, NUP, E); } break;
        case 2: { EpiRes E{X, mod, l, 2, 0.5f}; gemm_phase<4, EpiRes>(F, HH, (const bf16*)(ws + WS_WDN + (size_t)(l * 2) * WDN_SZ), FF, D, E); } break;
        case 3: phase_norm(F, l, 1); break;
        case 4: { EpiStore E{P, LDP};
                  if ((l & 1) == 0) gemm_phase<7, EpiStore>(F, HN, (const bf16*)(ws + WS_EVIN + (size_t)e * EVIN_SZ), D, P_EVEN_PAD, E);
                  else gemm_phase<7, EpiStore>(F, HN, (const bf16*)(ws + WS_ODIN + (size_t)e * ODIN_SZ), D, P_ODD, E); } break;
        case 5: if ((l & 1) == 0) phase_even_pre(F, e); else phase_odd_a(F, e); break;
        case 6: if ((l & 1) == 0) phase_dn_scan(F, e); else phase_odd_b(F); break;
        case 7: if ((l & 1) == 0) phase_dn_fin(F, e); else phase_odd_c(F, e); break;
        case 8: { EpiRes E{X, mod, l, 5, 1.0f}; gemm_phase<4, EpiRes>(F, Y, (const bf16*)(ws + ((l & 1) ? WS_ODOUT : WS_EVOUT) + (size_t)e * SQ_SZ), D, D, E); } break;
        case 9: phase_norm(F, l, 2); break;
        case 10: { EpiUp E{HH}; gemm_phase<11, EpiUp>(F, HN, (const bf16*)(ws + WS_WUP + (size_t)(l * 2 + 1) * WUP_SZ), D, NUP, E); } break;
        case 11: { EpiRes E{X, mod, l, 8, 0.5f}; gemm_phase<4, EpiRes>(F, HH, (const bf16*)(ws + WS_WDN + (size_t)(l * 2 + 1) * WDN_SZ), FF, D, E); } break;
    }
}

__global__ void __launch_bounds__(512, 2) mk_fwd(Args args) {
    extern __shared__ __attribute__((aligned(16))) unsigned char lds_raw[];
    Frame F;
    F.lds = (LAS unsigned char*)lds_raw;
    F.tid = threadIdx.x; F.lane = F.tid & 63; F.wave = __builtin_amdgcn_readfirstlane(F.tid >> 6);
    F.G = gridDim.x; { const int bx = blockIdx.x; F.vcu = (F.G % 8 == 0) ? (bx % 8) * (F.G / 8) + bx / 8 : bx; }
    const CAS Args* ap = (const CAS Args*)__builtin_amdgcn_kernarg_segment_ptr();
    F.a = ap;
    const int ph_lo = ap->ph_lo, ph_hi = ap->ph_hi;
    unsigned char* ws0 = ap->ws;
    volatile LAS unsigned* MISC = (volatile LAS unsigned*)(F.lds + LDS_MISC);
    if (F.tid < 64) MISC[F.tid] = 0u;
    __syncthreads();
    const bool multi = (ph_hi - ph_lo) > 1;
    XcdBarrier bar; bar.bar = (unsigned*)(ws0 + WS_CTL) + CW_BAR; bar.x = 0; bar.st = MISC + 8;
    if (multi) bar = xcd_barrier_post((unsigned*)(ws0 + WS_CTL) + CW_BAR, MISC + 8);
    for (int ph = ph_lo; ph < ph_hi; ++ph) {
        { const CAS Args* a2 = ap; asm volatile("" : "+s"(a2)); F.a = a2; }
        { int t_ = threadIdx.x; asm volatile("" : "+v"(t_)); F.tid = t_; F.lane = t_ & 63; F.wave = __builtin_amdgcn_readfirstlane(t_ >> 6); }
        run_phase(F, ph);
        if (ph + 1 < ph_hi) xcd_barrier(bar);
    }
}

extern "C" void kernel_launch(void* const* d_in, const int* in_sizes, int n_in, void* d_out, int out_size, void* d_ws, size_t ws_size, hipStream_t stream) {
    static int grid = 0;
    if (grid == 0) {
        if (n_in != 31 || ws_size < WS_END) { fprintf(stderr, "kernel_launch: unexpected n_in %d or ws_size %zu (need %zu)\n", n_in, ws_size, (size_t)WS_END); grid = -1; return; }
        int dev = 0, cus = 0;
        if (hipGetDevice(&dev) != hipSuccess || hipDeviceGetAttribute(&cus, hipDeviceAttributeMultiprocessorCount, dev) != hipSuccess) { grid = -1; return; }
        if (hipFuncSetAttribute((const void*)mk_fwd, hipFuncAttributeMaxDynamicSharedMemorySize, LDS_BYTES) != hipSuccess) { fprintf(stderr, "kernel_launch: hipFuncSetAttribute failed\n"); grid = -1; return; }
        (void)hipGetLastError();
        grid = cus;
    }
    if (grid < 0) return;
    (void)hipMemsetAsync((char*)d_ws + WS_CTL, 0, CTL_BYTES, stream);
    Args a{};
    for (int i = 0; i < 31; ++i) a.in[i] = (const float*)d_in[i];
    a.out = (float*)d_out; a.ws = (unsigned char*)d_ws;
#if ONE_LAUNCH
    a.ph_lo = 0; a.ph_hi = N_PHASES;
    hipLaunchKernelGGL(mk_fwd, dim3(grid), dim3(512), LDS_BYTES, stream, a);
#else
    for (int ph = 0; ph < N_PHASES; ++ph) {
        a.ph_lo = ph; a.ph_hi = ph + 1;
        hipLaunchKernelGGL(mk_fwd, dim3(grid), dim3(512), LDS_BYTES, stream, a);
    }
#endif
}
```

```cpp
#include <hip/hip_runtime.h>
#include <cstdio>
#include <cstdint>

#ifndef ONE_LAUNCH
#define ONE_LAUNCH 1
#endif

#define GAS __attribute__((address_space(1)))
#define LAS __attribute__((address_space(3)))
#define CAS __attribute__((address_space(4)))
typedef unsigned short bf16;
typedef float f32x4 __attribute__((ext_vector_type(4)));
typedef float f32x2 __attribute__((ext_vector_type(2)));
typedef short bf16x8 __attribute__((ext_vector_type(8)));
typedef unsigned u32x4 __attribute__((ext_vector_type(4)));
typedef unsigned u32x2 __attribute__((ext_vector_type(2)));

constexpr int D = 1024, NCTX = 4096, NLAT = 2048, M = 6144, FF = 2816, DEPTH = 4;
constexpr int CTX_B = 16, CTX_L = 256, LAT_B = 2, LAT_L = 1024;
constexpr int NUP = 2 * FF;
constexpr int P_EVEN = 3352, P_EVEN_PAD = 3584, P_ODD = 1792;
constexpr int LDP = 3584;
constexpr int NH = 6, DK = 128;
constexpr float EPS = 1e-6f;
constexpr int NSEQ = CTX_B + LAT_B;

constexpr size_t MiB = 1u << 20;
constexpr size_t WS_CTL = 0, CTL_BYTES = 1 * MiB;
constexpr size_t WS_MOD = 1 * MiB;
constexpr size_t WS_WUP = 2 * MiB, WUP_SZ = 11 * MiB;
constexpr size_t WS_WDN = 90 * MiB, WDN_SZ = 5632 * 1024;
constexpr size_t WS_EVIN = 134 * MiB, EVIN_SZ = 7 * MiB;
constexpr size_t WS_EVOUT = 148 * MiB, SQ_SZ = 2 * MiB;
constexpr size_t WS_ODIN = 152 * MiB, ODIN_SZ = 4 * MiB;
constexpr size_t WS_ODOUT = 160 * MiB;
constexpr size_t WS_X = 164 * MiB;
constexpr size_t WS_HN = 188 * MiB;
constexpr size_t WS_HH = 200 * MiB;
constexpr size_t WS_P = 233 * MiB;
constexpr size_t WS_Y = 317 * MiB;
constexpr size_t WS_QN = 329 * MiB, WS_KN = 347 * MiB, WS_VV = 365 * MiB, WS_OF = 383 * MiB, WS_OB = 401 * MiB;
constexpr size_t WS_AG = 419 * MiB, WS_BT = 420 * MiB;
constexpr size_t WS_ZR = 421 * MiB, WS_ZI = 427 * MiB, WS_SPEC = 433 * MiB;
constexpr size_t WS_END = 439 * MiB;

constexpr int CW_BAR = 4096;

constexpr int LDS_MAIN = 139264;
constexpr int LDS_MISC = LDS_MAIN;
constexpr int LDS_BYTES = LDS_MAIN + 1024;

__device__ __forceinline__ float wave_sum(float v) {
#pragma unroll
    for (int o = 1; o < 64; o <<= 1) v += __shfl_xor(v, o);
    return v;
}
__device__ __forceinline__ unsigned f2bf(float f) { unsigned u = __builtin_bit_cast(unsigned, f); return (u + 0x7fffu + ((u >> 16) & 1u)) >> 16; }
__device__ __forceinline__ unsigned pk2(float lo, float hi) { return f2bf(lo) | (f2bf(hi) << 16); }
__device__ __forceinline__ float silu_f(float x) { return x / (1.f + __expf(-x)); }
__device__ __forceinline__ float sigmoid_f(float x) { return 1.f / (1.f + __expf(-x)); }
__device__ __forceinline__ float gelu_tanh(float x) { const float u = 0.7978845608028654f * (x + 0.044715f * x * x * x); return 0.5f * x * (1.f + tanhf(u)); }
__device__ __forceinline__ float softplus_f(float x) { return x > 20.f ? x : log1pf(expf(x)); }
__device__ __forceinline__ int cond_of_row(int r) { return r < NCTX ? 0 : (r < NCTX + LAT_L ? 1 : 2); }
__device__ __forceinline__ void seq_of_row(int r, int& s0, int& L) { if (r < NCTX) { s0 = r & ~(CTX_L - 1); L = CTX_L; } else { s0 = NCTX + ((r - NCTX) & ~(LAT_L - 1)); L = LAT_L; } }

#define XB_TMO      128
#define XB_XCNT(j)  (256  + 64 * (j))
#define XB_XSUB(j)  (1280 + 64 * (j))
#define XB_XGEN(j)  (2304 + 64 * (j))
#define XB_TOP      3328
#define XB_TOPGEN   3392
#define XCD_BAR_WORDS 3456
#define XB_SPIN_CAP (1u << 18)
__device__ __forceinline__ unsigned xb_ld(unsigned* p)              { return __hip_atomic_load(p, __ATOMIC_RELAXED, __HIP_MEMORY_SCOPE_AGENT); }
__device__ __forceinline__ unsigned xb_add(unsigned* p, unsigned v) { return __hip_atomic_fetch_add(p, v, __ATOMIC_RELAXED, __HIP_MEMORY_SCOPE_AGENT); }
__device__ __forceinline__ unsigned xb_xcc_id() { return (unsigned)__builtin_amdgcn_s_getreg((3 << 11) | 20) & 0xFu; }
#define XB_SPIN(cond, bar) do { unsigned _sp = 0; while (cond) { __builtin_amdgcn_s_sleep(1); \
    if ((++_sp & 255u) == 0u) { if (xb_ld(&(bar)[XB_TMO])) break; if (_sp > XB_SPIN_CAP) { atomicAdd(&(bar)[XB_TMO], 1u); break; } } } } while (0)
struct XcdBarrier { unsigned* bar; unsigned x; volatile LAS unsigned* st; };
__device__ __forceinline__ XcdBarrier xcd_barrier_post(unsigned* bar, volatile LAS unsigned* st) {
    XcdBarrier b; b.bar = bar; b.x = xb_xcc_id(); b.st = st;
    if (threadIdx.x == 0) (void)xb_add(&bar[XB_XCNT(b.x)], 1u);
    return b;
}
__device__ __forceinline__ void xcd_barrier_complete(unsigned* bar, unsigned x, unsigned& nloc, unsigned& nx) {
    const unsigned G = gridDim.x * gridDim.y * gridDim.z;
    unsigned sum, cnt, mine, sp = 0u;
    for (;;) {
        sum = 0u; cnt = 0u; mine = 0u;
#pragma unroll
        for (unsigned j = 0; j < 16; ++j) { const unsigned c = xb_ld(&bar[XB_XCNT(j)]); sum += c; cnt += (c > 0u) ? 1u : 0u; mine = (j == x) ? c : mine; }
        if (sum == G) break;
        __builtin_amdgcn_s_sleep(1);
        if ((++sp & 255u) == 0u) { if (xb_ld(&bar[XB_TMO])) break; if (sp > XB_SPIN_CAP) { atomicAdd(&bar[XB_TMO], 1u); break; } }
    }
    nloc = mine > 0u ? mine : 1u; nx = cnt > 0u ? cnt : 1u;
}
__device__ __forceinline__ void xcd_barrier(const XcdBarrier& b) {
    asm volatile("s_waitcnt vmcnt(0)" ::: "memory");
    __syncthreads();
    if (threadIdx.x == 0) {
        unsigned* bar = b.bar;
        __builtin_amdgcn_s_waitcnt(0);
        unsigned nloc = b.st[0], nx = b.st[1];
        if (nloc == 0u) { xcd_barrier_complete(bar, b.x, nloc, nx); b.st[0] = nloc; b.st[1] = nx; }
        const unsigned old = xb_add(&bar[XB_XSUB(b.x)], 1u);
        const unsigned gen = old / nloc;
        if (old + 1u == (gen + 1u) * nloc) {
            __builtin_amdgcn_fence(__ATOMIC_RELEASE, "agent");
            asm volatile("s_waitcnt vmcnt(0)" ::: "memory");
            const unsigned og = xb_add(&bar[XB_TOP], 1u);
            const unsigned tg = og / nx;
            if (og + 1u == (tg + 1u) * nx) xb_add(&bar[XB_TOPGEN], 1u);
            else XB_SPIN(xb_ld(&bar[XB_TOPGEN]) == tg, bar);
            __builtin_amdgcn_fence(__ATOMIC_ACQUIRE, "agent");
            xb_add(&bar[XB_XGEN(b.x)], 1u);
            asm volatile("s_waitcnt vmcnt(0)" ::: "memory");
        } else {
            XB_SPIN(xb_ld(&bar[XB_XGEN(b.x)]) == gen, bar);
            __builtin_amdgcn_fence(__ATOMIC_ACQUIRE, "agent");
            asm volatile("s_waitcnt vmcnt(0)" ::: "memory");
        }
    }
    __syncthreads();
}

struct Args { const float* in[31]; float* out; unsigned char* ws; int ph_lo, ph_hi; };
enum { I_XP = 0, I_XS, I_STATE, I_C, I_CCTX, I_F1N, I_F1G, I_F1U, I_F1D, I_MIXN, I_F2N, I_F2G, I_F2U, I_F2D, I_ADAW, I_ADAB, I_EVIN, I_EVOUT,
       I_POOLW, I_POOLS, I_CONVW, I_ALOG, I_DTB, I_DNNW, I_ODIN, I_ODOUT, I_SGUN, I_SGUW, I_SGUB, I_FNETW, I_FINN };

struct Frame {
    LAS unsigned char* lds;
    int tid, lane, wave, vcu, G;
    const CAS Args* a;
};

template <int NFRAG, class Epi>
__device__ __forceinline__ void gemm_tile(LAS unsigned char* lds, const int tid, const bf16* A, const bf16* Bt, int K, int row0, int col0, const Epi& E) {
    constexpr int BN = 32 * NFRAG, NPB = BN / 8, A_BYTES = 192 * 128, B_BYTES = BN * 128, STAGE = A_BYTES + B_BYTES, NBI = (NPB + 7) / 8;
    static_assert(2 * STAGE <= LDS_MAIN, "LDS");
    const int lane = tid & 63, wid = __builtin_amdgcn_readfirstlane(tid >> 6), wm = wid >> 1, wn = wid & 1, fr = lane & 15, fq = lane >> 4;
    const int r = lane >> 3, slot = lane & 7;
    const int srow = wid * 8 + r;
    const int chunk = slot ^ ((srow >> 1) & 7);
    const char* gA = (const char*)(A + (size_t)(row0 + srow) * K) + chunk * 16;
    const char* gB = (const char*)(Bt + (size_t)(col0 + srow) * K) + chunk * 16;
    const size_t pstep = (size_t)64 * K * 2;
    const int nt = K / 64;
    const int rowA0 = wm * 48 + fr, rowB0 = wn * NFRAG * 16 + fr;
    int offA[2], offB[2];
#pragma unroll
    for (int kk = 0; kk < 2; ++kk) {
        offA[kk] = rowA0 * 128 + (((kk * 4 + fq) ^ ((rowA0 >> 1) & 7)) << 4);
        offB[kk] = A_BYTES + rowB0 * 128 + (((kk * 4 + fq) ^ ((rowB0 >> 1) & 7)) << 4);
    }
    f32x4 acc[3][NFRAG];
#pragma unroll
    for (int i = 0; i < 3; ++i)
#pragma unroll
        for (int j = 0; j < NFRAG; ++j) acc[i][j] = (f32x4){0.f, 0.f, 0.f, 0.f};

#define GEMM_STAGE(buf, t) do { LAS unsigned char* sA_ = lds + (buf) * STAGE + wid * 1024; \
        _Pragma("unroll") for (int i_ = 0; i_ < 3; ++i_) \
            __builtin_amdgcn_global_load_lds((const unsigned*)(gA + i_ * pstep + (size_t)(t) * 128), (LAS unsigned*)(sA_ + i_ * 8192), 16, 0, 0); \
        _Pragma("unroll") for (int i_ = 0; i_ < NBI; ++i_) if (wid + 8 * i_ < NPB) \
            __builtin_amdgcn_global_load_lds((const unsigned*)(gB + i_ * pstep + (size_t)(t) * 128), (LAS unsigned*)(sA_ + A_BYTES + i_ * 8192), 16, 0, 0); } while (0)

    GEMM_STAGE(0, 0);
    for (int t = 0; t < nt; ++t) {
        asm volatile("s_waitcnt vmcnt(0)" ::: "memory");
        __syncthreads();
        if (t + 1 < nt) GEMM_STAGE((t + 1) & 1, t + 1);
        LAS unsigned char* sb = lds + (t & 1) * STAGE;
#pragma unroll
        for (int kk = 0; kk < 2; ++kk) {
            bf16x8 af[3];
#pragma unroll
            for (int mf = 0; mf < 3; ++mf) af[mf] = *(const LAS bf16x8*)(sb + offA[kk] + mf * 2048);
#pragma unroll
            for (int nf = 0; nf < NFRAG; ++nf) {
                const bf16x8 bfr = *(const LAS bf16x8*)(sb + offB[kk] + nf * 2048);
#pragma unroll
                for (int mf = 0; mf < 3; ++mf) acc[mf][nf] = __builtin_amdgcn_mfma_f32_16x16x32_bf16(bfr, af[mf], acc[mf][nf], 0, 0, 0);
            }
        }
    }
#undef GEMM_STAGE
    E(acc, row0 + wm * 48 + fr, col0 + wn * NFRAG * 16 + fq * 4, fq);
    __syncthreads();
}

struct EpiUp {
    bf16* H;
    template <int NFRAG> __device__ __forceinline__ void operator()(f32x4 (&acc)[3][NFRAG], int row, int colq, int fq) const {
#pragma unroll
        for (int mf = 0; mf < 3; ++mf)
#pragma unroll
            for (int nf = 0; nf < NFRAG; ++nf) {
                f32x4 v = acc[mf][nf], o;
                o[0] = __shfl_xor(v[0], 16); o[1] = __shfl_xor(v[1], 16); o[2] = __shfl_xor(v[2], 16); o[3] = __shfl_xor(v[3], 16);
                if ((fq & 1) == 0) {
                    const int c = colq + nf * 16;
                    const int hid = (c >> 3) * 4;
                    u32x2 w; w.x = pk2(silu_f(v[0]) * o[0], silu_f(v[1]) * o[1]); w.y = pk2(silu_f(v[2]) * o[2], silu_f(v[3]) * o[3]);
                    *(u32x2*)(H + (size_t)(row + mf * 16) * FF + hid) = w;
                }
            }
    }
};
struct EpiRes {
    float* X; const float* mod; int layer, gidx; float scale;
    template <int NFRAG> __device__ __forceinline__ void operator()(f32x4 (&acc)[3][NFRAG], int row, int colq, int) const {
#pragma unroll
        for (int mf = 0; mf < 3; ++mf) {
            const int rr = row + mf * 16;
            const float* g = mod + ((size_t)(layer * 3 + cond_of_row(rr)) * 9 + gidx) * 1024;
#pragma unroll
            for (int nf = 0; nf < NFRAG; ++nf) {
                const int c = colq + nf * 16;
                const f32x4 gv = *(const f32x4*)(g + c);
                f32x4* xp = (f32x4*)(X + (size_t)rr * D + c);
                f32x4 xv = *xp;
                xv += acc[mf][nf] * gv * scale;
                *xp = xv;
            }
        }
    }
};
struct EpiStore {
    float* P; int ld;
    template <int NFRAG> __device__ __forceinline__ void operator()(f32x4 (&acc)[3][NFRAG], int row, int colq, int) const {
#pragma unroll
        for (int mf = 0; mf < 3; ++mf)
#pragma unroll
            for (int nf = 0; nf < NFRAG; ++nf) *(f32x4*)(P + (size_t)(row + mf * 16) * ld + colq + nf * 16) = acc[mf][nf];
    }
};

template <int NFRAG, class Epi>
__device__ __forceinline__ void gemm_phase(Frame& F, const bf16* A, const bf16* Bt, int K, int N, const Epi& E) {
    constexpr int BN = 32 * NFRAG;
    const int NT = N / BN, nitems = 32 * NT;
    for (int i = F.vcu; i < nitems; i += F.G) {
        const int panel = (i >> 3) & 31, ct = (i & 7) + 8 * (i >> 8);
        gemm_tile<NFRAG, Epi>(F.lds, F.tid, A, Bt, K, panel * 192, ct * BN, E);
    }
}

__device__ __forceinline__ void transpose_item(const float* W, int K, int N, bf16* WT, int mode, LAS float* scr, int item, int lane) {
    const int nblk = (N + 31) / 32, kb = item / nblk, nb = item % nblk, k0 = 64 * kb, n0 = 32 * nb;
    const int nn = n0 + (lane & 31);
#pragma unroll 8
    for (int i = 0; i < 32; ++i) { const int kk = 2 * i + (lane >> 5); scr[kk * 33 + (lane & 31)] = (nn < N) ? W[(size_t)(k0 + kk) * N + nn] : 0.f; }
    asm volatile("s_waitcnt lgkmcnt(0)" ::: "memory");
    const int c = lane & 7;
#pragma unroll
    for (int j = 0; j < 4; ++j) {
        const int nl = (lane >> 3) + 8 * j, n = n0 + nl; const LAS float* s = scr + (8 * c) * 33 + nl;
        u32x4 o; o.x = pk2(s[0 * 33], s[1 * 33]); o.y = pk2(s[2 * 33], s[3 * 33]); o.z = pk2(s[4 * 33], s[5 * 33]); o.w = pk2(s[6 * 33], s[7 * 33]);
        const int dr = (mode == 0) ? n : ((n >> 2) * 8 + (n & 3) + (mode == 2 ? 4 : 0));
        if (n < N) *(u32x4*)(WT + (size_t)dr * K + k0 + 8 * c) = o;
    }
    asm volatile("s_waitcnt lgkmcnt(0)" ::: "memory");
}

__device__ __forceinline__ void phase_setup(Frame& F) {
    const CAS Args& a = *F.a;
    unsigned char* ws = a.ws;
    {
        LAS float* sc = (LAS float*)F.lds;
        LAS float* red = sc + 3 * 1024;
        for (int i = F.tid; i < 3 * 1024; i += 512) { const int c = i >> 10, k = i & 1023; const float v = (c == 0) ? a.in[I_CCTX][k] : a.in[I_C][(c - 1) * 1024 + k]; sc[i] = silu_f(v); }
        __syncthreads();
        float* mod = (float*)(ws + WS_MOD);
        for (int it = F.vcu; it < 4 * 72; it += F.G) {
            const int l = it / 72, cb = it % 72, q = F.tid & 31, kg = F.tid >> 5;
            const float* W = a.in[I_ADAW] + (size_t)l * 1024 * 9216 + cb * 128 + q * 4;
            f32x4 s0 = {0, 0, 0, 0}, s1 = s0, s2 = s0;
#pragma unroll 4
            for (int k = kg * 64; k < kg * 64 + 64; ++k) {
                const f32x4 w = *(const f32x4*)(W + (size_t)k * 9216);
                s0 += w * sc[k]; s1 += w * sc[1024 + k]; s2 += w * sc[2048 + k];
            }
            LAS float* rp = red + (kg * 32 + q) * 12;
#pragma unroll
            for (int j = 0; j < 4; ++j) { rp[j] = s0[j]; rp[4 + j] = s1[j]; rp[8 + j] = s2[j]; }
            __syncthreads();
            if (F.tid < 384) {
                const int qq = F.tid / 12, v = F.tid % 12; float s = 0.f;
#pragma unroll
                for (int g = 0; g < 16; ++g) s += red[(g * 32 + qq) * 12 + v];
                const int c = v >> 2, j = v & 3, n = cb * 128 + qq * 4 + j;
                mod[(size_t)(l * 3 + c) * 9216 + n] = s + a.in[I_ADAB][l * 9216 + n];
            }
            __syncthreads();
        }
        __syncthreads();
    }
    {
        LAS float* scr = (LAS float*)(F.lds + F.wave * 16384);
        const int gw = F.vcu * 8 + F.wave, NGW = F.G * 8;
        constexpr int IT_G = 16 * 88, IT_D = 44 * 32, IT_EVIN = 16 * 105, IT_SQ = 16 * 32, IT_ODIN = 16 * 56;
        static_assert(IT_G == IT_D, "decode");
        constexpr int PER_FFN = 2 * IT_G + IT_D;
        constexpr int TOT = 8 * PER_FFN + 2 * (IT_EVIN + IT_SQ + IT_ODIN + IT_SQ);
        for (int it = gw; it < TOT; it += NGW) {
            int r = it; const float* W; bf16* WT; int K, N, mode;
            if (r < 8 * PER_FFN) {
                const int f = r / PER_FFN, l = f >> 1, s = f & 1; r -= f * PER_FFN;
                const int sub = r / IT_G; r -= sub * IT_G;
                const int idx = (sub == 0) ? (s ? I_F2G : I_F1G) : ((sub == 1) ? (s ? I_F2U : I_F1U) : (s ? I_F2D : I_F1D));
                W = a.in[idx] + (size_t)l * D * FF;
                WT = (sub == 2) ? (bf16*)(ws + WS_WDN + (size_t)f * WDN_SZ) : (bf16*)(ws + WS_WUP + (size_t)f * WUP_SZ);
                K = (sub == 2) ? FF : D; N = (sub == 2) ? D : FF; mode = (sub == 2) ? 0 : sub + 1;
            } else {
                r -= 8 * PER_FFN;
                constexpr int PER_E = IT_EVIN + IT_SQ + IT_ODIN + IT_SQ;
                const int e = r / PER_E; r -= e * PER_E;
                K = D; mode = 0;
                if (r < IT_EVIN) { W = a.in[I_EVIN] + (size_t)e * D * P_EVEN; N = P_EVEN; WT = (bf16*)(ws + WS_EVIN + (size_t)e * EVIN_SZ); }
                else if (r < IT_EVIN + IT_SQ) { r -= IT_EVIN; W = a.in[I_EVOUT] + (size_t)e * D * D; N = D; WT = (bf16*)(ws + WS_EVOUT + (size_t)e * SQ_SZ); }
                else if (r < IT_EVIN + IT_SQ + IT_ODIN) { r -= IT_EVIN + IT_SQ; W = a.in[I_ODIN] + (size_t)e * D * P_ODD; N = P_ODD; WT = (bf16*)(ws + WS_ODIN + (size_t)e * ODIN_SZ); }
                else { r -= IT_EVIN + IT_SQ + IT_ODIN; W = a.in[I_ODOUT] + (size_t)e * D * D; N = D; WT = (bf16*)(ws + WS_ODOUT + (size_t)e * SQ_SZ); }
            }
            transpose_item(W, K, N, WT, mode, scr, r, F.lane);
        }
        for (int it = gw; it < 2 * (P_EVEN_PAD - P_EVEN); it += NGW) {
            const int e = it / (P_EVEN_PAD - P_EVEN), rr = P_EVEN + it % (P_EVEN_PAD - P_EVEN);
            u32x4* p = (u32x4*)((bf16*)(ws + WS_EVIN + (size_t)e * EVIN_SZ) + (size_t)rr * D);
            p[F.lane] = (u32x4){0, 0, 0, 0}; p[64 + F.lane] = (u32x4){0, 0, 0, 0};
        }
        float* X = (float*)(ws + WS_X);
        for (int row = gw; row < M; row += NGW) {
            float* xo = X + (size_t)row * D;
            if (row < NCTX) {
                const f32x4* src = (const f32x4*)(a.in[I_XP] + (size_t)row * D);
#pragma unroll
                for (int j = 0; j < 4; ++j) ((f32x4*)xo)[j * 64 + F.lane] = src[j * 64 + F.lane];
            } else {
                const int t = (row - NCTX) & (LAT_L - 1); const float pr = (float)(t >> 6), pc = (float)(t & 63);
                const float* src = a.in[I_XS] + (size_t)(row - NCTX) * D;
#pragma unroll
                for (int j = 0; j < 16; ++j) {
                    const int ch = j * 64 + F.lane, seg = ch >> 8, i = ch & 255;
                    const float freq = expf(-9.210340371976184f * (float)i * (1.0f / 256.0f));
                    const float ang = ((seg < 2) ? pr : pc) * freq;
                    const float pe = (seg & 1) ? cosf(ang) : sinf(ang);
                    xo[ch] = src[ch] + pe;
                }
            }
        }
    }
}

__device__ __forceinline__ void phase_norm(Frame& F, int layer, int which) {
    const CAS Args& a = *F.a;
    const float* X = (const float*)(a.ws + WS_X); bf16* HN = (bf16*)(a.ws + WS_HN);
    const float* mod = (const float*)(a.ws + WS_MOD);
    const float* nw = a.in[which == 0 ? I_F1N : (which == 1 ? I_MIXN : I_F2N)] + layer * D;
    const int gw = F.vcu * 8 + F.wave, NGW = F.G * 8;
    for (int row = gw; row < M; row += NGW) {
        const f32x4* xr = (const f32x4*)(X + (size_t)row * D) + F.lane;
        f32x4 v[4]; float s = 0.f;
#pragma unroll
        for (int j = 0; j < 4; ++j) { v[j] = xr[64 * j]; s += v[j][0] * v[j][0] + v[j][1] * v[j][1] + v[j][2] * v[j][2] + v[j][3] * v[j][3]; }
        const float rstd = 1.0f / sqrtf(wave_sum(s) * (1.f / D) + EPS);
        const float* mb = mod + ((size_t)(layer * 3 + cond_of_row(row)) * 9 + which * 3) * 1024;
        u32x2* o = (u32x2*)(HN + (size_t)row * D) + F.lane;
#pragma unroll
        for (int j = 0; j < 4; ++j) {
            const int k = (64 * j + F.lane) * 4;
            const f32x4 w = *(const f32x4*)(nw + k), sh = *(const f32x4*)(mb + k), sc = *(const f32x4*)(mb + 1024 + k);
            const f32x4 h = (v[j] * rstd * w) * (sc + 1.0f) + sh;
            u32x2 pkd; pkd.x = pk2(h[0], h[1]); pkd.y = pk2(h[2], h[3]);
            o[64 * j] = pkd;
        }
    }
}

__device__ __forceinline__ void phase_final(Frame& F) {
    const CAS Args& a = *F.a;
    const float* X = (const float*)(a.ws + WS_X);
    const float* nw = a.in[I_FINN];
    const int gw = F.vcu * 8 + F.wave, NGW = F.G * 8;
    for (int row = gw; row < M; row += NGW) {
        const f32x4* xr = (const f32x4*)(X + (size_t)row * D) + F.lane;
        f32x4 v[4]; float s = 0.f;
#pragma unroll
        for (int j = 0; j < 4; ++j) { v[j] = xr[64 * j]; s += v[j][0] * v[j][0] + v[j][1] * v[j][1] + v[j][2] * v[j][2] + v[j][3] * v[j][3]; }
        const float rstd = 1.0f / sqrtf(wave_sum(s) * (1.f / D) + EPS);
        f32x4* o = (f32x4*)(a.out + (size_t)row * D) + F.lane;
#pragma unroll
        for (int j = 0; j < 4; ++j) { const f32x4 w = *(const f32x4*)(nw + (64 * j + F.lane) * 4); o[64 * j] = v[j] * rstd * w; }
    }
}

__device__ __forceinline__ float wave_matvec64(float d, const float* W, int lane) {
    float y = 0.f;
#pragma unroll
    for (int c = 0; c < 64; ++c) { const float dc = __builtin_bit_cast(float, __builtin_amdgcn_readlane(__builtin_bit_cast(int, d), c)); y += dc * W[c * 64 + lane]; }
    return y;
}

__device__ __forceinline__ void phase_even_pre(Frame& F, int e) {
    const CAS Args& a = *F.a;
    const float* P = (const float*)(a.ws + WS_P);
    float* QN = (float*)(a.ws + WS_QN); float* KN = (float*)(a.ws + WS_KN); float* VV = (float*)(a.ws + WS_VV);
    float* AG = (float*)(a.ws + WS_AG); float* BT = (float*)(a.ws + WS_BT);
    bf16* Y = (bf16*)(a.ws + WS_Y);
    const float* cw = a.in[I_CONVW] + (size_t)e * 3 * 2304;
    const int gw = F.vcu * 8 + F.wave, NGW = F.G * 8;
    for (int it = gw; it < M * NH; it += NGW) {
        const int row = it / NH, h = it % NH; int s0, L; seq_of_row(row, s0, L);
        const int t = row - s0; const bool hp = t > 0, hn = t < L - 1;
        const int c2 = F.lane * 2;
        float res[3][2];
#pragma unroll
        for (int part = 0; part < 3; ++part) {
            const int pc = 256 + part * 768 + h * 128 + c2, wc = part * 768 + h * 128 + c2;
            const f32x2 x1 = *(const f32x2*)(P + (size_t)row * LDP + pc);
            const f32x2 x0 = hp ? *(const f32x2*)(P + (size_t)(row - 1) * LDP + pc) : (f32x2){0.f, 0.f};
            const f32x2 x2 = hn ? *(const f32x2*)(P + (size_t)(row + 1) * LDP + pc) : (f32x2){0.f, 0.f};
            const f32x2 w0 = *(const f32x2*)(cw + wc), w1 = *(const f32x2*)(cw + 2304 + wc), w2 = *(const f32x2*)(cw + 4608 + wc);
            const f32x2 y = x0 * w0 + x1 * w1 + x2 * w2;
            res[part][0] = silu_f(y[0]); res[part][1] = silu_f(y[1]);
        }
        const float qs = wave_sum(res[0][0] * res[0][0] + res[0][1] * res[0][1]);
        const float ks = wave_sum(res[1][0] * res[1][0] + res[1][1] * res[1][1]);
        const float qr = (1.0f / sqrtf(qs + EPS)) * 0.08838834764831845f, kr = 1.0f / sqrtf(ks + EPS);
        const size_t o = (size_t)row * 768 + h * 128 + c2;
        *(f32x2*)(QN + o) = (f32x2){res[0][0] * qr, res[0][1] * qr};
        *(f32x2*)(KN + o) = (f32x2){res[1][0] * kr, res[1][1] * kr};
        *(f32x2*)(VV + o) = (f32x2){res[2][0], res[2][1]};
        if (F.lane < 2) {
            const int d = F.lane;
            const float braw = P[(size_t)row * LDP + 3328 + d * 6 + h], araw = P[(size_t)row * LDP + 3340 + d * 6 + h];
            const float al = a.in[I_ALOG][(e * 2 + d) * 6 + h], dtb = a.in[I_DTB][(e * 2 + d) * 6 + h];
            const float g = -expf(al) * softplus_f(araw + dtb);
            AG[(size_t)row * 12 + d * 6 + h] = expf(g);
            BT[(size_t)row * 12 + d * 6 + h] = sigmoid_f(braw);
        }
    }
    const float* pw = a.in[I_POOLW] + (size_t)e * 4 * 64 * 64; const float* ps = a.in[I_POOLS] + e * 256;
    for (int it = gw; it < M * 4; it += NGW) {
        const int row = it >> 2, g = it & 3; int s0, L; seq_of_row(row, s0, L);
        const int t = row - s0, half = 1 << g;
        const int lo = max(t - half, 0), hi = min(t + half, L);
        float sum = 0.f;
        for (int p = lo; p < hi; ++p) sum += P[(size_t)(s0 + p) * LDP + g * 64 + F.lane];
        const float d = sum / (float)(hi - lo) - P[(size_t)row * LDP + g * 64 + F.lane];
        const float y = wave_matvec64(d, pw + g * 4096, F.lane) * ps[g * 64 + F.lane];
        Y[(size_t)row * D + g * 64 + F.lane] = (bf16)f2bf(y);
    }
}

__device__ __forceinline__ void phase_dn_scan(Frame& F, int e) {
    const CAS Args& a = *F.a;
    const float* QN = (const float*)(a.ws + WS_QN); const float* KN = (const float*)(a.ws + WS_KN); const float* VV = (const float*)(a.ws + WS_VV);
    const float* AG = (const float*)(a.ws + WS_AG); const float* BT = (const float*)(a.ws + WS_BT);
    constexpr int TCH = 16;
    LAS float* sk = (LAS float*)F.lds;
    LAS float* sq = sk + TCH * 128;
    LAS float* sv = sq + TCH * 128;
    LAS float* sab = sv + TCH * 128;
    const int cl = F.lane & 15, rg = F.lane >> 4, col = F.wave * 16 + cl;
    for (int it = F.vcu; it < NSEQ * 2 * NH; it += F.G) {
        int seq, dir, h;
        if (it < LAT_B * 2 * NH) { seq = CTX_B + it / (2 * NH); dir = (it / NH) & 1; h = it % NH; }
        else { const int j = it - LAT_B * 2 * NH; seq = j / (2 * NH); dir = (j / NH) & 1; h = j % NH; }
        const bool lat = seq >= CTX_B;
        const int L = lat ? LAT_L : CTX_L, row0 = lat ? NCTX + (seq - CTX_B) * LAT_L : seq * CTX_L;
        float S[32];
        if (lat) {
            const float* s0 = a.in[I_STATE] + ((((size_t)(seq - CTX_B) * 2 + e) * 2 + dir) * NH + h) * 128 * 128;
#pragma unroll
            for (int i = 0; i < 32; ++i) S[i] = s0[(size_t)(rg * 32 + i) * 128 + col];
        } else {
#pragma unroll
            for (int i = 0; i < 32; ++i) S[i] = 0.f;
        }
        float* O = (float*)(a.ws + (dir ? WS_OB : WS_OF));
        for (int c0 = 0; c0 < L; c0 += TCH) {
            __syncthreads();
            for (int i = F.tid; i < TCH * 96; i += 512) {
                const int tt = i / 96, w = i % 96, part = w >> 5, c4 = (w & 31) * 4;
                const int step = c0 + tt, row = row0 + (dir ? (L - 1 - step) : step);
                const float* src = (part == 0 ? KN : (part == 1 ? QN : VV)) + (size_t)row * 768 + h * 128 + c4;
                LAS float* dst = (part == 0 ? sk : (part == 1 ? sq : sv)) + tt * 128 + c4;
                *(LAS f32x4*)dst = *(const f32x4*)src;
            }
            if (F.tid < TCH * 2) {
                const int tt = F.tid >> 1, w = F.tid & 1, step = c0 + tt, row = row0 + (dir ? (L - 1 - step) : step);
                sab[F.tid] = (w ? BT : AG)[(size_t)row * 12 + dir * 6 + h];
            }
            __syncthreads();
            for (int tt = 0; tt < TCH; ++tt) {
                const float av = sab[tt * 2], bv = sab[tt * 2 + 1];
                const LAS float* kp = sk + tt * 128 + rg * 32; const LAS float* qp = sq + tt * 128 + rg * 32;
                float kr[32];
#pragma unroll
                for (int i = 0; i < 32; i += 4) { const f32x4 k4 = *(const LAS f32x4*)(kp + i); kr[i] = k4[0]; kr[i + 1] = k4[1]; kr[i + 2] = k4[2]; kr[i + 3] = k4[3]; }
                float dot = 0.f;
#pragma unroll
                for (int i = 0; i < 32; ++i) dot += kr[i] * S[i];
                dot += __shfl_xor(dot, 16); dot += __shfl_xor(dot, 32);
                const float coef = bv * (sv[tt * 128 + col] - av * dot);
                float o = 0.f;
#pragma unroll
                for (int i = 0; i < 32; i += 4) {
                    const f32x4 q4 = *(const LAS f32x4*)(qp + i);
#pragma unroll
                    for (int j = 0; j < 4; ++j) { S[i + j] = av * S[i + j] + kr[i + j] * coef; o += q4[j] * S[i + j]; }
                }
                o += __shfl_xor(o, 16); o += __shfl_xor(o, 32);
                if (rg == 0) { const int step = c0 + tt, row = row0 + (dir ? (L - 1 - step) : step); O[(size_t)row * 768 + h * 128 + col] = o; }
            }
        }
        if (!lat) {
            float* so = a.out + (size_t)M * D + ((((size_t)seq * 2 + e) * 2 + dir) * NH + h) * 128 * 128;
#pragma unroll
            for (int i = 0; i < 32; ++i) so[(size_t)(rg * 32 + i) * 128 + col] = S[i];
        }
    }
}

__device__ __forceinline__ void phase_dn_fin(Frame& F, int e) {
    const CAS Args& a = *F.a;
    const float* P = (const float*)(a.ws + WS_P);
    const float* OF = (const float*)(a.ws + WS_OF); const float* OB = (const float*)(a.ws + WS_OB);
    bf16* Y = (bf16*)(a.ws + WS_Y);
    const float* nw = a.in[I_DNNW] + e * 128;
    const int gw = F.vcu * 8 + F.wave, NGW = F.G * 8;
    for (int it = gw; it < M * NH; it += NGW) {
        const int row = it / NH, h = it % NH, c2 = F.lane * 2;
        const size_t o = (size_t)row * 768 + h * 128 + c2;
        const f32x2 v = *(const f32x2*)(OF + o) + *(const f32x2*)(OB + o);
        const float ms = wave_sum(v[0] * v[0] + v[1] * v[1]) * (1.f / 128.f);
        const float rs = 1.0f / sqrtf(ms + EPS);
        const f32x2 z = *(const f32x2*)(P + (size_t)row * LDP + 2560 + h * 128 + c2);
        const f32x2 w = *(const f32x2*)(nw + c2);
        *(unsigned*)(Y + (size_t)row * D + 256 + h * 128 + c2) = pk2(v[0] * rs * w[0] * silu_f(z[0]), v[1] * rs * w[1] * silu_f(z[1]));
    }
}

__device__ __forceinline__ void phase_odd_a(Frame& F, int j) {
    const CAS Args& a = *F.a;
    const float* P = (const float*)(a.ws + WS_P);
    bf16* Y = (bf16*)(a.ws + WS_Y);
    {
        LAS float* tw = (LAS float*)(F.lds + LDS_MAIN - 1024);
        if (F.tid < 64) { tw[F.tid] = cospif((float)F.tid * (1.f / 32.f)); tw[64 + F.tid] = sinpif((float)F.tid * (1.f / 32.f)); }
        __syncthreads();
        float* ZR = (float*)(a.ws + WS_ZR); float* ZI = (float*)(a.ws + WS_ZI);
        const int gw = F.vcu * 8 + F.wave, NGW = F.G * 8;
        for (int it = gw; it < M * 4; it += NGW) {
            const int row = it >> 2, g = it & 3;
            const float x = P[(size_t)row * LDP + 1536 + g * 64 + F.lane];
            float zr = 0.f, zi = 0.f;
#pragma unroll
            for (int c = 0; c < 64; ++c) {
                const float xc = __builtin_bit_cast(float, __builtin_amdgcn_readlane(__builtin_bit_cast(int, x), c));
                const int idx = (F.lane * c) & 63;
                zr += xc * tw[idx]; zi -= xc * tw[64 + idx];
            }
            ZR[(size_t)row * 256 + g * 64 + F.lane] = zr; ZI[(size_t)row * 256 + g * 64 + F.lane] = zi;
        }
        __syncthreads();
    }
    {
        LAS float* Wl = (LAS float*)F.lds;
        LAS float* vn = Wl + 128 * 128;
        const float* nw = a.in[I_SGUN] + j * 768;
        for (int it = F.vcu; it < (M / 128) * NH; it += F.G) {
            const int ch = it / NH, h = it % NH, r0 = ch * 128;
            __syncthreads();
            for (int tt = 0; tt < 16; ++tt) {
                const int s = F.wave * 16 + tt; const float* pr = P + (size_t)(r0 + s) * LDP + 768;
                float g[12]; float sum = 0.f;
#pragma unroll
                for (int q = 0; q < 12; ++q) { g[q] = gelu_tanh(pr[q * 64 + F.lane]); sum += g[q]; }
                const float mu = wave_sum(sum) * (1.f / 768.f); float sq = 0.f;
#pragma unroll
                for (int q = 0; q < 12; ++q) { const float dd = g[q] - mu; sq += dd * dd; }
                const float rstd = 1.0f / sqrtf(wave_sum(sq) * (1.f / 768.f) + EPS);
#pragma unroll
                for (int q = 0; q < 12; ++q) if ((q >> 1) == h) { const int c = (q & 1) * 64 + F.lane; vn[s * 128 + c] = (g[q] - mu) * rstd * nw[h * 128 + c]; }
            }
            const float* Wg = a.in[I_SGUW] + ((size_t)j * NH + h) * 128 * 128;
            for (int i = F.tid; i < 128 * 32; i += 512) *(LAS f32x4*)(Wl + i * 4) = *(const f32x4*)(Wg + i * 4);
            __syncthreads();
            const int p0 = (F.tid >> 4) * 4, c0 = (F.tid & 15) * 8;
            float acc[4][8];
#pragma unroll
            for (int pp = 0; pp < 4; ++pp)
#pragma unroll
                for (int cc = 0; cc < 8; ++cc) acc[pp][cc] = 0.f;
            for (int s = 0; s < 128; ++s) {
                const f32x4 v0 = *(const LAS f32x4*)(vn + s * 128 + c0), v1 = *(const LAS f32x4*)(vn + s * 128 + c0 + 4);
#pragma unroll
                for (int pp = 0; pp < 4; ++pp) {
                    const float w = Wl[(p0 + pp) * 128 + s];
#pragma unroll
                    for (int cc = 0; cc < 4; ++cc) { acc[pp][cc] += w * v0[cc]; acc[pp][4 + cc] += w * v1[cc]; }
                }
            }
            const float* bs = a.in[I_SGUB] + ((size_t)j * NH + h) * 128;
#pragma unroll
            for (int pp = 0; pp < 4; ++pp) {
                const int row = r0 + p0 + pp; const float b = bs[p0 + pp];
                const float* ur = P + (size_t)row * LDP + h * 128 + c0;
                u32x4 o;
                o.x = pk2(gelu_tanh(ur[0]) * (acc[pp][0] + b), gelu_tanh(ur[1]) * (acc[pp][1] + b));
                o.y = pk2(gelu_tanh(ur[2]) * (acc[pp][2] + b), gelu_tanh(ur[3]) * (acc[pp][3] + b));
                o.z = pk2(gelu_tanh(ur[4]) * (acc[pp][4] + b), gelu_tanh(ur[5]) * (acc[pp][5] + b));
                o.w = pk2(gelu_tanh(ur[6]) * (acc[pp][6] + b), gelu_tanh(ur[7]) * (acc[pp][7] + b));
                *(u32x4*)(Y + (size_t)row * D + h * 128 + c0) = o;
            }
        }
        __syncthreads();
    }
}

__device__ __forceinline__ void phase_odd_b(Frame& F) {
    const CAS Args& a = *F.a;
    const float* ZR = (const float*)(a.ws + WS_ZR); const float* ZI = (const float*)(a.ws + WS_ZI); float* SP = (float*)(a.ws + WS_SPEC);
    LAS float* twc = (LAS float*)F.lds;
    LAS float* tws = twc + 1024;
    LAS float* red = tws + 1024;
    constexpr int LAT_ITEMS = LAT_B * (LAT_L / 8), CTX_ITEMS = CTX_B * (CTX_L / 8);
    int curN = 0;
    for (int it = F.vcu; it < LAT_ITEMS + CTX_ITEMS; it += F.G) {
        int row0, N, k0;
        if (it < LAT_ITEMS) { N = LAT_L; row0 = NCTX + (it / (LAT_L / 8)) * LAT_L; k0 = (it % (LAT_L / 8)) * 8; }
        else { const int q = it - LAT_ITEMS; N = CTX_L; row0 = (q / (CTX_L / 8)) * CTX_L; k0 = (q % (CTX_L / 8)) * 8; }
        __syncthreads();
        if (N != curN) {
            for (int i = F.tid; i < N; i += 512) { const float x = 2.0f * (float)i / (float)N; twc[i] = cospif(x); tws[i] = sinpif(x); }
            curN = N;
        }
        __syncthreads();
        const int col = F.tid & 255, nh = F.tid >> 8, nb = nh * (N / 2);
        float acc[8];
#pragma unroll
        for (int q = 0; q < 8; ++q) acc[q] = 0.f;
        for (int n = nb; n < nb + N / 2; ++n) {
            const float zr = ZR[(size_t)(row0 + n) * 256 + col], zi = ZI[(size_t)(row0 + n) * 256 + col];
#pragma unroll
            for (int q = 0; q < 8; ++q) { const int idx = ((k0 + q) * n) & (N - 1); acc[q] += twc[idx] * zr + tws[idx] * zi; }
        }
        if (nh == 1) {
#pragma unroll
            for (int q = 0; q < 8; ++q) red[col * 8 + q] = acc[q];
        }
        __syncthreads();
        if (nh == 0) {
            const float sc = 1.0f / sqrtf(64.0f * (float)N);
#pragma unroll
            for (int q = 0; q < 8; ++q) SP[(size_t)(row0 + k0 + q) * 256 + col] = (acc[q] + red[col * 8 + q]) * sc;
        }
    }
    __syncthreads();
}

__device__ __forceinline__ void phase_odd_c(Frame& F, int j) {
    const CAS Args& a = *F.a;
    const float* SP = (const float*)(a.ws + WS_SPEC); bf16* Y = (bf16*)(a.ws + WS_Y);
    const float* fw = a.in[I_FNETW] + (size_t)j * 4 * 4096;
    const int gw = F.vcu * 8 + F.wave, NGW = F.G * 8;
    for (int it = gw; it < M * 4; it += NGW) {
        const int row = it >> 2, g = it & 3;
        const float d = SP[(size_t)row * 256 + g * 64 + F.lane];
        const float y = wave_matvec64(d, fw + g * 4096, F.lane);
        Y[(size_t)row * D + 768 + g * 64 + F.lane] = (bf16)f2bf(y);
    }
}

constexpr int STEPS = 12, N_PHASES = 1 + DEPTH * STEPS + 1;
__device__ __forceinline__ void run_phase(Frame& F, int ph) {
    const CAS Args& a = *F.a; unsigned char* ws = a.ws;
    if (ph == 0) { phase_setup(F); return; }
    if (ph == N_PHASES - 1) { phase_final(F); return; }
    const int l = (ph - 1) / STEPS, st = (ph - 1) % STEPS, e = l >> 1;
    const bf16* HN = (const bf16*)(ws + WS_HN); bf16* HH = (bf16*)(ws + WS_HH); float* X = (float*)(ws + WS_X); float* P = (float*)(ws + WS_P);
    const bf16* Y = (const bf16*)(ws + WS_Y); const float* mod = (const float*)(ws + WS_MOD);
    switch (st) {
        case 0: phase_norm(F, l, 0); break;
        case 1: { EpiUp E{HH}; gemm_phase<11, EpiUp>(F, HN, (const bf16*)(ws + WS_WUP + (size_t)(l * 2) * WUP_SZ), D, NUP, E); } break;
        case 2: { EpiRes E{X, mod, l, 2, 0.5f}; gemm_phase<4, EpiRes>(F, HH, (const bf16*)(ws + WS_WDN + (size_t)(l * 2) * WDN_SZ), FF, D, E); } break;
        case 3: phase_norm(F, l, 1); break;
        case 4: { EpiStore E{P, LDP};
                  if ((l & 1) == 0) gemm_phase<7, EpiStore>(F, HN, (const bf16*)(ws + WS_EVIN + (size_t)e * EVIN_SZ), D, P_EVEN_PAD, E);
                  else gemm_phase<7, EpiStore>(F, HN, (const bf16*)(ws + WS_ODIN + (size_t)e * ODIN_SZ), D, P_ODD, E); } break;
        case 5: if ((l & 1) == 0) phase_even_pre(F, e); else phase_odd_a(F, e); break;
        case 6: if ((l & 1) == 0) phase_dn_scan(F, e); else phase_odd_b(F); break;
        case 7: if ((l & 1) == 0) phase_dn_fin(F, e); else phase_odd_c(F, e); break;
        case 8: { EpiRes E{X, mod, l, 5, 1.0f}; gemm_phase<4, EpiRes>(F, Y, (const bf16*)(ws + ((l & 1) ? WS_ODOUT : WS_EVOUT) + (size_t)e * SQ_SZ), D, D, E); } break;
        case 9: phase_norm(F, l, 2); break;
        case 10: { EpiUp E{HH}; gemm_phase<11, EpiUp>(F, HN, (const bf16*)(ws + WS_WUP + (size_t)(l * 2 + 1) * WUP_SZ), D, NUP, E); } break;
        case 11: { EpiRes E{X, mod, l, 8, 0.5f}; gemm_phase<4, EpiRes>(F, HH, (const bf16*)(ws + WS_WDN + (size_t)(l * 2 + 1) * WDN_SZ), FF, D, E); } break;
    }
}

__global__ void __launch_bounds__(512, 2) mk_fwd(Args args) {
    extern __shared__ __attribute__((aligned(16))) unsigned char lds_raw[];
    Frame F;
    F.lds = (LAS unsigned char*)lds_raw;
    F.tid = threadIdx.x; F.lane = F.tid & 63; F.wave = __builtin_amdgcn_readfirstlane(F.tid >> 6);
    F.G = gridDim.x; { const int bx = blockIdx.x; F.vcu = (F.G % 8 == 0) ? (bx % 8) * (F.G / 8) + bx / 8 : bx; }
    const CAS Args* ap = (const CAS Args*)__builtin_amdgcn_kernarg_segment_ptr();
    F.a = ap;
    const int ph_lo = ap->ph_lo, ph_hi = ap->ph_hi;
    unsigned char* ws0 = ap->ws;
    volatile LAS unsigned* MISC = (volatile LAS unsigned*)(F.lds + LDS_MISC);
    if (F.tid < 64) MISC[F.tid] = 0u;
    __syncthreads();
    const bool multi = (ph_hi - ph_lo) > 1;
    XcdBarrier bar; bar.bar = (unsigned*)(ws0 + WS_CTL) + CW_BAR; bar.x = 0; bar.st = MISC + 8;
    if (multi) bar = xcd_barrier_post((unsigned*)(ws0 + WS_CTL) + CW_BAR, MISC + 8);
    for (int ph = ph_lo; ph < ph_hi; ++ph) {
        { const CAS Args* a2 = ap; asm volatile("" : "+s"(a2)); F.a = a2; }
        { int t_ = threadIdx.x; asm volatile("" : "+v"(t_)); F.tid = t_; F.lane = t_ & 63; F.wave = __builtin_amdgcn_readfirstlane(t_ >> 6); }
        run_phase(F, ph);
        if (ph + 1 < ph_hi) xcd_barrier(bar);
    }
}

extern "C" void kernel_launch(void* const* d_in, const int* in_sizes, int n_in, void* d_out, int out_size, void* d_ws, size_t ws_size, hipStream_t stream) {
    static int grid = 0;
    if (grid == 0) {
        if (n_in != 31 || ws_size < WS_END) { fprintf(stderr, "kernel_launch: unexpected n_in %d or ws_size %zu (need %zu)\n", n_in, ws_size, (size_t)WS_END); grid = -1; return; }
        int dev = 0, cus = 0;
        if (hipGetDevice(&dev) != hipSuccess || hipDeviceGetAttribute(&cus, hipDeviceAttributeMultiprocessorCount, dev) != hipSuccess) { grid = -1; return; }
        if (hipFuncSetAttribute((const void*)mk_fwd, hipFuncAttributeMaxDynamicSharedMemorySize, LDS_BYTES) != hipSuccess) { fprintf(stderr, "kernel_launch: hipFuncSetAttribute failed\n"); grid = -1; return; }
        (void)hipGetLastError();
        grid = cus;
    }
    if (grid < 0) return;
    (void)hipMemsetAsync((char*)d_ws + WS_CTL, 0, CTL_BYTES, stream);
    Args a{};
    for (int i = 0; i < 31; ++i) a.in[i] = (const float*)d_in[i];
    a.out = (float*)d_out; a.ws = (unsigned char*)d_ws;
#if ONE_LAUNCH
    a.ph_lo = 0; a.ph_hi = N_PHASES;
    hipLaunchKernelGGL(mk_fwd, dim3(grid), dim3(512), LDS_BYTES, stream, a);
#else
    for (int ph = 0; ph < N_PHASES; ++ph) {
        a.ph_lo = ph; a.ph_hi = ph + 1;
        hipLaunchKernelGGL(mk_fwd, dim3(grid), dim3(512), LDS_BYTES, stream, a);
    }
#endif
}
```

```cpp
#include <hip/hip_runtime.h>
#include <cstdio>
#include <cstdint>

#ifndef ONE_LAUNCH
#define ONE_LAUNCH 1
#endif

#define GAS __attribute__((address_space(1)))
#define LAS __attribute__((address_space(3)))
#define CAS __attribute__((address_space(4)))
typedef unsigned short bf16;
typedef float f32x4 __attribute__((ext_vector_type(4)));
typedef float f32x2 __attribute__((ext_vector_type(2)));
typedef short bf16x8 __attribute__((ext_vector_type(8)));
typedef unsigned u32x4 __attribute__((ext_vector_type(4)));
typedef unsigned u32x2 __attribute__((ext_vector_type(2)));

constexpr int D = 1024, NCTX = 4096, NLAT = 2048, M = 6144, FF = 2816, DEPTH = 4;
constexpr int CTX_B = 16, CTX_L = 256, LAT_B = 2, LAT_L = 1024;
constexpr int NUP = 2 * FF;
constexpr int P_EVEN = 3352, P_EVEN_PAD = 3584, P_ODD = 1792;
constexpr int LDP = 3584;
constexpr int NH = 6, DK = 128;
constexpr float EPS = 1e-6f;
constexpr int NSEQ = CTX_B + LAT_B;

constexpr size_t MiB = 1u << 20;
constexpr size_t WS_CTL = 0, CTL_BYTES = 1 * MiB;
constexpr size_t WS_MOD = 1 * MiB;
constexpr size_t WS_WUP = 2 * MiB, WUP_SZ = 11 * MiB;
constexpr size_t WS_WDN = 90 * MiB, WDN_SZ = 5632 * 1024;
constexpr size_t WS_EVIN = 134 * MiB, EVIN_SZ = 7 * MiB;
constexpr size_t WS_EVOUT = 148 * MiB, SQ_SZ = 2 * MiB;
constexpr size_t WS_ODIN = 152 * MiB, ODIN_SZ = 4 * MiB;
constexpr size_t WS_ODOUT = 160 * MiB;
constexpr size_t WS_X = 164 * MiB;
constexpr size_t WS_HN = 188 * MiB;
constexpr size_t WS_HH = 200 * MiB;
constexpr size_t WS_P = 233 * MiB;
constexpr size_t WS_Y = 317 * MiB;
constexpr size_t WS_QN = 329 * MiB, WS_KN = 347 * MiB, WS_VV = 365 * MiB, WS_OF = 383 * MiB, WS_OB = 401 * MiB;
constexpr size_t WS_AG = 419 * MiB, WS_BT = 420 * MiB;
constexpr size_t WS_ZR = 421 * MiB, WS_ZI = 427 * MiB, WS_SPEC = 433 * MiB;
constexpr size_t WS_DW = 439 * MiB, WS_DQ = 457 * MiB, WS_DAI = 475 * MiB, WS_DKT = 484 * MiB, WS_DUT = 502 * MiB, WS_DGL = 520 * MiB;
constexpr size_t WS_END = 521 * MiB;

constexpr int CW_BAR = 4096;

constexpr int LDS_MAIN = 155648;
constexpr int LDS_MISC = LDS_MAIN;
constexpr int LDS_BYTES = LDS_MAIN + 1024;

__device__ __forceinline__ float wave_sum(float v) {
#pragma unroll
    for (int o = 1; o < 64; o <<= 1) v += __shfl_xor(v, o);
    return v;
}
__device__ __forceinline__ unsigned f2bf(float f) { unsigned u = __builtin_bit_cast(unsigned, f); return (u + 0x7fffu + ((u >> 16) & 1u)) >> 16; }
__device__ __forceinline__ unsigned pk2(float lo, float hi) { return f2bf(lo) | (f2bf(hi) << 16); }
__device__ __forceinline__ float silu_f(float x) { return x / (1.f + __expf(-x)); }
__device__ __forceinline__ float sigmoid_f(float x) { return 1.f / (1.f + __expf(-x)); }
__device__ __forceinline__ float gelu_tanh(float x) { const float u = 0.7978845608028654f * (x + 0.044715f * x * x * x); return 0.5f * x * (1.f + tanhf(u)); }
__device__ __forceinline__ float softplus_f(float x) { return x > 20.f ? x : log1pf(expf(x)); }
__device__ __forceinline__ int cond_of_row(int r) { return r < NCTX ? 0 : (r < NCTX + LAT_L ? 1 : 2); }
__device__ __forceinline__ void seq_of_row(int r, int& s0, int& L) { if (r < NCTX) { s0 = r & ~(CTX_L - 1); L = CTX_L; } else { s0 = NCTX + ((r - NCTX) & ~(LAT_L - 1)); L = LAT_L; } }

#define XB_TMO      128
#define XB_XCNT(j)  (256  + 64 * (j))
#define XB_XSUB(j)  (1280 + 64 * (j))
#define XB_XGEN(j)  (2304 + 64 * (j))
#define XB_TOP      3328
#define XB_TOPGEN   3392
#define XCD_BAR_WORDS 3456
#define XB_SPIN_CAP (1u << 18)
__device__ __forceinline__ unsigned xb_ld(unsigned* p)              { return __hip_atomic_load(p, __ATOMIC_RELAXED, __HIP_MEMORY_SCOPE_AGENT); }
__device__ __forceinline__ unsigned xb_add(unsigned* p, unsigned v) { return __hip_atomic_fetch_add(p, v, __ATOMIC_RELAXED, __HIP_MEMORY_SCOPE_AGENT); }
__device__ __forceinline__ unsigned xb_xcc_id() { return (unsigned)__builtin_amdgcn_s_getreg((3 << 11) | 20) & 0xFu; }
#define XB_SPIN(cond, bar) do { unsigned _sp = 0; while (cond) { __builtin_amdgcn_s_sleep(1); \
    if ((++_sp & 255u) == 0u) { if (xb_ld(&(bar)[XB_TMO])) break; if (_sp > XB_SPIN_CAP) { atomicAdd(&(bar)[XB_TMO], 1u); break; } } } } while (0)
struct XcdBarrier { unsigned* bar; unsigned x; volatile LAS unsigned* st; };
__device__ __forceinline__ XcdBarrier xcd_barrier_post(unsigned* bar, volatile LAS unsigned* st) {
    XcdBarrier b; b.bar = bar; b.x = xb_xcc_id(); b.st = st;
    if (threadIdx.x == 0) (void)xb_add(&bar[XB_XCNT(b.x)], 1u);
    return b;
}
__device__ __forceinline__ void xcd_barrier_complete(unsigned* bar, unsigned x, unsigned& nloc, unsigned& nx) {
    const unsigned G = gridDim.x * gridDim.y * gridDim.z;
    unsigned sum, cnt, mine, sp = 0u;
    for (;;) {
        sum = 0u; cnt = 0u; mine = 0u;
#pragma unroll
        for (unsigned j = 0; j < 16; ++j) { const unsigned c = xb_ld(&bar[XB_XCNT(j)]); sum += c; cnt += (c > 0u) ? 1u : 0u; mine = (j == x) ? c : mine; }
        if (sum == G) break;
        __builtin_amdgcn_s_sleep(1);
        if ((++sp & 255u) == 0u) { if (xb_ld(&bar[XB_TMO])) break; if (sp > XB_SPIN_CAP) { atomicAdd(&bar[XB_TMO], 1u); break; } }
    }
    nloc = mine > 0u ? mine : 1u; nx = cnt > 0u ? cnt : 1u;
}
__device__ __forceinline__ void xcd_barrier(const XcdBarrier& b) {
    asm volatile("s_waitcnt vmcnt(0)" ::: "memory");
    __syncthreads();
    if (threadIdx.x == 0) {
        unsigned* bar = b.bar;
        __builtin_amdgcn_s_waitcnt(0);
        unsigned nloc = b.st[0], nx = b.st[1];
        if (nloc == 0u) { xcd_barrier_complete(bar, b.x, nloc, nx); b.st[0] = nloc; b.st[1] = nx; }
        const unsigned old = xb_add(&bar[XB_XSUB(b.x)], 1u);
        const unsigned gen = old / nloc;
        if (old + 1u == (gen + 1u) * nloc) {
            __builtin_amdgcn_fence(__ATOMIC_RELEASE, "agent");
            asm volatile("s_waitcnt vmcnt(0)" ::: "memory");
            const unsigned og = xb_add(&bar[XB_TOP], 1u);
            const unsigned tg = og / nx;
            if (og + 1u == (tg + 1u) * nx) xb_add(&bar[XB_TOPGEN], 1u);
            else XB_SPIN(xb_ld(&bar[XB_TOPGEN]) == tg, bar);
            __builtin_amdgcn_fence(__ATOMIC_ACQUIRE, "agent");
            xb_add(&bar[XB_XGEN(b.x)], 1u);
            asm volatile("s_waitcnt vmcnt(0)" ::: "memory");
        } else {
            XB_SPIN(xb_ld(&bar[XB_XGEN(b.x)]) == gen, bar);
            __builtin_amdgcn_fence(__ATOMIC_ACQUIRE, "agent");
            asm volatile("s_waitcnt vmcnt(0)" ::: "memory");
        }
    }
    __syncthreads();
}

struct Args { const float* in[31]; float* out; unsigned char* ws; int ph_lo, ph_hi; };
enum { I_XP = 0, I_XS, I_STATE, I_C, I_CCTX, I_F1N, I_F1G, I_F1U, I_F1D, I_MIXN, I_F2N, I_F2G, I_F2U, I_F2D, I_ADAW, I_ADAB, I_EVIN, I_EVOUT,
       I_POOLW, I_POOLS, I_CONVW, I_ALOG, I_DTB, I_DNNW, I_ODIN, I_ODOUT, I_SGUN, I_SGUW, I_SGUB, I_FNETW, I_FINN };

struct Frame {
    LAS unsigned char* lds;
    int tid, lane, wave, vcu, G;
    const CAS Args* a;
};

template <int NFRAG, class Epi>
__device__ __forceinline__ void gemm_tile(LAS unsigned char* lds, const int tid, const bf16* A, const bf16* Bt, int K, int row0, int col0, const Epi& E) {
    constexpr int BN = 32 * NFRAG, NPB = BN / 8, A_BYTES = 192 * 128, B_BYTES = BN * 128, STAGE = A_BYTES + B_BYTES, NBI = (NPB + 7) / 8;
    static_assert(2 * STAGE <= LDS_MAIN, "LDS");
    const int lane = tid & 63, wid = __builtin_amdgcn_readfirstlane(tid >> 6), wm = wid >> 1, wn = wid & 1, fr = lane & 15, fq = lane >> 4;
    const int r = lane >> 3, slot = lane & 7;
    const int srow = wid * 8 + r;
    const int chunk = slot ^ ((srow >> 1) & 7);
    const char* gA = (const char*)(A + (size_t)(row0 + srow) * K) + chunk * 16;
    const char* gB = (const char*)(Bt + (size_t)(col0 + srow) * K) + chunk * 16;
    const size_t pstep = (size_t)64 * K * 2;
    const int nt = K / 64;
    const int rowA0 = wm * 48 + fr, rowB0 = wn * NFRAG * 16 + fr;
    int offA[2], offB[2];
#pragma unroll
    for (int kk = 0; kk < 2; ++kk) {
        offA[kk] = rowA0 * 128 + (((kk * 4 + fq) ^ ((rowA0 >> 1) & 7)) << 4);
        offB[kk] = A_BYTES + rowB0 * 128 + (((kk * 4 + fq) ^ ((rowB0 >> 1) & 7)) << 4);
    }
    f32x4 acc[3][NFRAG];
#pragma unroll
    for (int i = 0; i < 3; ++i)
#pragma unroll
        for (int j = 0; j < NFRAG; ++j) acc[i][j] = (f32x4){0.f, 0.f, 0.f, 0.f};

#define GEMM_STAGE(buf, t) do { LAS unsigned char* sA_ = lds + (buf) * STAGE + wid * 1024; \
        _Pragma("unroll") for (int i_ = 0; i_ < 3; ++i_) \
            __builtin_amdgcn_global_load_lds((const unsigned*)(gA + i_ * pstep + (size_t)(t) * 128), (LAS unsigned*)(sA_ + i_ * 8192), 16, 0, 0); \
        _Pragma("unroll") for (int i_ = 0; i_ < NBI; ++i_) if (wid + 8 * i_ < NPB) \
            __builtin_amdgcn_global_load_lds((const unsigned*)(gB + i_ * pstep + (size_t)(t) * 128), (LAS unsigned*)(sA_ + A_BYTES + i_ * 8192), 16, 0, 0); } while (0)

    GEMM_STAGE(0, 0);
    for (int t = 0; t < nt; ++t) {
        asm volatile("s_waitcnt vmcnt(0)" ::: "memory");
        __syncthreads();
        if (t + 1 < nt) GEMM_STAGE((t + 1) & 1, t + 1);
        LAS unsigned char* sb = lds + (t & 1) * STAGE;
#pragma unroll
        for (int kk = 0; kk < 2; ++kk) {
            bf16x8 af[3];
#pragma unroll
            for (int mf = 0; mf < 3; ++mf) af[mf] = *(const LAS bf16x8*)(sb + offA[kk] + mf * 2048);
#pragma unroll
            for (int nf = 0; nf < NFRAG; ++nf) {
                const bf16x8 bfr = *(const LAS bf16x8*)(sb + offB[kk] + nf * 2048);
#pragma unroll
                for (int mf = 0; mf < 3; ++mf) acc[mf][nf] = __builtin_amdgcn_mfma_f32_16x16x32_bf16(bfr, af[mf], acc[mf][nf], 0, 0, 0);
            }
        }
    }
#undef GEMM_STAGE
    E(acc, row0 + wm * 48 + fr, col0 + wn * NFRAG * 16 + fq * 4, fq);
    __syncthreads();
}

struct EpiUp {
    bf16* H;
    template <int NFRAG> __device__ __forceinline__ void operator()(f32x4 (&acc)[3][NFRAG], int row, int colq, int fq) const {
#pragma unroll
        for (int mf = 0; mf < 3; ++mf)
#pragma unroll
            for (int nf = 0; nf < NFRAG; ++nf) {
                f32x4 v = acc[mf][nf], o;
                o[0] = __shfl_xor(v[0], 16); o[1] = __shfl_xor(v[1], 16); o[2] = __shfl_xor(v[2], 16); o[3] = __shfl_xor(v[3], 16);
                if ((fq & 1) == 0) {
                    const int c = colq + nf * 16;
                    const int hid = (c >> 3) * 4;
                    u32x2 w; w.x = pk2(silu_f(v[0]) * o[0], silu_f(v[1]) * o[1]); w.y = pk2(silu_f(v[2]) * o[2], silu_f(v[3]) * o[3]);
                    *(u32x2*)(H + (size_t)(row + mf * 16) * FF + hid) = w;
                }
            }
    }
};
struct EpiRes {
    float* X; const float* mod; int layer, gidx; float scale;
    template <int NFRAG> __device__ __forceinline__ void operator()(f32x4 (&acc)[3][NFRAG], int row, int colq, int) const {
#pragma unroll
        for (int mf = 0; mf < 3; ++mf) {
            const int rr = row + mf * 16;
            const float* g = mod + ((size_t)(layer * 3 + cond_of_row(rr)) * 9 + gidx) * 1024;
#pragma unroll
            for (int nf = 0; nf < NFRAG; ++nf) {
                const int c = colq + nf * 16;
                const f32x4 gv = *(const f32x4*)(g + c);
                f32x4* xp = (f32x4*)(X + (size_t)rr * D + c);
                f32x4 xv = *xp;
                xv += acc[mf][nf] * gv * scale;
                *xp = xv;
            }
        }
    }
};
struct EpiStore {
    float* P; int ld;
    template <int NFRAG> __device__ __forceinline__ void operator()(f32x4 (&acc)[3][NFRAG], int row, int colq, int) const {
#pragma unroll
        for (int mf = 0; mf < 3; ++mf)
#pragma unroll
            for (int nf = 0; nf < NFRAG; ++nf) *(f32x4*)(P + (size_t)(row + mf * 16) * ld + colq + nf * 16) = acc[mf][nf];
    }
};

template <int NFRAG, class Epi>
__device__ __forceinline__ void gemm_phase(Frame& F, const bf16* A, const bf16* Bt, int K, int N, const Epi& E) {
    constexpr int BN = 32 * NFRAG;
    const int NT = N / BN, nitems = 32 * NT;
    for (int i = F.vcu; i < nitems; i += F.G) {
        const int panel = (i >> 3) & 31, ct = (i & 7) + 8 * (i >> 8);
        gemm_tile<NFRAG, Epi>(F.lds, F.tid, A, Bt, K, panel * 192, ct * BN, E);
    }
}

__device__ __forceinline__ void transpose_item(const float* W, int K, int N, bf16* WT, int mode, LAS float* scr, int item, int lane) {
    const int nblk = (N + 31) / 32, kb = item / nblk, nb = item % nblk, k0 = 64 * kb, n0 = 32 * nb;
    const int nn = n0 + (lane & 31);
#pragma unroll 8
    for (int i = 0; i < 32; ++i) { const int kk = 2 * i + (lane >> 5); scr[kk * 33 + (lane & 31)] = (nn < N) ? W[(size_t)(k0 + kk) * N + nn] : 0.f; }
    asm volatile("s_waitcnt lgkmcnt(0)" ::: "memory");
    const int c = lane & 7;
#pragma unroll
    for (int j = 0; j < 4; ++j) {
        const int nl = (lane >> 3) + 8 * j, n = n0 + nl; const LAS float* s = scr + (8 * c) * 33 + nl;
        u32x4 o; o.x = pk2(s[0 * 33], s[1 * 33]); o.y = pk2(s[2 * 33], s[3 * 33]); o.z = pk2(s[4 * 33], s[5 * 33]); o.w = pk2(s[6 * 33], s[7 * 33]);
        const int dr = (mode == 0) ? n : ((n >> 2) * 8 + (n & 3) + (mode == 2 ? 4 : 0));
        if (n < N) *(u32x4*)(WT + (size_t)dr * K + k0 + 8 * c) = o;
    }
    asm volatile("s_waitcnt lgkmcnt(0)" ::: "memory");
}

__device__ __forceinline__ void phase_setup(Frame& F) {
    const CAS Args& a = *F.a;
    unsigned char* ws = a.ws;
    {
        LAS float* sc = (LAS float*)F.lds;
        LAS float* red = sc + 3 * 1024;
        for (int i = F.tid; i < 3 * 1024; i += 512) { const int c = i >> 10, k = i & 1023; const float v = (c == 0) ? a.in[I_CCTX][k] : a.in[I_C][(c - 1) * 1024 + k]; sc[i] = silu_f(v); }
        __syncthreads();
        float* mod = (float*)(ws + WS_MOD);
        for (int it = F.vcu; it < 4 * 72; it += F.G) {
            const int l = it / 72, cb = it % 72, q = F.tid & 31, kg = F.tid >> 5;
            const float* W = a.in[I_ADAW] + (size_t)l * 1024 * 9216 + cb * 128 + q * 4;
            f32x4 s0 = {0, 0, 0, 0}, s1 = s0, s2 = s0;
#pragma unroll 4
            for (int k = kg * 64; k < kg * 64 + 64; ++k) {
                const f32x4 w = *(const f32x4*)(W + (size_t)k * 9216);
                s0 += w * sc[k]; s1 += w * sc[1024 + k]; s2 += w * sc[2048 + k];
            }
            LAS float* rp = red + (kg * 32 + q) * 12;
#pragma unroll
            for (int j = 0; j < 4; ++j) { rp[j] = s0[j]; rp[4 + j] = s1[j]; rp[8 + j] = s2[j]; }
            __syncthreads();
            if (F.tid < 384) {
                const int qq = F.tid / 12, v = F.tid % 12; float s = 0.f;
#pragma unroll
                for (int g = 0; g < 16; ++g) s += red[(g * 32 + qq) * 12 + v];
                const int c = v >> 2, j = v & 3, n = cb * 128 + qq * 4 + j;
                mod[(size_t)(l * 3 + c) * 9216 + n] = s + a.in[I_ADAB][l * 9216 + n];
            }
            __syncthreads();
        }
        __syncthreads();
    }
    {
        LAS float* scr = (LAS float*)(F.lds + F.wave * 16384);
        const int gw = F.vcu * 8 + F.wave, NGW = F.G * 8;
        constexpr int IT_G = 16 * 88, IT_D = 44 * 32, IT_EVIN = 16 * 105, IT_SQ = 16 * 32, IT_ODIN = 16 * 56;
        static_assert(IT_G == IT_D, "decode");
        constexpr int PER_FFN = 2 * IT_G + IT_D;
        constexpr int TOT = 8 * PER_FFN + 2 * (IT_EVIN + IT_SQ + IT_ODIN + IT_SQ);
        for (int it = gw; it < TOT; it += NGW) {
            int r = it; const float* W; bf16* WT; int K, N, mode;
            if (r < 8 * PER_FFN) {
                const int f = r / PER_FFN, l = f >> 1, s = f & 1; r -= f * PER_FFN;
                const int sub = r / IT_G; r -= sub * IT_G;
                const int idx = (sub == 0) ? (s ? I_F2G : I_F1G) : ((sub == 1) ? (s ? I_F2U : I_F1U) : (s ? I_F2D : I_F1D));
                W = a.in[idx] + (size_t)l * D * FF;
                WT = (sub == 2) ? (bf16*)(ws + WS_WDN + (size_t)f * WDN_SZ) : (bf16*)(ws + WS_WUP + (size_t)f * WUP_SZ);
                K = (sub == 2) ? FF : D; N = (sub == 2) ? D : FF; mode = (sub == 2) ? 0 : sub + 1;
            } else {
                r -= 8 * PER_FFN;
                constexpr int PER_E = IT_EVIN + IT_SQ + IT_ODIN + IT_SQ;
                const int e = r / PER_E; r -= e * PER_E;
                K = D; mode = 0;
                if (r < IT_EVIN) { W = a.in[I_EVIN] + (size_t)e * D * P_EVEN; N = P_EVEN; WT = (bf16*)(ws + WS_EVIN + (size_t)e * EVIN_SZ); }
                else if (r < IT_EVIN + IT_SQ) { r -= IT_EVIN; W = a.in[I_EVOUT] + (size_t)e * D * D; N = D; WT = (bf16*)(ws + WS_EVOUT + (size_t)e * SQ_SZ); }
                else if (r < IT_EVIN + IT_SQ + IT_ODIN) { r -= IT_EVIN + IT_SQ; W = a.in[I_ODIN] + (size_t)e * D * P_ODD; N = P_ODD; WT = (bf16*)(ws + WS_ODIN + (size_t)e * ODIN_SZ); }
                else { r -= IT_EVIN + IT_SQ + IT_ODIN; W = a.in[I_ODOUT] + (size_t)e * D * D; N = D; WT = (bf16*)(ws + WS_ODOUT + (size_t)e * SQ_SZ); }
            }
            transpose_item(W, K, N, WT, mode, scr, r, F.lane);
        }
        for (int it = gw; it < 2 * (P_EVEN_PAD - P_EVEN); it += NGW) {
            const int e = it / (P_EVEN_PAD - P_EVEN), rr = P_EVEN + it % (P_EVEN_PAD - P_EVEN);
            u32x4* p = (u32x4*)((bf16*)(ws + WS_EVIN + (size_t)e * EVIN_SZ) + (size_t)rr * D);
            p[F.lane] = (u32x4){0, 0, 0, 0}; p[64 + F.lane] = (u32x4){0, 0, 0, 0};
        }
        float* X = (float*)(ws + WS_X);
        for (int row = gw; row < M; row += NGW) {
            float* xo = X + (size_t)row * D;
            if (row < NCTX) {
                const f32x4* src = (const f32x4*)(a.in[I_XP] + (size_t)row * D);
#pragma unroll
                for (int j = 0; j < 4; ++j) ((f32x4*)xo)[j * 64 + F.lane] = src[j * 64 + F.lane];
            } else {
                const int t = (row - NCTX) & (LAT_L - 1); const float pr = (float)(t >> 6), pc = (float)(t & 63);
                const float* src = a.in[I_XS] + (size_t)(row - NCTX) * D;
#pragma unroll
                for (int j = 0; j < 16; ++j) {
                    const int ch = j * 64 + F.lane, seg = ch >> 8, i = ch & 255;
                    const float freq = expf(-9.210340371976184f * (float)i * (1.0f / 256.0f));
                    const float ang = ((seg < 2) ? pr : pc) * freq;
                    const float pe = (seg & 1) ? cosf(ang) : sinf(ang);
                    xo[ch] = src[ch] + pe;
                }
            }
        }
    }
}

__device__ __forceinline__ void phase_norm(Frame& F, int layer, int which) {
    const CAS Args& a = *F.a;
    const float* X = (const float*)(a.ws + WS_X); bf16* HN = (bf16*)(a.ws + WS_HN);
    const float* mod = (const float*)(a.ws + WS_MOD);
    const float* nw = a.in[which == 0 ? I_F1N : (which == 1 ? I_MIXN : I_F2N)] + layer * D;
    const int gw = F.vcu * 8 + F.wave, NGW = F.G * 8;
    for (int row = gw; row < M; row += NGW) {
        const f32x4* xr = (const f32x4*)(X + (size_t)row * D) + F.lane;
        f32x4 v[4]; float s = 0.f;
#pragma unroll
        for (int j = 0; j < 4; ++j) { v[j] = xr[64 * j]; s += v[j][0] * v[j][0] + v[j][1] * v[j][1] + v[j][2] * v[j][2] + v[j][3] * v[j][3]; }
        const float rstd = 1.0f / sqrtf(wave_sum(s) * (1.f / D) + EPS);
        const float* mb = mod + ((size_t)(layer * 3 + cond_of_row(row)) * 9 + which * 3) * 1024;
        u32x2* o = (u32x2*)(HN + (size_t)row * D) + F.lane;
#pragma unroll
        for (int j = 0; j < 4; ++j) {
            const int k = (64 * j + F.lane) * 4;
            const f32x4 w = *(const f32x4*)(nw + k), sh = *(const f32x4*)(mb + k), sc = *(const f32x4*)(mb + 1024 + k);
            const f32x4 h = (v[j] * rstd * w) * (sc + 1.0f) + sh;
            u32x2 pkd; pkd.x = pk2(h[0], h[1]); pkd.y = pk2(h[2], h[3]);
            o[64 * j] = pkd;
        }
    }
}

__device__ __forceinline__ void phase_final(Frame& F) {
    const CAS Args& a = *F.a;
    const float* X = (const float*)(a.ws + WS_X);
    const float* nw = a.in[I_FINN];
    const int gw = F.vcu * 8 + F.wave, NGW = F.G * 8;
    for (int row = gw; row < M; row += NGW) {
        const f32x4* xr = (const f32x4*)(X + (size_t)row * D) + F.lane;
        f32x4 v[4]; float s = 0.f;
#pragma unroll
        for (int j = 0; j < 4; ++j) { v[j] = xr[64 * j]; s += v[j][0] * v[j][0] + v[j][1] * v[j][1] + v[j][2] * v[j][2] + v[j][3] * v[j][3]; }
        const float rstd = 1.0f / sqrtf(wave_sum(s) * (1.f / D) + EPS);
        f32x4* o = (f32x4*)(a.out + (size_t)row * D) + F.lane;
#pragma unroll
        for (int j = 0; j < 4; ++j) { const f32x4 w = *(const f32x4*)(nw + (64 * j + F.lane) * 4); o[64 * j] = v[j] * rstd * w; }
    }
}

__device__ __forceinline__ float wave_matvec64(float d, const float* W, int lane) {
    float y = 0.f;
#pragma unroll
    for (int c = 0; c < 64; ++c) { const float dc = __builtin_bit_cast(float, __builtin_amdgcn_readlane(__builtin_bit_cast(int, d), c)); y += dc * W[c * 64 + lane]; }
    return y;
}

__device__ __forceinline__ void phase_even_pre(Frame& F, int e) {
    const CAS Args& a = *F.a;
    const float* P = (const float*)(a.ws + WS_P);
    float* QN = (float*)(a.ws + WS_QN); float* KN = (float*)(a.ws + WS_KN); float* VV = (float*)(a.ws + WS_VV);
    float* AG = (float*)(a.ws + WS_AG); float* BT = (float*)(a.ws + WS_BT);
    bf16* Y = (bf16*)(a.ws + WS_Y);
    const float* cw = a.in[I_CONVW] + (size_t)e * 3 * 2304;
    const int gw = F.vcu * 8 + F.wave, NGW = F.G * 8;
    for (int it = gw; it < M * NH; it += NGW) {
        const int row = it / NH, h = it % NH; int s0, L; seq_of_row(row, s0, L);
        const int t = row - s0; const bool hp = t > 0, hn = t < L - 1;
        const int c2 = F.lane * 2;
        float res[3][2];
#pragma unroll
        for (int part = 0; part < 3; ++part) {
            const int pc = 256 + part * 768 + h * 128 + c2, wc = part * 768 + h * 128 + c2;
            const f32x2 x1 = *(const f32x2*)(P + (size_t)row * LDP + pc);
            const f32x2 x0 = hp ? *(const f32x2*)(P + (size_t)(row - 1) * LDP + pc) : (f32x2){0.f, 0.f};
            const f32x2 x2 = hn ? *(const f32x2*)(P + (size_t)(row + 1) * LDP + pc) : (f32x2){0.f, 0.f};
            const f32x2 w0 = *(const f32x2*)(cw + wc), w1 = *(const f32x2*)(cw + 2304 + wc), w2 = *(const f32x2*)(cw + 4608 + wc);
            const f32x2 y = x0 * w0 + x1 * w1 + x2 * w2;
            res[part][0] = silu_f(y[0]); res[part][1] = silu_f(y[1]);
        }
        const float qs = wave_sum(res[0][0] * res[0][0] + res[0][1] * res[0][1]);
        const float ks = wave_sum(res[1][0] * res[1][0] + res[1][1] * res[1][1]);
        const float qr = (1.0f / sqrtf(qs + EPS)) * 0.08838834764831845f, kr = 1.0f / sqrtf(ks + EPS);
        const size_t o = (size_t)row * 768 + h * 128 + c2;
        *(f32x2*)(QN + o) = (f32x2){res[0][0] * qr, res[0][1] * qr};
        *(f32x2*)(KN + o) = (f32x2){res[1][0] * kr, res[1][1] * kr};
        *(f32x2*)(VV + o) = (f32x2){res[2][0], res[2][1]};
        if (F.lane < 2) {
            const int d = F.lane;
            const float braw = P[(size_t)row * LDP + 3328 + d * 6 + h], araw = P[(size_t)row * LDP + 3340 + d * 6 + h];
            const float al = a.in[I_ALOG][(e * 2 + d) * 6 + h], dtb = a.in[I_DTB][(e * 2 + d) * 6 + h];
            const float g = -expf(al) * softplus_f(araw + dtb);
            AG[(size_t)row * 12 + d * 6 + h] = g;
            BT[(size_t)row * 12 + d * 6 + h] = sigmoid_f(braw);
        }
    }
    const float* pw = a.in[I_POOLW] + (size_t)e * 4 * 64 * 64; const float* ps = a.in[I_POOLS] + e * 256;
    for (int it = gw; it < M * 4; it += NGW) {
        const int row = it >> 2, g = it & 3; int s0, L; seq_of_row(row, s0, L);
        const int t = row - s0, half = 1 << g;
        const int lo = max(t - half, 0), hi = min(t + half, L);
        float sum = 0.f;
        for (int p = lo; p < hi; ++p) sum += P[(size_t)(s0 + p) * LDP + g * 64 + F.lane];
        const float d = sum / (float)(hi - lo) - P[(size_t)row * LDP + g * 64 + F.lane];
        const float y = wave_matvec64(d, pw + g * 4096, F.lane) * ps[g * 64 + F.lane];
        Y[(size_t)row * D + g * 64 + F.lane] = (bf16)f2bf(y);
    }
}

__device__ __forceinline__ int perm32(int x) { return (x & ~31) | ((x & 12) << 1) | ((x & 16) >> 2) | (x & 3); }
__device__ __forceinline__ int sw256(int row, int c16) { return row * 256 + ((c16 ^ (row & 15)) << 4); }
__device__ __forceinline__ int sw128(int row, int c8) { return row * 128 + ((c8 ^ ((row >> 1) & 7)) << 4); }
__device__ __forceinline__ int e128(int row, int col) { return sw128(row, col >> 3) + (col & 7) * 2; }
__device__ __forceinline__ void dn_item_decode(int cc, int& row0, int& L, int& c) {
    if (cc < 64) { row0 = (cc >> 2) * CTX_L; L = CTX_L; c = cc & 3; } else { const int q = cc - 64; row0 = NCTX + (q >> 4) * LAT_L; L = LAT_L; c = q & 15; }
}
#define MFMA16(a, b, c) __builtin_amdgcn_mfma_f32_16x16x32_bf16((a), (b), (c), 0, 0, 0)

__device__ __forceinline__ void phase_dn_prep(Frame& F, int e) {
    const CAS Args& a = *F.a;
    const float* QN = (const float*)(a.ws + WS_QN); const float* KN = (const float*)(a.ws + WS_KN); const float* VV = (const float*)(a.ws + WS_VV);
    const float* GLg = (const float*)(a.ws + WS_AG); const float* BT = (const float*)(a.ws + WS_BT);
    LAS unsigned char* L = F.lds;
    constexpr int KB = 0, QB = 16384, VBT = 32768, KGT = 49152, KDT = 65536, AIo = 81920, MM = 90112, TT = 98304, TN = 106496, MD = 114688, XT = 118784, SM = 139264;
    LAS float* sm = (LAS float*)(L + SM);
    const int wave = F.wave;
    for (int rec = F.vcu; rec < 1152; rec += F.G) {
        int tid_ = F.tid; asm volatile("" : "+v"(tid_));
        const int lane = tid_ & 63, fr = lane & 15, fq = lane >> 4;
        const int dir = rec & 1, h = (rec >> 1) % NH, cc = rec / (2 * NH);
        int row0, Ls, c; dn_item_decode(cc, row0, Ls, c);
        __syncthreads();
        if (wave == 0) {
            const int row = row0 + (dir ? (Ls - 1 - (c * 64 + lane)) : (c * 64 + lane));
            float x = GLg[(size_t)row * 12 + dir * 6 + h]; const float b = BT[(size_t)row * 12 + dir * 6 + h];
#pragma unroll
            for (int o = 1; o < 64; o <<= 1) { const float t = __shfl_up(x, o); if (lane >= o) x += t; }
            const float gl = __shfl(x, 63);
            sm[lane] = x; sm[64 + lane] = b; sm[128 + lane] = expf(x); sm[192 + lane] = expf(gl - x);
            if (lane == 63) ((float*)(a.ws + WS_DGL))[rec] = expf(x);
        }
        __syncthreads();
        {
            const int i = tid_ >> 3, cg = tid_ & 7;
            const int row = row0 + (dir ? (Ls - 1 - (c * 64 + i)) : (c * 64 + i));
            const size_t base = (size_t)row * 768 + h * 128 + cg * 16;
            float kf[16], qf[16], vf[16];
#pragma unroll
            for (int q4 = 0; q4 < 4; ++q4) {
                const f32x4 k4 = *(const f32x4*)(KN + base + q4 * 4), q4v = *(const f32x4*)(QN + base + q4 * 4), v4 = *(const f32x4*)(VV + base + q4 * 4);
#pragma unroll
                for (int j = 0; j < 4; ++j) { kf[q4 * 4 + j] = k4[j]; qf[q4 * 4 + j] = q4v[j]; vf[q4 * 4 + j] = v4[j]; }
            }
            const float be = sm[64 + i], eg = sm[128 + i], ek = sm[192 + i];
#pragma unroll
            for (int hf = 0; hf < 2; ++hf) {
                u32x4 kk, qq;
                kk.x = pk2(kf[hf * 8 + 0], kf[hf * 8 + 1]); kk.y = pk2(kf[hf * 8 + 2], kf[hf * 8 + 3]); kk.z = pk2(kf[hf * 8 + 4], kf[hf * 8 + 5]); kk.w = pk2(kf[hf * 8 + 6], kf[hf * 8 + 7]);
                qq.x = pk2(qf[hf * 8 + 0], qf[hf * 8 + 1]); qq.y = pk2(qf[hf * 8 + 2], qf[hf * 8 + 3]); qq.z = pk2(qf[hf * 8 + 4], qf[hf * 8 + 5]); qq.w = pk2(qf[hf * 8 + 6], qf[hf * 8 + 7]);
                *(LAS u32x4*)(L + KB + sw256(i, cg * 2 + hf)) = kk;
                *(LAS u32x4*)(L + QB + sw256(i, cg * 2 + hf)) = qq;
            }
            bf16* QD = (bf16*)(a.ws + WS_DQ) + (size_t)rec * 8192 + i * 128;
#pragma unroll
            for (int qq = 0; qq < 4; ++qq) {
                const int pos = perm32(cg * 16 + 4 * qq);
                u32x2 w; w.x = pk2(qf[4 * qq] * eg, qf[4 * qq + 1] * eg); w.y = pk2(qf[4 * qq + 2] * eg, qf[4 * qq + 3] * eg);
                *(u32x2*)(QD + pos) = w;
            }
            const int pi = perm32(i); const float bg = be * eg;
#pragma unroll
            for (int ee = 0; ee < 16; ++ee) {
                const int kd = cg * 16 + ee;
                *(LAS bf16*)(L + VBT + e128(kd, i)) = (bf16)f2bf(vf[ee] * be);
                *(LAS bf16*)(L + KGT + e128(kd, i)) = (bf16)f2bf(kf[ee] * bg);
                *(LAS bf16*)(L + KDT + e128(kd, pi)) = (bf16)f2bf(kf[ee] * ek);
            }
        }
        __syncthreads();
        const int mi = wave >> 1;
#pragma unroll
        for (int f = 0; f < 2; ++f) {
            const int nj = (wave & 1) * 2 + f;
            f32x4 kkacc = {0.f, 0.f, 0.f, 0.f}, qkacc = {0.f, 0.f, 0.f, 0.f};
            if (nj <= mi) {
#pragma unroll
                for (int ks = 0; ks < 4; ++ks) {
                    const bf16x8 ak = *(const LAS bf16x8*)(L + KB + sw256(mi * 16 + fr, ks * 4 + fq));
                    const bf16x8 aq = *(const LAS bf16x8*)(L + QB + sw256(mi * 16 + fr, ks * 4 + fq));
                    const bf16x8 bk = *(const LAS bf16x8*)(L + KB + sw256(nj * 16 + fr, ks * 4 + fq));
                    kkacc = MFMA16(ak, bk, kkacc); qkacc = MFMA16(aq, bk, qkacc);
                }
            }
            const int j = nj * 16 + fr, i0 = mi * 16 + 4 * fq; const float gcj = sm[j];
#pragma unroll
            for (int r = 0; r < 4; ++r) {
                const int i = i0 + r; const float dec = (i >= j) ? expf(sm[i] - gcj) : 0.f;
                const float mv = (i > j) ? (sm[64 + i] * kkacc[r] * dec) : 0.f;
                if (nj <= mi) *(LAS bf16*)(L + MM + e128(i, j)) = (bf16)f2bf(mv);
                if (nj == mi) *(LAS float*)(L + MD + ((mi * 16 + 4 * fq + r) * 16 + fr) * 4) = mv;
                if (nj > mi) *(LAS bf16*)(L + TN + e128(i, j)) = (bf16)0;
                *(LAS bf16*)(L + AIo + e128(i, perm32(j))) = (bf16)f2bf(qkacc[r] * dec);
            }
        }
        __syncthreads();
        if (wave == 0) {
            const int b = lane >> 4, cc_ = lane & 15;
            const LAS float* md = (const LAS float*)(L + MD) + b * 256;
            float T[16];
#pragma unroll
            for (int i = 0; i < 16; ++i) {
                float s = (i == cc_) ? 1.f : 0.f;
#pragma unroll
                for (int jj = 0; jj < i; ++jj) s -= md[i * 16 + jj] * T[jj];
                T[i] = s;
            }
#pragma unroll
            for (int i = 0; i < 16; ++i) *(LAS bf16*)(L + TN + e128(16 * b + i, 16 * b + cc_)) = (bf16)f2bf(T[i]);
#pragma unroll
            for (int hf = 0; hf < 2; ++hf) {
                u32x4 t; t.x = pk2(T[hf * 8 + 0], T[hf * 8 + 1]); t.y = pk2(T[hf * 8 + 2], T[hf * 8 + 3]); t.z = pk2(T[hf * 8 + 4], T[hf * 8 + 5]); t.w = pk2(T[hf * 8 + 6], T[hf * 8 + 7]);
                *(LAS u32x4*)(L + TT + sw128(16 * b + cc_, 2 * b + hf)) = t;
            }
        }
        __syncthreads();
#pragma unroll
        for (int lvl = 1; lvl <= 3; ++lvl) {
            if (wave < 4 - lvl) {
                const int J = wave, I = wave + lvl;
                f32x4 x = {0.f, 0.f, 0.f, 0.f};
                const bf16x8 zero8 = {0, 0, 0, 0, 0, 0, 0, 0};
#pragma unroll
                for (int ks = 0; ks < (lvl == 3 ? 2 : 1); ++ks) {
                    const bf16x8 am = *(const LAS bf16x8*)(L + MM + sw128(16 * I + fr, 2 * J + 4 * ks + fq));
                    bf16x8 bt = *(const LAS bf16x8*)(L + TT + sw128(16 * J + fr, 2 * J + 4 * ks + fq));
                    if (4 * ks + fq >= 2 * lvl) bt = zero8;
                    x = MFMA16(am, bt, x);
                }
                LAS unsigned char* xt = L + XT + wave * 512;
                { u32x2 t; t.x = pk2(x[0], x[1]); t.y = pk2(x[2], x[3]); *(LAS u32x2*)(xt + fr * 32 + fq * 8) = t; }
                const bf16x8 ad = *(const LAS bf16x8*)(L + TN + sw128(16 * I + fr, 2 * I + (fq & 1)));
                bf16x8 bx = *(const LAS bf16x8*)(xt + fr * 32 + (fq & 1) * 16);
                if (fq >= 2) bx = zero8;
                f32x4 t4 = {0.f, 0.f, 0.f, 0.f};
                t4 = MFMA16(ad, bx, t4);
#pragma unroll
                for (int r = 0; r < 4; ++r) *(LAS bf16*)(L + TN + e128(16 * I + 4 * fq + r, 16 * J + fr)) = (bf16)f2bf(-t4[r]);
                { u32x2 t; t.x = pk2(-t4[0], -t4[1]); t.y = pk2(-t4[2], -t4[3]); *(LAS u32x2*)(L + TT + e128(16 * J + fr, 16 * I + 4 * fq)) = t; }
            }
            __syncthreads();
        }
        {
            bf16* UT = (bf16*)(a.ws + WS_DUT) + (size_t)rec * 8192;
            bf16* Wn = (bf16*)(a.ws + WS_DW) + (size_t)rec * 8192;
            const int ui = wave & 3;
#pragma unroll
            for (int f = 0; f < 4; ++f) {
                const int dvf = (wave >> 2) * 4 + f;
                f32x4 acc = {0.f, 0.f, 0.f, 0.f};
#pragma unroll
                for (int ks = 0; ks < 2; ++ks) {
                    const bf16x8 ta = *(const LAS bf16x8*)(L + TN + sw128(ui * 16 + fr, ks * 4 + fq));
                    const bf16x8 vb = *(const LAS bf16x8*)(L + VBT + sw128(dvf * 16 + fr, ks * 4 + fq));
                    acc = MFMA16(ta, vb, acc);
                }
                u32x2 t; t.x = pk2(acc[0], acc[1]); t.y = pk2(acc[2], acc[3]);
                *(u32x2*)(UT + (dvf * 16 + fr) * 64 + ui * 16 + 4 * fq) = t;
            }
#pragma unroll
            for (int f = 0; f < 4; ++f) {
                f32x4 acc = {0.f, 0.f, 0.f, 0.f};
#pragma unroll
                for (int ks = 0; ks < 2; ++ks) {
                    const bf16x8 ka = *(const LAS bf16x8*)(L + KGT + sw128(wave * 16 + fr, ks * 4 + fq));
                    const bf16x8 tb = *(const LAS bf16x8*)(L + TN + sw128(f * 16 + fr, ks * 4 + fq));
                    acc = MFMA16(ka, tb, acc);
                }
                u32x2 t; t.x = pk2(-acc[0], -acc[1]); t.y = pk2(-acc[2], -acc[3]);
                *(u32x2*)(Wn + (f * 16 + fr) * 128 + perm32(wave * 16 + 4 * fq)) = t;
            }
            {
                const int rw = tid_ >> 3, c8 = tid_ & 7;
                *(u32x4*)((unsigned char*)(a.ws + WS_DAI) + (size_t)rec * 8192 + rw * 128 + c8 * 16) = *(const LAS u32x4*)(L + AIo + sw128(rw, c8));
#pragma unroll
                for (int k2 = 0; k2 < 2; ++k2) {
                    const int rr = rw + 64 * k2;
                    *(u32x4*)((unsigned char*)(a.ws + WS_DKT) + (size_t)rec * 16384 + rr * 128 + c8 * 16) = *(const LAS u32x4*)(L + KDT + sw128(rr, c8));
                }
            }
        }
    }
    __syncthreads();
}

__device__ __forceinline__ void phase_dn_scan(Frame& F, int e) {
    const CAS Args& a = *F.a;
    LAS unsigned char* L = F.lds;
    constexpr int BUF = 57344, oW = 0, oQ = 16384, oA = 32768, oK = 40960;
    const int wave = F.wave;
    const unsigned char* gW = (const unsigned char*)(a.ws + WS_DW); const unsigned char* gQ = (const unsigned char*)(a.ws + WS_DQ);
    const unsigned char* gA = (const unsigned char*)(a.ws + WS_DAI); const unsigned char* gK = (const unsigned char*)(a.ws + WS_DKT);
    const bf16* gU = (const bf16*)(a.ws + WS_DUT); const float* gGL = (const float*)(a.ws + WS_DGL);
    for (int it = F.vcu; it < NSEQ * 2 * NH; it += F.G) {
        int tid_ = F.tid; asm volatile("" : "+v"(tid_));
        const int lane = tid_ & 63, fr = lane & 15, fq = lane >> 4, dvc = wave * 16 + fr;
        const int r4 = lane >> 4, s16 = lane & 15, r8 = lane >> 3, s8 = lane & 7;
        int seq, dir, h;
        if (it < LAT_B * 2 * NH) { seq = CTX_B + it / (2 * NH); dir = (it / NH) & 1; h = it % NH; }
        else { const int j = it - LAT_B * 2 * NH; seq = j / (2 * NH); dir = (j / NH) & 1; h = j % NH; }
        const bool lat = seq >= CTX_B;
        const int Ls = lat ? LAT_L : CTX_L, row0 = lat ? NCTX + (seq - CTX_B) * LAT_L : seq * CTX_L, nch = Ls / 64;
        const int cbase = lat ? 64 + (seq - CTX_B) * 16 : seq * 4;
        f32x4 S[8];
        if (lat) {
            const float* s0 = a.in[I_STATE] + ((((size_t)(seq - CTX_B) * 2 + e) * 2 + dir) * NH + h) * 128 * 128;
#pragma unroll
            for (int mf = 0; mf < 8; ++mf)
#pragma unroll
                for (int r = 0; r < 4; ++r) S[mf][r] = s0[(size_t)(mf * 16 + 4 * fq + r) * 128 + dvc];
        } else {
#pragma unroll
            for (int mf = 0; mf < 8; ++mf) S[mf] = (f32x4){0.f, 0.f, 0.f, 0.f};
        }
        float* O = (float*)(a.ws + (dir ? WS_OB : WS_OF));
#define DN_STAGE(bufi, rec_) do { LAS unsigned char* sb_ = L + (bufi) * BUF; const size_t ro_ = (size_t)(rec_); \
        _Pragma("unroll") for (int p_ = 0; p_ < 2; ++p_) { const int pc_ = wave + 8 * p_; const int rw_ = pc_ * 4 + r4; const int so_ = rw_ * 256 + ((s16 ^ (rw_ & 15)) << 4); \
            __builtin_amdgcn_global_load_lds((const unsigned*)(gW + ro_ * 16384 + so_), (LAS unsigned*)(sb_ + oW + pc_ * 1024), 16, 0, 0); \
            __builtin_amdgcn_global_load_lds((const unsigned*)(gQ + ro_ * 16384 + so_), (LAS unsigned*)(sb_ + oQ + pc_ * 1024), 16, 0, 0); \
            const int rk_ = pc_ * 8 + r8; const int sk_ = rk_ * 128 + ((s8 ^ ((rk_ >> 1) & 7)) << 4); \
            __builtin_amdgcn_global_load_lds((const unsigned*)(gK + ro_ * 16384 + sk_), (LAS unsigned*)(sb_ + oK + pc_ * 1024), 16, 0, 0); } \
        { const int ra_ = wave * 8 + r8; const int sa_ = ra_ * 128 + ((s8 ^ ((ra_ >> 1) & 7)) << 4); \
            __builtin_amdgcn_global_load_lds((const unsigned*)(gA + ro_ * 8192 + sa_), (LAS unsigned*)(sb_ + oA + wave * 1024), 16, 0, 0); } } while (0)
        __syncthreads();
        int rec = (cbase * NH + h) * 2 + dir;
        DN_STAGE(0, rec);
        u32x2 un[4]; float gln;
#pragma unroll
        for (int mf = 0; mf < 4; ++mf) un[mf] = *(const u32x2*)(gU + (size_t)rec * 8192 + dvc * 64 + mf * 16 + 4 * fq);
        gln = gGL[rec];
        for (int c = 0; c < nch; ++c) {
            asm volatile("s_waitcnt vmcnt(0)" ::: "memory");
            __syncthreads();
            u32x2 uc[4]; const float gl = gln;
#pragma unroll
            for (int mf = 0; mf < 4; ++mf) uc[mf] = un[mf];
            if (c + 1 < nch) {
                const int rn = rec + 2 * NH;
                DN_STAGE((c + 1) & 1, rn);
#pragma unroll
                for (int mf = 0; mf < 4; ++mf) un[mf] = *(const u32x2*)(gU + (size_t)rn * 8192 + dvc * 64 + mf * 16 + 4 * fq);
                gln = gGL[rn];
            }
            LAS unsigned char* sb = L + (c & 1) * BUF;
            bf16x8 Sb[4];
#pragma unroll
            for (int ks = 0; ks < 4; ++ks) {
                u32x4 t; t.x = pk2(S[2 * ks][0], S[2 * ks][1]); t.y = pk2(S[2 * ks][2], S[2 * ks][3]); t.z = pk2(S[2 * ks + 1][0], S[2 * ks + 1][1]); t.w = pk2(S[2 * ks + 1][2], S[2 * ks + 1][3]);
                Sb[ks] = __builtin_bit_cast(bf16x8, t);
            }
            f32x4 vn[4], o[4];
#pragma unroll
            for (int mf = 0; mf < 4; ++mf) {
                vn[mf][0] = __builtin_bit_cast(float, uc[mf].x << 16); vn[mf][1] = __builtin_bit_cast(float, uc[mf].x & 0xffff0000u);
                vn[mf][2] = __builtin_bit_cast(float, uc[mf].y << 16); vn[mf][3] = __builtin_bit_cast(float, uc[mf].y & 0xffff0000u);
                o[mf] = (f32x4){0.f, 0.f, 0.f, 0.f};
#pragma unroll
                for (int ks = 0; ks < 4; ++ks) {
                    const bf16x8 wf = *(const LAS bf16x8*)(sb + oW + sw256(mf * 16 + fr, ks * 4 + fq));
                    const bf16x8 qf = *(const LAS bf16x8*)(sb + oQ + sw256(mf * 16 + fr, ks * 4 + fq));
                    vn[mf] = MFMA16(wf, Sb[ks], vn[mf]);
                    o[mf] = MFMA16(qf, Sb[ks], o[mf]);
                }
            }
            bf16x8 Vb[2];
#pragma unroll
            for (int ks = 0; ks < 2; ++ks) {
                u32x4 t; t.x = pk2(vn[2 * ks][0], vn[2 * ks][1]); t.y = pk2(vn[2 * ks][2], vn[2 * ks][3]); t.z = pk2(vn[2 * ks + 1][0], vn[2 * ks + 1][1]); t.w = pk2(vn[2 * ks + 1][2], vn[2 * ks + 1][3]);
                Vb[ks] = __builtin_bit_cast(bf16x8, t);
            }
#pragma unroll
            for (int mf = 0; mf < 4; ++mf)
#pragma unroll
                for (int ks = 0; ks < 2; ++ks) {
                    const bf16x8 af = *(const LAS bf16x8*)(sb + oA + sw128(mf * 16 + fr, ks * 4 + fq));
                    o[mf] = MFMA16(af, Vb[ks], o[mf]);
                }
#pragma unroll
            for (int mf = 0; mf < 8; ++mf) {
                S[mf] = S[mf] * gl;
#pragma unroll
                for (int ks = 0; ks < 2; ++ks) {
                    const bf16x8 kf = *(const LAS bf16x8*)(sb + oK + sw128(mf * 16 + fr, ks * 4 + fq));
                    S[mf] = MFMA16(kf, Vb[ks], S[mf]);
                }
            }
#pragma unroll
            for (int mf = 0; mf < 4; ++mf)
#pragma unroll
                for (int r = 0; r < 4; ++r) {
                    const int step = c * 64 + mf * 16 + 4 * fq + r, row = row0 + (dir ? (Ls - 1 - step) : step);
                    O[(size_t)row * 768 + h * 128 + dvc] = o[mf][r];
                }
            rec += 2 * NH;
        }
#undef DN_STAGE
        if (!lat) {
            float* so = a.out + (size_t)M * D + ((((size_t)seq * 2 + e) * 2 + dir) * NH + h) * 128 * 128;
#pragma unroll
            for (int mf = 0; mf < 8; ++mf)
#pragma unroll
                for (int r = 0; r < 4; ++r) so[(size_t)(mf * 16 + 4 * fq + r) * 128 + dvc] = S[mf][r];
        }
    }
    __syncthreads();
}

__device__ __forceinline__ void phase_dn_fin(Frame& F, int e) {
    const CAS Args& a = *F.a;
    const float* P = (const float*)(a.ws + WS_P);
    const float* OF = (const float*)(a.ws + WS_OF); const float* OB = (const float*)(a.ws + WS_OB);
    bf16* Y = (bf16*)(a.ws + WS_Y);
    const float* nw = a.in[I_DNNW] + e * 128;
    const int gw = F.vcu * 8 + F.wave, NGW = F.G * 8;
    for (int it = gw; it < M * NH; it += NGW) {
        const int row = it / NH, h = it % NH, c2 = F.lane * 2;
        const size_t o = (size_t)row * 768 + h * 128 + c2;
        const f32x2 v = *(const f32x2*)(OF + o) + *(const f32x2*)(OB + o);
        const float ms = wave_sum(v[0] * v[0] + v[1] * v[1]) * (1.f / 128.f);
        const float rs = 1.0f / sqrtf(ms + EPS);
        const f32x2 z = *(const f32x2*)(P + (size_t)row * LDP + 2560 + h * 128 + c2);
        const f32x2 w = *(const f32x2*)(nw + c2);
        *(unsigned*)(Y + (size_t)row * D + 256 + h * 128 + c2) = pk2(v[0] * rs * w[0] * silu_f(z[0]), v[1] * rs * w[1] * silu_f(z[1]));
    }
}

__device__ __forceinline__ void phase_odd_a(Frame& F, int j) {
    const CAS Args& a = *F.a;
    const float* P = (const float*)(a.ws + WS_P);
    bf16* Y = (bf16*)(a.ws + WS_Y);
    {
        LAS float* tw = (LAS float*)(F.lds + LDS_MAIN - 1024);
        if (F.tid < 64) { tw[F.tid] = cospif((float)F.tid * (1.f / 32.f)); tw[64 + F.tid] = sinpif((float)F.tid * (1.f / 32.f)); }
        __syncthreads();
        float* ZR = (float*)(a.ws + WS_ZR); float* ZI = (float*)(a.ws + WS_ZI);
        const int gw = F.vcu * 8 + F.wave, NGW = F.G * 8;
        for (int it = gw; it < M * 4; it += NGW) {
            const int row = it >> 2, g = it & 3;
            const float x = P[(size_t)row * LDP + 1536 + g * 64 + F.lane];
            float zr = 0.f, zi = 0.f;
#pragma unroll
            for (int c = 0; c < 64; ++c) {
                const float xc = __builtin_bit_cast(float, __builtin_amdgcn_readlane(__builtin_bit_cast(int, x), c));
                const int idx = (F.lane * c) & 63;
                zr += xc * tw[idx]; zi -= xc * tw[64 + idx];
            }
            ZR[(size_t)row * 256 + g * 64 + F.lane] = zr; ZI[(size_t)row * 256 + g * 64 + F.lane] = zi;
        }
        __syncthreads();
    }
    {
        LAS float* Wl = (LAS float*)F.lds;
        LAS float* vn = Wl + 128 * 128;
        const float* nw = a.in[I_SGUN] + j * 768;
        for (int it = F.vcu; it < (M / 128) * NH; it += F.G) {
            const int ch = it / NH, h = it % NH, r0 = ch * 128;
            __syncthreads();
            for (int tt = 0; tt < 16; ++tt) {
                const int s = F.wave * 16 + tt; const float* pr = P + (size_t)(r0 + s) * LDP + 768;
                float g[12]; float sum = 0.f;
#pragma unroll
                for (int q = 0; q < 12; ++q) { g[q] = gelu_tanh(pr[q * 64 + F.lane]); sum += g[q]; }
                const float mu = wave_sum(sum) * (1.f / 768.f); float sq = 0.f;
#pragma unroll
                for (int q = 0; q < 12; ++q) { const float dd = g[q] - mu; sq += dd * dd; }
                const float rstd = 1.0f / sqrtf(wave_sum(sq) * (1.f / 768.f) + EPS);
#pragma unroll
                for (int q = 0; q < 12; ++q) if ((q >> 1) == h) { const int c = (q & 1) * 64 + F.lane; vn[s * 128 + c] = (g[q] - mu) * rstd * nw[h * 128 + c]; }
            }
            const float* Wg = a.in[I_SGUW] + ((size_t)j * NH + h) * 128 * 128;
            for (int i = F.tid; i < 128 * 32; i += 512) *(LAS f32x4*)(Wl + i * 4) = *(const f32x4*)(Wg + i * 4);
            __syncthreads();
            const int p0 = (F.tid >> 4) * 4, c0 = (F.tid & 15) * 8;
            float acc[4][8];
#pragma unroll
            for (int pp = 0; pp < 4; ++pp)
#pragma unroll
                for (int cc = 0; cc < 8; ++cc) acc[pp][cc] = 0.f;
            for (int s = 0; s < 128; ++s) {
                const f32x4 v0 = *(const LAS f32x4*)(vn + s * 128 + c0), v1 = *(const LAS f32x4*)(vn + s * 128 + c0 + 4);
#pragma unroll
                for (int pp = 0; pp < 4; ++pp) {
                    const float w = Wl[(p0 + pp) * 128 + s];
#pragma unroll
                    for (int cc = 0; cc < 4; ++cc) { acc[pp][cc] += w * v0[cc]; acc[pp][4 + cc] += w * v1[cc]; }
                }
            }
            const float* bs = a.in[I_SGUB] + ((size_t)j * NH + h) * 128;
#pragma unroll
            for (int pp = 0; pp < 4; ++pp) {
                const int row = r0 + p0 + pp; const float b = bs[p0 + pp];
                const float* ur = P + (size_t)row * LDP + h * 128 + c0;
                u32x4 o;
                o.x = pk2(gelu_tanh(ur[0]) * (acc[pp][0] + b), gelu_tanh(ur[1]) * (acc[pp][1] + b));
                o.y = pk2(gelu_tanh(ur[2]) * (acc[pp][2] + b), gelu_tanh(ur[3]) * (acc[pp][3] + b));
                o.z = pk2(gelu_tanh(ur[4]) * (acc[pp][4] + b), gelu_tanh(ur[5]) * (acc[pp][5] + b));
                o.w = pk2(gelu_tanh(ur[6]) * (acc[pp][6] + b), gelu_tanh(ur[7]) * (acc[pp][7] + b));
                *(u32x4*)(Y + (size_t)row * D + h * 128 + c0) = o;
            }
        }
        __syncthreads();
    }
}

__device__ __forceinline__ void phase_odd_b(Frame& F) {
    const CAS Args& a = *F.a;
    const float* ZR = (const float*)(a.ws + WS_ZR); const float* ZI = (const float*)(a.ws + WS_ZI); float* SP = (float*)(a.ws + WS_SPEC);
    LAS float* twc = (LAS float*)F.lds;
    LAS float* tws = twc + 1024;
    LAS float* red = tws + 1024;
    constexpr int LAT_ITEMS = LAT_B * (LAT_L / 8), CTX_ITEMS = CTX_B * (CTX_L / 8);
    int curN = 0;
    for (int it = F.vcu; it < LAT_ITEMS + CTX_ITEMS; it += F.G) {
        int row0, N, k0;
        if (it < LAT_ITEMS) { N = LAT_L; row0 = NCTX + (it / (LAT_L / 8)) * LAT_L; k0 = (it % (LAT_L / 8)) * 8; }
        else { const int q = it - LAT_ITEMS; N = CTX_L; row0 = (q / (CTX_L / 8)) * CTX_L; k0 = (q % (CTX_L / 8)) * 8; }
        __syncthreads();
        if (N != curN) {
            for (int i = F.tid; i < N; i += 512) { const float x = 2.0f * (float)i / (float)N; twc[i] = cospif(x); tws[i] = sinpif(x); }
            curN = N;
        }
        __syncthreads();
        const int col = F.tid & 255, nh = F.tid >> 8, nb = nh * (N / 2);
        float acc[8];
#pragma unroll
        for (int q = 0; q < 8; ++q) acc[q] = 0.f;
        for (int n = nb; n < nb + N / 2; ++n) {
            const float zr = ZR[(size_t)(row0 + n) * 256 + col], zi = ZI[(size_t)(row0 + n) * 256 + col];
#pragma unroll
            for (int q = 0; q < 8; ++q) { const int idx = ((k0 + q) * n) & (N - 1); acc[q] += twc[idx] * zr + tws[idx] * zi; }
        }
        if (nh == 1) {
#pragma unroll
            for (int q = 0; q < 8; ++q) red[col * 8 + q] = acc[q];
        }
        __syncthreads();
        if (nh == 0) {
            const float sc = 1.0f / sqrtf(64.0f * (float)N);
#pragma unroll
            for (int q = 0; q < 8; ++q) SP[(size_t)(row0 + k0 + q) * 256 + col] = (acc[q] + red[col * 8 + q]) * sc;
        }
    }
    __syncthreads();
}

__device__ __forceinline__ void phase_odd_c(Frame& F, int j) {
    const CAS Args& a = *F.a;
    const float* SP = (const float*)(a.ws + WS_SPEC); bf16* Y = (bf16*)(a.ws + WS_Y);
    const float* fw = a.in[I_FNETW] + (size_t)j * 4 * 4096;
    const int gw = F.vcu * 8 + F.wave, NGW = F.G * 8;
    for (int it = gw; it < M * 4; it += NGW) {
        const int row = it >> 2, g = it & 3;
        const float d = SP[(size_t)row * 256 + g * 64 + F.lane];
        const float y = wave_matvec64(d, fw + g * 4096, F.lane);
        Y[(size_t)row * D + 768 + g * 64 + F.lane] = (bf16)f2bf(y);
    }
}

constexpr int STEPS = 13, N_PHASES = 1 + DEPTH * STEPS + 1;
__device__ __forceinline__ void run_phase(Frame& F, int ph) {
    const CAS Args& a = *F.a; unsigned char* ws = a.ws;
    if (ph == 0) { phase_setup(F); return; }
    if (ph == N_PHASES - 1) { phase_final(F); return; }
    const int l = (ph - 1) / STEPS, st = (ph - 1) % STEPS, e = l >> 1;
    const bf16* HN = (const bf16*)(ws + WS_HN); bf16* HH = (bf16*)(ws + WS_HH); float* X = (float*)(ws + WS_X); float* P = (float*)(ws + WS_P);
    const bf16* Y = (const bf16*)(ws + WS_Y); const float* mod = (const float*)(ws + WS_MOD);
    switch (st) {
        case 0: phase_norm(F, l, 0); break;
        case 1: { EpiUp E{HH}; gemm_phase<11, EpiUp>(F, HN, (const bf16*)(ws + WS_WUP + (size_t)(l * 2) * WUP_SZ), D, NUP, E); } break;
        case 2: { EpiRes E{X, mod, l, 2, 0.5f}; gemm_phase<4, EpiRes>(F, HH, (const bf16*)(ws + WS_WDN + (size_t)(l * 2) * WDN_SZ), FF, D, E); } break;
        case 3: phase_norm(F, l, 1); break;
        case 4: { EpiStore E{P, LDP};
                  if ((l & 1) == 0) gemm_phase<7, EpiStore>(F, HN, (const bf16*)(ws + WS_EVIN + (size_t)e * EVIN_SZ), D, P_EVEN_PAD, E);
                  else gemm_phase<7, EpiStore>(F, HN, (const bf16*)(ws + WS_ODIN + (size_t)e * ODIN_SZ), D, P_ODD, E); } break;
        case 5: if ((l & 1) == 0) phase_even_pre(F, e); else phase_odd_a(F, e); break;
        case 6: if ((l & 1) == 0) phase_dn_prep(F, e); else phase_odd_b(F); break;
        case 7: if ((l & 1) == 0) phase_dn_scan(F, e); break;
        case 8: if ((l & 1) == 0) phase_dn_fin(F, e); else phase_odd_c(F, e); break;
        case 9: { EpiRes E{X, mod, l, 5, 1.0f}; gemm_phase<4, EpiRes>(F, Y, (const bf16*)(ws + ((l & 1) ? WS_ODOUT : WS_EVOUT) + (size_t)e * SQ_SZ), D, D, E); } break;
        case 10: phase_norm(F, l, 2); break;
        case 11: { EpiUp E{HH}; gemm_phase<11, EpiUp>(F, HN, (const bf16*)(ws + WS_WUP + (size_t)(l * 2 + 1) * WUP_SZ), D, NUP, E); } break;
        case 12: { EpiRes E{X, mod, l, 8, 0.5f}; gemm_phase<4, EpiRes>(F, HH, (const bf16*)(ws + WS_WDN + (size_t)(l * 2 + 1) * WDN_SZ), FF, D, E); } break;
    }
}

__global__ void __launch_bounds__(512, 2) mk_fwd(Args args) {
    extern __shared__ __attribute__((aligned(16))) unsigned char lds_raw[];
    Frame F;
    F.lds = (LAS unsigned char*)lds_raw;
    F.tid = threadIdx.x; F.lane = F.tid & 63; F.wave = __builtin_amdgcn_readfirstlane(F.tid >> 6);
    F.G = gridDim.x; { const int bx = blockIdx.x; F.vcu = (F.G % 8 == 0) ? (bx % 8) * (F.G / 8) + bx / 8 : bx; }
    const CAS Args* ap = (const CAS Args*)__builtin_amdgcn_kernarg_segment_ptr();
    F.a = ap;
    const int ph_lo = ap->ph_lo, ph_hi = ap->ph_hi;
    unsigned char* ws0 = ap->ws;
    volatile LAS unsigned* MISC = (volatile LAS unsigned*)(F.lds + LDS_MISC);
    if (F.tid < 64) MISC[F.tid] = 0u;
    __syncthreads();
    const bool multi = (ph_hi - ph_lo) > 1;
    XcdBarrier bar; bar.bar = (unsigned*)(ws0 + WS_CTL) + CW_BAR; bar.x = 0; bar.st = MISC + 8;
    if (multi) bar = xcd_barrier_post((unsigned*)(ws0 + WS_CTL) + CW_BAR, MISC + 8);
    for (int ph = ph_lo; ph < ph_hi; ++ph) {
        { const CAS Args* a2 = ap; asm volatile("" : "+s"(a2)); F.a = a2; }
        { int t_ = threadIdx.x; asm volatile("" : "+v"(t_)); F.tid = t_; F.lane = t_ & 63; F.wave = __builtin_amdgcn_readfirstlane(t_ >> 6); }
        if (ph >= 1 && ph < N_PHASES - 1 && (ph - 1) % STEPS == 7 && ((((ph - 1) / STEPS) & 1) == 1)) continue;
        run_phase(F, ph);
        if (ph + 1 < ph_hi) xcd_barrier(bar);
    }
}

extern "C" void kernel_launch(void* const* d_in, const int* in_sizes, int n_in, void* d_out, int out_size, void* d_ws, size_t ws_size, hipStream_t stream) {
    static int grid = 0;
    if (grid == 0) {
        if (n_in != 31 || ws_size < WS_END) { fprintf(stderr, "kernel_launch: unexpected n_in %d or ws_size %zu (need %zu)\n", n_in, ws_size, (size_t)WS_END); grid = -1; return; }
        int dev = 0, cus = 0;
        if (hipGetDevice(&dev) != hipSuccess || hipDeviceGetAttribute(&cus, hipDeviceAttributeMultiprocessorCount, dev) != hipSuccess) { grid = -1; return; }
        if (hipFuncSetAttribute((const void*)mk_fwd, hipFuncAttributeMaxDynamicSharedMemorySize, LDS_BYTES) != hipSuccess) { fprintf(stderr, "kernel_launch: hipFuncSetAttribute failed\n"); grid = -1; return; }
        (void)hipGetLastError();
        grid = cus;
    }
    if (grid < 0) return;
    (void)hipMemsetAsync((char*)d_ws + WS_CTL, 0, CTL_BYTES, stream);
    Args a{};
    for (int i = 0; i < 31; ++i) a.in[i] = (const float*)d_in[i];
    a.out = (float*)d_out; a.ws = (unsigned char*)d_ws;
#if ONE_LAUNCH
    a.ph_lo = 0; a.ph_hi = N_PHASES;
    hipLaunchKernelGGL(mk_fwd, dim3(grid), dim3(512), LDS_BYTES, stream, a);
#else
    for (int ph = 0; ph < N_PHASES; ++ph) {
        a.ph_lo = ph; a.ph_hi = ph + 1;
        hipLaunchKernelGGL(mk_fwd, dim3(grid), dim3(512), LDS_BYTES, stream, a);
    }
#endif
}
```

```cpp
#include <hip/hip_runtime.h>
#include <cstdio>
#include <cstdint>

#ifndef ONE_LAUNCH
#define ONE_LAUNCH 1
#endif

#define GAS __attribute__((address_space(1)))
#define LAS __attribute__((address_space(3)))
#define CAS __attribute__((address_space(4)))
typedef unsigned short bf16;
typedef float f32x4 __attribute__((ext_vector_type(4)));
typedef float f32x2 __attribute__((ext_vector_type(2)));
typedef short bf16x8 __attribute__((ext_vector_type(8)));
typedef unsigned u32x4 __attribute__((ext_vector_type(4)));
typedef unsigned u32x2 __attribute__((ext_vector_type(2)));

constexpr int D = 1024, NCTX = 4096, NLAT = 2048, M = 6144, FF = 2816, DEPTH = 4;
constexpr int CTX_B = 16, CTX_L = 256, LAT_B = 2, LAT_L = 1024;
constexpr int NUP = 2 * FF;
constexpr int P_EVEN = 3352, P_EVEN_PAD = 3584, P_ODD = 1792;
constexpr int LDP = 3584;
constexpr int NH = 6, DK = 128;
constexpr float EPS = 1e-6f;
constexpr int NSEQ = CTX_B + LAT_B;

constexpr size_t MiB = 1u << 20;
constexpr size_t WS_CTL = 0, CTL_BYTES = 1 * MiB;
constexpr size_t WS_MOD = 1 * MiB;
constexpr size_t WS_WUP = 2 * MiB, WUP_SZ = 11 * MiB;
constexpr size_t WS_WDN = 90 * MiB, WDN_SZ = 5632 * 1024;
constexpr size_t WS_EVIN = 134 * MiB, EVIN_SZ = 7 * MiB;
constexpr size_t WS_EVOUT = 148 * MiB, SQ_SZ = 2 * MiB;
constexpr size_t WS_ODIN = 152 * MiB, ODIN_SZ = 4 * MiB;
constexpr size_t WS_ODOUT = 160 * MiB;
constexpr size_t WS_X = 164 * MiB;
constexpr size_t WS_HN = 188 * MiB;
constexpr size_t WS_HH = 200 * MiB;
constexpr size_t WS_P = 233 * MiB;
constexpr size_t WS_Y = 317 * MiB;
constexpr size_t WS_QN = 329 * MiB, WS_KN = 347 * MiB, WS_VV = 365 * MiB, WS_OF = 383 * MiB, WS_OB = 401 * MiB;
constexpr size_t WS_AG = 419 * MiB, WS_BT = 420 * MiB;
constexpr size_t WS_ZR = 421 * MiB, WS_ZI = 427 * MiB, WS_SPEC = 433 * MiB;
constexpr size_t WS_DW = 439 * MiB, WS_DQ = 457 * MiB, WS_DAI = 475 * MiB, WS_DKT = 484 * MiB, WS_DUT = 502 * MiB, WS_DGL = 520 * MiB;
constexpr size_t WS_END = 521 * MiB;

constexpr size_t CTL_ST_OFF = 262144;
constexpr size_t WS_SGUW = 1 * MiB + 512 * 1024;
constexpr int CW_BAR = 4096;

constexpr int LDS_MAIN = 155648;
constexpr int LDS_MISC = LDS_MAIN;
constexpr int LDS_BYTES = LDS_MAIN + 1024;

__device__ __forceinline__ float wave_sum(float v) {
#pragma unroll
    for (int o = 1; o < 64; o <<= 1) v += __shfl_xor(v, o);
    return v;
}
__device__ __forceinline__ unsigned f2bf(float f) { unsigned u = __builtin_bit_cast(unsigned, f); return (u + 0x7fffu + ((u >> 16) & 1u)) >> 16; }
__device__ __forceinline__ unsigned pk2(float lo, float hi) { return f2bf(lo) | (f2bf(hi) << 16); }
__device__ __forceinline__ float silu_f(float x) { return x / (1.f + __expf(-x)); }
__device__ __forceinline__ float sigmoid_f(float x) { return 1.f / (1.f + __expf(-x)); }
__device__ __forceinline__ float gelu_tanh(float x) { const float u = 0.7978845608028654f * (x + 0.044715f * x * x * x); return 0.5f * x * (1.f + tanhf(u)); }
__device__ __forceinline__ float softplus_f(float x) { return x > 20.f ? x : log1pf(expf(x)); }
__device__ __forceinline__ int cond_of_row(int r) { return r < NCTX ? 0 : (r < NCTX + LAT_L ? 1 : 2); }
__device__ __forceinline__ void seq_of_row(int r, int& s0, int& L) { if (r < NCTX) { s0 = r & ~(CTX_L - 1); L = CTX_L; } else { s0 = NCTX + ((r - NCTX) & ~(LAT_L - 1)); L = LAT_L; } }

#define XB_TMO      128
#define XB_XCNT(j)  (256  + 64 * (j))
#define XB_XSUB(j)  (1280 + 64 * (j))
#define XB_XGEN(j)  (2304 + 64 * (j))
#define XB_TOP      3328
#define XB_TOPGEN   3392
#define XCD_BAR_WORDS 3456
#define XB_SPIN_CAP (1u << 18)
__device__ __forceinline__ unsigned xb_ld(unsigned* p)              { return __hip_atomic_load(p, __ATOMIC_RELAXED, __HIP_MEMORY_SCOPE_AGENT); }
__device__ __forceinline__ unsigned xb_add(unsigned* p, unsigned v) { return __hip_atomic_fetch_add(p, v, __ATOMIC_RELAXED, __HIP_MEMORY_SCOPE_AGENT); }
__device__ __forceinline__ unsigned xb_xcc_id() { return (unsigned)__builtin_amdgcn_s_getreg((3 << 11) | 20) & 0xFu; }
#define XB_SPIN(cond, bar) do { unsigned _sp = 0; while (cond) { __builtin_amdgcn_s_sleep(1); \
    if ((++_sp & 255u) == 0u) { if (xb_ld(&(bar)[XB_TMO])) break; if (_sp > XB_SPIN_CAP) { atomicAdd(&(bar)[XB_TMO], 1u); break; } } } } while (0)
struct XcdBarrier { unsigned* bar; unsigned x; volatile LAS unsigned* st; };
__device__ __forceinline__ XcdBarrier xcd_barrier_post(unsigned* bar, volatile LAS unsigned* st) {
    XcdBarrier b; b.bar = bar; b.x = xb_xcc_id(); b.st = st;
    if (threadIdx.x == 0) (void)xb_add(&bar[XB_XCNT(b.x)], 1u);
    return b;
}
__device__ __forceinline__ void xcd_barrier_complete(unsigned* bar, unsigned x, unsigned& nloc, unsigned& nx) {
    const unsigned G = gridDim.x * gridDim.y * gridDim.z;
    unsigned sum, cnt, mine, sp = 0u;
    for (;;) {
        sum = 0u; cnt = 0u; mine = 0u;
#pragma unroll
        for (unsigned j = 0; j < 16; ++j) { const unsigned c = xb_ld(&bar[XB_XCNT(j)]); sum += c; cnt += (c > 0u) ? 1u : 0u; mine = (j == x) ? c : mine; }
        if (sum == G) break;
        __builtin_amdgcn_s_sleep(1);
        if ((++sp & 255u) == 0u) { if (xb_ld(&bar[XB_TMO])) break; if (sp > XB_SPIN_CAP) { atomicAdd(&bar[XB_TMO], 1u); break; } }
    }
    nloc = mine > 0u ? mine : 1u; nx = cnt > 0u ? cnt : 1u;
}
__device__ __forceinline__ void xcd_barrier(const XcdBarrier& b) {
    asm volatile("s_waitcnt vmcnt(0)" ::: "memory");
    __syncthreads();
    if (threadIdx.x == 0) {
        unsigned* bar = b.bar;
        __builtin_amdgcn_s_waitcnt(0);
        unsigned nloc = b.st[0], nx = b.st[1];
        if (nloc == 0u) { xcd_barrier_complete(bar, b.x, nloc, nx); b.st[0] = nloc; b.st[1] = nx; }
        const unsigned old = xb_add(&bar[XB_XSUB(b.x)], 1u);
        const unsigned gen = old / nloc;
        if (old + 1u == (gen + 1u) * nloc) {
            __builtin_amdgcn_fence(__ATOMIC_RELEASE, "agent");
            asm volatile("s_waitcnt vmcnt(0)" ::: "memory");
            const unsigned og = xb_add(&bar[XB_TOP], 1u);
            const unsigned tg = og / nx;
            if (og + 1u == (tg + 1u) * nx) xb_add(&bar[XB_TOPGEN], 1u);
            else XB_SPIN(xb_ld(&bar[XB_TOPGEN]) == tg, bar);
            __builtin_amdgcn_fence(__ATOMIC_ACQUIRE, "agent");
            xb_add(&bar[XB_XGEN(b.x)], 1u);
            asm volatile("s_waitcnt vmcnt(0)" ::: "memory");
        } else {
            XB_SPIN(xb_ld(&bar[XB_XGEN(b.x)]) == gen, bar);
            __builtin_amdgcn_fence(__ATOMIC_ACQUIRE, "agent");
            asm volatile("s_waitcnt vmcnt(0)" ::: "memory");
        }
    }
    __syncthreads();
}

struct Args { const float* in[31]; float* out; unsigned char* ws; int ph_lo, ph_hi; };
enum { I_XP = 0, I_XS, I_STATE, I_C, I_CCTX, I_F1N, I_F1G, I_F1U, I_F1D, I_MIXN, I_F2N, I_F2G, I_F2U, I_F2D, I_ADAW, I_ADAB, I_EVIN, I_EVOUT,
       I_POOLW, I_POOLS, I_CONVW, I_ALOG, I_DTB, I_DNNW, I_ODIN, I_ODOUT, I_SGUN, I_SGUW, I_SGUB, I_FNETW, I_FINN };

struct Frame {
    LAS unsigned char* lds;
    int tid, lane, wave, vcu, G;
    const CAS Args* a;
};

#define DS_READ128(dst, addr) asm volatile("ds_read_b128 %0, %1" : "=v"(dst) : "v"((unsigned)(addr)))
__device__ __forceinline__ void lgkm_wait(int n) {
    switch (n) { case 0: asm volatile("s_waitcnt lgkmcnt(0)" ::: "memory"); break; case 1: asm volatile("s_waitcnt lgkmcnt(1)" ::: "memory"); break;
                 case 2: asm volatile("s_waitcnt lgkmcnt(2)" ::: "memory"); break; default: asm volatile("s_waitcnt lgkmcnt(3)" ::: "memory"); break; }
}
template <int NFRAG, class Epi>
__device__ __forceinline__ void gemm_tile(LAS unsigned char* lds, const int tid, const bf16* A, const bf16* Bt, int K, int row0, int col0, const Epi& E) {
    constexpr int BN = 32 * NFRAG, NPB = BN / 8, A_BYTES = 192 * 128, B_BYTES = BN * 128, STAGE = A_BYTES + B_BYTES, NBI = (NPB + 7) / 8;
    static_assert(2 * STAGE <= LDS_MAIN, "LDS");
    const int lane = tid & 63, wid = __builtin_amdgcn_readfirstlane(tid >> 6), wm = wid >> 1, wn = wid & 1, fr = lane & 15, fq = lane >> 4;
    const int r = lane >> 3, slot = lane & 7;
    const int srow = wid * 8 + r;
    const int chunk = slot ^ ((srow >> 1) & 7);
    const char* gA = (const char*)(A + (size_t)(row0 + srow) * K) + chunk * 16;
    const char* gB = (const char*)(Bt + (size_t)(col0 + srow) * K) + chunk * 16;
    const size_t pstep = (size_t)64 * K * 2;
    const int nt = K / 64;
    const unsigned ldsb = (unsigned)(uintptr_t)lds;
    const int rowA0 = wm * 48 + fr, rowB0 = wn * NFRAG * 16 + fr;
    int offA[2], offB[2];
#pragma unroll
    for (int kk = 0; kk < 2; ++kk) {
        offA[kk] = rowA0 * 128 + (((kk * 4 + fq) ^ ((rowA0 >> 1) & 7)) << 4);
        offB[kk] = A_BYTES + rowB0 * 128 + (((kk * 4 + fq) ^ ((rowB0 >> 1) & 7)) << 4);
    }
    f32x4 acc[3][NFRAG];
#pragma unroll
    for (int i = 0; i < 3; ++i)
#pragma unroll
        for (int j = 0; j < NFRAG; ++j) acc[i][j] = (f32x4){0.f, 0.f, 0.f, 0.f};

#define GEMM_STAGE(buf, t) do { LAS unsigned char* sA_ = lds + (buf) * STAGE + wid * 1024; \
        _Pragma("unroll") for (int i_ = 0; i_ < 3; ++i_) \
            __builtin_amdgcn_global_load_lds((const unsigned*)(gA + i_ * pstep + (size_t)(t) * 128), (LAS unsigned*)(sA_ + i_ * 8192), 16, 0, 0); \
        _Pragma("unroll") for (int i_ = 0; i_ < NBI; ++i_) if (wid + 8 * i_ < NPB) \
            __builtin_amdgcn_global_load_lds((const unsigned*)(gB + i_ * pstep + (size_t)(t) * 128), (LAS unsigned*)(sA_ + A_BYTES + i_ * 8192), 16, 0, 0); } while (0)

    GEMM_STAGE(0, 0);
    for (int t = 0; t < nt; ++t) {
        asm volatile("s_waitcnt vmcnt(0)" ::: "memory");
        __syncthreads();
        if (t + 1 < nt) GEMM_STAGE((t + 1) & 1, t + 1);
        {
            const unsigned sbo = (unsigned)(t & 1) * STAGE;
            const unsigned aA0 = ldsb + sbo + offA[0], aA1 = ldsb + sbo + offA[1], aB0 = ldsb + sbo + offB[0], aB1 = ldsb + sbo + offB[1];
            bf16x8 af[2][3], bq[4];
#pragma unroll
            for (int mf = 0; mf < 3; ++mf) { DS_READ128(af[0][mf], aA0 + mf * 2048); }
#pragma unroll
            for (int mf = 0; mf < 3; ++mf) { DS_READ128(af[1][mf], aA1 + mf * 2048); }
            constexpr int TOT = 2 * NFRAG;
#pragma unroll
            for (int f = 0; f < 3; ++f) { DS_READ128(bq[f], aB0 + f * 2048); }
#pragma unroll
            for (int f = 0; f < TOT; ++f) {
                if (f + 3 < TOT) { const int g = f + 3; DS_READ128(bq[g & 3], ((g >= NFRAG) ? aB1 + (g - NFRAG) * 2048 : aB0 + g * 2048)); }
                const int outstanding = (f + 3 < TOT) ? 3 : (TOT - 1 - f);
                lgkm_wait(outstanding);
                asm volatile("" : "+v"(bq[f & 3]));
                __builtin_amdgcn_sched_barrier(0);
                const int kk = (f >= NFRAG) ? 1 : 0, nf = f - kk * NFRAG;
#pragma unroll
                for (int mf = 0; mf < 3; ++mf) acc[mf][nf] = __builtin_amdgcn_mfma_f32_16x16x32_bf16(bq[f & 3], af[kk][mf], acc[mf][nf], 0, 0, 0);
            }
        }
    }
#undef GEMM_STAGE
    E(acc, row0 + wm * 48 + fr, col0 + wn * NFRAG * 16 + fq * 4, fq);
    __syncthreads();
}

struct EpiUp {
    bf16* H;
    template <int NFRAG> __device__ __forceinline__ void operator()(f32x4 (&acc)[3][NFRAG], int row, int colq, int fq) const {
#pragma unroll
        for (int mf = 0; mf < 3; ++mf)
#pragma unroll
            for (int nf = 0; nf < NFRAG; ++nf) {
                f32x4 v = acc[mf][nf], o;
                o[0] = __shfl_xor(v[0], 16); o[1] = __shfl_xor(v[1], 16); o[2] = __shfl_xor(v[2], 16); o[3] = __shfl_xor(v[3], 16);
                if ((fq & 1) == 0) {
                    const int c = colq + nf * 16;
                    const int hid = (c >> 3) * 4;
                    u32x2 w; w.x = pk2(silu_f(v[0]) * o[0], silu_f(v[1]) * o[1]); w.y = pk2(silu_f(v[2]) * o[2], silu_f(v[3]) * o[3]);
                    *(u32x2*)(H + (size_t)(row + mf * 16) * FF + hid) = w;
                }
            }
    }
};
struct EpiRes {
    float* X; const float* mod; int layer, gidx; float scale;
    template <int NFRAG> __device__ __forceinline__ void operator()(f32x4 (&acc)[3][NFRAG], int row, int colq, int) const {
#pragma unroll
        for (int mf = 0; mf < 3; ++mf) {
            const int rr = row + mf * 16;
            const float* g = mod + ((size_t)(layer * 3 + cond_of_row(rr)) * 9 + gidx) * 1024;
#pragma unroll
            for (int nf = 0; nf < NFRAG; ++nf) {
                const int c = colq + nf * 16;
                const f32x4 gv = *(const f32x4*)(g + c);
                f32x4* xp = (f32x4*)(X + (size_t)rr * D + c);
                f32x4 xv = *xp;
                xv += acc[mf][nf] * gv * scale;
                *xp = xv;
            }
        }
    }
};
struct EpiStore {
    float* P; int ld;
    template <int NFRAG> __device__ __forceinline__ void operator()(f32x4 (&acc)[3][NFRAG], int row, int colq, int) const {
#pragma unroll
        for (int mf = 0; mf < 3; ++mf)
#pragma unroll
            for (int nf = 0; nf < NFRAG; ++nf) *(f32x4*)(P + (size_t)(row + mf * 16) * ld + colq + nf * 16) = acc[mf][nf];
    }
};

template <int NFRAG, class Epi>
__device__ __forceinline__ void gemm_phase(Frame& F, const bf16* A, const bf16* Bt, int K, int N, const Epi& E) {
    constexpr int BN = 32 * NFRAG;
    const int NT = N / BN, nitems = 32 * NT;
    for (int i = F.vcu; i < nitems; i += F.G) {
        const int panel = (i >> 3) & 31, ct = (i & 7) + 8 * (i >> 8);
        gemm_tile<NFRAG, Epi>(F.lds, F.tid, A, Bt, K, panel * 192, ct * BN, E);
    }
}

__device__ __forceinline__ void transpose_item(const float* W, int K, int N, int ldw, bf16* WT, int mode, LAS float* scr, int item, int lane) {
    const int nblk = (N + 31) / 32, kb = item / nblk, nb = item % nblk, k0 = 64 * kb, n0 = 32 * nb;
    const int nn = n0 + (lane & 31);
#pragma unroll 8
    for (int i = 0; i < 32; ++i) { const int kk = 2 * i + (lane >> 5); scr[kk * 33 + (lane & 31)] = (nn < N) ? W[(size_t)(k0 + kk) * ldw + nn] : 0.f; }
    asm volatile("s_waitcnt lgkmcnt(0)" ::: "memory");
    const int c = lane & 7;
#pragma unroll
    for (int j = 0; j < 4; ++j) {
        const int nl = (lane >> 3) + 8 * j, n = n0 + nl; const LAS float* s = scr + (8 * c) * 33 + nl;
        u32x4 o; o.x = pk2(s[0 * 33], s[1 * 33]); o.y = pk2(s[2 * 33], s[3 * 33]); o.z = pk2(s[4 * 33], s[5 * 33]); o.w = pk2(s[6 * 33], s[7 * 33]);
        const int dr = (mode == 0) ? n : ((n >> 2) * 8 + (n & 3) + (mode == 2 ? 4 : 0));
        if (n < N) *(u32x4*)(WT + (size_t)dr * K + k0 + 8 * c) = o;
    }
    asm volatile("s_waitcnt lgkmcnt(0)" ::: "memory");
}

__device__ __forceinline__ void phase_setup(Frame& F) {
    const CAS Args& a = *F.a;
    unsigned char* ws = a.ws;
    {
        LAS float* sc = (LAS float*)F.lds;
        LAS float* red = sc + 3 * 1024;
        for (int i = F.tid; i < 3 * 1024; i += 512) { const int c = i >> 10, k = i & 1023; const float v = (c == 0) ? a.in[I_CCTX][k] : a.in[I_C][(c - 1) * 1024 + k]; sc[i] = silu_f(v); }
        __syncthreads();
        float* mod = (float*)(ws + WS_MOD);
        for (int it = F.vcu; it < 4 * 72; it += F.G) {
            const int l = it / 72, cb = it % 72, q = F.tid & 31, kg = F.tid >> 5;
            const float* W = a.in[I_ADAW] + (size_t)l * 1024 * 9216 + cb * 128 + q * 4;
            f32x4 s0 = {0, 0, 0, 0}, s1 = s0, s2 = s0;
#pragma unroll 4
            for (int k = kg * 64; k < kg * 64 + 64; ++k) {
                const f32x4 w = *(const f32x4*)(W + (size_t)k * 9216);
                s0 += w * sc[k]; s1 += w * sc[1024 + k]; s2 += w * sc[2048 + k];
            }
            LAS float* rp = red + (kg * 32 + q) * 12;
#pragma unroll
            for (int j = 0; j < 4; ++j) { rp[j] = s0[j]; rp[4 + j] = s1[j]; rp[8 + j] = s2[j]; }
            __syncthreads();
            if (F.tid < 384) {
                const int qq = F.tid / 12, v = F.tid % 12; float s = 0.f;
#pragma unroll
                for (int g = 0; g < 16; ++g) s += red[(g * 32 + qq) * 12 + v];
                const int c = v >> 2, j = v & 3, n = cb * 128 + qq * 4 + j;
                mod[(size_t)(l * 3 + c) * 9216 + n] = s + a.in[I_ADAB][l * 9216 + n];
            }
            __syncthreads();
        }
        __syncthreads();
    }
    {
        LAS float* T = (LAS float*)F.lds;
        LAS float* wt = T + 64 * 128;
        LAS float* tw = wt + 64 * 65;
        if (F.tid < 64) { tw[F.tid] = cospif((float)F.tid * (1.f / 32.f)); tw[64 + F.tid] = sinpif((float)F.tid * (1.f / 32.f)); }
        __syncthreads();
        for (int it = F.vcu; it < 2 * 4 * 16; it += F.G) {
            const int j = it >> 6, g = (it >> 4) & 3, k0 = (it & 15) * 64;
            const float* Wg = a.in[I_FNETW] + ((size_t)j * 4 + g) * 4096;
            {
                const int c = F.tid >> 3, eb = (F.tid & 7) * 8;
                float ac[8], as[8];
#pragma unroll
                for (int q = 0; q < 8; ++q) { ac[q] = 0.f; as[q] = 0.f; }
                for (int m = 0; m < 64; ++m) {
                    const int idx = (m * c) & 63; const float cs = tw[idx], sn = tw[64 + idx];
                    const f32x4 w0 = *(const f32x4*)(Wg + m * 64 + eb), w1 = *(const f32x4*)(Wg + m * 64 + eb + 4);
#pragma unroll
                    for (int q = 0; q < 4; ++q) { ac[q] += cs * w0[q]; ac[4 + q] += cs * w1[q]; as[q] -= sn * w0[q]; as[4 + q] -= sn * w1[q]; }
                }
#pragma unroll
                for (int q = 0; q < 8; ++q) { T[c * 128 + eb + q] = ac[q] * 0.125f; T[c * 128 + 64 + eb + q] = as[q] * 0.125f; }
                const int kk = F.tid >> 3, c8 = (F.tid & 7) * 8;
                const float* wp = a.in[I_ODIN] + (size_t)j * D * P_ODD + (size_t)(k0 + kk) * P_ODD + 1536 + g * 64 + c8;
                const f32x4 x0 = *(const f32x4*)wp, x1 = *(const f32x4*)(wp + 4);
#pragma unroll
                for (int q = 0; q < 4; ++q) { wt[kk * 65 + c8 + q] = x0[q]; wt[kk * 65 + c8 + 4 + q] = x1[q]; }
            }
            __syncthreads();
            {
                const int col = F.tid & 127, kq = F.tid >> 7;
                float acc[16];
#pragma unroll
                for (int q = 0; q < 16; ++q) acc[q] = 0.f;
                for (int c = 0; c < 64; ++c) {
                    const float t = T[c * 128 + col];
#pragma unroll
                    for (int q = 0; q < 16; ++q) acc[q] += wt[(kq * 16 + q) * 65 + c] * t;
                }
                const int drow = 1536 + ((col < 64) ? (g * 64 + col) : (256 + g * 64 + col - 64));
                bf16* dst = (bf16*)(ws + WS_ODIN + (size_t)j * ODIN_SZ) + (size_t)drow * D + k0 + kq * 16;
                u32x4 o0, o1;
                o0.x = pk2(acc[0], acc[1]); o0.y = pk2(acc[2], acc[3]); o0.z = pk2(acc[4], acc[5]); o0.w = pk2(acc[6], acc[7]);
                o1.x = pk2(acc[8], acc[9]); o1.y = pk2(acc[10], acc[11]); o1.z = pk2(acc[12], acc[13]); o1.w = pk2(acc[14], acc[15]);
                *(u32x4*)dst = o0; *(u32x4*)(dst + 8) = o1;
            }
            __syncthreads();
        }
        const int gw = F.vcu * 8 + F.wave, NGW = F.G * 8;
        for (int it = gw; it < 2 * NH * 16384 / 512; it += NGW) {
            const float* sp = a.in[I_SGUW] + (size_t)it * 512 + F.lane * 8;
            const f32x4 x0 = *(const f32x4*)sp, x1 = *(const f32x4*)(sp + 4);
            u32x4 o; o.x = pk2(x0[0], x0[1]); o.y = pk2(x0[2], x0[3]); o.z = pk2(x1[0], x1[1]); o.w = pk2(x1[2], x1[3]);
            *(u32x4*)((bf16*)(ws + WS_SGUW) + (size_t)it * 512 + F.lane * 8) = o;
        }
        __syncthreads();
    }
    {
        LAS float* scr = (LAS float*)(F.lds + F.wave * 16384);
        const int gw = F.vcu * 8 + F.wave, NGW = F.G * 8;
        constexpr int IT_G = 16 * 88, IT_D = 44 * 32, IT_EVIN = 16 * 105, IT_SQ = 16 * 32, IT_ODIN = 16 * 48;
        static_assert(IT_G == IT_D, "decode");
        constexpr int PER_FFN = 2 * IT_G + IT_D;
        constexpr int TOT = 8 * PER_FFN + 2 * (IT_EVIN + IT_SQ + IT_ODIN + IT_SQ);
        for (int it = gw; it < TOT; it += NGW) {
            int r = it; const float* W; bf16* WT; int K, N, mode, ldw = 0;
            if (r < 8 * PER_FFN) {
                const int f = r / PER_FFN, l = f >> 1, s = f & 1; r -= f * PER_FFN;
                const int sub = r / IT_G; r -= sub * IT_G;
                const int idx = (sub == 0) ? (s ? I_F2G : I_F1G) : ((sub == 1) ? (s ? I_F2U : I_F1U) : (s ? I_F2D : I_F1D));
                W = a.in[idx] + (size_t)l * D * FF;
                WT = (sub == 2) ? (bf16*)(ws + WS_WDN + (size_t)f * WDN_SZ) : (bf16*)(ws + WS_WUP + (size_t)f * WUP_SZ);
                K = (sub == 2) ? FF : D; N = (sub == 2) ? D : FF; mode = (sub == 2) ? 0 : sub + 1;
            } else {
                r -= 8 * PER_FFN;
                constexpr int PER_E = IT_EVIN + IT_SQ + IT_ODIN + IT_SQ;
                const int e = r / PER_E; r -= e * PER_E;
                K = D; mode = 0;
                if (r < IT_EVIN) { W = a.in[I_EVIN] + (size_t)e * D * P_EVEN; N = P_EVEN; WT = (bf16*)(ws + WS_EVIN + (size_t)e * EVIN_SZ); }
                else if (r < IT_EVIN + IT_SQ) { r -= IT_EVIN; W = a.in[I_EVOUT] + (size_t)e * D * D; N = D; WT = (bf16*)(ws + WS_EVOUT + (size_t)e * SQ_SZ); }
                else if (r < IT_EVIN + IT_SQ + IT_ODIN) { r -= IT_EVIN + IT_SQ; W = a.in[I_ODIN] + (size_t)e * D * P_ODD; N = 1536; ldw = P_ODD; WT = (bf16*)(ws + WS_ODIN + (size_t)e * ODIN_SZ); }
                else { r -= IT_EVIN + IT_SQ + IT_ODIN; W = a.in[I_ODOUT] + (size_t)e * D * D; N = D; WT = (bf16*)(ws + WS_ODOUT + (size_t)e * SQ_SZ); }
            }
            transpose_item(W, K, N, ldw ? ldw : N, WT, mode, scr, r, F.lane);
        }
        for (int it = gw; it < 2 * (P_EVEN_PAD - P_EVEN); it += NGW) {
            const int e = it / (P_EVEN_PAD - P_EVEN), rr = P_EVEN + it % (P_EVEN_PAD - P_EVEN);
            u32x4* p = (u32x4*)((bf16*)(ws + WS_EVIN + (size_t)e * EVIN_SZ) + (size_t)rr * D);
            p[F.lane] = (u32x4){0, 0, 0, 0}; p[64 + F.lane] = (u32x4){0, 0, 0, 0};
        }
        float* X = (float*)(ws + WS_X);
        for (int row = gw; row < M; row += NGW) {
            float* xo = X + (size_t)row * D;
            if (row < NCTX) {
                const f32x4* src = (const f32x4*)(a.in[I_XP] + (size_t)row * D);
#pragma unroll
                for (int j = 0; j < 4; ++j) ((f32x4*)xo)[j * 64 + F.lane] = src[j * 64 + F.lane];
            } else {
                const int t = (row - NCTX) & (LAT_L - 1); const float pr = (float)(t >> 6), pc = (float)(t & 63);
                const float* src = a.in[I_XS] + (size_t)(row - NCTX) * D;
#pragma unroll
                for (int j = 0; j < 16; ++j) {
                    const int ch = j * 64 + F.lane, seg = ch >> 8, i = ch & 255;
                    const float freq = expf(-9.210340371976184f * (float)i * (1.0f / 256.0f));
                    const float ang = ((seg < 2) ? pr : pc) * freq;
                    const float pe = (seg & 1) ? cosf(ang) : sinf(ang);
                    xo[ch] = src[ch] + pe;
                }
            }
        }
    }
}

__device__ __forceinline__ void phase_norm(Frame& F, int layer, int which) {
    const CAS Args& a = *F.a;
    const float* X = (const float*)(a.ws + WS_X); bf16* HN = (bf16*)(a.ws + WS_HN);
    const float* mod = (const float*)(a.ws + WS_MOD);
    const float* nw = a.in[which == 0 ? I_F1N : (which == 1 ? I_MIXN : I_F2N)] + layer * D;
    const int gw = F.vcu * 8 + F.wave, NGW = F.G * 8;
    for (int row = gw; row < M; row += NGW) {
        const f32x4* xr = (const f32x4*)(X + (size_t)row * D) + F.lane;
        f32x4 v[4]; float s = 0.f;
#pragma unroll
        for (int j = 0; j < 4; ++j) { v[j] = xr[64 * j]; s += v[j][0] * v[j][0] + v[j][1] * v[j][1] + v[j][2] * v[j][2] + v[j][3] * v[j][3]; }
        const float rstd = 1.0f / sqrtf(wave_sum(s) * (1.f / D) + EPS);
        const float* mb = mod + ((size_t)(layer * 3 + cond_of_row(row)) * 9 + which * 3) * 1024;
        u32x2* o = (u32x2*)(HN + (size_t)row * D) + F.lane;
#pragma unroll
        for (int j = 0; j < 4; ++j) {
            const int k = (64 * j + F.lane) * 4;
            const f32x4 w = *(const f32x4*)(nw + k), sh = *(const f32x4*)(mb + k), sc = *(const f32x4*)(mb + 1024 + k);
            const f32x4 h = (v[j] * rstd * w) * (sc + 1.0f) + sh;
            u32x2 pkd; pkd.x = pk2(h[0], h[1]); pkd.y = pk2(h[2], h[3]);
            o[64 * j] = pkd;
        }
    }
}

__device__ __forceinline__ void phase_final(Frame& F) {
    const CAS Args& a = *F.a;
    const float* X = (const float*)(a.ws + WS_X);
    const float* nw = a.in[I_FINN];
    const int gw = F.vcu * 8 + F.wave, NGW = F.G * 8;
    for (int row = gw; row < M; row += NGW) {
        const f32x4* xr = (const f32x4*)(X + (size_t)row * D) + F.lane;
        f32x4 v[4]; float s = 0.f;
#pragma unroll
        for (int j = 0; j < 4; ++j) { v[j] = xr[64 * j]; s += v[j][0] * v[j][0] + v[j][1] * v[j][1] + v[j][2] * v[j][2] + v[j][3] * v[j][3]; }
        const float rstd = 1.0f / sqrtf(wave_sum(s) * (1.f / D) + EPS);
        f32x4* o = (f32x4*)(a.out + (size_t)row * D) + F.lane;
#pragma unroll
        for (int j = 0; j < 4; ++j) { const f32x4 w = *(const f32x4*)(nw + (64 * j + F.lane) * 4); o[64 * j] = v[j] * rstd * w; }
    }
}

__device__ __forceinline__ float wave_matvec64(float d, const float* W, int lane) {
    float y = 0.f;
#pragma unroll
    for (int c = 0; c < 64; ++c) { const float dc = __builtin_bit_cast(float, __builtin_amdgcn_readlane(__builtin_bit_cast(int, d), c)); y += dc * W[c * 64 + lane]; }
    return y;
}

__device__ __forceinline__ void phase_even_pre(Frame& F, int e) {
    const CAS Args& a = *F.a;
    const float* P = (const float*)(a.ws + WS_P);
    float* QN = (float*)(a.ws + WS_QN); float* KN = (float*)(a.ws + WS_KN); float* VV = (float*)(a.ws + WS_VV);
    float* AG = (float*)(a.ws + WS_AG); float* BT = (float*)(a.ws + WS_BT);
    bf16* Y = (bf16*)(a.ws + WS_Y);
    const float* cw = a.in[I_CONVW] + (size_t)e * 3 * 2304;
    const int gw = F.vcu * 8 + F.wave, NGW = F.G * 8;
    for (int it = gw; it < M * NH; it += NGW) {
        const int row = it / NH, h = it % NH; int s0, L; seq_of_row(row, s0, L);
        const int t = row - s0; const bool hp = t > 0, hn = t < L - 1;
        const int c2 = F.lane * 2;
        float res[3][2];
#pragma unroll
        for (int part = 0; part < 3; ++part) {
            const int pc = 256 + part * 768 + h * 128 + c2, wc = part * 768 + h * 128 + c2;
            const f32x2 x1 = *(const f32x2*)(P + (size_t)row * LDP + pc);
            const f32x2 x0 = hp ? *(const f32x2*)(P + (size_t)(row - 1) * LDP + pc) : (f32x2){0.f, 0.f};
            const f32x2 x2 = hn ? *(const f32x2*)(P + (size_t)(row + 1) * LDP + pc) : (f32x2){0.f, 0.f};
            const f32x2 w0 = *(const f32x2*)(cw + wc), w1 = *(const f32x2*)(cw + 2304 + wc), w2 = *(const f32x2*)(cw + 4608 + wc);
            const f32x2 y = x0 * w0 + x1 * w1 + x2 * w2;
            res[part][0] = silu_f(y[0]); res[part][1] = silu_f(y[1]);
        }
        const float qs = wave_sum(res[0][0] * res[0][0] + res[0][1] * res[0][1]);
        const float ks = wave_sum(res[1][0] * res[1][0] + res[1][1] * res[1][1]);
        const float qr = (1.0f / sqrtf(qs + EPS)) * 0.08838834764831845f, kr = 1.0f / sqrtf(ks + EPS);
        const size_t o = (size_t)row * 768 + h * 128 + c2;
        *(f32x2*)(QN + o) = (f32x2){res[0][0] * qr, res[0][1] * qr};
        *(f32x2*)(KN + o) = (f32x2){res[1][0] * kr, res[1][1] * kr};
        *(f32x2*)(VV + o) = (f32x2){res[2][0], res[2][1]};
        if (F.lane < 2) {
            const int d = F.lane;
            const float braw = P[(size_t)row * LDP + 3328 + d * 6 + h], araw = P[(size_t)row * LDP + 3340 + d * 6 + h];
            const float al = a.in[I_ALOG][(e * 2 + d) * 6 + h], dtb = a.in[I_DTB][(e * 2 + d) * 6 + h];
            const float g = -expf(al) * softplus_f(araw + dtb);
            AG[(size_t)row * 12 + d * 6 + h] = g;
            BT[(size_t)row * 12 + d * 6 + h] = sigmoid_f(braw);
        }
    }
    const float* pw = a.in[I_POOLW] + (size_t)e * 4 * 64 * 64; const float* ps = a.in[I_POOLS] + e * 256;
    for (int it = gw; it < M * 4; it += NGW) {
        const int row = it >> 2, g = it & 3; int s0, L; seq_of_row(row, s0, L);
        const int t = row - s0, half = 1 << g;
        const int lo = max(t - half, 0), hi = min(t + half, L);
        float sum = 0.f;
        for (int p = lo; p < hi; ++p) sum += P[(size_t)(s0 + p) * LDP + g * 64 + F.lane];
        const float d = sum / (float)(hi - lo) - P[(size_t)row * LDP + g * 64 + F.lane];
        const float y = wave_matvec64(d, pw + g * 4096, F.lane) * ps[g * 64 + F.lane];
        Y[(size_t)row * D + g * 64 + F.lane] = (bf16)f2bf(y);
    }
}

__device__ __forceinline__ int perm32(int x) { return (x & ~31) | ((x & 12) << 1) | ((x & 16) >> 2) | (x & 3); }
__device__ __forceinline__ int sw256(int row, int c16) { return row * 256 + ((c16 ^ (row & 15)) << 4); }
__device__ __forceinline__ int sw128(int row, int c8) { return row * 128 + ((c8 ^ ((row >> 1) & 7)) << 4); }
__device__ __forceinline__ int e128(int row, int col) { return sw128(row, col >> 3) + (col & 7) * 2; }
__device__ __forceinline__ void dn_item_decode(int cc, int& row0, int& L, int& c) {
    if (cc < 64) { row0 = (cc >> 2) * CTX_L; L = CTX_L; c = cc & 3; } else { const int q = cc - 64; row0 = NCTX + (q >> 4) * LAT_L; L = LAT_L; c = q & 15; }
}
#define MFMA16(a, b, c) __builtin_amdgcn_mfma_f32_16x16x32_bf16((a), (b), (c), 0, 0, 0)

__device__ __forceinline__ void phase_dn_prep(Frame& F, int e) {
    const CAS Args& a = *F.a;
    const float* QN = (const float*)(a.ws + WS_QN); const float* KN = (const float*)(a.ws + WS_KN); const float* VV = (const float*)(a.ws + WS_VV);
    const float* GLg = (const float*)(a.ws + WS_AG); const float* BT = (const float*)(a.ws + WS_BT);
    LAS unsigned char* L = F.lds;
    constexpr int KB = 0, QB = 16384, VBT = 32768, KGT = 49152, KDT = 65536, AIo = 81920, MM = 90112, TT = 98304, TN = 106496, MD = 114688, XT = 118784, SM = 139264;
    LAS float* sm = (LAS float*)(L + SM);
    const int wave = F.wave;
    for (int rec = F.vcu; rec < 1152; rec += F.G) {
        int tid_ = F.tid; asm volatile("" : "+v"(tid_));
        const int lane = tid_ & 63, fr = lane & 15, fq = lane >> 4;
        const int dir = rec & 1, h = (rec >> 1) % NH, cc = rec / (2 * NH);
        int row0, Ls, c; dn_item_decode(cc, row0, Ls, c);
        __syncthreads();
        if (wave == 0) {
            const int row = row0 + (dir ? (Ls - 1 - (c * 64 + lane)) : (c * 64 + lane));
            float x = GLg[(size_t)row * 12 + dir * 6 + h]; const float b = BT[(size_t)row * 12 + dir * 6 + h];
#pragma unroll
            for (int o = 1; o < 64; o <<= 1) { const float t = __shfl_up(x, o); if (lane >= o) x += t; }
            const float gl = __shfl(x, 63);
            sm[lane] = x; sm[64 + lane] = b; sm[128 + lane] = expf(x); sm[192 + lane] = expf(gl - x);
            if (lane == 63) ((float*)(a.ws + WS_DGL))[rec] = expf(x);
        }
        __syncthreads();
        {
            const int i = tid_ >> 3, cg = tid_ & 7;
            const int row = row0 + (dir ? (Ls - 1 - (c * 64 + i)) : (c * 64 + i));
            const size_t base = (size_t)row * 768 + h * 128 + cg * 16;
            float kf[16], qf[16], vf[16];
#pragma unroll
            for (int q4 = 0; q4 < 4; ++q4) {
                const f32x4 k4 = *(const f32x4*)(KN + base + q4 * 4), q4v = *(const f32x4*)(QN + base + q4 * 4), v4 = *(const f32x4*)(VV + base + q4 * 4);
#pragma unroll
                for (int j = 0; j < 4; ++j) { kf[q4 * 4 + j] = k4[j]; qf[q4 * 4 + j] = q4v[j]; vf[q4 * 4 + j] = v4[j]; }
            }
            const float be = sm[64 + i], eg = sm[128 + i], ek = sm[192 + i];
#pragma unroll
            for (int hf = 0; hf < 2; ++hf) {
                u32x4 kk, qq;
                kk.x = pk2(kf[hf * 8 + 0], kf[hf * 8 + 1]); kk.y = pk2(kf[hf * 8 + 2], kf[hf * 8 + 3]); kk.z = pk2(kf[hf * 8 + 4], kf[hf * 8 + 5]); kk.w = pk2(kf[hf * 8 + 6], kf[hf * 8 + 7]);
                qq.x = pk2(qf[hf * 8 + 0], qf[hf * 8 + 1]); qq.y = pk2(qf[hf * 8 + 2], qf[hf * 8 + 3]); qq.z = pk2(qf[hf * 8 + 4], qf[hf * 8 + 5]); qq.w = pk2(qf[hf * 8 + 6], qf[hf * 8 + 7]);
                *(LAS u32x4*)(L + KB + sw256(i, cg * 2 + hf)) = kk;
                *(LAS u32x4*)(L + QB + sw256(i, cg * 2 + hf)) = qq;
            }
            bf16* QD = (bf16*)(a.ws + WS_DQ) + (size_t)rec * 8192 + i * 128;
#pragma unroll
            for (int qq = 0; qq < 4; ++qq) {
                const int pos = perm32(cg * 16 + 4 * qq);
                u32x2 w; w.x = pk2(qf[4 * qq] * eg, qf[4 * qq + 1] * eg); w.y = pk2(qf[4 * qq + 2] * eg, qf[4 * qq + 3] * eg);
                *(u32x2*)(QD + pos) = w;
            }
            const int pi = perm32(i); const float bg = be * eg;
#pragma unroll
            for (int ee = 0; ee < 16; ++ee) {
                const int kd = cg * 16 + ee;
                *(LAS bf16*)(L + VBT + e128(kd, i)) = (bf16)f2bf(vf[ee] * be);
                *(LAS bf16*)(L + KGT + e128(kd, i)) = (bf16)f2bf(kf[ee] * bg);
                *(LAS bf16*)(L + KDT + e128(kd, pi)) = (bf16)f2bf(kf[ee] * ek);
            }
        }
        __syncthreads();
        const int mi = wave >> 1;
#pragma unroll
        for (int f = 0; f < 2; ++f) {
            const int nj = (wave & 1) * 2 + f;
            f32x4 kkacc = {0.f, 0.f, 0.f, 0.f}, qkacc = {0.f, 0.f, 0.f, 0.f};
            if (nj <= mi) {
#pragma unroll
                for (int ks = 0; ks < 4; ++ks) {
                    const bf16x8 ak = *(const LAS bf16x8*)(L + KB + sw256(mi * 16 + fr, ks * 4 + fq));
                    const bf16x8 aq = *(const LAS bf16x8*)(L + QB + sw256(mi * 16 + fr, ks * 4 + fq));
                    const bf16x8 bk = *(const LAS bf16x8*)(L + KB + sw256(nj * 16 + fr, ks * 4 + fq));
                    kkacc = MFMA16(ak, bk, kkacc); qkacc = MFMA16(aq, bk, qkacc);
                }
            }
            const int j = nj * 16 + fr, i0 = mi * 16 + 4 * fq; const float gcj = sm[j];
#pragma unroll
            for (int r = 0; r < 4; ++r) {
                const int i = i0 + r; const float dec = (i >= j) ? expf(sm[i] - gcj) : 0.f;
                const float mv = (i > j) ? (sm[64 + i] * kkacc[r] * dec) : 0.f;
                if (nj <= mi) *(LAS bf16*)(L + MM + e128(i, j)) = (bf16)f2bf(mv);
                if (nj == mi) *(LAS float*)(L + MD + ((mi * 16 + 4 * fq + r) * 16 + fr) * 4) = mv;
                if (nj > mi) *(LAS bf16*)(L + TN + e128(i, j)) = (bf16)0;
                *(LAS bf16*)(L + AIo + e128(i, perm32(j))) = (bf16)f2bf(qkacc[r] * dec);
            }
        }
        __syncthreads();
        if (wave == 0) {
            const int b = lane >> 4, cc_ = lane & 15;
            const LAS float* md = (const LAS float*)(L + MD) + b * 256;
            float T[16];
#pragma unroll
            for (int i = 0; i < 16; ++i) {
                float s = (i == cc_) ? 1.f : 0.f;
#pragma unroll
                for (int jj = 0; jj < i; ++jj) s -= md[i * 16 + jj] * T[jj];
                T[i] = s;
            }
#pragma unroll
            for (int i = 0; i < 16; ++i) *(LAS bf16*)(L + TN + e128(16 * b + i, 16 * b + cc_)) = (bf16)f2bf(T[i]);
#pragma unroll
            for (int hf = 0; hf < 2; ++hf) {
                u32x4 t; t.x = pk2(T[hf * 8 + 0], T[hf * 8 + 1]); t.y = pk2(T[hf * 8 + 2], T[hf * 8 + 3]); t.z = pk2(T[hf * 8 + 4], T[hf * 8 + 5]); t.w = pk2(T[hf * 8 + 6], T[hf * 8 + 7]);
                *(LAS u32x4*)(L + TT + sw128(16 * b + cc_, 2 * b + hf)) = t;
            }
        }
        __syncthreads();
#pragma unroll
        for (int lvl = 1; lvl <= 3; ++lvl) {
            if (wave < 4 - lvl) {
                const int J = wave, I = wave + lvl;
                f32x4 x = {0.f, 0.f, 0.f, 0.f};
                const bf16x8 zero8 = {0, 0, 0, 0, 0, 0, 0, 0};
#pragma unroll
                for (int ks = 0; ks < (lvl == 3 ? 2 : 1); ++ks) {
                    const bf16x8 am = *(const LAS bf16x8*)(L + MM + sw128(16 * I + fr, 2 * J + 4 * ks + fq));
                    bf16x8 bt = *(const LAS bf16x8*)(L + TT + sw128(16 * J + fr, 2 * J + 4 * ks + fq));
                    if (4 * ks + fq >= 2 * lvl) bt = zero8;
                    x = MFMA16(am, bt, x);
                }
                LAS unsigned char* xt = L + XT + wave * 512;
                { u32x2 t; t.x = pk2(x[0], x[1]); t.y = pk2(x[2], x[3]); *(LAS u32x2*)(xt + fr * 32 + fq * 8) = t; }
                const bf16x8 ad = *(const LAS bf16x8*)(L + TN + sw128(16 * I + fr, 2 * I + (fq & 1)));
                bf16x8 bx = *(const LAS bf16x8*)(xt + fr * 32 + (fq & 1) * 16);
                if (fq >= 2) bx = zero8;
                f32x4 t4 = {0.f, 0.f, 0.f, 0.f};
                t4 = MFMA16(ad, bx, t4);
#pragma unroll
                for (int r = 0; r < 4; ++r) *(LAS bf16*)(L + TN + e128(16 * I + 4 * fq + r, 16 * J + fr)) = (bf16)f2bf(-t4[r]);
                { u32x2 t; t.x = pk2(-t4[0], -t4[1]); t.y = pk2(-t4[2], -t4[3]); *(LAS u32x2*)(L + TT + e128(16 * J + fr, 16 * I + 4 * fq)) = t; }
            }
            __syncthreads();
        }
        {
            bf16* UT = (bf16*)(a.ws + WS_DUT) + (size_t)rec * 8192;
            bf16* Wn = (bf16*)(a.ws + WS_DW) + (size_t)rec * 8192;
            const int ui = wave & 3;
#pragma unroll
            for (int f = 0; f < 4; ++f) {
                const int dvf = (wave >> 2) * 4 + f;
                f32x4 acc = {0.f, 0.f, 0.f, 0.f};
#pragma unroll
                for (int ks = 0; ks < 2; ++ks) {
                    const bf16x8 ta = *(const LAS bf16x8*)(L + TN + sw128(ui * 16 + fr, ks * 4 + fq));
                    const bf16x8 vb = *(const LAS bf16x8*)(L + VBT + sw128(dvf * 16 + fr, ks * 4 + fq));
                    acc = MFMA16(ta, vb, acc);
                }
                u32x2 t; t.x = pk2(acc[0], acc[1]); t.y = pk2(acc[2], acc[3]);
                *(u32x2*)(UT + (dvf * 16 + fr) * 64 + ui * 16 + 4 * fq) = t;
            }
#pragma unroll
            for (int f = 0; f < 4; ++f) {
                f32x4 acc = {0.f, 0.f, 0.f, 0.f};
#pragma unroll
                for (int ks = 0; ks < 2; ++ks) {
                    const bf16x8 ka = *(const LAS bf16x8*)(L + KGT + sw128(wave * 16 + fr, ks * 4 + fq));
                    const bf16x8 tb = *(const LAS bf16x8*)(L + TN + sw128(f * 16 + fr, ks * 4 + fq));
                    acc = MFMA16(ka, tb, acc);
                }
                u32x2 t; t.x = pk2(-acc[0], -acc[1]); t.y = pk2(-acc[2], -acc[3]);
                *(u32x2*)(Wn + (f * 16 + fr) * 128 + perm32(wave * 16 + 4 * fq)) = t;
            }
            {
                const int rw = tid_ >> 3, c8 = tid_ & 7;
                *(u32x4*)((unsigned char*)(a.ws + WS_DAI) + (size_t)rec * 8192 + rw * 128 + c8 * 16) = *(const LAS u32x4*)(L + AIo + sw128(rw, c8));
#pragma unroll
                for (int k2 = 0; k2 < 2; ++k2) {
                    const int rr = rw + 64 * k2;
                    *(u32x4*)((unsigned char*)(a.ws + WS_DKT) + (size_t)rec * 16384 + rr * 128 + c8 * 16) = *(const LAS u32x4*)(L + KDT + sw128(rr, c8));
                }
            }
        }
    }
    __syncthreads();
}

__device__ __forceinline__ void phase_dn_scan(Frame& F, int e) {
    const CAS Args& a = *F.a;
    LAS unsigned char* L = F.lds;
    constexpr int BUF = 57344, oW = 0, oQ = 16384, oA = 32768, oK = 40960;
    const int wave = F.wave;
    const unsigned char* gW = (const unsigned char*)(a.ws + WS_DW); const unsigned char* gQ = (const unsigned char*)(a.ws + WS_DQ);
    const unsigned char* gA = (const unsigned char*)(a.ws + WS_DAI); const unsigned char* gK = (const unsigned char*)(a.ws + WS_DKT);
    const bf16* gU = (const bf16*)(a.ws + WS_DUT); const float* gGL = (const float*)(a.ws + WS_DGL);
    for (int it = F.vcu; it < NSEQ * 2 * NH; it += F.G) {
        int tid_ = F.tid; asm volatile("" : "+v"(tid_));
        const int lane = tid_ & 63, fr = lane & 15, fq = lane >> 4, dvc = wave * 16 + fr;
        const int r4 = lane >> 4, s16 = lane & 15, r8 = lane >> 3, s8 = lane & 7;
        int seq, dir, h;
        if (it < LAT_B * 2 * NH) { seq = CTX_B + it / (2 * NH); dir = (it / NH) & 1; h = it % NH; }
        else { const int j = it - LAT_B * 2 * NH; seq = j / (2 * NH); dir = (j / NH) & 1; h = j % NH; }
        const bool lat = seq >= CTX_B;
        const int Ls = lat ? LAT_L : CTX_L, row0 = lat ? NCTX + (seq - CTX_B) * LAT_L : seq * CTX_L, nch = Ls / 64;
        const int cbase = lat ? 64 + (seq - CTX_B) * 16 : seq * 4;
        f32x4 S[8];
        if (lat) {
            const float* s0 = a.in[I_STATE] + ((((size_t)(seq - CTX_B) * 2 + e) * 2 + dir) * NH + h) * 128 * 128;
#pragma unroll
            for (int mf = 0; mf < 8; ++mf)
#pragma unroll
                for (int r = 0; r < 4; ++r) S[mf][r] = s0[(size_t)(mf * 16 + 4 * fq + r) * 128 + dvc];
        } else {
#pragma unroll
            for (int mf = 0; mf < 8; ++mf) S[mf] = (f32x4){0.f, 0.f, 0.f, 0.f};
        }
        float* O = (float*)(a.ws + (dir ? WS_OB : WS_OF));
#define DN_STAGE(bufi, rec_) do { LAS unsigned char* sb_ = L + (bufi) * BUF; const size_t ro_ = (size_t)(rec_); \
        _Pragma("unroll") for (int p_ = 0; p_ < 2; ++p_) { const int pc_ = wave + 8 * p_; const int rw_ = pc_ * 4 + r4; const int so_ = rw_ * 256 + ((s16 ^ (rw_ & 15)) << 4); \
            __builtin_amdgcn_global_load_lds((const unsigned*)(gW + ro_ * 16384 + so_), (LAS unsigned*)(sb_ + oW + pc_ * 1024), 16, 0, 0); \
            __builtin_amdgcn_global_load_lds((const unsigned*)(gQ + ro_ * 16384 + so_), (LAS unsigned*)(sb_ + oQ + pc_ * 1024), 16, 0, 0); \
            const int rk_ = pc_ * 8 + r8; const int sk_ = rk_ * 128 + ((s8 ^ ((rk_ >> 1) & 7)) << 4); \
            __builtin_amdgcn_global_load_lds((const unsigned*)(gK + ro_ * 16384 + sk_), (LAS unsigned*)(sb_ + oK + pc_ * 1024), 16, 0, 0); } \
        { const int ra_ = wave * 8 + r8; const int sa_ = ra_ * 128 + ((s8 ^ ((ra_ >> 1) & 7)) << 4); \
            __builtin_amdgcn_global_load_lds((const unsigned*)(gA + ro_ * 8192 + sa_), (LAS unsigned*)(sb_ + oA + wave * 1024), 16, 0, 0); } } while (0)
        __syncthreads();
        int rec = (cbase * NH + h) * 2 + dir;
        DN_STAGE(0, rec);
        u32x2 un[4]; float gln;
#pragma unroll
        for (int mf = 0; mf < 4; ++mf) un[mf] = *(const u32x2*)(gU + (size_t)rec * 8192 + dvc * 64 + mf * 16 + 4 * fq);
        gln = gGL[rec];
        for (int c = 0; c < nch; ++c) {
            asm volatile("s_waitcnt vmcnt(0)" ::: "memory");
            __syncthreads();
            u32x2 uc[4]; const float gl = gln;
#pragma unroll
            for (int mf = 0; mf < 4; ++mf) uc[mf] = un[mf];
            if (c + 1 < nch) {
                const int rn = rec + 2 * NH;
                DN_STAGE((c + 1) & 1, rn);
#pragma unroll
                for (int mf = 0; mf < 4; ++mf) un[mf] = *(const u32x2*)(gU + (size_t)rn * 8192 + dvc * 64 + mf * 16 + 4 * fq);
                gln = gGL[rn];
            }
            LAS unsigned char* sb = L + (c & 1) * BUF;
            bf16x8 Sb[4];
#pragma unroll
            for (int ks = 0; ks < 4; ++ks) {
                u32x4 t; t.x = pk2(S[2 * ks][0], S[2 * ks][1]); t.y = pk2(S[2 * ks][2], S[2 * ks][3]); t.z = pk2(S[2 * ks + 1][0], S[2 * ks + 1][1]); t.w = pk2(S[2 * ks + 1][2], S[2 * ks + 1][3]);
                Sb[ks] = __builtin_bit_cast(bf16x8, t);
            }
            f32x4 vn[4], o[4];
#pragma unroll
            for (int mf = 0; mf < 4; ++mf) {
                vn[mf][0] = __builtin_bit_cast(float, uc[mf].x << 16); vn[mf][1] = __builtin_bit_cast(float, uc[mf].x & 0xffff0000u);
                vn[mf][2] = __builtin_bit_cast(float, uc[mf].y << 16); vn[mf][3] = __builtin_bit_cast(float, uc[mf].y & 0xffff0000u);
                o[mf] = (f32x4){0.f, 0.f, 0.f, 0.f};
#pragma unroll
                for (int ks = 0; ks < 4; ++ks) {
                    const bf16x8 wf = *(const LAS bf16x8*)(sb + oW + sw256(mf * 16 + fr, ks * 4 + fq));
                    const bf16x8 qf = *(const LAS bf16x8*)(sb + oQ + sw256(mf * 16 + fr, ks * 4 + fq));
                    vn[mf] = MFMA16(wf, Sb[ks], vn[mf]);
                    o[mf] = MFMA16(qf, Sb[ks], o[mf]);
                }
            }
            bf16x8 Vb[2];
#pragma unroll
            for (int ks = 0; ks < 2; ++ks) {
                u32x4 t; t.x = pk2(vn[2 * ks][0], vn[2 * ks][1]); t.y = pk2(vn[2 * ks][2], vn[2 * ks][3]); t.z = pk2(vn[2 * ks + 1][0], vn[2 * ks + 1][1]); t.w = pk2(vn[2 * ks + 1][2], vn[2 * ks + 1][3]);
                Vb[ks] = __builtin_bit_cast(bf16x8, t);
            }
#pragma unroll
            for (int mf = 0; mf < 4; ++mf)
#pragma unroll
                for (int ks = 0; ks < 2; ++ks) {
                    const bf16x8 af = *(const LAS bf16x8*)(sb + oA + sw128(mf * 16 + fr, ks * 4 + fq));
                    o[mf] = MFMA16(af, Vb[ks], o[mf]);
                }
#pragma unroll
            for (int mf = 0; mf < 8; ++mf) {
                S[mf] = S[mf] * gl;
#pragma unroll
                for (int ks = 0; ks < 2; ++ks) {
                    const bf16x8 kf = *(const LAS bf16x8*)(sb + oK + sw128(mf * 16 + fr, ks * 4 + fq));
                    S[mf] = MFMA16(kf, Vb[ks], S[mf]);
                }
            }
#pragma unroll
            for (int mf = 0; mf < 4; ++mf)
#pragma unroll
                for (int r = 0; r < 4; ++r) {
                    const int step = c * 64 + mf * 16 + 4 * fq + r, row = row0 + (dir ? (Ls - 1 - step) : step);
                    O[(size_t)row * 768 + h * 128 + dvc] = o[mf][r];
                }
            rec += 2 * NH;
        }
#undef DN_STAGE
        if (!lat) {
            float* so = a.out + (size_t)M * D + ((((size_t)seq * 2 + e) * 2 + dir) * NH + h) * 128 * 128;
#pragma unroll
            for (int mf = 0; mf < 8; ++mf)
#pragma unroll
                for (int r = 0; r < 4; ++r) so[(size_t)(mf * 16 + 4 * fq + r) * 128 + dvc] = S[mf][r];
        }
    }
    __syncthreads();
}

__device__ __forceinline__ void phase_dn_fin(Frame& F, int e) {
    const CAS Args& a = *F.a;
    const float* P = (const float*)(a.ws + WS_P);
    const float* OF = (const float*)(a.ws + WS_OF); const float* OB = (const float*)(a.ws + WS_OB);
    bf16* Y = (bf16*)(a.ws + WS_Y);
    const float* nw = a.in[I_DNNW] + e * 128;
    const int gw = F.vcu * 8 + F.wave, NGW = F.G * 8;
    for (int it = gw; it < M * NH; it += NGW) {
        const int row = it / NH, h = it % NH, c2 = F.lane * 2;
        const size_t o = (size_t)row * 768 + h * 128 + c2;
        const f32x2 v = *(const f32x2*)(OF + o) + *(const f32x2*)(OB + o);
        const float ms = wave_sum(v[0] * v[0] + v[1] * v[1]) * (1.f / 128.f);
        const float rs = 1.0f / sqrtf(ms + EPS);
        const f32x2 z = *(const f32x2*)(P + (size_t)row * LDP + 2560 + h * 128 + c2);
        const f32x2 w = *(const f32x2*)(nw + c2);
        *(unsigned*)(Y + (size_t)row * D + 256 + h * 128 + c2) = pk2(v[0] * rs * w[0] * silu_f(z[0]), v[1] * rs * w[1] * silu_f(z[1]));
    }
}

struct EpiOdd {
    bf16* G; float* ZR; float* ZI; float* ST;
    template <int NFRAG> __device__ __forceinline__ void operator()(f32x4 (&acc)[3][NFRAG], int row, int colq, int fq) const {
        const int ct = colq >> 8;
        if (ct < 6) {
#pragma unroll
            for (int mf = 0; mf < 3; ++mf) {
                const int rr = row + mf * 16; float s1 = 0.f, s2 = 0.f;
#pragma unroll
                for (int nf = 0; nf < NFRAG; ++nf) {
                    const f32x4 v = acc[mf][nf];
                    const float g0 = gelu_tanh(v[0]), g1 = gelu_tanh(v[1]), g2 = gelu_tanh(v[2]), g3 = gelu_tanh(v[3]);
                    u32x2 w; w.x = pk2(g0, g1); w.y = pk2(g2, g3);
                    *(u32x2*)(G + (size_t)rr * 1536 + colq + nf * 16) = w;
                    s1 += (g0 + g1) + (g2 + g3); s2 += (g0 * g0 + g1 * g1) + (g2 * g2 + g3 * g3);
                }
                if (ct >= 3) {
                    s1 += __shfl_xor(s1, 16); s1 += __shfl_xor(s1, 32); s2 += __shfl_xor(s2, 16); s2 += __shfl_xor(s2, 32);
                    if (fq == 0) { atomicAdd(ST + (size_t)rr * 2, s1); atomicAdd(ST + (size_t)rr * 2 + 1, s2); }
                }
            }
        } else {
            float* Z = (ct == 6) ? ZR : ZI; const int cb = colq - ct * 256;
#pragma unroll
            for (int mf = 0; mf < 3; ++mf)
#pragma unroll
                for (int nf = 0; nf < NFRAG; ++nf) *(f32x4*)(Z + (size_t)(row + mf * 16) * 256 + cb + nf * 16) = acc[mf][nf];
        }
    }
};

template <int R>
__device__ __forceinline__ void fourier_a_item(const float* ZR, const float* ZI, float* BR, float* BI, int row0, int n2, const LAS float* twR, const LAS float* twN, int tid) {
    const int col = tid & 255, hf = tid >> 8;
    float zr[R], zi[R];
#pragma unroll
    for (int n1 = 0; n1 < R; ++n1) { const size_t o = (size_t)(row0 + R * n1 + n2) * 256 + col; zr[n1] = ZR[o]; zi[n1] = ZI[o]; }
#pragma unroll 1
    for (int kk = 0; kk < R / 2; ++kk) {
        const int k1 = hf * (R / 2) + kk;
        float ar = 0.f, ai = 0.f;
#pragma unroll
        for (int n1 = 0; n1 < R; ++n1) { const int idx = (k1 * n1) & (R - 1); const float c = twR[idx], s = twR[R + idx]; ar += c * zr[n1] + s * zi[n1]; ai += c * zi[n1] - s * zr[n1]; }
        const int t = k1 * n2; const float c = twN[t], s = twN[R * R + t];
        const size_t o = (size_t)(row0 + k1 * R + n2) * 256 + col;
        BR[o] = c * ar + s * ai; BI[o] = c * ai - s * ar;
    }
}
template <int R>
__device__ __forceinline__ void fourier_c_item(const float* BR, const float* BI, bf16* Y, int row0, int k1, const LAS float* twR, int tid) {
    const int col = tid & 255, hf = tid >> 8;
    float br[R], bi[R];
#pragma unroll
    for (int n2 = 0; n2 < R; ++n2) { const size_t o = (size_t)(row0 + k1 * R + n2) * 256 + col; br[n2] = BR[o]; bi[n2] = BI[o]; }
    const float sc = 1.0f / (float)R;
#pragma unroll 1
    for (int kk = 0; kk < R / 2; ++kk) {
        const int k2 = hf * (R / 2) + kk;
        float x = 0.f;
#pragma unroll
        for (int n2 = 0; n2 < R; ++n2) { const int idx = (k2 * n2) & (R - 1); x += twR[idx] * br[n2] + twR[R + idx] * bi[n2]; }
        Y[(size_t)(row0 + k1 + R * k2) * D + 768 + col] = (bf16)f2bf(x * sc);
    }
}
__device__ __forceinline__ void fourier_tables(LAS float* tw, int tid) {
    for (int i = tid; i < 1024; i += 512) { const float x = (float)i * (1.f / 512.f); tw[64 + i] = cospif(x); tw[64 + 1024 + i] = sinpif(x); }
    if (tid < 256) { const float x = (float)tid * (1.f / 128.f); tw[2144 + tid] = cospif(x); tw[2144 + 256 + tid] = sinpif(x); }
    if (tid < 32) { const float x = (float)tid * (1.f / 16.f); tw[tid] = cospif(x); tw[32 + tid] = sinpif(x); }
    if (tid < 16) { const float x = (float)tid * (1.f / 8.f); tw[2112 + tid] = cospif(x); tw[2112 + 16 + tid] = sinpif(x); }
}

__device__ __forceinline__ void phase_odd_mix(Frame& F, int j) {
    const CAS Args& a = *F.a;
    const bf16* G = (const bf16*)(a.ws + WS_P); bf16* Y = (bf16*)(a.ws + WS_Y);
    const float* ZR = (const float*)(a.ws + WS_ZR); const float* ZI = (const float*)(a.ws + WS_ZI);
    float* BR = (float*)(a.ws + WS_QN); float* BI = (float*)(a.ws + WS_KN);
    const float* ST = (const float*)(a.ws + WS_CTL + CTL_ST_OFF) + (size_t)j * M * 2;
    LAS unsigned char* L = F.lds;
    LAS float* tw = (LAS float*)(L + 65536);
    fourier_tables(tw, F.tid);
    __syncthreads();
    const int wave = F.wave;
    constexpr int NA_LAT = LAT_B * 32, NSGU = (M / 128) * NH, NA_CTX = CTX_B * 16;
    for (int it = F.vcu; it < NA_LAT + NSGU + NA_CTX; it += F.G) {
        int tid_ = F.tid; asm volatile("" : "+v"(tid_));
        if (it < NA_LAT) { fourier_a_item<32>(ZR, ZI, BR, BI, NCTX + (it >> 5) * LAT_L, it & 31, tw, tw + 64, tid_); continue; }
        if (it >= NA_LAT + NSGU) { const int q = it - NA_LAT - NSGU; fourier_a_item<16>(ZR, ZI, BR, BI, (q >> 4) * CTX_L, q & 15, tw + 2112, tw + 2144, tid_); continue; }
        const int q = it - NA_LAT, ch = q / NH, h = q % NH, r0 = ch * 128;
        const int lane = tid_ & 63, fr = lane & 15, fq = lane >> 4;
        __syncthreads();
        {
            const int s = tid_ >> 2, cq = tid_ & 3, row = r0 + s;
            const float s1 = ST[(size_t)row * 2], s2 = ST[(size_t)row * 2 + 1];
            const float mu = s1 * (1.f / 768.f), var = s2 * (1.f / 768.f) - mu * mu, rstd = 1.0f / sqrtf(fmaxf(var, 0.f) + EPS);
            const bf16* gp = G + (size_t)row * 1536 + 768 + h * 128 + cq * 32;
            const float* nw = a.in[I_SGUN] + j * 768 + h * 128 + cq * 32;
#pragma unroll
            for (int v8 = 0; v8 < 4; ++v8) {
                const u32x4 raw = *(const u32x4*)(gp + v8 * 8);
                const unsigned wds[4] = {raw.x, raw.y, raw.z, raw.w};
#pragma unroll
                for (int e2 = 0; e2 < 4; ++e2) {
                    const float g0 = __builtin_bit_cast(float, wds[e2] << 16), g1 = __builtin_bit_cast(float, wds[e2] & 0xffff0000u);
                    const int c0 = cq * 32 + v8 * 8 + e2 * 2;
                    const float v0 = (g0 - mu) * rstd * nw[v8 * 8 + e2 * 2], v1 = (g1 - mu) * rstd * nw[v8 * 8 + e2 * 2 + 1];
                    *(LAS bf16*)(L + c0 * 256 + (((s >> 3) ^ (c0 & 15)) << 4) + (s & 7) * 2) = (bf16)f2bf(v0);
                    *(LAS bf16*)(L + (c0 + 1) * 256 + (((s >> 3) ^ ((c0 + 1) & 15)) << 4) + (s & 7) * 2) = (bf16)f2bf(v1);
                }
            }
        }
        __syncthreads();
        {
            const bf16* Wb = (const bf16*)(a.ws + WS_SGUW) + ((size_t)j * NH + h) * 16384;
            f32x4 acc[8];
#pragma unroll
            for (int pf = 0; pf < 8; ++pf) acc[pf] = (f32x4){0.f, 0.f, 0.f, 0.f};
#pragma unroll
            for (int ks = 0; ks < 4; ++ks) {
                const bf16x8 av = *(const LAS bf16x8*)(L + (wave * 16 + fr) * 256 + (((ks * 4 + fq) ^ fr) << 4));
#pragma unroll
                for (int pf = 0; pf < 8; ++pf) {
                    const bf16x8 bw = *(const bf16x8*)(Wb + (pf * 16 + fr) * 128 + ks * 32 + fq * 8);
                    acc[pf] = MFMA16(av, bw, acc[pf]);
                }
            }
            const float* bs = a.in[I_SGUB] + ((size_t)j * NH + h) * 128;
#pragma unroll
            for (int pf = 0; pf < 8; ++pf) {
                const int p = pf * 16 + fr, row = r0 + p, c = wave * 16 + 4 * fq; const float b = bs[p];
                const u32x2 gu = *(const u32x2*)(G + (size_t)row * 1536 + h * 128 + c);
                const float u0 = __builtin_bit_cast(float, gu.x << 16), u1 = __builtin_bit_cast(float, gu.x & 0xffff0000u), u2 = __builtin_bit_cast(float, gu.y << 16), u3 = __builtin_bit_cast(float, gu.y & 0xffff0000u);
                u32x2 o; o.x = pk2(u0 * (acc[pf][0] + b), u1 * (acc[pf][1] + b)); o.y = pk2(u2 * (acc[pf][2] + b), u3 * (acc[pf][3] + b));
                *(u32x2*)(Y + (size_t)row * D + h * 128 + c) = o;
            }
        }
    }
    __syncthreads();
}
__device__ __forceinline__ void phase_odd_fc(Frame& F) {
    const CAS Args& a = *F.a;
    const float* BR = (const float*)(a.ws + WS_QN); const float* BI = (const float*)(a.ws + WS_KN); bf16* Y = (bf16*)(a.ws + WS_Y);
    LAS float* tw = (LAS float*)(F.lds + 65536);
    fourier_tables(tw, F.tid);
    __syncthreads();
    constexpr int NC_LAT = LAT_B * 32, NC_CTX = CTX_B * 16;
    for (int it = F.vcu; it < NC_LAT + NC_CTX; it += F.G) {
        int tid_ = F.tid; asm volatile("" : "+v"(tid_));
        if (it < NC_LAT) fourier_c_item<32>(BR, BI, Y, NCTX + (it >> 5) * LAT_L, it & 31, tw, tid_);
        else { const int q = it - NC_LAT; fourier_c_item<16>(BR, BI, Y, (q >> 4) * CTX_L, q & 15, tw + 2112, tid_); }
    }
    __syncthreads();
}

constexpr int STEPS = 13, N_PHASES = 1 + DEPTH * STEPS + 1;
__device__ __forceinline__ void run_phase(Frame& F, int ph) {
    const CAS Args& a = *F.a; unsigned char* ws = a.ws;
    if (ph == 0) { phase_setup(F); return; }
    if (ph == N_PHASES - 1) { phase_final(F); return; }
    const int l = (ph - 1) / STEPS, st = (ph - 1) % STEPS, e = l >> 1;
    const bf16* HN = (const bf16*)(ws + WS_HN); bf16* HH = (bf16*)(ws + WS_HH); float* X = (float*)(ws + WS_X); float* P = (float*)(ws + WS_P);
    const bf16* Y = (const bf16*)(ws + WS_Y); const float* mod = (const float*)(ws + WS_MOD);
    switch (st) {
        case 0: phase_norm(F, l, 0); break;
        case 1: { EpiUp E{HH}; gemm_phase<11, EpiUp>(F, HN, (const bf16*)(ws + WS_WUP + (size_t)(l * 2) * WUP_SZ), D, NUP, E); } break;
        case 2: { EpiRes E{X, mod, l, 2, 0.5f}; gemm_phase<4, EpiRes>(F, HH, (const bf16*)(ws + WS_WDN + (size_t)(l * 2) * WDN_SZ), FF, D, E); } break;
        case 3: phase_norm(F, l, 1); break;
        case 4: { EpiStore E{P, LDP};
                  if ((l & 1) == 0) gemm_phase<7, EpiStore>(F, HN, (const bf16*)(ws + WS_EVIN + (size_t)e * EVIN_SZ), D, P_EVEN_PAD, E);
                  else { EpiOdd EO{(bf16*)(ws + WS_P), (float*)(ws + WS_ZR), (float*)(ws + WS_ZI), (float*)(ws + WS_CTL + CTL_ST_OFF) + (size_t)e * M * 2};
                         gemm_phase<8, EpiOdd>(F, HN, (const bf16*)(ws + WS_ODIN + (size_t)e * ODIN_SZ), D, 2048, EO); } } break;
        case 5: if ((l & 1) == 0) phase_even_pre(F, e); else phase_odd_mix(F, e); break;
        case 6: if ((l & 1) == 0) phase_dn_prep(F, e); else phase_odd_fc(F); break;
        case 7: if ((l & 1) == 0) phase_dn_scan(F, e); break;
        case 8: if ((l & 1) == 0) phase_dn_fin(F, e); break;
        case 9: { EpiRes E{X, mod, l, 5, 1.0f}; gemm_phase<4, EpiRes>(F, Y, (const bf16*)(ws + ((l & 1) ? WS_ODOUT : WS_EVOUT) + (size_t)e * SQ_SZ), D, D, E); } break;
        case 10: phase_norm(F, l, 2); break;
        case 11: { EpiUp E{HH}; gemm_phase<11, EpiUp>(F, HN, (const bf16*)(ws + WS_WUP + (size_t)(l * 2 + 1) * WUP_SZ), D, NUP, E); } break;
        case 12: { EpiRes E{X, mod, l, 8, 0.5f}; gemm_phase<4, EpiRes>(F, HH, (const bf16*)(ws + WS_WDN + (size_t)(l * 2 + 1) * WDN_SZ), FF, D, E); } break;
    }
}

__global__ void __launch_bounds__(512, 2) mk_fwd(Args args) {
    extern __shared__ __attribute__((aligned(16))) unsigned char lds_raw[];
    Frame F;
    F.lds = (LAS unsigned char*)lds_raw;
    F.tid = threadIdx.x; F.lane = F.tid & 63; F.wave = __builtin_amdgcn_readfirstlane(F.tid >> 6);
    F.G = gridDim.x; { const int bx = blockIdx.x; F.vcu = (F.G % 8 == 0) ? (bx % 8) * (F.G / 8) + bx / 8 : bx; }
    const CAS Args* ap = (const CAS Args*)__builtin_amdgcn_kernarg_segment_ptr();
    F.a = ap;
    const int ph_lo = ap->ph_lo, ph_hi = ap->ph_hi;
    unsigned char* ws0 = ap->ws;
    volatile LAS unsigned* MISC = (volatile LAS unsigned*)(F.lds + LDS_MISC);
    if (F.tid < 64) MISC[F.tid] = 0u;
    __syncthreads();
    const bool multi = (ph_hi - ph_lo) > 1;
    XcdBarrier bar; bar.bar = (unsigned*)(ws0 + WS_CTL) + CW_BAR; bar.x = 0; bar.st = MISC + 8;
    if (multi) bar = xcd_barrier_post((unsigned*)(ws0 + WS_CTL) + CW_BAR, MISC + 8);
    for (int ph = ph_lo; ph < ph_hi; ++ph) {
        { const CAS Args* a2 = ap; asm volatile("" : "+s"(a2)); F.a = a2; }
        { int t_ = threadIdx.x; asm volatile("" : "+v"(t_)); F.tid = t_; F.lane = t_ & 63; F.wave = __builtin_amdgcn_readfirstlane(t_ >> 6); }
        if (ph >= 1 && ph < N_PHASES - 1 && ((ph - 1) % STEPS == 7 || (ph - 1) % STEPS == 8) && ((((ph - 1) / STEPS) & 1) == 1)) continue;
        run_phase(F, ph);
        if (ph + 1 < ph_hi) xcd_barrier(bar);
    }
}

extern "C" void kernel_launch(void* const* d_in, const int* in_sizes, int n_in, void* d_out, int out_size, void* d_ws, size_t ws_size, hipStream_t stream) {
    static int grid = 0;
    if (grid == 0) {
        if (n_in != 31 || ws_size < WS_END) { fprintf(stderr, "kernel_launch: unexpected n_in %d or ws_size %zu (need %zu)\n", n_in, ws_size, (size_t)WS_END); grid = -1; return; }
        int dev = 0, cus = 0;
        if (hipGetDevice(&dev) != hipSuccess || hipDeviceGetAttribute(&cus, hipDeviceAttributeMultiprocessorCount, dev) != hipSuccess) { grid = -1; return; }
        if (hipFuncSetAttribute((const void*)mk_fwd, hipFuncAttributeMaxDynamicSharedMemorySize, LDS_BYTES) != hipSuccess) { fprintf(stderr, "kernel_launch: hipFuncSetAttribute failed\n"); grid = -1; return; }
        (void)hipGetLastError();
        grid = cus;
    }
    if (grid < 0) return;
    (void)hipMemsetAsync((char*)d_ws + WS_CTL, 0, CTL_BYTES, stream);
    Args a{};
    for (int i = 0; i < 31; ++i) a.in[i] = (const float*)d_in[i];
    a.out = (float*)d_out; a.ws = (unsigned char*)d_ws;
#if ONE_LAUNCH
    a.ph_lo = 0; a.ph_hi = N_PHASES;
    hipLaunchKernelGGL(mk_fwd, dim3(grid), dim3(512), LDS_BYTES, stream, a);
#else
    for (int ph = 0; ph < N_PHASES; ++ph) {
        a.ph_lo = ph; a.ph_hi = ph + 1;
        hipLaunchKernelGGL(mk_fwd, dim3(grid), dim3(512), LDS_BYTES, stream, a);
    }
#endif
}
```

```cpp
#include <hip/hip_runtime.h>
#include <cstdio>
#include <cstdint>

#ifndef ONE_LAUNCH
#define ONE_LAUNCH 1
#endif

#define GAS __attribute__((address_space(1)))
#define LAS __attribute__((address_space(3)))
#define CAS __attribute__((address_space(4)))
typedef unsigned short bf16;
typedef float f32x4 __attribute__((ext_vector_type(4)));
typedef float f32x2 __attribute__((ext_vector_type(2)));
typedef short bf16x8 __attribute__((ext_vector_type(8)));
typedef unsigned u32x4 __attribute__((ext_vector_type(4)));
typedef unsigned u32x2 __attribute__((ext_vector_type(2)));

constexpr int D = 1024, NCTX = 4096, NLAT = 2048, M = 6144, FF = 2816, DEPTH = 4;
constexpr int CTX_B = 16, CTX_L = 256, LAT_B = 2, LAT_L = 1024;
constexpr int NUP = 2 * FF;
constexpr int P_EVEN = 3352, P_EVEN_PAD = 3584, P_ODD = 1792;
constexpr int LDP = 3584;
constexpr int NH = 6, DK = 128;
constexpr float EPS = 1e-6f;
constexpr int NSEQ = CTX_B + LAT_B;

constexpr size_t MiB = 1u << 20;
constexpr size_t WS_CTL = 0, CTL_BYTES = 1 * MiB;
constexpr size_t WS_MOD = 1 * MiB;
constexpr size_t WS_WUP = 2 * MiB, WUP_SZ = 11 * MiB;
constexpr size_t WS_WDN = 90 * MiB, WDN_SZ = 5632 * 1024;
constexpr size_t WS_EVIN = 134 * MiB, EVIN_SZ = 7 * MiB;
constexpr size_t WS_EVOUT = 148 * MiB, SQ_SZ = 2 * MiB;
constexpr size_t WS_ODIN = 152 * MiB, ODIN_SZ = 4 * MiB;
constexpr size_t WS_ODOUT = 160 * MiB;
constexpr size_t WS_X = 164 * MiB;
constexpr size_t WS_HN = 188 * MiB;
constexpr size_t WS_HH = 200 * MiB;
constexpr size_t WS_P = 233 * MiB;
constexpr size_t WS_Y = 317 * MiB;
constexpr size_t WS_QN = 329 * MiB, WS_KN = 347 * MiB, WS_VV = 365 * MiB, WS_OF = 383 * MiB, WS_OB = 401 * MiB;
constexpr size_t WS_AG = 419 * MiB, WS_BT = 420 * MiB;
constexpr size_t WS_ZR = 421 * MiB, WS_ZI = 427 * MiB, WS_SPEC = 433 * MiB;
constexpr size_t WS_DW = 439 * MiB, WS_DQ = 457 * MiB, WS_DAI = 475 * MiB, WS_DKT = 484 * MiB, WS_DUT = 502 * MiB, WS_DGL = 520 * MiB;
constexpr size_t WS_BIAS = 521 * MiB;
constexpr size_t WS_END = 522 * MiB;

constexpr size_t CTL_ST_OFF = 262144;
constexpr size_t CTL_SS_OFF = 524288;
constexpr int NBMAX = 5632;
constexpr size_t WS_SGUW = 1 * MiB + 512 * 1024;
constexpr int CW_BAR = 4096;

constexpr int LDS_MAIN = 160768;
constexpr int LDS_MISC = LDS_MAIN;
constexpr int LDS_BYTES = LDS_MAIN + 1024;

__device__ __forceinline__ float wave_sum(float v) {
#pragma unroll
    for (int o = 1; o < 64; o <<= 1) v += __shfl_xor(v, o);
    return v;
}
__device__ __forceinline__ unsigned f2bf(float f) { unsigned u = __builtin_bit_cast(unsigned, f); return (u + 0x7fffu + ((u >> 16) & 1u)) >> 16; }
__device__ __forceinline__ unsigned pk2(float lo, float hi) { return f2bf(lo) | (f2bf(hi) << 16); }
__device__ __forceinline__ float silu_f(float x) { return x / (1.f + __expf(-x)); }
__device__ __forceinline__ float sigmoid_f(float x) { return 1.f / (1.f + __expf(-x)); }
__device__ __forceinline__ float gelu_tanh(float x) { const float u = 0.7978845608028654f * (x + 0.044715f * x * x * x); return 0.5f * x * (1.f + tanhf(u)); }
__device__ __forceinline__ float softplus_f(float x) { return x > 20.f ? x : log1pf(expf(x)); }
__device__ __forceinline__ int cond_of_row(int r) { return r < NCTX ? 0 : (r < NCTX + LAT_L ? 1 : 2); }
__device__ __forceinline__ void seq_of_row(int r, int& s0, int& L) { if (r < NCTX) { s0 = r & ~(CTX_L - 1); L = CTX_L; } else { s0 = NCTX + ((r - NCTX) & ~(LAT_L - 1)); L = LAT_L; } }

#define XB_TMO      128
#define XB_XCNT(j)  (256  + 64 * (j))
#define XB_XSUB(j)  (1280 + 64 * (j))
#define XB_XGEN(j)  (2304 + 64 * (j))
#define XB_TOP      3328
#define XB_TOPGEN   3392
#define XCD_BAR_WORDS 3456
#define XB_SPIN_CAP (1u << 18)
__device__ __forceinline__ unsigned xb_ld(unsigned* p)              { return __hip_atomic_load(p, __ATOMIC_RELAXED, __HIP_MEMORY_SCOPE_AGENT); }
__device__ __forceinline__ unsigned xb_add(unsigned* p, unsigned v) { return __hip_atomic_fetch_add(p, v, __ATOMIC_RELAXED, __HIP_MEMORY_SCOPE_AGENT); }
__device__ __forceinline__ unsigned xb_xcc_id() { return (unsigned)__builtin_amdgcn_s_getreg((3 << 11) | 20) & 0xFu; }
#define XB_SPIN(cond, bar) do { unsigned _sp = 0; while (cond) { __builtin_amdgcn_s_sleep(1); \
    if ((++_sp & 255u) == 0u) { if (xb_ld(&(bar)[XB_TMO])) break; if (_sp > XB_SPIN_CAP) { atomicAdd(&(bar)[XB_TMO], 1u); break; } } } } while (0)
struct XcdBarrier { unsigned* bar; unsigned x; volatile LAS unsigned* st; };
__device__ __forceinline__ XcdBarrier xcd_barrier_post(unsigned* bar, volatile LAS unsigned* st) {
    XcdBarrier b; b.bar = bar; b.x = xb_xcc_id(); b.st = st;
    if (threadIdx.x == 0) (void)xb_add(&bar[XB_XCNT(b.x)], 1u);
    return b;
}
__device__ __forceinline__ void xcd_barrier_complete(unsigned* bar, unsigned x, unsigned& nloc, unsigned& nx) {
    const unsigned G = gridDim.x * gridDim.y * gridDim.z;
    unsigned sum, cnt, mine, sp = 0u;
    for (;;) {
        sum = 0u; cnt = 0u; mine = 0u;
#pragma unroll
        for (unsigned j = 0; j < 16; ++j) { const unsigned c = xb_ld(&bar[XB_XCNT(j)]); sum += c; cnt += (c > 0u) ? 1u : 0u; mine = (j == x) ? c : mine; }
        if (sum == G) break;
        __builtin_amdgcn_s_sleep(1);
        if ((++sp & 255u) == 0u) { if (xb_ld(&bar[XB_TMO])) break; if (sp > XB_SPIN_CAP) { atomicAdd(&bar[XB_TMO], 1u); break; } }
    }
    nloc = mine > 0u ? mine : 1u; nx = cnt > 0u ? cnt : 1u;
}
__device__ __forceinline__ void xcd_barrier(const XcdBarrier& b) {
    asm volatile("s_waitcnt vmcnt(0)" ::: "memory");
    __syncthreads();
    if (threadIdx.x == 0) {
        unsigned* bar = b.bar;
        __builtin_amdgcn_s_waitcnt(0);
        unsigned nloc = b.st[0], nx = b.st[1];
        if (nloc == 0u) { xcd_barrier_complete(bar, b.x, nloc, nx); b.st[0] = nloc; b.st[1] = nx; }
        const unsigned old = xb_add(&bar[XB_XSUB(b.x)], 1u);
        const unsigned gen = old / nloc;
        if (old + 1u == (gen + 1u) * nloc) {
            __builtin_amdgcn_fence(__ATOMIC_RELEASE, "agent");
            asm volatile("s_waitcnt vmcnt(0)" ::: "memory");
            const unsigned og = xb_add(&bar[XB_TOP], 1u);
            const unsigned tg = og / nx;
            if (og + 1u == (tg + 1u) * nx) xb_add(&bar[XB_TOPGEN], 1u);
            else XB_SPIN(xb_ld(&bar[XB_TOPGEN]) == tg, bar);
            __builtin_amdgcn_fence(__ATOMIC_ACQUIRE, "agent");
            xb_add(&bar[XB_XGEN(b.x)], 1u);
            asm volatile("s_waitcnt vmcnt(0)" ::: "memory");
        } else {
            XB_SPIN(xb_ld(&bar[XB_XGEN(b.x)]) == gen, bar);
            __builtin_amdgcn_fence(__ATOMIC_ACQUIRE, "agent");
            asm volatile("s_waitcnt vmcnt(0)" ::: "memory");
        }
    }
    __syncthreads();
}

struct Args { const float* in[31]; float* out; unsigned char* ws; int ph_lo, ph_hi; };
enum { I_XP = 0, I_XS, I_STATE, I_C, I_CCTX, I_F1N, I_F1G, I_F1U, I_F1D, I_MIXN, I_F2N, I_F2G, I_F2U, I_F2D, I_ADAW, I_ADAB, I_EVIN, I_EVOUT,
       I_POOLW, I_POOLS, I_CONVW, I_ALOG, I_DTB, I_DNNW, I_ODIN, I_ODOUT, I_SGUN, I_SGUW, I_SGUB, I_FNETW, I_FINN };

struct Frame {
    LAS unsigned char* lds;
    int tid, lane, wave, vcu, G;
    const CAS Args* a;
};

#define DS_READ128(dst, addr) asm volatile("ds_read_b128 %0, %1" : "=v"(dst) : "v"((unsigned)(addr)))
__device__ __forceinline__ void lgkm_wait(int n) {
    switch (n) { case 0: asm volatile("s_waitcnt lgkmcnt(0)" ::: "memory"); break; case 1: asm volatile("s_waitcnt lgkmcnt(1)" ::: "memory"); break;
                 case 2: asm volatile("s_waitcnt lgkmcnt(2)" ::: "memory"); break; default: asm volatile("s_waitcnt lgkmcnt(3)" ::: "memory"); break; }
}
__device__ __forceinline__ void vm_wait(int n) {
    switch (n) { case 0: asm volatile("s_waitcnt vmcnt(0)" ::: "memory"); break; case 4: asm volatile("s_waitcnt vmcnt(4)" ::: "memory"); break;
                 case 5: asm volatile("s_waitcnt vmcnt(5)" ::: "memory"); break; case 6: asm volatile("s_waitcnt vmcnt(6)" ::: "memory"); break;
                 case 7: asm volatile("s_waitcnt vmcnt(7)" ::: "memory"); break; case 8: asm volatile("s_waitcnt vmcnt(8)" ::: "memory"); break;
                 case 9: asm volatile("s_waitcnt vmcnt(9)" ::: "memory"); break; default: asm volatile("s_waitcnt vmcnt(0)" ::: "memory"); break; }
}
template <int NFRAG, class Epi>
__device__ __forceinline__ void gemm_tile(LAS unsigned char* lds, const int tid, const bf16* A, const bf16* Bt, int K, int row0, int col0, const Epi& E) {
    constexpr int BN = 32 * NFRAG, NPB = BN / 8, A_BYTES = 192 * 128, B_BYTES = BN * 128, STAGE = A_BYTES + B_BYTES, NBI = (NPB + 7) / 8;
    constexpr int NS = (3 * STAGE <= LDS_MAIN) ? 3 : 2;
    static_assert(NS * STAGE <= LDS_MAIN, "LDS");
    const int lane = tid & 63, wid = __builtin_amdgcn_readfirstlane(tid >> 6), wm = wid >> 1, wn = wid & 1, fr = lane & 15, fq = lane >> 4;
    const int r = lane >> 3, slot = lane & 7;
    const int srow = wid * 8 + r;
    const int chunk = slot ^ ((srow >> 1) & 7);
    const char* gA = (const char*)(A + (size_t)(row0 + srow) * K) + chunk * 16;
    const char* gB = (const char*)(Bt + (size_t)(col0 + srow) * K) + chunk * 16;
    const size_t pstep = (size_t)64 * K * 2;
    const int nt = K / 64;
    const int nbw = (NPB - wid + 7) / 8;
    const unsigned ldsb = (unsigned)(uintptr_t)lds;
    const int rowA0 = wm * 48 + fr, rowB0 = wn * NFRAG * 16 + fr;
    int offA[2], offB[2];
#pragma unroll
    for (int kk = 0; kk < 2; ++kk) {
        offA[kk] = rowA0 * 128 + (((kk * 4 + fq) ^ ((rowA0 >> 1) & 7)) << 4);
        offB[kk] = A_BYTES + rowB0 * 128 + (((kk * 4 + fq) ^ ((rowB0 >> 1) & 7)) << 4);
    }
    f32x4 acc[3][NFRAG];
#pragma unroll
    for (int i = 0; i < 3; ++i)
#pragma unroll
        for (int j = 0; j < NFRAG; ++j) acc[i][j] = (f32x4){0.f, 0.f, 0.f, 0.f};

#define GEMM_STAGE(buf, t) do { LAS unsigned char* sA_ = lds + (buf) * STAGE + wid * 1024; \
        _Pragma("unroll") for (int i_ = 0; i_ < 3; ++i_) \
            __builtin_amdgcn_global_load_lds((const unsigned*)(gA + i_ * pstep + (size_t)(t) * 128), (LAS unsigned*)(sA_ + i_ * 8192), 16, 0, 0); \
        _Pragma("unroll") for (int i_ = 0; i_ < NBI; ++i_) if (wid + 8 * i_ < NPB) \
            __builtin_amdgcn_global_load_lds((const unsigned*)(gB + i_ * pstep + (size_t)(t) * 128), (LAS unsigned*)(sA_ + A_BYTES + i_ * 8192), 16, 0, 0); } while (0)

    GEMM_STAGE(0, 0);
    if (NS == 3) GEMM_STAGE(1, 1);
    int sbuf = 0;
    for (int t = 0; t < nt; ++t) {
        if (NS == 3) {
            if (t + 1 < nt) { if (nbw == NBI) vm_wait(3 + NBI); else vm_wait(3 + NBI - 1); } else vm_wait(0);
            __builtin_amdgcn_s_barrier();
            if (t + 2 < nt) { const int nb_ = (sbuf >= 1) ? sbuf - 1 : 2; GEMM_STAGE(nb_, t + 2); }
        } else {
            asm volatile("s_waitcnt vmcnt(0)" ::: "memory");
            __syncthreads();
            if (t + 1 < nt) GEMM_STAGE((t + 1) & 1, t + 1);
        }
        {
            const unsigned sbo = (unsigned)sbuf * STAGE;
            const unsigned aA0 = ldsb + sbo + offA[0], aA1 = ldsb + sbo + offA[1], aB0 = ldsb + sbo + offB[0], aB1 = ldsb + sbo + offB[1];
            bf16x8 af[2][3], bq[4];
#pragma unroll
            for (int mf = 0; mf < 3; ++mf) { DS_READ128(af[0][mf], aA0 + mf * 2048); }
#pragma unroll
            for (int mf = 0; mf < 3; ++mf) { DS_READ128(af[1][mf], aA1 + mf * 2048); }
            constexpr int TOT = 2 * NFRAG;
#pragma unroll
            for (int f = 0; f < 3; ++f) { DS_READ128(bq[f], aB0 + f * 2048); }
#pragma unroll
            for (int f = 0; f < TOT; ++f) {
                if (f + 3 < TOT) { const int g = f + 3; DS_READ128(bq[g & 3], ((g >= NFRAG) ? aB1 + (g - NFRAG) * 2048 : aB0 + g * 2048)); }
                const int outstanding = (f + 3 < TOT) ? 3 : (TOT - 1 - f);
                lgkm_wait(outstanding);
                asm volatile("" : "+v"(bq[f & 3]));
                __builtin_amdgcn_sched_barrier(0);
                const int kk = (f >= NFRAG) ? 1 : 0, nf = f - kk * NFRAG;
#pragma unroll
                for (int mf = 0; mf < 3; ++mf) acc[mf][nf] = __builtin_amdgcn_mfma_f32_16x16x32_bf16(bq[f & 3], af[kk][mf], acc[mf][nf], 0, 0, 0);
            }
        }
        sbuf = (sbuf + 1 == NS) ? 0 : sbuf + 1;
    }
#undef GEMM_STAGE
    E(acc, row0 + wm * 48 + fr, col0 + wn * NFRAG * 16 + fq * 4, fq);
    asm volatile("s_waitcnt vmcnt(0)" ::: "memory");
    __syncthreads();
}

struct Pre { const float* ss; const float* bias; };
__device__ __forceinline__ float pre_rstd(const Pre& p, int row) { return 1.0f / sqrtf(p.ss[row] * (1.f / D) + EPS); }
struct EpiUp {
    bf16* H; Pre pre;
    template <int NFRAG> __device__ __forceinline__ void operator()(f32x4 (&acc)[3][NFRAG], int row, int colq, int) const {
#pragma unroll
        for (int mf = 0; mf < 3; ++mf) {
            const int rr = row + mf * 16; const float rs = pre_rstd(pre, rr);
            const float* bp = pre.bias + cond_of_row(rr) * NBMAX + colq;
#pragma unroll
            for (int nf = 0; nf < NFRAG; ++nf) {
                const f32x4 v = acc[mf][nf] * rs + *(const f32x4*)(bp + nf * 16);
                *(unsigned*)(H + (size_t)rr * FF + ((colq + nf * 16) >> 1)) = pk2(silu_f(v[0]) * v[2], silu_f(v[1]) * v[3]);
            }
        }
    }
};
struct EpiRes {
    float* X; const float* mod; int layer, gidx; float scale;
    bf16* XS; float* ssn; const float* nwn; int ln, wn;
    template <int NFRAG> __device__ __forceinline__ void operator()(f32x4 (&acc)[3][NFRAG], int row, int colq, int fq) const {
#pragma unroll
        for (int mf = 0; mf < 3; ++mf) {
            const int rr = row + mf * 16, cnd = cond_of_row(rr);
            const float* g = mod + ((size_t)(layer * 3 + cnd) * 9 + gidx) * 1024;
            const float* scn = mod + ((size_t)(ln * 3 + cnd) * 9 + wn * 3 + 1) * 1024;
            float ssq = 0.f;
#pragma unroll
            for (int nf = 0; nf < NFRAG; ++nf) {
                const int c = colq + nf * 16;
                const f32x4 gv = *(const f32x4*)(g + c);
                f32x4* xp = (f32x4*)(X + (size_t)rr * D + c);
                f32x4 xv = *xp;
                xv += acc[mf][nf] * gv * scale;
                *xp = xv;
                if (ssn) {
                    const f32x4 cv = *(const f32x4*)(nwn + c) * (*(const f32x4*)(scn + c) + 1.0f);
                    const f32x4 hs = xv * cv;
                    u32x2 w; w.x = pk2(hs[0], hs[1]); w.y = pk2(hs[2], hs[3]);
                    *(u32x2*)(XS + (size_t)rr * D + c) = w;
                    ssq += (xv[0] * xv[0] + xv[1] * xv[1]) + (xv[2] * xv[2] + xv[3] * xv[3]);
                }
            }
            if (ssn) { ssq += __shfl_xor(ssq, 16); ssq += __shfl_xor(ssq, 32); if (fq == 0) atomicAdd(ssn + rr, ssq); }
        }
    }
};
struct EpiStore {
    float* P; int ld; Pre pre;
    template <int NFRAG> __device__ __forceinline__ void operator()(f32x4 (&acc)[3][NFRAG], int row, int colq, int) const {
#pragma unroll
        for (int mf = 0; mf < 3; ++mf) {
            const int rr = row + mf * 16; const float rs = pre_rstd(pre, rr);
            const float* bp = pre.bias + cond_of_row(rr) * NBMAX + colq;
#pragma unroll
            for (int nf = 0; nf < NFRAG; ++nf) *(f32x4*)(P + (size_t)rr * ld + colq + nf * 16) = acc[mf][nf] * rs + *(const f32x4*)(bp + nf * 16);
        }
    }
};

template <int NFRAG, class Epi>
__device__ __forceinline__ void gemm_phase(Frame& F, const bf16* A, const bf16* Bt, int K, int N, const Epi& E) {
    constexpr int BN = 32 * NFRAG;
    const int NT = N / BN, nitems = 32 * NT;
    for (int i = F.vcu; i < nitems; i += F.G) {
        const int panel = (i >> 3) & 31, ct = (i & 7) + 8 * (i >> 8);
        gemm_tile<NFRAG, Epi>(F.lds, F.tid, A, Bt, K, panel * 192, ct * BN, E);
    }
}

__device__ __forceinline__ void transpose_item(const float* W, int K, int N, int ldw, bf16* WT, int mode, LAS float* scr, int item, int lane) {
    const int nblk = (N + 63) / 64, kb = item / nblk, nb = item % nblk, k0 = 64 * kb, n0 = 64 * nb;
    const int lc = (lane & 15) * 4, lr = lane >> 4;
    f32x4 v[16];
#pragma unroll
    for (int i = 0; i < 16; ++i) v[i] = (n0 + lc < N) ? *(const f32x4*)(W + (size_t)(k0 + 4 * i + lr) * ldw + n0 + lc) : (f32x4){0.f, 0.f, 0.f, 0.f};
#pragma unroll
    for (int i = 0; i < 16; ++i) { LAS float* p = scr + (4 * i + lr) * 65 + lc; p[0] = v[i][0]; p[1] = v[i][1]; p[2] = v[i][2]; p[3] = v[i][3]; }
    asm volatile("s_waitcnt lgkmcnt(0)" ::: "memory");
    const int c = lane & 7;
#pragma unroll
    for (int j = 0; j < 8; ++j) {
        const int nl = (lane >> 3) + 8 * j, n = n0 + nl; const LAS float* s = scr + (8 * c) * 65 + nl;
        u32x4 o; o.x = pk2(s[0 * 65], s[1 * 65]); o.y = pk2(s[2 * 65], s[3 * 65]); o.z = pk2(s[4 * 65], s[5 * 65]); o.w = pk2(s[6 * 65], s[7 * 65]);
        const int dr = (mode == 0) ? n : ((n >> 1) * 4 + (n & 1) + (mode == 2 ? 2 : 0));
        if (n < N) *(u32x4*)(WT + (size_t)dr * K + k0 + 8 * c) = o;
    }
    asm volatile("s_waitcnt lgkmcnt(0)" ::: "memory");
}

__device__ __forceinline__ void phase_setup(Frame& F) {
    const CAS Args& a = *F.a;
    unsigned char* ws = a.ws;
    {
        LAS float* sc = (LAS float*)F.lds;
        LAS float* red = sc + 3 * 1024;
        for (int i = F.tid; i < 3 * 1024; i += 512) { const int c = i >> 10, k = i & 1023; const float v = (c == 0) ? a.in[I_CCTX][k] : a.in[I_C][(c - 1) * 1024 + k]; sc[i] = silu_f(v); }
        __syncthreads();
        float* mod = (float*)(ws + WS_MOD);
        for (int it = F.vcu; it < 4 * 72; it += F.G) {
            const int l = it / 72, cb = it % 72, q = F.tid & 31, kg = F.tid >> 5;
            const float* W = a.in[I_ADAW] + (size_t)l * 1024 * 9216 + cb * 128 + q * 4;
            f32x4 s0 = {0, 0, 0, 0}, s1 = s0, s2 = s0;
#pragma unroll 4
            for (int k = kg * 64; k < kg * 64 + 64; ++k) {
                const f32x4 w = *(const f32x4*)(W + (size_t)k * 9216);
                s0 += w * sc[k]; s1 += w * sc[1024 + k]; s2 += w * sc[2048 + k];
            }
            LAS float* rp = red + (kg * 32 + q) * 12;
#pragma unroll
            for (int j = 0; j < 4; ++j) { rp[j] = s0[j]; rp[4 + j] = s1[j]; rp[8 + j] = s2[j]; }
            __syncthreads();
            if (F.tid < 384) {
                const int qq = F.tid / 12, v = F.tid % 12; float s = 0.f;
#pragma unroll
                for (int g = 0; g < 16; ++g) s += red[(g * 32 + qq) * 12 + v];
                const int c = v >> 2, j = v & 3, n = cb * 128 + qq * 4 + j;
                mod[(size_t)(l * 3 + c) * 9216 + n] = s + a.in[I_ADAB][l * 9216 + n];
            }
            __syncthreads();
        }
        __syncthreads();
    }
    {
        LAS float* T = (LAS float*)F.lds;
        LAS float* wt = T + 64 * 128;
        LAS float* tw = wt + 64 * 65;
        if (F.tid < 64) { tw[F.tid] = cospif((float)F.tid * (1.f / 32.f)); tw[64 + F.tid] = sinpif((float)F.tid * (1.f / 32.f)); }
        __syncthreads();
        for (int it = F.vcu; it < 2 * 4 * 16; it += F.G) {
            const int j = it >> 6, g = (it >> 4) & 3, k0 = (it & 15) * 64;
            const float* Wg = a.in[I_FNETW] + ((size_t)j * 4 + g) * 4096;
            {
                const int c = F.tid >> 3, eb = (F.tid & 7) * 8;
                float ac[8], as[8];
#pragma unroll
                for (int q = 0; q < 8; ++q) { ac[q] = 0.f; as[q] = 0.f; }
                for (int m = 0; m < 64; ++m) {
                    const int idx = (m * c) & 63; const float cs = tw[idx], sn = tw[64 + idx];
                    const f32x4 w0 = *(const f32x4*)(Wg + m * 64 + eb), w1 = *(const f32x4*)(Wg + m * 64 + eb + 4);
#pragma unroll
                    for (int q = 0; q < 4; ++q) { ac[q] += cs * w0[q]; ac[4 + q] += cs * w1[q]; as[q] -= sn * w0[q]; as[4 + q] -= sn * w1[q]; }
                }
#pragma unroll
                for (int q = 0; q < 8; ++q) { T[c * 128 + eb + q] = ac[q] * 0.125f; T[c * 128 + 64 + eb + q] = as[q] * 0.125f; }
                const int kk = F.tid >> 3, c8 = (F.tid & 7) * 8;
                const float* wp = a.in[I_ODIN] + (size_t)j * D * P_ODD + (size_t)(k0 + kk) * P_ODD + 1536 + g * 64 + c8;
                const f32x4 x0 = *(const f32x4*)wp, x1 = *(const f32x4*)(wp + 4);
#pragma unroll
                for (int q = 0; q < 4; ++q) { wt[kk * 65 + c8 + q] = x0[q]; wt[kk * 65 + c8 + 4 + q] = x1[q]; }
            }
            __syncthreads();
            {
                const int col = F.tid & 127, kq = F.tid >> 7;
                float acc[16];
#pragma unroll
                for (int q = 0; q < 16; ++q) acc[q] = 0.f;
                for (int c = 0; c < 64; ++c) {
                    const float t = T[c * 128 + col];
#pragma unroll
                    for (int q = 0; q < 16; ++q) acc[q] += wt[(kq * 16 + q) * 65 + c] * t;
                }
                const int drow = 1536 + ((col < 64) ? (g * 64 + col) : (256 + g * 64 + col - 64));
                bf16* dst = (bf16*)(ws + WS_ODIN + (size_t)j * ODIN_SZ) + (size_t)drow * D + k0 + kq * 16;
                u32x4 o0, o1;
                o0.x = pk2(acc[0], acc[1]); o0.y = pk2(acc[2], acc[3]); o0.z = pk2(acc[4], acc[5]); o0.w = pk2(acc[6], acc[7]);
                o1.x = pk2(acc[8], acc[9]); o1.y = pk2(acc[10], acc[11]); o1.z = pk2(acc[12], acc[13]); o1.w = pk2(acc[14], acc[15]);
                *(u32x4*)dst = o0; *(u32x4*)(dst + 8) = o1;
            }
            __syncthreads();
        }
        const int gw = F.vcu * 8 + F.wave, NGW = F.G * 8;
        for (int it = gw; it < 2 * NH * 16384 / 512; it += NGW) {
            const float* sp = a.in[I_SGUW] + (size_t)it * 512 + F.lane * 8;
            const f32x4 x0 = *(const f32x4*)sp, x1 = *(const f32x4*)(sp + 4);
            u32x4 o; o.x = pk2(x0[0], x0[1]); o.y = pk2(x0[2], x0[3]); o.z = pk2(x1[0], x1[1]); o.w = pk2(x1[2], x1[3]);
            *(u32x4*)((bf16*)(ws + WS_SGUW) + (size_t)it * 512 + F.lane * 8) = o;
        }
        __syncthreads();
    }
    {
        LAS float* scr = (LAS float*)(F.lds + F.wave * 16640);
        const int gw = F.vcu * 8 + F.wave, NGW = F.G * 8;
        constexpr int IT_G = 16 * 44, IT_D = 44 * 16, IT_EVIN = 16 * 53, IT_SQ = 16 * 16, IT_ODIN = 16 * 24;
        static_assert(IT_G == IT_D, "decode");
        constexpr int PER_FFN = 2 * IT_G + IT_D;
        constexpr int TOT = 8 * PER_FFN + 2 * (IT_EVIN + IT_SQ + IT_ODIN + IT_SQ);
        for (int it = gw; it < TOT; it += NGW) {
            int r = it; const float* W; bf16* WT; int K, N, mode, ldw = 0;
            if (r < 8 * PER_FFN) {
                const int f = r / PER_FFN, l = f >> 1, s = f & 1; r -= f * PER_FFN;
                const int sub = r / IT_G; r -= sub * IT_G;
                const int idx = (sub == 0) ? (s ? I_F2G : I_F1G) : ((sub == 1) ? (s ? I_F2U : I_F1U) : (s ? I_F2D : I_F1D));
                W = a.in[idx] + (size_t)l * D * FF;
                WT = (sub == 2) ? (bf16*)(ws + WS_WDN + (size_t)f * WDN_SZ) : (bf16*)(ws + WS_WUP + (size_t)f * WUP_SZ);
                K = (sub == 2) ? FF : D; N = (sub == 2) ? D : FF; mode = (sub == 2) ? 0 : sub + 1;
            } else {
                r -= 8 * PER_FFN;
                constexpr int PER_E = IT_EVIN + IT_SQ + IT_ODIN + IT_SQ;
                const int e = r / PER_E; r -= e * PER_E;
                K = D; mode = 0;
                if (r < IT_EVIN) { W = a.in[I_EVIN] + (size_t)e * D * P_EVEN; N = P_EVEN; WT = (bf16*)(ws + WS_EVIN + (size_t)e * EVIN_SZ); }
                else if (r < IT_EVIN + IT_SQ) { r -= IT_EVIN; W = a.in[I_EVOUT] + (size_t)e * D * D; N = D; WT = (bf16*)(ws + WS_EVOUT + (size_t)e * SQ_SZ); }
                else if (r < IT_EVIN + IT_SQ + IT_ODIN) { r -= IT_EVIN + IT_SQ; W = a.in[I_ODIN] + (size_t)e * D * P_ODD; N = 1536; ldw = P_ODD; WT = (bf16*)(ws + WS_ODIN + (size_t)e * ODIN_SZ); }
                else { r -= IT_EVIN + IT_SQ + IT_ODIN; W = a.in[I_ODOUT] + (size_t)e * D * D; N = D; WT = (bf16*)(ws + WS_ODOUT + (size_t)e * SQ_SZ); }
            }
            transpose_item(W, K, N, ldw ? ldw : N, WT, mode, scr, r, F.lane);
        }
        for (int it = gw; it < 2 * (P_EVEN_PAD - P_EVEN); it += NGW) {
            const int e = it / (P_EVEN_PAD - P_EVEN), rr = P_EVEN + it % (P_EVEN_PAD - P_EVEN);
            u32x4* p = (u32x4*)((bf16*)(ws + WS_EVIN + (size_t)e * EVIN_SZ) + (size_t)rr * D);
            p[F.lane] = (u32x4){0, 0, 0, 0}; p[64 + F.lane] = (u32x4){0, 0, 0, 0};
        }
        float* X = (float*)(ws + WS_X);
        for (int row = gw; row < M; row += NGW) {
            float* xo = X + (size_t)row * D;
            if (row < NCTX) {
                const f32x4* src = (const f32x4*)(a.in[I_XP] + (size_t)row * D);
#pragma unroll
                for (int j = 0; j < 4; ++j) ((f32x4*)xo)[j * 64 + F.lane] = src[j * 64 + F.lane];
            } else {
                const int t = (row - NCTX) & (LAT_L - 1); const float pr = (float)(t >> 6), pc = (float)(t & 63);
                const float* src = a.in[I_XS] + (size_t)(row - NCTX) * D;
#pragma unroll
                for (int j = 0; j < 16; ++j) {
                    const int ch = j * 64 + F.lane, seg = ch >> 8, i = ch & 255;
                    const float freq = expf(-9.210340371976184f * (float)i * (1.0f / 256.0f));
                    const float ang = ((seg < 2) ? pr : pc) * freq;
                    const float pe = (seg & 1) ? cosf(ang) : sinf(ang);
                    xo[ch] = src[ch] + pe;
                }
            }
        }
    }
}

__device__ __forceinline__ const bf16* sub_weight(unsigned char* ws, int s, int& N) {
    const int l = s / 3, which = s % 3, e = l >> 1;
    if (which != 1) { N = NUP; return (const bf16*)(ws + WS_WUP + (size_t)(l * 2 + (which == 2 ? 1 : 0)) * WUP_SZ); }
    if ((l & 1) == 0) { N = P_EVEN_PAD; return (const bf16*)(ws + WS_EVIN + (size_t)e * EVIN_SZ); }
    N = 2048; return (const bf16*)(ws + WS_ODIN + (size_t)e * ODIN_SZ);
}
__device__ __forceinline__ void phase_init(Frame& F) {
    const CAS Args& a = *F.a; unsigned char* ws = a.ws;
    const float* mod = (const float*)(ws + WS_MOD);
    const int gw = F.vcu * 8 + F.wave, NGW = F.G * 8;
    {
        float* bias = (float*)(ws + WS_BIAS);
        constexpr int IT_FF = NUP / 16, IT_EV = P_EVEN_PAD / 16, IT_OD = 2048 / 16, PER_PAIR = 4 * IT_FF + IT_EV + IT_OD;
        for (int it = gw; it < 2 * PER_PAIR; it += NGW) {
            int r = it % PER_PAIR; const int pair = it / PER_PAIR;
            int s;
            if (r < IT_FF) { s = 0; } else if ((r -= IT_FF) < IT_EV) { s = 1; } else if ((r -= IT_EV) < IT_FF) { s = 2; } else if ((r -= IT_FF) < IT_FF) { s = 3; } else if ((r -= IT_FF) < IT_OD) { s = 4; } else { r -= IT_OD; s = 5; }
            s += pair * 6;
            int N; const bf16* WT = sub_weight(ws, s, N);
            const int l = s / 3, which = s % 3;
            float sh[3][16];
#pragma unroll
            for (int c = 0; c < 3; ++c) {
                const float* sp = mod + ((size_t)(l * 3 + c) * 9 + which * 3) * 1024 + F.lane * 16;
#pragma unroll
                for (int q = 0; q < 4; ++q) { const f32x4 t = *(const f32x4*)(sp + q * 4); sh[c][q * 4] = t[0]; sh[c][q * 4 + 1] = t[1]; sh[c][q * 4 + 2] = t[2]; sh[c][q * 4 + 3] = t[3]; }
            }
            for (int rb = 0; rb < 16; rb += 8) {
                u32x4 w0[8], w1[8];
#pragma unroll
                for (int u = 0; u < 8; ++u) { const bf16* wp = WT + (size_t)(r * 16 + rb + u) * D + F.lane * 16; w0[u] = *(const u32x4*)wp; w1[u] = *(const u32x4*)(wp + 8); }
#pragma unroll
                for (int u = 0; u < 8; ++u) {
                    const unsigned wd[8] = {w0[u].x, w0[u].y, w0[u].z, w0[u].w, w1[u].x, w1[u].y, w1[u].z, w1[u].w};
                    float d0 = 0.f, d1 = 0.f, d2 = 0.f;
#pragma unroll
                    for (int q = 0; q < 8; ++q) {
                        const float lo = __builtin_bit_cast(float, wd[q] << 16), hi = __builtin_bit_cast(float, wd[q] & 0xffff0000u);
                        d0 += lo * sh[0][2 * q] + hi * sh[0][2 * q + 1]; d1 += lo * sh[1][2 * q] + hi * sh[1][2 * q + 1]; d2 += lo * sh[2][2 * q] + hi * sh[2][2 * q + 1];
                    }
                    d0 = wave_sum(d0); d1 = wave_sum(d1); d2 = wave_sum(d2);
                    const int n = r * 16 + rb + u;
                    if (F.lane == 0) { bias[((size_t)s * 3 + 0) * NBMAX + n] = d0; bias[((size_t)s * 3 + 1) * NBMAX + n] = d1; bias[((size_t)s * 3 + 2) * NBMAX + n] = d2; }
                }
            }
        }
    }
    {
        const float* X = (const float*)(ws + WS_X); bf16* XS = (bf16*)(ws + WS_HN);
        float* ss = (float*)(ws + WS_CTL + CTL_SS_OFF);
        const float* nw = a.in[I_F1N];
        for (int row = gw; row < M; row += NGW) {
            const f32x4* xr = (const f32x4*)(X + (size_t)row * D) + F.lane;
            f32x4 v[4]; float s = 0.f;
#pragma unroll
            for (int j = 0; j < 4; ++j) { v[j] = xr[64 * j]; s += v[j][0] * v[j][0] + v[j][1] * v[j][1] + v[j][2] * v[j][2] + v[j][3] * v[j][3]; }
            s = wave_sum(s);
            if (F.lane == 0) ss[row] = s;
            const float* mb = mod + ((size_t)(0 * 3 + cond_of_row(row)) * 9 + 1) * 1024;
            u32x2* o = (u32x2*)(XS + (size_t)row * D) + F.lane;
#pragma unroll
            for (int j = 0; j < 4; ++j) {
                const int k = (64 * j + F.lane) * 4;
                const f32x4 h = v[j] * *(const f32x4*)(nw + k) * (*(const f32x4*)(mb + k) + 1.0f);
                u32x2 pkd; pkd.x = pk2(h[0], h[1]); pkd.y = pk2(h[2], h[3]);
                o[64 * j] = pkd;
            }
        }
    }
}

__device__ __forceinline__ void phase_final(Frame& F) {
    const CAS Args& a = *F.a;
    const float* X = (const float*)(a.ws + WS_X);
    const float* nw = a.in[I_FINN];
    const int gw = F.vcu * 8 + F.wave, NGW = F.G * 8;
    for (int row = gw; row < M; row += NGW) {
        const f32x4* xr = (const f32x4*)(X + (size_t)row * D) + F.lane;
        f32x4 v[4]; float s = 0.f;
#pragma unroll
        for (int j = 0; j < 4; ++j) { v[j] = xr[64 * j]; s += v[j][0] * v[j][0] + v[j][1] * v[j][1] + v[j][2] * v[j][2] + v[j][3] * v[j][3]; }
        const float rstd = 1.0f / sqrtf(wave_sum(s) * (1.f / D) + EPS);
        f32x4* o = (f32x4*)(a.out + (size_t)row * D) + F.lane;
#pragma unroll
        for (int j = 0; j < 4; ++j) { const f32x4 w = *(const f32x4*)(nw + (64 * j + F.lane) * 4); o[64 * j] = v[j] * rstd * w; }
    }
}

__device__ __forceinline__ float wave_matvec64(float d, const float* W, int lane) {
    float y = 0.f;
#pragma unroll
    for (int c = 0; c < 64; ++c) { const float dc = __builtin_bit_cast(float, __builtin_amdgcn_readlane(__builtin_bit_cast(int, d), c)); y += dc * W[c * 64 + lane]; }
    return y;
}

__device__ __forceinline__ int perm32(int x) { return (x & ~31) | ((x & 12) << 1) | ((x & 16) >> 2) | (x & 3); }
__device__ __forceinline__ int sw256(int row, int c16) { return row * 256 + ((c16 ^ (row & 15)) << 4); }
__device__ __forceinline__ int sw128(int row, int c8) { return row * 128 + ((c8 ^ ((row >> 1) & 7)) << 4); }
__device__ __forceinline__ int e128(int row, int col) { return sw128(row, col >> 3) + (col & 7) * 2; }
__device__ __forceinline__ void dn_item_decode(int cc, int& row0, int& L, int& c) {
    if (cc < 64) { row0 = (cc >> 2) * CTX_L; L = CTX_L; c = cc & 3; } else { const int q = cc - 64; row0 = NCTX + (q >> 4) * LAT_L; L = LAT_L; c = q & 15; }
}
#define MFMA16(a, b, c) __builtin_amdgcn_mfma_f32_16x16x32_bf16((a), (b), (c), 0, 0, 0)

__device__ __forceinline__ void phase_dn_prep(Frame& F, int e) {
    const CAS Args& a = *F.a;
    const float* P = (const float*)(a.ws + WS_P);
    const float* cw = a.in[I_CONVW] + (size_t)e * 3 * 2304;
    LAS unsigned char* L = F.lds;
    constexpr int KB = 0, QB = 16384, VBT = 32768, KGT = 49152, KDT = 65536, AIo = 81920, MM = 90112, TT = 98304, TN = 106496, MD = 114688, XT = 118784, SM = 139264;
    LAS float* sm = (LAS float*)(L + SM);
    const int wave = F.wave;
    for (int rec = F.vcu; rec < 1152; rec += F.G) {
        int tid_ = F.tid; asm volatile("" : "+v"(tid_));
        const int lane = tid_ & 63, fr = lane & 15, fq = lane >> 4;
        const int dir = rec & 1, h = (rec >> 1) % NH, cc = rec / (2 * NH);
        int row0, Ls, c; dn_item_decode(cc, row0, Ls, c);
        __syncthreads();
        if (wave == 0) {
            const int row = row0 + (dir ? (Ls - 1 - (c * 64 + lane)) : (c * 64 + lane));
            const float araw = P[(size_t)row * LDP + 3340 + dir * 6 + h], braw = P[(size_t)row * LDP + 3328 + dir * 6 + h];
            const float al = a.in[I_ALOG][(e * 2 + dir) * 6 + h], dtb = a.in[I_DTB][(e * 2 + dir) * 6 + h];
            float x = -expf(al) * softplus_f(araw + dtb); const float b = sigmoid_f(braw);
#pragma unroll
            for (int o = 1; o < 64; o <<= 1) { const float t = __shfl_up(x, o); if (lane >= o) x += t; }
            const float gl = __shfl(x, 63);
            sm[lane] = x; sm[64 + lane] = b; sm[128 + lane] = expf(x); sm[192 + lane] = expf(gl - x);
            if (lane == 63) ((float*)(a.ws + WS_DGL))[rec] = expf(x);
        }
        __syncthreads();
        {
            const int i = tid_ >> 3, cg = tid_ & 7;
            const int row = row0 + (dir ? (Ls - 1 - (c * 64 + i)) : (c * 64 + i));
            const int tl = row - row0; const bool hp = tl > 0, hn = tl < Ls - 1;
            float kf[16], qf[16], vf[16];
#pragma unroll
            for (int part = 0; part < 3; ++part) {
                const int pc = 256 + part * 768 + h * 128 + cg * 16, wc = part * 768 + h * 128 + cg * 16;
                const float* p1 = P + (size_t)row * LDP + pc;
                float out[16];
#pragma unroll
                for (int q4 = 0; q4 < 4; ++q4) {
                    const f32x4 x1 = *(const f32x4*)(p1 + q4 * 4);
                    const f32x4 x0 = hp ? *(const f32x4*)(p1 - LDP + q4 * 4) : (f32x4){0.f, 0.f, 0.f, 0.f};
                    const f32x4 x2 = hn ? *(const f32x4*)(p1 + LDP + q4 * 4) : (f32x4){0.f, 0.f, 0.f, 0.f};
                    const f32x4 w0 = *(const f32x4*)(cw + wc + q4 * 4), w1 = *(const f32x4*)(cw + 2304 + wc + q4 * 4), w2 = *(const f32x4*)(cw + 4608 + wc + q4 * 4);
                    const f32x4 y = x0 * w0 + x1 * w1 + x2 * w2;
#pragma unroll
                    for (int j = 0; j < 4; ++j) out[q4 * 4 + j] = silu_f(y[j]);
                }
                if (part < 2) {
                    float ssq = 0.f;
#pragma unroll
                    for (int j = 0; j < 16; ++j) ssq += out[j] * out[j];
                    ssq += __shfl_xor(ssq, 1); ssq += __shfl_xor(ssq, 2); ssq += __shfl_xor(ssq, 4);
                    const float rs = (1.0f / sqrtf(ssq + EPS)) * (part == 0 ? 0.08838834764831845f : 1.0f);
#pragma unroll
                    for (int j = 0; j < 16; ++j) { if (part == 0) qf[j] = out[j] * rs; else kf[j] = out[j] * rs; }
                } else {
#pragma unroll
                    for (int j = 0; j < 16; ++j) vf[j] = out[j];
                }
            }
            const float be = sm[64 + i], eg = sm[128 + i], ek = sm[192 + i];
#pragma unroll
            for (int hf = 0; hf < 2; ++hf) {
                u32x4 kk, qq;
                kk.x = pk2(kf[hf * 8 + 0], kf[hf * 8 + 1]); kk.y = pk2(kf[hf * 8 + 2], kf[hf * 8 + 3]); kk.z = pk2(kf[hf * 8 + 4], kf[hf * 8 + 5]); kk.w = pk2(kf[hf * 8 + 6], kf[hf * 8 + 7]);
                qq.x = pk2(qf[hf * 8 + 0], qf[hf * 8 + 1]); qq.y = pk2(qf[hf * 8 + 2], qf[hf * 8 + 3]); qq.z = pk2(qf[hf * 8 + 4], qf[hf * 8 + 5]); qq.w = pk2(qf[hf * 8 + 6], qf[hf * 8 + 7]);
                *(LAS u32x4*)(L + KB + sw256(i, cg * 2 + hf)) = kk;
                *(LAS u32x4*)(L + QB + sw256(i, cg * 2 + hf)) = qq;
            }
            bf16* QD = (bf16*)(a.ws + WS_DQ) + (size_t)rec * 8192 + i * 128;
#pragma unroll
            for (int qq = 0; qq < 4; ++qq) {
                const int pos = perm32(cg * 16 + 4 * qq);
                u32x2 w; w.x = pk2(qf[4 * qq] * eg, qf[4 * qq + 1] * eg); w.y = pk2(qf[4 * qq + 2] * eg, qf[4 * qq + 3] * eg);
                *(u32x2*)(QD + pos) = w;
            }
            const int pi = perm32(i); const float bg = be * eg;
#pragma unroll
            for (int ee = 0; ee < 16; ++ee) {
                const int kd = cg * 16 + ee;
                *(LAS bf16*)(L + VBT + e128(kd, i)) = (bf16)f2bf(vf[ee] * be);
                *(LAS bf16*)(L + KGT + e128(kd, i)) = (bf16)f2bf(kf[ee] * bg);
                *(LAS bf16*)(L + KDT + e128(kd, pi)) = (bf16)f2bf(kf[ee] * ek);
            }
        }
        __syncthreads();
        const int mi = wave >> 1;
#pragma unroll
        for (int f = 0; f < 2; ++f) {
            const int nj = (wave & 1) * 2 + f;
            f32x4 kkacc = {0.f, 0.f, 0.f, 0.f}, qkacc = {0.f, 0.f, 0.f, 0.f};
            if (nj <= mi) {
#pragma unroll
                for (int ks = 0; ks < 4; ++ks) {
                    const bf16x8 ak = *(const LAS bf16x8*)(L + KB + sw256(mi * 16 + fr, ks * 4 + fq));
                    const bf16x8 aq = *(const LAS bf16x8*)(L + QB + sw256(mi * 16 + fr, ks * 4 + fq));
                    const bf16x8 bk = *(const LAS bf16x8*)(L + KB + sw256(nj * 16 + fr, ks * 4 + fq));
                    kkacc = MFMA16(ak, bk, kkacc); qkacc = MFMA16(aq, bk, qkacc);
                }
            }
            const int j = nj * 16 + fr, i0 = mi * 16 + 4 * fq; const float gcj = sm[j];
#pragma unroll
            for (int r = 0; r < 4; ++r) {
                const int i = i0 + r; const float dec = (i >= j) ? expf(sm[i] - gcj) : 0.f;
                const float mv = (i > j) ? (sm[64 + i] * kkacc[r] * dec) : 0.f;
                if (nj <= mi) *(LAS bf16*)(L + MM + e128(i, j)) = (bf16)f2bf(mv);
                if (nj == mi) *(LAS float*)(L + MD + ((mi * 16 + 4 * fq + r) * 16 + fr) * 4) = mv;
                if (nj > mi) *(LAS bf16*)(L + TN + e128(i, j)) = (bf16)0;
                *(LAS bf16*)(L + AIo + e128(i, perm32(j))) = (bf16)f2bf(qkacc[r] * dec);
            }
        }
        __syncthreads();
        if (wave == 0) {
            const int b = lane >> 4, cc_ = lane & 15;
            const LAS float* md = (const LAS float*)(L + MD) + b * 256;
            float T[16];
#pragma unroll
            for (int i = 0; i < 16; ++i) {
                float s = (i == cc_) ? 1.f : 0.f;
#pragma unroll
                for (int jj = 0; jj < i; ++jj) s -= md[i * 16 + jj] * T[jj];
                T[i] = s;
            }
#pragma unroll
            for (int i = 0; i < 16; ++i) *(LAS bf16*)(L + TN + e128(16 * b + i, 16 * b + cc_)) = (bf16)f2bf(T[i]);
#pragma unroll
            for (int hf = 0; hf < 2; ++hf) {
                u32x4 t; t.x = pk2(T[hf * 8 + 0], T[hf * 8 + 1]); t.y = pk2(T[hf * 8 + 2], T[hf * 8 + 3]); t.z = pk2(T[hf * 8 + 4], T[hf * 8 + 5]); t.w = pk2(T[hf * 8 + 6], T[hf * 8 + 7]);
                *(LAS u32x4*)(L + TT + sw128(16 * b + cc_, 2 * b + hf)) = t;
            }
        }
        __syncthreads();
#pragma unroll
        for (int lvl = 1; lvl <= 3; ++lvl) {
            if (wave < 4 - lvl) {
                const int J = wave, I = wave + lvl;
                f32x4 x = {0.f, 0.f, 0.f, 0.f};
                const bf16x8 zero8 = {0, 0, 0, 0, 0, 0, 0, 0};
#pragma unroll
                for (int ks = 0; ks < (lvl == 3 ? 2 : 1); ++ks) {
                    const bf16x8 am = *(const LAS bf16x8*)(L + MM + sw128(16 * I + fr, 2 * J + 4 * ks + fq));
                    bf16x8 bt = *(const LAS bf16x8*)(L + TT + sw128(16 * J + fr, 2 * J + 4 * ks + fq));
                    if (4 * ks + fq >= 2 * lvl) bt = zero8;
                    x = MFMA16(am, bt, x);
                }
                LAS unsigned char* xt = L + XT + wave * 512;
                { u32x2 t; t.x = pk2(x[0], x[1]); t.y = pk2(x[2], x[3]); *(LAS u32x2*)(xt + fr * 32 + fq * 8) = t; }
                const bf16x8 ad = *(const LAS bf16x8*)(L + TN + sw128(16 * I + fr, 2 * I + (fq & 1)));
                bf16x8 bx = *(const LAS bf16x8*)(xt + fr * 32 + (fq & 1) * 16);
                if (fq >= 2) bx = zero8;
                f32x4 t4 = {0.f, 0.f, 0.f, 0.f};
                t4 = MFMA16(ad, bx, t4);
#pragma unroll
                for (int r = 0; r < 4; ++r) *(LAS bf16*)(L + TN + e128(16 * I + 4 * fq + r, 16 * J + fr)) = (bf16)f2bf(-t4[r]);
                { u32x2 t; t.x = pk2(-t4[0], -t4[1]); t.y = pk2(-t4[2], -t4[3]); *(LAS u32x2*)(L + TT + e128(16 * J + fr, 16 * I + 4 * fq)) = t; }
            }
            __syncthreads();
        }
        {
            bf16* UT = (bf16*)(a.ws + WS_DUT) + (size_t)rec * 8192;
            bf16* Wn = (bf16*)(a.ws + WS_DW) + (size_t)rec * 8192;
            const int ui = wave & 3;
#pragma unroll
            for (int f = 0; f < 4; ++f) {
                const int dvf = (wave >> 2) * 4 + f;
                f32x4 acc = {0.f, 0.f, 0.f, 0.f};
#pragma unroll
                for (int ks = 0; ks < 2; ++ks) {
                    const bf16x8 ta = *(const LAS bf16x8*)(L + TN + sw128(ui * 16 + fr, ks * 4 + fq));
                    const bf16x8 vb = *(const LAS bf16x8*)(L + VBT + sw128(dvf * 16 + fr, ks * 4 + fq));
                    acc = MFMA16(ta, vb, acc);
                }
                u32x2 t; t.x = pk2(acc[0], acc[1]); t.y = pk2(acc[2], acc[3]);
                *(u32x2*)(UT + (dvf * 16 + fr) * 64 + ui * 16 + 4 * fq) = t;
            }
#pragma unroll
            for (int f = 0; f < 4; ++f) {
                f32x4 acc = {0.f, 0.f, 0.f, 0.f};
#pragma unroll
                for (int ks = 0; ks < 2; ++ks) {
                    const bf16x8 ka = *(const LAS bf16x8*)(L + KGT + sw128(wave * 16 + fr, ks * 4 + fq));
                    const bf16x8 tb = *(const LAS bf16x8*)(L + TN + sw128(f * 16 + fr, ks * 4 + fq));
                    acc = MFMA16(ka, tb, acc);
                }
                u32x2 t; t.x = pk2(-acc[0], -acc[1]); t.y = pk2(-acc[2], -acc[3]);
                *(u32x2*)(Wn + (f * 16 + fr) * 128 + perm32(wave * 16 + 4 * fq)) = t;
            }
            {
                const int rw = tid_ >> 3, c8 = tid_ & 7;
                *(u32x4*)((unsigned char*)(a.ws + WS_DAI) + (size_t)rec * 8192 + rw * 128 + c8 * 16) = *(const LAS u32x4*)(L + AIo + sw128(rw, c8));
#pragma unroll
                for (int k2 = 0; k2 < 2; ++k2) {
                    const int rr = rw + 64 * k2;
                    *(u32x4*)((unsigned char*)(a.ws + WS_DKT) + (size_t)rec * 16384 + rr * 128 + c8 * 16) = *(const LAS u32x4*)(L + KDT + sw128(rr, c8));
                }
            }
        }
    }
    __syncthreads();
}

__device__ __forceinline__ void phase_dn_scan(Frame& F, int e) {
    const CAS Args& a = *F.a;
    LAS unsigned char* L = F.lds;
    constexpr int BUF = 57344, oW = 0, oQ = 16384, oA = 32768, oK = 40960;
    const int wave = F.wave;
    const unsigned char* gW = (const unsigned char*)(a.ws + WS_DW); const unsigned char* gQ = (const unsigned char*)(a.ws + WS_DQ);
    const unsigned char* gA = (const unsigned char*)(a.ws + WS_DAI); const unsigned char* gK = (const unsigned char*)(a.ws + WS_DKT);
    const bf16* gU = (const bf16*)(a.ws + WS_DUT); const float* gGL = (const float*)(a.ws + WS_DGL);
    for (int it = F.vcu; it < (2 * LAT_B + CTX_B) * 2 * NH; it += F.G) {
        int tid_ = F.tid; asm volatile("" : "+v"(tid_));
        const int lane = tid_ & 63, fr = lane & 15, fq = lane >> 4;
        const int r4 = lane >> 4, s16 = lane & 15, r8 = lane >> 3, s8 = lane & 7;
        int seq, dir, h, half = 0;
        if (it < 2 * LAT_B * 2 * NH) { half = it & 1; const int j = it >> 1; seq = CTX_B + j / (2 * NH); dir = (j / NH) & 1; h = j % NH; }
        else { const int j = it - 2 * LAT_B * 2 * NH; seq = j / (2 * NH); dir = (j / NH) & 1; h = j % NH; }
        const bool lat = seq >= CTX_B;
        const bool active = lat ? (wave < 4) : true;
        const int dvc = (lat ? half * 64 : 0) + (wave & (lat ? 3 : 7)) * 16 + fr;
        const int Ls = lat ? LAT_L : CTX_L, row0 = lat ? NCTX + (seq - CTX_B) * LAT_L : seq * CTX_L, nch = Ls / 64;
        const int cbase = lat ? 64 + (seq - CTX_B) * 16 : seq * 4;
        f32x4 S[8];
        if (lat) {
            const float* s0 = a.in[I_STATE] + ((((size_t)(seq - CTX_B) * 2 + e) * 2 + dir) * NH + h) * 128 * 128;
#pragma unroll
            for (int mf = 0; mf < 8; ++mf)
#pragma unroll
                for (int r = 0; r < 4; ++r) S[mf][r] = s0[(size_t)(mf * 16 + 4 * fq + r) * 128 + dvc];
        } else {
#pragma unroll
            for (int mf = 0; mf < 8; ++mf) S[mf] = (f32x4){0.f, 0.f, 0.f, 0.f};
        }
        float* O = (float*)(a.ws + (dir ? WS_OB : WS_OF));
#define DN_STAGE(bufi, rec_) do { LAS unsigned char* sb_ = L + (bufi) * BUF; const size_t ro_ = (size_t)(rec_); \
        _Pragma("unroll") for (int p_ = 0; p_ < 2; ++p_) { const int pc_ = wave + 8 * p_; const int rw_ = pc_ * 4 + r4; const int so_ = rw_ * 256 + ((s16 ^ (rw_ & 15)) << 4); \
            __builtin_amdgcn_global_load_lds((const unsigned*)(gW + ro_ * 16384 + so_), (LAS unsigned*)(sb_ + oW + pc_ * 1024), 16, 0, 0); \
            __builtin_amdgcn_global_load_lds((const unsigned*)(gQ + ro_ * 16384 + so_), (LAS unsigned*)(sb_ + oQ + pc_ * 1024), 16, 0, 0); \
            const int rk_ = pc_ * 8 + r8; const int sk_ = rk_ * 128 + ((s8 ^ ((rk_ >> 1) & 7)) << 4); \
            __builtin_amdgcn_global_load_lds((const unsigned*)(gK + ro_ * 16384 + sk_), (LAS unsigned*)(sb_ + oK + pc_ * 1024), 16, 0, 0); } \
        { const int ra_ = wave * 8 + r8; const int sa_ = ra_ * 128 + ((s8 ^ ((ra_ >> 1) & 7)) << 4); \
            __builtin_amdgcn_global_load_lds((const unsigned*)(gA + ro_ * 8192 + sa_), (LAS unsigned*)(sb_ + oA + wave * 1024), 16, 0, 0); } } while (0)
        __syncthreads();
        int rec = (cbase * NH + h) * 2 + dir;
        DN_STAGE(0, rec);
        u32x2 un[4]; float gln;
#pragma unroll
        for (int mf = 0; mf < 4; ++mf) un[mf] = *(const u32x2*)(gU + (size_t)rec * 8192 + dvc * 64 + mf * 16 + 4 * fq);
        gln = gGL[rec];
        for (int c = 0; c < nch; ++c) {
            asm volatile("s_waitcnt vmcnt(0)" ::: "memory");
            __syncthreads();
            u32x2 uc[4]; const float gl = gln;
#pragma unroll
            for (int mf = 0; mf < 4; ++mf) uc[mf] = un[mf];
            if (c + 1 < nch) {
                const int rn = rec + 2 * NH;
                DN_STAGE((c + 1) & 1, rn);
#pragma unroll
                for (int mf = 0; mf < 4; ++mf) un[mf] = *(const u32x2*)(gU + (size_t)rn * 8192 + dvc * 64 + mf * 16 + 4 * fq);
                gln = gGL[rn];
            }
            if (active) {
            LAS unsigned char* sb = L + (c & 1) * BUF;
            bf16x8 Sb[4];
#pragma unroll
            for (int ks = 0; ks < 4; ++ks) {
                u32x4 t; t.x = pk2(S[2 * ks][0], S[2 * ks][1]); t.y = pk2(S[2 * ks][2], S[2 * ks][3]); t.z = pk2(S[2 * ks + 1][0], S[2 * ks + 1][1]); t.w = pk2(S[2 * ks + 1][2], S[2 * ks + 1][3]);
                Sb[ks] = __builtin_bit_cast(bf16x8, t);
            }
            f32x4 vn[4], o[4];
#pragma unroll
            for (int mf = 0; mf < 4; ++mf) {
                vn[mf][0] = __builtin_bit_cast(float, uc[mf].x << 16); vn[mf][1] = __builtin_bit_cast(float, uc[mf].x & 0xffff0000u);
                vn[mf][2] = __builtin_bit_cast(float, uc[mf].y << 16); vn[mf][3] = __builtin_bit_cast(float, uc[mf].y & 0xffff0000u);
                o[mf] = (f32x4){0.f, 0.f, 0.f, 0.f};
#pragma unroll
                for (int ks = 0; ks < 4; ++ks) {
                    const bf16x8 wf = *(const LAS bf16x8*)(sb + oW + sw256(mf * 16 + fr, ks * 4 + fq));
                    const bf16x8 qf = *(const LAS bf16x8*)(sb + oQ + sw256(mf * 16 + fr, ks * 4 + fq));
                    vn[mf] = MFMA16(wf, Sb[ks], vn[mf]);
                    o[mf] = MFMA16(qf, Sb[ks], o[mf]);
                }
            }
            bf16x8 Vb[2];
#pragma unroll
            for (int ks = 0; ks < 2; ++ks) {
                u32x4 t; t.x = pk2(vn[2 * ks][0], vn[2 * ks][1]); t.y = pk2(vn[2 * ks][2], vn[2 * ks][3]); t.z = pk2(vn[2 * ks + 1][0], vn[2 * ks + 1][1]); t.w = pk2(vn[2 * ks + 1][2], vn[2 * ks + 1][3]);
                Vb[ks] = __builtin_bit_cast(bf16x8, t);
            }
#pragma unroll
            for (int mf = 0; mf < 4; ++mf)
#pragma unroll
                for (int ks = 0; ks < 2; ++ks) {
                    const bf16x8 af = *(const LAS bf16x8*)(sb + oA + sw128(mf * 16 + fr, ks * 4 + fq));
                    o[mf] = MFMA16(af, Vb[ks], o[mf]);
                }
#pragma unroll
            for (int mf = 0; mf < 8; ++mf) {
                S[mf] = S[mf] * gl;
#pragma unroll
                for (int ks = 0; ks < 2; ++ks) {
                    const bf16x8 kf = *(const LAS bf16x8*)(sb + oK + sw128(mf * 16 + fr, ks * 4 + fq));
                    S[mf] = MFMA16(kf, Vb[ks], S[mf]);
                }
            }
#pragma unroll
            for (int mf = 0; mf < 4; ++mf)
#pragma unroll
                for (int r = 0; r < 4; ++r) {
                    const int step = c * 64 + mf * 16 + 4 * fq + r, row = row0 + (dir ? (Ls - 1 - step) : step);
                    O[(size_t)row * 768 + h * 128 + dvc] = o[mf][r];
                }
            }
            rec += 2 * NH;
        }
#undef DN_STAGE
        if (!lat) {
            float* so = a.out + (size_t)M * D + ((((size_t)seq * 2 + e) * 2 + dir) * NH + h) * 128 * 128;
#pragma unroll
            for (int mf = 0; mf < 8; ++mf)
#pragma unroll
                for (int r = 0; r < 4; ++r) so[(size_t)(mf * 16 + 4 * fq + r) * 128 + dvc] = S[mf][r];
        }
    }
    __syncthreads();
}

__device__ __forceinline__ void phase_dn_fin(Frame& F, int e) {
    const CAS Args& a = *F.a;
    const float* P = (const float*)(a.ws + WS_P);
    const float* OF = (const float*)(a.ws + WS_OF); const float* OB = (const float*)(a.ws + WS_OB);
    bf16* Y = (bf16*)(a.ws + WS_Y);
    const float* nw = a.in[I_DNNW] + e * 128;
    const int gw = F.vcu * 8 + F.wave, NGW = F.G * 8;
    for (int it = gw; it < M * NH; it += NGW) {
        const int row = it / NH, h = it % NH, c2 = F.lane * 2;
        const size_t o = (size_t)row * 768 + h * 128 + c2;
        const f32x2 v = *(const f32x2*)(OF + o) + *(const f32x2*)(OB + o);
        const float ms = wave_sum(v[0] * v[0] + v[1] * v[1]) * (1.f / 128.f);
        const float rs = 1.0f / sqrtf(ms + EPS);
        const f32x2 z = *(const f32x2*)(P + (size_t)row * LDP + 2560 + h * 128 + c2);
        const f32x2 w = *(const f32x2*)(nw + c2);
        *(unsigned*)(Y + (size_t)row * D + 256 + h * 128 + c2) = pk2(v[0] * rs * w[0] * silu_f(z[0]), v[1] * rs * w[1] * silu_f(z[1]));
    }
    const float* pw = a.in[I_POOLW] + (size_t)e * 4 * 64 * 64; const float* ps = a.in[I_POOLS] + e * 256;
    LAS float* wl = (LAS float*)F.lds;
    for (int i = F.tid; i < 4 * 4096 / 4; i += 512) *(LAS f32x4*)(wl + i * 4) = *(const f32x4*)(pw + i * 4);
    __syncthreads();
    for (int it = gw; it < M * 4; it += NGW) {
        const int row = it >> 2, g = it & 3; int s0, L; seq_of_row(row, s0, L);
        const int t = row - s0, half = 1 << g;
        const int lo = max(t - half, 0), hi = min(t + half, L);
        float sum = 0.f;
        for (int p = lo; p < hi; ++p) sum += P[(size_t)(s0 + p) * LDP + g * 64 + F.lane];
        const float d = sum / (float)(hi - lo) - P[(size_t)row * LDP + g * 64 + F.lane];
        const LAS float* wg = wl + g * 4096 + F.lane;
        float y0 = 0.f, y1 = 0.f;
#pragma unroll 16
        for (int c = 0; c < 64; c += 2) {
            y0 += __builtin_bit_cast(float, __builtin_amdgcn_readlane(__builtin_bit_cast(int, d), c)) * wg[c * 64];
            y1 += __builtin_bit_cast(float, __builtin_amdgcn_readlane(__builtin_bit_cast(int, d), c + 1)) * wg[(c + 1) * 64];
        }
        Y[(size_t)row * D + g * 64 + F.lane] = (bf16)f2bf((y0 + y1) * ps[g * 64 + F.lane]);
    }
    __syncthreads();
}

struct EpiOdd {
    bf16* G; float* ZR; float* ZI; float* ST; Pre pre;
    template <int NFRAG> __device__ __forceinline__ void operator()(f32x4 (&acc)[3][NFRAG], int row, int colq, int fq) const {
        const int ct = colq >> 8;
        if (ct < 6) {
#pragma unroll
            for (int mf = 0; mf < 3; ++mf) {
                const int rr = row + mf * 16; float s1 = 0.f, s2 = 0.f;
                const float rs = pre_rstd(pre, rr); const float* bp = pre.bias + cond_of_row(rr) * NBMAX + colq;
#pragma unroll
                for (int nf = 0; nf < NFRAG; ++nf) {
                    const f32x4 v = acc[mf][nf] * rs + *(const f32x4*)(bp + nf * 16);
                    const float g0 = gelu_tanh(v[0]), g1 = gelu_tanh(v[1]), g2 = gelu_tanh(v[2]), g3 = gelu_tanh(v[3]);
                    u32x2 w; w.x = pk2(g0, g1); w.y = pk2(g2, g3);
                    *(u32x2*)(G + (size_t)rr * 1536 + colq + nf * 16) = w;
                    s1 += (g0 + g1) + (g2 + g3); s2 += (g0 * g0 + g1 * g1) + (g2 * g2 + g3 * g3);
                }
                if (ct >= 3) {
                    s1 += __shfl_xor(s1, 16); s1 += __shfl_xor(s1, 32); s2 += __shfl_xor(s2, 16); s2 += __shfl_xor(s2, 32);
                    if (fq == 0) { atomicAdd(ST + (size_t)rr * 2, s1); atomicAdd(ST + (size_t)rr * 2 + 1, s2); }
                }
            }
        } else {
            float* Z = (ct == 6) ? ZR : ZI; const int cb = colq - ct * 256;
#pragma unroll
            for (int mf = 0; mf < 3; ++mf) {
                const int rr = row + mf * 16; const float rs = pre_rstd(pre, rr); const float* bp = pre.bias + cond_of_row(rr) * NBMAX + colq;
#pragma unroll
                for (int nf = 0; nf < NFRAG; ++nf) *(f32x4*)(Z + (size_t)rr * 256 + cb + nf * 16) = acc[mf][nf] * rs + *(const f32x4*)(bp + nf * 16);
            }
        }
    }
};

template <int R>
__device__ __forceinline__ void fourier_a_item(const float* ZR, const float* ZI, float* BR, float* BI, int row0, int n2, const LAS float* twR, const LAS float* twN, int tid) {
    const int col = tid & 255, hf = tid >> 8;
    float zr[R], zi[R];
#pragma unroll
    for (int n1 = 0; n1 < R; ++n1) { const size_t o = (size_t)(row0 + R * n1 + n2) * 256 + col; zr[n1] = ZR[o]; zi[n1] = ZI[o]; }
#pragma unroll 1
    for (int kk = 0; kk < R / 2; ++kk) {
        const int k1 = hf * (R / 2) + kk;
        float ar = 0.f, ai = 0.f;
#pragma unroll
        for (int n1 = 0; n1 < R; ++n1) { const int idx = (k1 * n1) & (R - 1); const float c = twR[idx], s = twR[R + idx]; ar += c * zr[n1] + s * zi[n1]; ai += c * zi[n1] - s * zr[n1]; }
        const int t = k1 * n2; const float c = twN[t], s = twN[R * R + t];
        const size_t o = (size_t)(row0 + k1 * R + n2) * 256 + col;
        BR[o] = c * ar + s * ai; BI[o] = c * ai - s * ar;
    }
}
template <int R>
__device__ __forceinline__ void fourier_c_item(const float* BR, const float* BI, bf16* Y, int row0, int k1, const LAS float* twR, int tid) {
    const int col = tid & 255, hf = tid >> 8;
    float br[R], bi[R];
#pragma unroll
    for (int n2 = 0; n2 < R; ++n2) { const size_t o = (size_t)(row0 + k1 * R + n2) * 256 + col; br[n2] = BR[o]; bi[n2] = BI[o]; }
    const float sc = 1.0f / (float)R;
#pragma unroll 1
    for (int kk = 0; kk < R / 2; ++kk) {
        const int k2 = hf * (R / 2) + kk;
        float x = 0.f;
#pragma unroll
        for (int n2 = 0; n2 < R; ++n2) { const int idx = (k2 * n2) & (R - 1); x += twR[idx] * br[n2] + twR[R + idx] * bi[n2]; }
        Y[(size_t)(row0 + k1 + R * k2) * D + 768 + col] = (bf16)f2bf(x * sc);
    }
}
__device__ __forceinline__ void fourier_tables(LAS float* tw, int tid) {
    for (int i = tid; i < 1024; i += 512) { const float x = (float)i * (1.f / 512.f); tw[64 + i] = cospif(x); tw[64 + 1024 + i] = sinpif(x); }
    if (tid < 256) { const float x = (float)tid * (1.f / 128.f); tw[2144 + tid] = cospif(x); tw[2144 + 256 + tid] = sinpif(x); }
    if (tid < 32) { const float x = (float)tid * (1.f / 16.f); tw[tid] = cospif(x); tw[32 + tid] = sinpif(x); }
    if (tid < 16) { const float x = (float)tid * (1.f / 8.f); tw[2112 + tid] = cospif(x); tw[2112 + 16 + tid] = sinpif(x); }
}

__device__ __forceinline__ void phase_odd_mix(Frame& F, int j) {
    const CAS Args& a = *F.a;
    const bf16* G = (const bf16*)(a.ws + WS_P); bf16* Y = (bf16*)(a.ws + WS_Y);
    const float* ZR = (const float*)(a.ws + WS_ZR); const float* ZI = (const float*)(a.ws + WS_ZI);
    float* BR = (float*)(a.ws + WS_QN); float* BI = (float*)(a.ws + WS_KN);
    const float* ST = (const float*)(a.ws + WS_CTL + CTL_ST_OFF) + (size_t)j * M * 2;
    LAS unsigned char* L = F.lds;
    LAS float* tw = (LAS float*)(L + 65536);
    fourier_tables(tw, F.tid);
    __syncthreads();
    const int wave = F.wave;
    constexpr int NA_LAT = LAT_B * 32, NSGU = (M / 128) * NH, NA_CTX = CTX_B * 16;
    for (int it = F.vcu; it < NA_LAT + NSGU + NA_CTX; it += F.G) {
        int tid_ = F.tid; asm volatile("" : "+v"(tid_));
        if (it < NA_LAT) { fourier_a_item<32>(ZR, ZI, BR, BI, NCTX + (it >> 5) * LAT_L, it & 31, tw, tw + 64, tid_); continue; }
        if (it >= NA_LAT + NSGU) { const int q = it - NA_LAT - NSGU; fourier_a_item<16>(ZR, ZI, BR, BI, (q >> 4) * CTX_L, q & 15, tw + 2112, tw + 2144, tid_); continue; }
        const int q = it - NA_LAT, ch = q / NH, h = q % NH, r0 = ch * 128;
        const int lane = tid_ & 63, fr = lane & 15, fq = lane >> 4;
        __syncthreads();
        {
            const int s = tid_ >> 2, cq = tid_ & 3, row = r0 + s;
            const float s1 = ST[(size_t)row * 2], s2 = ST[(size_t)row * 2 + 1];
            const float mu = s1 * (1.f / 768.f), var = s2 * (1.f / 768.f) - mu * mu, rstd = 1.0f / sqrtf(fmaxf(var, 0.f) + EPS);
            const bf16* gp = G + (size_t)row * 1536 + 768 + h * 128 + cq * 32;
            const float* nw = a.in[I_SGUN] + j * 768 + h * 128 + cq * 32;
#pragma unroll
            for (int v8 = 0; v8 < 4; ++v8) {
                const u32x4 raw = *(const u32x4*)(gp + v8 * 8);
                const unsigned wds[4] = {raw.x, raw.y, raw.z, raw.w};
#pragma unroll
                for (int e2 = 0; e2 < 4; ++e2) {
                    const float g0 = __builtin_bit_cast(float, wds[e2] << 16), g1 = __builtin_bit_cast(float, wds[e2] & 0xffff0000u);
                    const int c0 = cq * 32 + v8 * 8 + e2 * 2;
                    const float v0 = (g0 - mu) * rstd * nw[v8 * 8 + e2 * 2], v1 = (g1 - mu) * rstd * nw[v8 * 8 + e2 * 2 + 1];
                    *(LAS bf16*)(L + c0 * 256 + (((s >> 3) ^ (c0 & 15)) << 4) + (s & 7) * 2) = (bf16)f2bf(v0);
                    *(LAS bf16*)(L + (c0 + 1) * 256 + (((s >> 3) ^ ((c0 + 1) & 15)) << 4) + (s & 7) * 2) = (bf16)f2bf(v1);
                }
            }
        }
        __syncthreads();
        {
            const bf16* Wb = (const bf16*)(a.ws + WS_SGUW) + ((size_t)j * NH + h) * 16384;
            f32x4 acc[8];
#pragma unroll
            for (int pf = 0; pf < 8; ++pf) acc[pf] = (f32x4){0.f, 0.f, 0.f, 0.f};
#pragma unroll
            for (int ks = 0; ks < 4; ++ks) {
                const bf16x8 av = *(const LAS bf16x8*)(L + (wave * 16 + fr) * 256 + (((ks * 4 + fq) ^ fr) << 4));
#pragma unroll
                for (int pf = 0; pf < 8; ++pf) {
                    const bf16x8 bw = *(const bf16x8*)(Wb + (pf * 16 + fr) * 128 + ks * 32 + fq * 8);
                    acc[pf] = MFMA16(av, bw, acc[pf]);
                }
            }
            const float* bs = a.in[I_SGUB] + ((size_t)j * NH + h) * 128;
#pragma unroll
            for (int pf = 0; pf < 8; ++pf) {
                const int p = pf * 16 + fr, row = r0 + p, c = wave * 16 + 4 * fq; const float b = bs[p];
                const u32x2 gu = *(const u32x2*)(G + (size_t)row * 1536 + h * 128 + c);
                const float u0 = __builtin_bit_cast(float, gu.x << 16), u1 = __builtin_bit_cast(float, gu.x & 0xffff0000u), u2 = __builtin_bit_cast(float, gu.y << 16), u3 = __builtin_bit_cast(float, gu.y & 0xffff0000u);
                u32x2 o; o.x = pk2(u0 * (acc[pf][0] + b), u1 * (acc[pf][1] + b)); o.y = pk2(u2 * (acc[pf][2] + b), u3 * (acc[pf][3] + b));
                *(u32x2*)(Y + (size_t)row * D + h * 128 + c) = o;
            }
        }
    }
    __syncthreads();
}
__device__ __forceinline__ void phase_odd_fc(Frame& F) {
    const CAS Args& a = *F.a;
    const float* BR = (const float*)(a.ws + WS_QN); const float* BI = (const float*)(a.ws + WS_KN); bf16* Y = (bf16*)(a.ws + WS_Y);
    LAS float* tw = (LAS float*)(F.lds + 65536);
    fourier_tables(tw, F.tid);
    __syncthreads();
    constexpr int NC_LAT = LAT_B * 32, NC_CTX = CTX_B * 16;
    for (int it = F.vcu; it < NC_LAT + NC_CTX; it += F.G) {
        int tid_ = F.tid; asm volatile("" : "+v"(tid_));
        if (it < NC_LAT) fourier_c_item<32>(BR, BI, Y, NCTX + (it >> 5) * LAT_L, it & 31, tw, tid_);
        else { const int q = it - NC_LAT; fourier_c_item<16>(BR, BI, Y, (q >> 4) * CTX_L, q & 15, tw + 2112, tid_); }
    }
    __syncthreads();
}

constexpr int STEPS = 9, N_PHASES = 2 + DEPTH * STEPS + 1;
__device__ __forceinline__ bool phase_active(int ph) {
    if (ph < 2 || ph == N_PHASES - 1) return true;
    const int l = (ph - 2) / STEPS, st = (ph - 2) % STEPS;
    return !((l & 1) && st == 5);
}
__device__ __forceinline__ void run_phase(Frame& F, int ph) {
    const CAS Args& a = *F.a; unsigned char* ws = a.ws;
    if (ph == 0) { phase_setup(F); return; }
    if (ph == 1) { phase_init(F); return; }
    if (ph == N_PHASES - 1) { phase_final(F); return; }
    const int l = (ph - 2) / STEPS, st = (ph - 2) % STEPS, e = l >> 1;
    bf16* XS = (bf16*)(ws + WS_HN); bf16* HH = (bf16*)(ws + WS_HH); float* X = (float*)(ws + WS_X); float* P = (float*)(ws + WS_P);
    const bf16* Y = (const bf16*)(ws + WS_Y); const float* mod = (const float*)(ws + WS_MOD);
    float* ssb = (float*)(ws + WS_CTL + CTL_SS_OFF); const float* biasb = (const float*)(ws + WS_BIAS);
#define PRE_OF(s_) Pre{ssb + (size_t)(s_) * M, biasb + (size_t)(s_) * 3 * NBMAX}
    switch (st) {
        case 0: { EpiUp E{HH, PRE_OF(3 * l)}; gemm_phase<11, EpiUp>(F, XS, (const bf16*)(ws + WS_WUP + (size_t)(l * 2) * WUP_SZ), D, NUP, E); } break;
        case 1: { EpiRes E{X, mod, l, 2, 0.5f, XS, ssb + (size_t)(3 * l + 1) * M, a.in[I_MIXN] + l * D, l, 1}; gemm_phase<4, EpiRes>(F, HH, (const bf16*)(ws + WS_WDN + (size_t)(l * 2) * WDN_SZ), FF, D, E); } break;
        case 2: { if ((l & 1) == 0) { EpiStore E{P, LDP, PRE_OF(3 * l + 1)}; gemm_phase<7, EpiStore>(F, XS, (const bf16*)(ws + WS_EVIN + (size_t)e * EVIN_SZ), D, P_EVEN_PAD, E); }
                  else { EpiOdd EO{(bf16*)(ws + WS_P), (float*)(ws + WS_ZR), (float*)(ws + WS_ZI), (float*)(ws + WS_CTL + CTL_ST_OFF) + (size_t)e * M * 2, PRE_OF(3 * l + 1)};
                         gemm_phase<8, EpiOdd>(F, XS, (const bf16*)(ws + WS_ODIN + (size_t)e * ODIN_SZ), D, 2048, EO); } } break;
        case 3: if ((l & 1) == 0) phase_dn_prep(F, e); else phase_odd_mix(F, e); break;
        case 4: if ((l & 1) == 0) phase_dn_scan(F, e); else phase_odd_fc(F); break;
        case 5: if ((l & 1) == 0) phase_dn_fin(F, e); break;
        case 6: { EpiRes E{X, mod, l, 5, 1.0f, XS, ssb + (size_t)(3 * l + 2) * M, a.in[I_F2N] + l * D, l, 2}; gemm_phase<4, EpiRes>(F, Y, (const bf16*)(ws + ((l & 1) ? WS_ODOUT : WS_EVOUT) + (size_t)e * SQ_SZ), D, D, E); } break;
        case 7: { EpiUp E{HH, PRE_OF(3 * l + 2)}; gemm_phase<11, EpiUp>(F, XS, (const bf16*)(ws + WS_WUP + (size_t)(l * 2 + 1) * WUP_SZ), D, NUP, E); } break;
        case 8: { const bool last = (l == DEPTH - 1);
                  EpiRes E{X, mod, l, 8, 0.5f, XS, last ? nullptr : ssb + (size_t)(3 * l + 3) * M, a.in[I_F1N] + (last ? l : l + 1) * D, last ? l : l + 1, 0};
                  gemm_phase<4, EpiRes>(F, HH, (const bf16*)(ws + WS_WDN + (size_t)(l * 2 + 1) * WDN_SZ), FF, D, E); } break;
    }
#undef PRE_OF
}

__global__ void __launch_bounds__(512, 2) mk_fwd(Args args) {
    extern __shared__ __attribute__((aligned(16))) unsigned char lds_raw[];
    Frame F;
    F.lds = (LAS unsigned char*)lds_raw;
    F.tid = threadIdx.x; F.lane = F.tid & 63; F.wave = __builtin_amdgcn_readfirstlane(F.tid >> 6);
    F.G = gridDim.x; { const int bx = blockIdx.x; F.vcu = (F.G % 8 == 0) ? (bx % 8) * (F.G / 8) + bx / 8 : bx; }
    const CAS Args* ap = (const CAS Args*)__builtin_amdgcn_kernarg_segment_ptr();
    F.a = ap;
    const int ph_lo = ap->ph_lo, ph_hi = ap->ph_hi;
    unsigned char* ws0 = ap->ws;
    volatile LAS unsigned* MISC = (volatile LAS unsigned*)(F.lds + LDS_MISC);
    if (F.tid < 64) MISC[F.tid] = 0u;
    __syncthreads();
    const bool multi = (ph_hi - ph_lo) > 1;
    XcdBarrier bar; bar.bar = (unsigned*)(ws0 + WS_CTL) + CW_BAR; bar.x = 0; bar.st = MISC + 8;
    if (multi) bar = xcd_barrier_post((unsigned*)(ws0 + WS_CTL) + CW_BAR, MISC + 8);
    for (int ph = ph_lo; ph < ph_hi; ++ph) {
        { const CAS Args* a2 = ap; asm volatile("" : "+s"(a2)); F.a = a2; }
        { int t_ = threadIdx.x; asm volatile("" : "+v"(t_)); F.tid = t_; F.lane = t_ & 63; F.wave = __builtin_amdgcn_readfirstlane(t_ >> 6); }
        if (!phase_active(ph)) continue;
        run_phase(F, ph);
        if (ph + 1 < ph_hi) xcd_barrier(bar);
    }
}

extern "C" void kernel_launch(void* const* d_in, const int* in_sizes, int n_in, void* d_out, int out_size, void* d_ws, size_t ws_size, hipStream_t stream) {
    static int grid = 0;
    if (grid == 0) {
        if (n_in != 31 || ws_size < WS_END) { fprintf(stderr, "kernel_launch: unexpected n_in %d or ws_size %zu (need %zu)\n", n_in, ws_size, (size_t)WS_END); grid = -1; return; }
        int dev = 0, cus = 0;
        if (hipGetDevice(&dev) != hipSuccess || hipDeviceGetAttribute(&cus, hipDeviceAttributeMultiprocessorCount, dev) != hipSuccess) { grid = -1; return; }
        if (hipFuncSetAttribute((const void*)mk_fwd, hipFuncAttributeMaxDynamicSharedMemorySize, LDS_BYTES) != hipSuccess) { fprintf(stderr, "kernel_launch: hipFuncSetAttribute failed\n"); grid = -1; return; }
        (void)hipGetLastError();
        grid = cus;
    }
    if (grid < 0) return;
    (void)hipMemsetAsync((char*)d_ws + WS_CTL, 0, CTL_BYTES, stream);
    Args a{};
    for (int i = 0; i < 31; ++i) a.in[i] = (const float*)d_in[i];
    a.out = (float*)d_out; a.ws = (unsigned char*)d_ws;
#if ONE_LAUNCH
    a.ph_lo = 0; a.ph_hi = N_PHASES;
    hipLaunchKernelGGL(mk_fwd, dim3(grid), dim3(512), LDS_BYTES, stream, a);
#else
    for (int ph = 0; ph < N_PHASES; ++ph) {
        a.ph_lo = ph; a.ph_hi = ph + 1;
        hipLaunchKernelGGL(mk_fwd, dim3(grid), dim3(512), LDS_BYTES, stream, a);
    }
#endif
}
```

```cpp
#include <hip/hip_runtime.h>
#include <cstdio>
#include <cstdint>

#ifndef ONE_LAUNCH
#define ONE_LAUNCH 1
#endif

#define GAS __attribute__((address_space(1)))
#define LAS __attribute__((address_space(3)))
#define CAS __attribute__((address_space(4)))
typedef unsigned short bf16;
typedef float f32x4 __attribute__((ext_vector_type(4)));
typedef float f32x2 __attribute__((ext_vector_type(2)));
typedef short bf16x8 __attribute__((ext_vector_type(8)));
typedef unsigned u32x4 __attribute__((ext_vector_type(4)));
typedef unsigned u32x2 __attribute__((ext_vector_type(2)));

constexpr int D = 1024, NCTX = 4096, NLAT = 2048, M = 6144, FF = 2816, DEPTH = 4;
constexpr int CTX_B = 16, CTX_L = 256, LAT_B = 2, LAT_L = 1024;
constexpr int NUP = 2 * FF;
constexpr int P_EVEN = 3352, P_EVEN_PAD = 3584, P_ODD = 1792;
constexpr int LDP = 3584;
constexpr int NH = 6, DK = 128;
constexpr float EPS = 1e-6f;
constexpr int NSEQ = CTX_B + LAT_B;

constexpr size_t MiB = 1u << 20;
constexpr size_t WS_CTL = 0, CTL_BYTES = 1 * MiB;
constexpr size_t WS_MOD = 1 * MiB;
constexpr size_t WS_WUP = 2 * MiB, WUP_SZ = 11 * MiB;
constexpr size_t WS_WDN = 90 * MiB, WDN_SZ = 5632 * 1024;
constexpr size_t WS_EVIN = 134 * MiB, EVIN_SZ = 7 * MiB;
constexpr size_t WS_EVOUT = 148 * MiB, SQ_SZ = 2 * MiB;
constexpr size_t WS_ODIN = 152 * MiB, ODIN_SZ = 4 * MiB;
constexpr size_t WS_ODOUT = 160 * MiB;
constexpr size_t WS_X = 164 * MiB;
constexpr size_t WS_HN = 188 * MiB;
constexpr size_t WS_HH = 200 * MiB;
constexpr size_t WS_P = 233 * MiB;
constexpr size_t WS_Y = 317 * MiB;
constexpr size_t WS_QN = 329 * MiB, WS_KN = 347 * MiB, WS_VV = 365 * MiB, WS_OF = 383 * MiB, WS_OB = 401 * MiB;
constexpr size_t WS_AG = 419 * MiB, WS_BT = 420 * MiB;
constexpr size_t WS_ZR = 421 * MiB, WS_ZI = 427 * MiB, WS_SPEC = 433 * MiB;
constexpr size_t WS_DW = 439 * MiB, WS_DQ = 457 * MiB, WS_DAI = 475 * MiB, WS_DKT = 484 * MiB, WS_DUT = 502 * MiB, WS_DGL = 520 * MiB;
constexpr size_t WS_BIAS = 521 * MiB;
constexpr size_t WS_END = 522 * MiB;

constexpr size_t CTL_ST_OFF = 262144;
constexpr size_t CTL_SS_OFF = 524288;
constexpr int NBMAX = 5632;
constexpr size_t WS_SGUW = 1 * MiB + 512 * 1024;
constexpr int CW_BAR = 4096;

constexpr int LDS_MAIN = 160768;
constexpr int LDS_MISC = LDS_MAIN;
constexpr int LDS_BYTES = LDS_MAIN + 1024;

__device__ __forceinline__ float wave_sum(float v) {
#pragma unroll
    for (int o = 1; o < 64; o <<= 1) v += __shfl_xor(v, o);
    return v;
}
typedef __bf16 bf16x2_t __attribute__((ext_vector_type(2)));
__device__ __forceinline__ unsigned pk2(float lo, float hi) { const f32x2 v = {lo, hi}; const bf16x2_t b = __builtin_convertvector(v, bf16x2_t); return __builtin_bit_cast(unsigned, b); }
__device__ __forceinline__ unsigned f2bf(float f) { return pk2(f, 0.f) & 0xffffu; }
__device__ __forceinline__ float rcp_f(float x) { return __builtin_amdgcn_rcpf(x); }
__device__ __forceinline__ float rsq_f(float x) { return __builtin_amdgcn_rsqf(x); }
__device__ __forceinline__ float silu_f(float x) { return x * rcp_f(1.f + __expf(-x)); }
__device__ __forceinline__ float sigmoid_f(float x) { return rcp_f(1.f + __expf(-x)); }
__device__ __forceinline__ float gelu_tanh(float x) { const float u2 = 1.5957691216057308f * (x + 0.044715f * x * x * x); return x * rcp_f(1.f + __expf(-u2)); }
__device__ __forceinline__ float softplus_f(float x) { return x > 20.f ? x : log1pf(expf(x)); }
__device__ __forceinline__ int cond_of_row(int r) { return r < NCTX ? 0 : (r < NCTX + LAT_L ? 1 : 2); }
__device__ __forceinline__ void seq_of_row(int r, int& s0, int& L) { if (r < NCTX) { s0 = r & ~(CTX_L - 1); L = CTX_L; } else { s0 = NCTX + ((r - NCTX) & ~(LAT_L - 1)); L = LAT_L; } }

#define XB_TMO      128
#define XB_XCNT(j)  (256  + 64 * (j))
#define XB_XSUB(j)  (1280 + 64 * (j))
#define XB_XGEN(j)  (2304 + 64 * (j))
#define XB_TOP      3328
#define XB_TOPGEN   3392
#define XCD_BAR_WORDS 3456
#define XB_SPIN_CAP (1u << 18)
__device__ __forceinline__ unsigned xb_ld(unsigned* p)              { return __hip_atomic_load(p, __ATOMIC_RELAXED, __HIP_MEMORY_SCOPE_AGENT); }
__device__ __forceinline__ unsigned xb_add(unsigned* p, unsigned v) { return __hip_atomic_fetch_add(p, v, __ATOMIC_RELAXED, __HIP_MEMORY_SCOPE_AGENT); }
__device__ __forceinline__ unsigned xb_xcc_id() { return (unsigned)__builtin_amdgcn_s_getreg((3 << 11) | 20) & 0xFu; }
#define XB_SPIN(cond, bar) do { unsigned _sp = 0; while (cond) { __builtin_amdgcn_s_sleep(1); \
    if ((++_sp & 255u) == 0u) { if (xb_ld(&(bar)[XB_TMO])) break; if (_sp > XB_SPIN_CAP) { atomicAdd(&(bar)[XB_TMO], 1u); break; } } } } while (0)
struct XcdBarrier { unsigned* bar; unsigned x; volatile LAS unsigned* st; };
__device__ __forceinline__ XcdBarrier xcd_barrier_post(unsigned* bar, volatile LAS unsigned* st) {
    XcdBarrier b; b.bar = bar; b.x = xb_xcc_id(); b.st = st;
    if (threadIdx.x == 0) (void)xb_add(&bar[XB_XCNT(b.x)], 1u);
    return b;
}
__device__ __forceinline__ void xcd_barrier_complete(unsigned* bar, unsigned x, unsigned& nloc, unsigned& nx) {
    const unsigned G = gridDim.x * gridDim.y * gridDim.z;
    unsigned sum, cnt, mine, sp = 0u;
    for (;;) {
        sum = 0u; cnt = 0u; mine = 0u;
#pragma unroll
        for (unsigned j = 0; j < 16; ++j) { const unsigned c = xb_ld(&bar[XB_XCNT(j)]); sum += c; cnt += (c > 0u) ? 1u : 0u; mine = (j == x) ? c : mine; }
        if (sum == G) break;
        __builtin_amdgcn_s_sleep(1);
        if ((++sp & 255u) == 0u) { if (xb_ld(&bar[XB_TMO])) break; if (sp > XB_SPIN_CAP) { atomicAdd(&bar[XB_TMO], 1u); break; } }
    }
    nloc = mine > 0u ? mine : 1u; nx = cnt > 0u ? cnt : 1u;
}
__device__ __forceinline__ void xcd_barrier(const XcdBarrier& b) {
    asm volatile("s_waitcnt vmcnt(0)" ::: "memory");
    __syncthreads();
    if (threadIdx.x == 0) {
        unsigned* bar = b.bar;
        __builtin_amdgcn_s_waitcnt(0);
        unsigned nloc = b.st[0], nx = b.st[1];
        if (nloc == 0u) { xcd_barrier_complete(bar, b.x, nloc, nx); b.st[0] = nloc; b.st[1] = nx; }
        const unsigned old = xb_add(&bar[XB_XSUB(b.x)], 1u);
        const unsigned gen = old / nloc;
        if (old + 1u == (gen + 1u) * nloc) {
            __builtin_amdgcn_fence(__ATOMIC_RELEASE, "agent");
            asm volatile("s_waitcnt vmcnt(0)" ::: "memory");
            const unsigned og = xb_add(&bar[XB_TOP], 1u);
            const unsigned tg = og / nx;
            if (og + 1u == (tg + 1u) * nx) xb_add(&bar[XB_TOPGEN], 1u);
            else XB_SPIN(xb_ld(&bar[XB_TOPGEN]) == tg, bar);
            __builtin_amdgcn_fence(__ATOMIC_ACQUIRE, "agent");
            xb_add(&bar[XB_XGEN(b.x)], 1u);
            asm volatile("s_waitcnt vmcnt(0)" ::: "memory");
        } else {
            XB_SPIN(xb_ld(&bar[XB_XGEN(b.x)]) == gen, bar);
            __builtin_amdgcn_fence(__ATOMIC_ACQUIRE, "agent");
            asm volatile("s_waitcnt vmcnt(0)" ::: "memory");
        }
    }
    __syncthreads();
}

struct Args { const float* in[31]; float* out; unsigned char* ws; int ph_lo, ph_hi; };
enum { I_XP = 0, I_XS, I_STATE, I_C, I_CCTX, I_F1N, I_F1G, I_F1U, I_F1D, I_MIXN, I_F2N, I_F2G, I_F2U, I_F2D, I_ADAW, I_ADAB, I_EVIN, I_EVOUT,
       I_POOLW, I_POOLS, I_CONVW, I_ALOG, I_DTB, I_DNNW, I_ODIN, I_ODOUT, I_SGUN, I_SGUW, I_SGUB, I_FNETW, I_FINN };

struct Frame {
    LAS unsigned char* lds;
    int tid, lane, wave, vcu, G;
    const CAS Args* a;
};

#define DS_READ128(dst, addr) asm volatile("ds_read_b128 %0, %1" : "=v"(dst) : "v"((unsigned)(addr)))
__device__ __forceinline__ void lgkm_wait(int n) {
    switch (n) { case 0: asm volatile("s_waitcnt lgkmcnt(0)" ::: "memory"); break; case 1: asm volatile("s_waitcnt lgkmcnt(1)" ::: "memory"); break;
                 case 2: asm volatile("s_waitcnt lgkmcnt(2)" ::: "memory"); break; default: asm volatile("s_waitcnt lgkmcnt(3)" ::: "memory"); break; }
}
__device__ __forceinline__ void vm_wait(int n) {
    switch (n) { case 0: asm volatile("s_waitcnt vmcnt(0)" ::: "memory"); break; case 4: asm volatile("s_waitcnt vmcnt(4)" ::: "memory"); break;
                 case 5: asm volatile("s_waitcnt vmcnt(5)" ::: "memory"); break; case 6: asm volatile("s_waitcnt vmcnt(6)" ::: "memory"); break;
                 case 7: asm volatile("s_waitcnt vmcnt(7)" ::: "memory"); break; case 8: asm volatile("s_waitcnt vmcnt(8)" ::: "memory"); break;
                 case 9: asm volatile("s_waitcnt vmcnt(9)" ::: "memory"); break; default: asm volatile("s_waitcnt vmcnt(0)" ::: "memory"); break; }
}
template <int NFRAG, class Epi>
__device__ __forceinline__ void gemm_tile(LAS unsigned char* lds, const int tid, const bf16* A, const bf16* Bt, int K, int row0, int col0, const Epi& E) {
    constexpr int BN = 32 * NFRAG, NPB = BN / 8, A_BYTES = 192 * 128, B_BYTES = BN * 128, STAGE = A_BYTES + B_BYTES, NBI = (NPB + 7) / 8;
    constexpr int NS = (3 * STAGE <= LDS_MAIN) ? 3 : 2;
    static_assert(NS * STAGE <= LDS_MAIN, "LDS");
    const int lane = tid & 63, wid = __builtin_amdgcn_readfirstlane(tid >> 6), wm = wid >> 1, wn = wid & 1, fr = lane & 15, fq = lane >> 4;
    const int r = lane >> 3, slot = lane & 7;
    const int srow = wid * 8 + r;
    const int chunk = slot ^ ((srow >> 1) & 7);
    const char* gA = (const char*)(A + (size_t)(row0 + srow) * K) + chunk * 16;
    const char* gB = (const char*)(Bt + (size_t)(col0 + srow) * K) + chunk * 16;
    const size_t pstep = (size_t)64 * K * 2;
    const int nt = K / 64;
    const int nbw = (NPB - wid + 7) / 8;
    const unsigned ldsb = (unsigned)(uintptr_t)lds;
    const int rowA0 = wm * 48 + fr, rowB0 = wn * NFRAG * 16 + fr;
    int offA[2], offB[2];
#pragma unroll
    for (int kk = 0; kk < 2; ++kk) {
        offA[kk] = rowA0 * 128 + (((kk * 4 + fq) ^ ((rowA0 >> 1) & 7)) << 4);
        offB[kk] = A_BYTES + rowB0 * 128 + (((kk * 4 + fq) ^ ((rowB0 >> 1) & 7)) << 4);
    }
    f32x4 acc[3][NFRAG];
#pragma unroll
    for (int i = 0; i < 3; ++i)
#pragma unroll
        for (int j = 0; j < NFRAG; ++j) acc[i][j] = (f32x4){0.f, 0.f, 0.f, 0.f};

#define GEMM_STAGE(buf, t) do { LAS unsigned char* sA_ = lds + (buf) * STAGE + wid * 1024; \
        _Pragma("unroll") for (int i_ = 0; i_ < 3; ++i_) \
            __builtin_amdgcn_global_load_lds((const unsigned*)(gA + i_ * pstep + (size_t)(t) * 128), (LAS unsigned*)(sA_ + i_ * 8192), 16, 0, 0); \
        _Pragma("unroll") for (int i_ = 0; i_ < NBI; ++i_) if (wid + 8 * i_ < NPB) \
            __builtin_amdgcn_global_load_lds((const unsigned*)(gB + i_ * pstep + (size_t)(t) * 128), (LAS unsigned*)(sA_ + A_BYTES + i_ * 8192), 16, 0, 0); } while (0)

    GEMM_STAGE(0, 0);
    if (NS == 3) GEMM_STAGE(1, 1);
    int sbuf = 0;
    for (int t = 0; t < nt; ++t) {
        if (NS == 3) {
            if (t + 1 < nt) { if (nbw == NBI) vm_wait(3 + NBI); else vm_wait(3 + NBI - 1); } else vm_wait(0);
            __builtin_amdgcn_s_barrier();
            if (t + 2 < nt) { const int nb_ = (sbuf >= 1) ? sbuf - 1 : 2; GEMM_STAGE(nb_, t + 2); }
        } else {
            asm volatile("s_waitcnt vmcnt(0)" ::: "memory");
            __syncthreads();
            if (t + 1 < nt) GEMM_STAGE((t + 1) & 1, t + 1);
        }
        {
            const unsigned sbo = (unsigned)sbuf * STAGE;
            const unsigned aA0 = ldsb + sbo + offA[0], aA1 = ldsb + sbo + offA[1], aB0 = ldsb + sbo + offB[0], aB1 = ldsb + sbo + offB[1];
            bf16x8 af[2][3], bq[4];
#pragma unroll
            for (int mf = 0; mf < 3; ++mf) { DS_READ128(af[0][mf], aA0 + mf * 2048); }
#pragma unroll
            for (int mf = 0; mf < 3; ++mf) { DS_READ128(af[1][mf], aA1 + mf * 2048); }
            constexpr int TOT = 2 * NFRAG;
#pragma unroll
            for (int f = 0; f < 3; ++f) { DS_READ128(bq[f], aB0 + f * 2048); }
#pragma unroll
            for (int f = 0; f < TOT; ++f) {
                if (f + 3 < TOT) { const int g = f + 3; DS_READ128(bq[g & 3], ((g >= NFRAG) ? aB1 + (g - NFRAG) * 2048 : aB0 + g * 2048)); }
                const int outstanding = (f + 3 < TOT) ? 3 : (TOT - 1 - f);
                lgkm_wait(outstanding);
                asm volatile("" : "+v"(bq[f & 3]));
                __builtin_amdgcn_sched_barrier(0);
                const int kk = (f >= NFRAG) ? 1 : 0, nf = f - kk * NFRAG;
#pragma unroll
                for (int mf = 0; mf < 3; ++mf) acc[mf][nf] = __builtin_amdgcn_mfma_f32_16x16x32_bf16(bq[f & 3], af[kk][mf], acc[mf][nf], 0, 0, 0);
            }
        }
        sbuf = (sbuf + 1 == NS) ? 0 : sbuf + 1;
    }
#undef GEMM_STAGE
    E(acc, row0 + wm * 48 + fr, col0 + wn * NFRAG * 16 + fq * 4, fq);
    asm volatile("s_waitcnt vmcnt(0)" ::: "memory");
    __syncthreads();
}

struct Pre { const float* ss; const float* bias; };
__device__ __forceinline__ float pre_rstd(const Pre& p, int row) { return rsq_f(p.ss[row] * (1.f / D) + EPS); }
struct EpiUp {
    bf16* H; Pre pre;
    template <int NFRAG> __device__ __forceinline__ void operator()(f32x4 (&acc)[3][NFRAG], int row, int colq, int) const {
#pragma unroll
        for (int mf = 0; mf < 3; ++mf) {
            const int rr = row + mf * 16; const float rs = pre_rstd(pre, rr);
            const float* bp = pre.bias + cond_of_row(rr) * NBMAX + colq;
#pragma unroll
            for (int nf = 0; nf < NFRAG; ++nf) {
                const f32x4 v = acc[mf][nf] * rs + *(const f32x4*)(bp + nf * 16);
                *(unsigned*)(H + (size_t)rr * FF + ((colq + nf * 16) >> 1)) = pk2(silu_f(v[0]) * v[2], silu_f(v[1]) * v[3]);
            }
        }
    }
};
struct EpiRes {
    float* X; const float* mod; int layer, gidx; float scale;
    bf16* XS; float* ssn; const float* nwn; int ln, wn;
    template <int NFRAG> __device__ __forceinline__ void operator()(f32x4 (&acc)[3][NFRAG], int row, int colq, int fq) const {
#pragma unroll
        for (int mf = 0; mf < 3; ++mf) {
            const int rr = row + mf * 16, cnd = cond_of_row(rr);
            const float* g = mod + ((size_t)(layer * 3 + cnd) * 9 + gidx) * 1024;
            const float* scn = mod + ((size_t)(ln * 3 + cnd) * 9 + wn * 3 + 1) * 1024;
            float ssq = 0.f;
#pragma unroll
            for (int nf = 0; nf < NFRAG; ++nf) {
                const int c = colq + nf * 16;
                const f32x4 gv = *(const f32x4*)(g + c);
                f32x4* xp = (f32x4*)(X + (size_t)rr * D + c);
                f32x4 xv = *xp;
                xv += acc[mf][nf] * gv * scale;
                *xp = xv;
                if (ssn) {
                    const f32x4 cv = *(const f32x4*)(nwn + c) * (*(const f32x4*)(scn + c) + 1.0f);
                    const f32x4 hs = xv * cv;
                    u32x2 w; w.x = pk2(hs[0], hs[1]); w.y = pk2(hs[2], hs[3]);
                    *(u32x2*)(XS + (size_t)rr * D + c) = w;
                    ssq += (xv[0] * xv[0] + xv[1] * xv[1]) + (xv[2] * xv[2] + xv[3] * xv[3]);
                }
            }
            if (ssn) { ssq += __shfl_xor(ssq, 16); ssq += __shfl_xor(ssq, 32); if (fq == 0) atomicAdd(ssn + rr, ssq); }
        }
    }
};
struct EpiStore {
    bf16* P; float* GT; Pre pre;
    template <int NFRAG> __device__ __forceinline__ void operator()(f32x4 (&acc)[3][NFRAG], int row, int colq, int) const {
#pragma unroll
        for (int mf = 0; mf < 3; ++mf) {
            const int rr = row + mf * 16; const float rs = pre_rstd(pre, rr);
            const float* bp = pre.bias + cond_of_row(rr) * NBMAX + colq;
#pragma unroll
            for (int nf = 0; nf < NFRAG; ++nf) {
                const f32x4 v = acc[mf][nf] * rs + *(const f32x4*)(bp + nf * 16);
                const int c = colq + nf * 16;
                u32x2 w; w.x = pk2(v[0], v[1]); w.y = pk2(v[2], v[3]);
                *(u32x2*)(P + (size_t)rr * LDP + c) = w;
                if (c >= 3328 && c < 3352) *(f32x4*)(GT + (size_t)rr * 24 + (c - 3328)) = v;
            }
        }
    }
};

template <int NFRAG, class Epi>
__device__ __forceinline__ void gemm_phase(Frame& F, const bf16* A, const bf16* Bt, int K, int N, const Epi& E) {
    constexpr int BN = 32 * NFRAG;
    const int NT = N / BN, nitems = 32 * NT;
    for (int i = F.vcu; i < nitems; i += F.G) {
        const int panel = (i >> 3) & 31, ct = (i & 7) + 8 * (i >> 8);
        gemm_tile<NFRAG, Epi>(F.lds, F.tid, A, Bt, K, panel * 192, ct * BN, E);
    }
}

__device__ __forceinline__ void transpose_item(const float* W, int K, int N, int ldw, bf16* WT, int mode, LAS float* scr, int item, int lane, const float* shp, float* biasp) {
    const int nblk = (N + 63) / 64, kb = item / nblk, nb = item % nblk, k0 = 64 * kb, n0 = 64 * nb;
    const int lc = (lane & 15) * 4, lr = lane >> 4;
    f32x4 v[16];
#pragma unroll
    for (int i = 0; i < 16; ++i) v[i] = (n0 + lc < N) ? *(const f32x4*)(W + (size_t)(k0 + 4 * i + lr) * ldw + n0 + lc) : (f32x4){0.f, 0.f, 0.f, 0.f};
    float sh0 = 0.f, sh1 = 0.f, sh2 = 0.f;
    if (biasp) { sh0 = shp[k0 + lane]; sh1 = shp[9216 + k0 + lane]; sh2 = shp[2 * 9216 + k0 + lane]; }
#pragma unroll
    for (int i = 0; i < 16; ++i) { LAS float* p = scr + (4 * i + lr) * 65 + lc; p[0] = v[i][0]; p[1] = v[i][1]; p[2] = v[i][2]; p[3] = v[i][3]; }
    asm volatile("s_waitcnt lgkmcnt(0)" ::: "memory");
    const int c = lane & 7;
#pragma unroll
    for (int j = 0; j < 8; ++j) {
        const int nl = (lane >> 3) + 8 * j, n = n0 + nl; const LAS float* s = scr + (8 * c) * 65 + nl;
        u32x4 o; o.x = pk2(s[0 * 65], s[1 * 65]); o.y = pk2(s[2 * 65], s[3 * 65]); o.z = pk2(s[4 * 65], s[5 * 65]); o.w = pk2(s[6 * 65], s[7 * 65]);
        const int dr = (mode == 0) ? n : ((n >> 1) * 4 + (n & 1) + (mode == 2 ? 2 : 0));
        if (n < N) *(u32x4*)(WT + (size_t)dr * K + k0 + 8 * c) = o;
    }
    if (biasp) {
        float b0 = 0.f, b1 = 0.f, b2 = 0.f;
#pragma unroll
        for (int kk = 0; kk < 64; ++kk) {
            const float w = scr[kk * 65 + lane];
            b0 += w * __builtin_bit_cast(float, __builtin_amdgcn_readlane(__builtin_bit_cast(int, sh0), kk));
            b1 += w * __builtin_bit_cast(float, __builtin_amdgcn_readlane(__builtin_bit_cast(int, sh1), kk));
            b2 += w * __builtin_bit_cast(float, __builtin_amdgcn_readlane(__builtin_bit_cast(int, sh2), kk));
        }
        const int n = n0 + lane, dr = (mode == 0) ? n : ((n >> 1) * 4 + (n & 1) + (mode == 2 ? 2 : 0));
        if (n < N) { atomicAdd(biasp + dr, b0); atomicAdd(biasp + NBMAX + dr, b1); atomicAdd(biasp + 2 * NBMAX + dr, b2); }
    }
    asm volatile("s_waitcnt lgkmcnt(0)" ::: "memory");
}

__device__ __forceinline__ void phase_setup(Frame& F) {
    const CAS Args& a = *F.a;
    unsigned char* ws = a.ws;
    {
        LAS float* sc = (LAS float*)F.lds;
        LAS float* red = sc + 3 * 1024;
        for (int i = F.tid; i < 3 * 1024; i += 512) { const int c = i >> 10, k = i & 1023; const float v = (c == 0) ? a.in[I_CCTX][k] : a.in[I_C][(c - 1) * 1024 + k]; sc[i] = silu_f(v); }
        __syncthreads();
        float* mod = (float*)(ws + WS_MOD);
        for (int it = F.vcu; it < 4 * 72; it += F.G) {
            const int l = it / 72, cb = it % 72, q = F.tid & 31, kg = F.tid >> 5;
            const float* W = a.in[I_ADAW] + (size_t)l * 1024 * 9216 + cb * 128 + q * 4;
            f32x4 s0 = {0, 0, 0, 0}, s1 = s0, s2 = s0;
#pragma unroll 4
            for (int k = kg * 64; k < kg * 64 + 64; ++k) {
                const f32x4 w = *(const f32x4*)(W + (size_t)k * 9216);
                s0 += w * sc[k]; s1 += w * sc[1024 + k]; s2 += w * sc[2048 + k];
            }
            LAS float* rp = red + (kg * 32 + q) * 12;
#pragma unroll
            for (int j = 0; j < 4; ++j) { rp[j] = s0[j]; rp[4 + j] = s1[j]; rp[8 + j] = s2[j]; }
            __syncthreads();
            if (F.tid < 384) {
                const int qq = F.tid / 12, v = F.tid % 12; float s = 0.f;
#pragma unroll
                for (int g = 0; g < 16; ++g) s += red[(g * 32 + qq) * 12 + v];
                const int c = v >> 2, j = v & 3, n = cb * 128 + qq * 4 + j;
                mod[(size_t)(l * 3 + c) * 9216 + n] = s + a.in[I_ADAB][l * 9216 + n];
            }
            __syncthreads();
        }
        __syncthreads();
    }
    {
        const int gw = F.vcu * 8 + F.wave, NGW = F.G * 8;
        for (int it = gw; it < 2 * NH * 16384 / 512; it += NGW) {
            const float* sp = a.in[I_SGUW] + (size_t)it * 512 + F.lane * 8;
            const f32x4 x0 = *(const f32x4*)sp, x1 = *(const f32x4*)(sp + 4);
            u32x4 o; o.x = pk2(x0[0], x0[1]); o.y = pk2(x0[2], x0[3]); o.z = pk2(x1[0], x1[1]); o.w = pk2(x1[2], x1[3]);
            *(u32x4*)((bf16*)(ws + WS_SGUW) + (size_t)it * 512 + F.lane * 8) = o;
        }
        __syncthreads();
    }
    {
        const int gw = F.vcu * 8 + F.wave, NGW = F.G * 8;
        for (int it = gw; it < 2 * (P_EVEN_PAD - P_EVEN); it += NGW) {
            const int e = it / (P_EVEN_PAD - P_EVEN), rr = P_EVEN + it % (P_EVEN_PAD - P_EVEN);
            u32x4* p = (u32x4*)((bf16*)(ws + WS_EVIN + (size_t)e * EVIN_SZ) + (size_t)rr * D);
            p[F.lane] = (u32x4){0, 0, 0, 0}; p[64 + F.lane] = (u32x4){0, 0, 0, 0};
        }
        float* X = (float*)(ws + WS_X);
        for (int row = gw; row < M; row += NGW) {
            float* xo = X + (size_t)row * D;
            if (row < NCTX) {
                const f32x4* src = (const f32x4*)(a.in[I_XP] + (size_t)row * D);
#pragma unroll
                for (int j = 0; j < 4; ++j) ((f32x4*)xo)[j * 64 + F.lane] = src[j * 64 + F.lane];
            } else {
                const int t = (row - NCTX) & (LAT_L - 1); const float pr = (float)(t >> 6), pc = (float)(t & 63);
                const float* src = a.in[I_XS] + (size_t)(row - NCTX) * D;
#pragma unroll
                for (int j = 0; j < 16; ++j) {
                    const int ch = j * 64 + F.lane, seg = ch >> 8, i = ch & 255;
                    const float freq = expf(-9.210340371976184f * (float)i * (1.0f / 256.0f));
                    const float ang = ((seg < 2) ? pr : pc) * freq;
                    const float pe = (seg & 1) ? cosf(ang) : sinf(ang);
                    xo[ch] = src[ch] + pe;
                }
            }
        }
    }
}

__device__ __forceinline__ const bf16* sub_weight(unsigned char* ws, int s, int& N) {
    const int l = s / 3, which = s % 3, e = l >> 1;
    if (which != 1) { N = NUP; return (const bf16*)(ws + WS_WUP + (size_t)(l * 2 + (which == 2 ? 1 : 0)) * WUP_SZ); }
    if ((l & 1) == 0) { N = P_EVEN_PAD; return (const bf16*)(ws + WS_EVIN + (size_t)e * EVIN_SZ); }
    N = 2048; return (const bf16*)(ws + WS_ODIN + (size_t)e * ODIN_SZ);
}
__device__ __forceinline__ void phase_init(Frame& F) {
    const CAS Args& a = *F.a; unsigned char* ws = a.ws;
    const float* mod = (const float*)(ws + WS_MOD);
    const int gw = F.vcu * 8 + F.wave, NGW = F.G * 8;
    {
        LAS float* T = (LAS float*)F.lds;
        LAS float* wt = T + 64 * 128;
        LAS float* tw = wt + 64 * 65;
        if (F.tid < 64) { tw[F.tid] = cospif((float)F.tid * (1.f / 32.f)); tw[64 + F.tid] = sinpif((float)F.tid * (1.f / 32.f)); }
        __syncthreads();
        for (int it = F.vcu; it < 2 * 4 * 16; it += F.G) {
            const int j = it >> 6, g = (it >> 4) & 3, k0 = (it & 15) * 64;
            const float* Wg = a.in[I_FNETW] + ((size_t)j * 4 + g) * 4096;
            {
                const int c = F.tid >> 3, eb = (F.tid & 7) * 8;
                float ac[8], as[8];
#pragma unroll
                for (int q = 0; q < 8; ++q) { ac[q] = 0.f; as[q] = 0.f; }
                for (int m = 0; m < 64; ++m) {
                    const int idx = (m * c) & 63; const float cs = tw[idx], sn = tw[64 + idx];
                    const f32x4 w0 = *(const f32x4*)(Wg + m * 64 + eb), w1 = *(const f32x4*)(Wg + m * 64 + eb + 4);
#pragma unroll
                    for (int q = 0; q < 4; ++q) { ac[q] += cs * w0[q]; ac[4 + q] += cs * w1[q]; as[q] -= sn * w0[q]; as[4 + q] -= sn * w1[q]; }
                }
#pragma unroll
                for (int q = 0; q < 8; ++q) { T[c * 128 + eb + q] = ac[q] * 0.125f; T[c * 128 + 64 + eb + q] = as[q] * 0.125f; }
                const int kk = F.tid >> 3, c8 = (F.tid & 7) * 8;
                const float* wp = a.in[I_ODIN] + (size_t)j * D * P_ODD + (size_t)(k0 + kk) * P_ODD + 1536 + g * 64 + c8;
                const f32x4 x0 = *(const f32x4*)wp, x1 = *(const f32x4*)(wp + 4);
#pragma unroll
                for (int q = 0; q < 4; ++q) { wt[kk * 65 + c8 + q] = x0[q]; wt[kk * 65 + c8 + 4 + q] = x1[q]; }
            }
            __syncthreads();
            {
                const int col = F.tid & 127, kq = F.tid >> 7;
                float acc[16];
#pragma unroll
                for (int q = 0; q < 16; ++q) acc[q] = 0.f;
                for (int c = 0; c < 64; ++c) {
                    const float t = T[c * 128 + col];
#pragma unroll
                    for (int q = 0; q < 16; ++q) acc[q] += wt[(kq * 16 + q) * 65 + c] * t;
                }
                const int drow = 1536 + ((col < 64) ? (g * 64 + col) : (256 + g * 64 + col - 64));
                bf16* dst = (bf16*)(ws + WS_ODIN + (size_t)j * ODIN_SZ) + (size_t)drow * D + k0 + kq * 16;
                u32x4 o0, o1;
                o0.x = pk2(acc[0], acc[1]); o0.y = pk2(acc[2], acc[3]); o0.z = pk2(acc[4], acc[5]); o0.w = pk2(acc[6], acc[7]);
                o1.x = pk2(acc[8], acc[9]); o1.y = pk2(acc[10], acc[11]); o1.z = pk2(acc[12], acc[13]); o1.w = pk2(acc[14], acc[15]);
                *(u32x4*)dst = o0; *(u32x4*)(dst + 8) = o1;
                const float* shp = (const float*)(ws + WS_MOD) + ((size_t)((2 * j + 1) * 3) * 9 + 3) * 1024 + k0 + kq * 16 + (F.lane & 15);
                const float s0v = shp[0], s1v = shp[9216], s2v = shp[2 * 9216];
                float b0 = 0.f, b1 = 0.f, b2 = 0.f;
#pragma unroll
                for (int q = 0; q < 16; ++q) {
                    b0 += acc[q] * __builtin_bit_cast(float, __builtin_amdgcn_readlane(__builtin_bit_cast(int, s0v), q));
                    b1 += acc[q] * __builtin_bit_cast(float, __builtin_amdgcn_readlane(__builtin_bit_cast(int, s1v), q));
                    b2 += acc[q] * __builtin_bit_cast(float, __builtin_amdgcn_readlane(__builtin_bit_cast(int, s2v), q));
                }
                float* bp = (float*)(ws + WS_BIAS) + (size_t)(3 * (2 * j + 1) + 1) * 3 * NBMAX + drow;
                atomicAdd(bp, b0); atomicAdd(bp + NBMAX, b1); atomicAdd(bp + 2 * NBMAX, b2);
            }
            __syncthreads();
        }
    }
    {
        LAS float* scr = (LAS float*)(F.lds + F.wave * 16640);
        const int gw = F.vcu * 8 + F.wave, NGW = F.G * 8;
        constexpr int IT_G = 16 * 44, IT_D = 44 * 16, IT_EVIN = 16 * 53, IT_SQ = 16 * 16, IT_ODIN = 16 * 24;
        static_assert(IT_G == IT_D, "decode");
        constexpr int PER_FFN = 2 * IT_G + IT_D;
        constexpr int TOT = 8 * PER_FFN + 2 * (IT_EVIN + IT_SQ + IT_ODIN + IT_SQ);
        for (int it = gw; it < TOT; it += NGW) {
            int r = it; const float* W; bf16* WT; int K, N, mode, ldw = 0, sub_s = -1;
            if (r < 8 * PER_FFN) {
                const int f = r / PER_FFN, l = f >> 1, s = f & 1; r -= f * PER_FFN;
                const int sub = r / IT_G; r -= sub * IT_G;
                const int idx = (sub == 0) ? (s ? I_F2G : I_F1G) : ((sub == 1) ? (s ? I_F2U : I_F1U) : (s ? I_F2D : I_F1D));
                W = a.in[idx] + (size_t)l * D * FF;
                WT = (sub == 2) ? (bf16*)(ws + WS_WDN + (size_t)f * WDN_SZ) : (bf16*)(ws + WS_WUP + (size_t)f * WUP_SZ);
                K = (sub == 2) ? FF : D; N = (sub == 2) ? D : FF; mode = (sub == 2) ? 0 : sub + 1;
                if (sub != 2) sub_s = 3 * l + (s ? 2 : 0);
            } else {
                r -= 8 * PER_FFN;
                constexpr int PER_E = IT_EVIN + IT_SQ + IT_ODIN + IT_SQ;
                const int e = r / PER_E; r -= e * PER_E;
                K = D; mode = 0;
                if (r < IT_EVIN) { W = a.in[I_EVIN] + (size_t)e * D * P_EVEN; N = P_EVEN; WT = (bf16*)(ws + WS_EVIN + (size_t)e * EVIN_SZ); sub_s = 3 * (2 * e) + 1; }
                else if (r < IT_EVIN + IT_SQ) { r -= IT_EVIN; W = a.in[I_EVOUT] + (size_t)e * D * D; N = D; WT = (bf16*)(ws + WS_EVOUT + (size_t)e * SQ_SZ); }
                else if (r < IT_EVIN + IT_SQ + IT_ODIN) { r -= IT_EVIN + IT_SQ; W = a.in[I_ODIN] + (size_t)e * D * P_ODD; N = 1536; ldw = P_ODD; WT = (bf16*)(ws + WS_ODIN + (size_t)e * ODIN_SZ); sub_s = 3 * (2 * e + 1) + 1; }
                else { r -= IT_EVIN + IT_SQ + IT_ODIN; W = a.in[I_ODOUT] + (size_t)e * D * D; N = D; WT = (bf16*)(ws + WS_ODOUT + (size_t)e * SQ_SZ); }
            }
            const float* shp = nullptr; float* biasp = nullptr;
            if (sub_s >= 0) { shp = (const float*)(ws + WS_MOD) + ((size_t)((sub_s / 3) * 3) * 9 + (sub_s % 3) * 3) * 1024; biasp = (float*)(ws + WS_BIAS) + (size_t)sub_s * 3 * NBMAX; }
            transpose_item(W, K, N, ldw ? ldw : N, WT, mode, scr, r, F.lane, shp, biasp);
        }
    }
    {
        const float* X = (const float*)(ws + WS_X); bf16* XS = (bf16*)(ws + WS_HN);
        float* ss = (float*)(ws + WS_CTL + CTL_SS_OFF);
        const float* nw = a.in[I_F1N];
        for (int row = gw; row < M; row += NGW) {
            const f32x4* xr = (const f32x4*)(X + (size_t)row * D) + F.lane;
            f32x4 v[4]; float s = 0.f;
#pragma unroll
            for (int j = 0; j < 4; ++j) { v[j] = xr[64 * j]; s += v[j][0] * v[j][0] + v[j][1] * v[j][1] + v[j][2] * v[j][2] + v[j][3] * v[j][3]; }
            s = wave_sum(s);
            if (F.lane == 0) ss[row] = s;
            const float* mb = mod + ((size_t)(0 * 3 + cond_of_row(row)) * 9 + 1) * 1024;
            u32x2* o = (u32x2*)(XS + (size_t)row * D) + F.lane;
#pragma unroll
            for (int j = 0; j < 4; ++j) {
                const int k = (64 * j + F.lane) * 4;
                const f32x4 h = v[j] * *(const f32x4*)(nw + k) * (*(const f32x4*)(mb + k) + 1.0f);
                u32x2 pkd; pkd.x = pk2(h[0], h[1]); pkd.y = pk2(h[2], h[3]);
                o[64 * j] = pkd;
            }
        }
    }
}

__device__ __forceinline__ void phase_final(Frame& F) {
    const CAS Args& a = *F.a;
    const float* X = (const float*)(a.ws + WS_X);
    const float* nw = a.in[I_FINN];
    const int gw = F.vcu * 8 + F.wave, NGW = F.G * 8;
    for (int row = gw; row < M; row += NGW) {
        const f32x4* xr = (const f32x4*)(X + (size_t)row * D) + F.lane;
        f32x4 v[4]; float s = 0.f;
#pragma unroll
        for (int j = 0; j < 4; ++j) { v[j] = xr[64 * j]; s += v[j][0] * v[j][0] + v[j][1] * v[j][1] + v[j][2] * v[j][2] + v[j][3] * v[j][3]; }
        const float rstd = 1.0f / sqrtf(wave_sum(s) * (1.f / D) + EPS);
        f32x4* o = (f32x4*)(a.out + (size_t)row * D) + F.lane;
#pragma unroll
        for (int j = 0; j < 4; ++j) { const f32x4 w = *(const f32x4*)(nw + (64 * j + F.lane) * 4); o[64 * j] = v[j] * rstd * w; }
    }
}

__device__ __forceinline__ float wave_matvec64(float d, const float* W, int lane) {
    float y = 0.f;
#pragma unroll
    for (int c = 0; c < 64; ++c) { const float dc = __builtin_bit_cast(float, __builtin_amdgcn_readlane(__builtin_bit_cast(int, d), c)); y += dc * W[c * 64 + lane]; }
    return y;
}

__device__ __forceinline__ int perm32(int x) { return (x & ~31) | ((x & 12) << 1) | ((x & 16) >> 2) | (x & 3); }
__device__ __forceinline__ int sw256(int row, int c16) { return row * 256 + ((c16 ^ (row & 15)) << 4); }
__device__ __forceinline__ int sw128(int row, int c8) { return row * 128 + ((c8 ^ ((row >> 1) & 7)) << 4); }
__device__ __forceinline__ int e128(int row, int col) { return sw128(row, col >> 3) + (col & 7) * 2; }
__device__ __forceinline__ void dn_item_decode(int cc, int& row0, int& L, int& c) {
    if (cc < 64) { row0 = (cc >> 2) * CTX_L; L = CTX_L; c = cc & 3; } else { const int q = cc - 64; row0 = NCTX + (q >> 4) * LAT_L; L = LAT_L; c = q & 15; }
}
#define MFMA16(a, b, c) __builtin_amdgcn_mfma_f32_16x16x32_bf16((a), (b), (c), 0, 0, 0)

__device__ __forceinline__ void phase_dn_prep(Frame& F, int e) {
    const CAS Args& a = *F.a;
    const bf16* P = (const bf16*)(a.ws + WS_P); const float* GT = (const float*)(a.ws + WS_AG);
    const float* cw = a.in[I_CONVW] + (size_t)e * 3 * 2304;
    LAS unsigned char* L = F.lds;
    constexpr int CWL = 114688;
    constexpr int KB = 0, QB = 16384, VBT = 32768, KGT = 49152, KDT = 65536, AIo = 81920, MM = 90112, TT = 98304, TN = 106496, MD = 114688, XT = 118784, SM = 139264, VB16 = 140288;
    LAS float* sm = (LAS float*)(L + SM);
    const int wave = F.wave;
    for (int rec = F.vcu; rec < 1152; rec += F.G) {
        int tid_ = F.tid; asm volatile("" : "+v"(tid_));
        const int lane = tid_ & 63, fr = lane & 15, fq = lane >> 4;
        const int dir = rec & 1, h = (rec >> 1) % NH, cc = rec / (2 * NH);
        int row0, Ls, c; dn_item_decode(cc, row0, Ls, c);
        __syncthreads();
        for (int i_ = tid_; i_ < 1152; i_ += 512) { const int part = i_ / 384, r_ = i_ % 384, tap = r_ >> 7, ch = r_ & 127; ((LAS float*)(L + CWL))[i_] = cw[tap * 2304 + part * 768 + h * 128 + ch]; }
        if (wave == 0) {
            const int row = row0 + (dir ? (Ls - 1 - (c * 64 + lane)) : (c * 64 + lane));
            const float araw = GT[(size_t)row * 24 + 12 + dir * 6 + h], braw = GT[(size_t)row * 24 + dir * 6 + h];
            const float al = a.in[I_ALOG][(e * 2 + dir) * 6 + h], dtb = a.in[I_DTB][(e * 2 + dir) * 6 + h];
            float x = -expf(al) * softplus_f(araw + dtb); const float b = sigmoid_f(braw);
#pragma unroll
            for (int o = 1; o < 64; o <<= 1) { const float t = __shfl_up(x, o); if (lane >= o) x += t; }
            const float gl = __shfl(x, 63);
            sm[lane] = x; sm[64 + lane] = b; sm[128 + lane] = expf(x); sm[192 + lane] = expf(gl - x);
            if (lane == 63) ((float*)(a.ws + WS_DGL))[rec] = expf(x);
        }
        __syncthreads();
        {
            const int i = tid_ >> 3, cg = tid_ & 7;
            const int row = row0 + (dir ? (Ls - 1 - (c * 64 + i)) : (c * 64 + i));
            const int tl = row - row0; const bool hp = tl > 0, hn = tl < Ls - 1;
            float kf[16], qf[16], vf[16];
#pragma unroll
            for (int part = 0; part < 3; ++part) {
                const int pc = 256 + part * 768 + h * 128 + cg * 16;
                const bf16* p1 = P + (size_t)row * LDP + pc;
                const LAS float* wl = (const LAS float*)(L + CWL) + part * 384 + cg * 16;
                float out[16];
#pragma unroll
                for (int q8 = 0; q8 < 2; ++q8) {
                    const u32x4 r1 = *(const u32x4*)(p1 + q8 * 8);
                    const u32x4 r0 = hp ? *(const u32x4*)(p1 - LDP + q8 * 8) : (u32x4){0, 0, 0, 0};
                    const u32x4 r2 = hn ? *(const u32x4*)(p1 + LDP + q8 * 8) : (u32x4){0, 0, 0, 0};
                    const unsigned a0[4] = {r0.x, r0.y, r0.z, r0.w}, a1[4] = {r1.x, r1.y, r1.z, r1.w}, a2[4] = {r2.x, r2.y, r2.z, r2.w};
#pragma unroll
                    for (int d = 0; d < 4; ++d) {
#pragma unroll
                        for (int hh = 0; hh < 2; ++hh) {
                            const int j = q8 * 8 + d * 2 + hh;
                            const float x0 = __builtin_bit_cast(float, hh ? (a0[d] & 0xffff0000u) : (a0[d] << 16));
                            const float x1 = __builtin_bit_cast(float, hh ? (a1[d] & 0xffff0000u) : (a1[d] << 16));
                            const float x2 = __builtin_bit_cast(float, hh ? (a2[d] & 0xffff0000u) : (a2[d] << 16));
                            out[j] = silu_f(x0 * wl[j] + x1 * wl[128 + j] + x2 * wl[256 + j]);
                        }
                    }
                }
                if (part < 2) {
                    float ssq = 0.f;
#pragma unroll
                    for (int j = 0; j < 16; ++j) ssq += out[j] * out[j];
                    ssq += __shfl_xor(ssq, 1); ssq += __shfl_xor(ssq, 2); ssq += __shfl_xor(ssq, 4);
                    const float rs = rsq_f(ssq + EPS) * (part == 0 ? 0.08838834764831845f : 1.0f);
#pragma unroll
                    for (int j = 0; j < 16; ++j) { if (part == 0) qf[j] = out[j] * rs; else kf[j] = out[j] * rs; }
                } else {
#pragma unroll
                    for (int j = 0; j < 16; ++j) vf[j] = out[j];
                }
            }
            const float eg = sm[128 + i];
#pragma unroll
            for (int hf = 0; hf < 2; ++hf) {
                u32x4 kk, qq, vv;
                kk.x = pk2(kf[hf * 8 + 0], kf[hf * 8 + 1]); kk.y = pk2(kf[hf * 8 + 2], kf[hf * 8 + 3]); kk.z = pk2(kf[hf * 8 + 4], kf[hf * 8 + 5]); kk.w = pk2(kf[hf * 8 + 6], kf[hf * 8 + 7]);
                qq.x = pk2(qf[hf * 8 + 0], qf[hf * 8 + 1]); qq.y = pk2(qf[hf * 8 + 2], qf[hf * 8 + 3]); qq.z = pk2(qf[hf * 8 + 4], qf[hf * 8 + 5]); qq.w = pk2(qf[hf * 8 + 6], qf[hf * 8 + 7]);
                vv.x = pk2(vf[hf * 8 + 0], vf[hf * 8 + 1]); vv.y = pk2(vf[hf * 8 + 2], vf[hf * 8 + 3]); vv.z = pk2(vf[hf * 8 + 4], vf[hf * 8 + 5]); vv.w = pk2(vf[hf * 8 + 6], vf[hf * 8 + 7]);
                *(LAS u32x4*)(L + KB + sw256(i, cg * 2 + hf)) = kk;
                *(LAS u32x4*)(L + QB + sw256(i, cg * 2 + hf)) = qq;
                *(LAS u32x4*)(L + VB16 + sw256(i, cg * 2 + hf)) = vv;
            }
            bf16* QD = (bf16*)(a.ws + WS_DQ) + (size_t)rec * 8192 + i * 128;
#pragma unroll
            for (int qq = 0; qq < 4; ++qq) {
                const int pos = perm32(cg * 16 + 4 * qq);
                u32x2 w; w.x = pk2(qf[4 * qq] * eg, qf[4 * qq + 1] * eg); w.y = pk2(qf[4 * qq + 2] * eg, qf[4 * qq + 3] * eg);
                *(u32x2*)(QD + pos) = w;
            }
        }
        __syncthreads();
        {
            const int kdl = lane & 15, ipl = lane >> 4;
#pragma unroll 2
            for (int it8 = 0; it8 < 8; ++it8) {
                const int combo = wave * 8 + it8, kd = (combo & 7) * 16 + kdl, i0 = 2 * ((combo >> 3) * 4 + ipl);
                const int a0 = sw256(i0, kd >> 3) + (kd & 7) * 2, a1 = sw256(i0 + 1, kd >> 3) + (kd & 7) * 2;
                const float k0 = __builtin_bit_cast(float, (unsigned)(*(const LAS bf16*)(L + KB + a0)) << 16), k1 = __builtin_bit_cast(float, (unsigned)(*(const LAS bf16*)(L + KB + a1)) << 16);
                const float v0 = __builtin_bit_cast(float, (unsigned)(*(const LAS bf16*)(L + VB16 + a0)) << 16), v1 = __builtin_bit_cast(float, (unsigned)(*(const LAS bf16*)(L + VB16 + a1)) << 16);
                const float be0 = sm[64 + i0], be1 = sm[65 + i0], eg0 = sm[128 + i0], eg1 = sm[129 + i0], ek0 = sm[192 + i0], ek1 = sm[193 + i0];
                *(LAS unsigned*)(L + VBT + e128(kd, i0)) = pk2(v0 * be0, v1 * be1);
                *(LAS unsigned*)(L + KGT + e128(kd, i0)) = pk2(k0 * be0 * eg0, k1 * be1 * eg1);
                *(LAS unsigned*)(L + KDT + e128(kd, perm32(i0))) = pk2(k0 * ek0, k1 * ek1);
            }
        }
        __syncthreads();
        const int mi = wave >> 1;
#pragma unroll
        for (int f = 0; f < 2; ++f) {
            const int nj = (wave & 1) * 2 + f;
            f32x4 kkacc = {0.f, 0.f, 0.f, 0.f}, qkacc = {0.f, 0.f, 0.f, 0.f};
            if (nj <= mi) {
#pragma unroll
                for (int ks = 0; ks < 4; ++ks) {
                    const bf16x8 ak = *(const LAS bf16x8*)(L + KB + sw256(mi * 16 + fr, ks * 4 + fq));
                    const bf16x8 aq = *(const LAS bf16x8*)(L + QB + sw256(mi * 16 + fr, ks * 4 + fq));
                    const bf16x8 bk = *(const LAS bf16x8*)(L + KB + sw256(nj * 16 + fr, ks * 4 + fq));
                    kkacc = MFMA16(ak, bk, kkacc); qkacc = MFMA16(aq, bk, qkacc);
                }
            }
            const int j = nj * 16 + fr, i0 = mi * 16 + 4 * fq; const float gcj = sm[j];
#pragma unroll
            for (int r = 0; r < 4; ++r) {
                const int i = i0 + r; const float dec = (i >= j) ? __expf(sm[i] - gcj) : 0.f;
                const float mv = (i > j) ? (sm[64 + i] * kkacc[r] * dec) : 0.f;
                if (nj <= mi) *(LAS bf16*)(L + MM + e128(i, j)) = (bf16)f2bf(mv);
                if (nj == mi) *(LAS float*)(L + MD + ((mi * 16 + 4 * fq + r) * 16 + fr) * 4) = mv;
                if (nj > mi) *(LAS bf16*)(L + TN + e128(i, j)) = (bf16)0;
                *(LAS bf16*)(L + AIo + e128(i, perm32(j))) = (bf16)f2bf(qkacc[r] * dec);
            }
        }
        __syncthreads();
        if (wave == 0) {
            const int b = lane >> 4, cc_ = lane & 15;
            const LAS float* md = (const LAS float*)(L + MD) + b * 256;
            float T[16];
#pragma unroll
            for (int i = 0; i < 16; ++i) {
                float s = (i == cc_) ? 1.f : 0.f;
#pragma unroll
                for (int jj = 0; jj < i; ++jj) s -= md[i * 16 + jj] * T[jj];
                T[i] = s;
            }
#pragma unroll
            for (int i = 0; i < 16; ++i) *(LAS bf16*)(L + TN + e128(16 * b + i, 16 * b + cc_)) = (bf16)f2bf(T[i]);
#pragma unroll
            for (int hf = 0; hf < 2; ++hf) {
                u32x4 t; t.x = pk2(T[hf * 8 + 0], T[hf * 8 + 1]); t.y = pk2(T[hf * 8 + 2], T[hf * 8 + 3]); t.z = pk2(T[hf * 8 + 4], T[hf * 8 + 5]); t.w = pk2(T[hf * 8 + 6], T[hf * 8 + 7]);
                *(LAS u32x4*)(L + TT + sw128(16 * b + cc_, 2 * b + hf)) = t;
            }
        }
        __syncthreads();
#pragma unroll
        for (int lvl = 1; lvl <= 3; ++lvl) {
            if (wave < 4 - lvl) {
                const int J = wave, I = wave + lvl;
                f32x4 x = {0.f, 0.f, 0.f, 0.f};
                const bf16x8 zero8 = {0, 0, 0, 0, 0, 0, 0, 0};
#pragma unroll
                for (int ks = 0; ks < (lvl == 3 ? 2 : 1); ++ks) {
                    const bf16x8 am = *(const LAS bf16x8*)(L + MM + sw128(16 * I + fr, 2 * J + 4 * ks + fq));
                    bf16x8 bt = *(const LAS bf16x8*)(L + TT + sw128(16 * J + fr, 2 * J + 4 * ks + fq));
                    if (4 * ks + fq >= 2 * lvl) bt = zero8;
                    x = MFMA16(am, bt, x);
                }
                LAS unsigned char* xt = L + XT + wave * 512;
                { u32x2 t; t.x = pk2(x[0], x[1]); t.y = pk2(x[2], x[3]); *(LAS u32x2*)(xt + fr * 32 + fq * 8) = t; }
                const bf16x8 ad = *(const LAS bf16x8*)(L + TN + sw128(16 * I + fr, 2 * I + (fq & 1)));
                bf16x8 bx = *(const LAS bf16x8*)(xt + fr * 32 + (fq & 1) * 16);
                if (fq >= 2) bx = zero8;
                f32x4 t4 = {0.f, 0.f, 0.f, 0.f};
                t4 = MFMA16(ad, bx, t4);
#pragma unroll
                for (int r = 0; r < 4; ++r) *(LAS bf16*)(L + TN + e128(16 * I + 4 * fq + r, 16 * J + fr)) = (bf16)f2bf(-t4[r]);
                { u32x2 t; t.x = pk2(-t4[0], -t4[1]); t.y = pk2(-t4[2], -t4[3]); *(LAS u32x2*)(L + TT + e128(16 * J + fr, 16 * I + 4 * fq)) = t; }
            }
            __syncthreads();
        }
        {
            bf16* UT = (bf16*)(a.ws + WS_DUT) + (size_t)rec * 8192;
            bf16* Wn = (bf16*)(a.ws + WS_DW) + (size_t)rec * 8192;
            const int ui = wave & 3;
#pragma unroll
            for (int f = 0; f < 4; ++f) {
                const int dvf = (wave >> 2) * 4 + f;
                f32x4 acc = {0.f, 0.f, 0.f, 0.f};
#pragma unroll
                for (int ks = 0; ks < 2; ++ks) {
                    const bf16x8 ta = *(const LAS bf16x8*)(L + TN + sw128(ui * 16 + fr, ks * 4 + fq));
                    const bf16x8 vb = *(const LAS bf16x8*)(L + VBT + sw128(dvf * 16 + fr, ks * 4 + fq));
                    acc = MFMA16(ta, vb, acc);
                }
                u32x2 t; t.x = pk2(acc[0], acc[1]); t.y = pk2(acc[2], acc[3]);
                *(u32x2*)(UT + (dvf * 16 + fr) * 64 + ui * 16 + 4 * fq) = t;
            }
#pragma unroll
            for (int f = 0; f < 4; ++f) {
                f32x4 acc = {0.f, 0.f, 0.f, 0.f};
#pragma unroll
                for (int ks = 0; ks < 2; ++ks) {
                    const bf16x8 ka = *(const LAS bf16x8*)(L + KGT + sw128(wave * 16 + fr, ks * 4 + fq));
                    const bf16x8 tb = *(const LAS bf16x8*)(L + TN + sw128(f * 16 + fr, ks * 4 + fq));
                    acc = MFMA16(ka, tb, acc);
                }
                u32x2 t; t.x = pk2(-acc[0], -acc[1]); t.y = pk2(-acc[2], -acc[3]);
                *(u32x2*)(Wn + (f * 16 + fr) * 128 + perm32(wave * 16 + 4 * fq)) = t;
            }
            {
                const int rw = tid_ >> 3, c8 = tid_ & 7;
                *(u32x4*)((unsigned char*)(a.ws + WS_DAI) + (size_t)rec * 8192 + rw * 128 + c8 * 16) = *(const LAS u32x4*)(L + AIo + sw128(rw, c8));
#pragma unroll
                for (int k2 = 0; k2 < 2; ++k2) {
                    const int rr = rw + 64 * k2;
                    *(u32x4*)((unsigned char*)(a.ws + WS_DKT) + (size_t)rec * 16384 + rr * 128 + c8 * 16) = *(const LAS u32x4*)(L + KDT + sw128(rr, c8));
                }
            }
        }
    }
    __syncthreads();
}

__device__ __forceinline__ void phase_dn_scan(Frame& F, int e) {
    const CAS Args& a = *F.a;
    LAS unsigned char* L = F.lds;
    constexpr int BUF = 57344, oW = 0, oQ = 16384, oA = 32768, oK = 40960;
    const int wave = F.wave;
    const unsigned char* gW = (const unsigned char*)(a.ws + WS_DW); const unsigned char* gQ = (const unsigned char*)(a.ws + WS_DQ);
    const unsigned char* gA = (const unsigned char*)(a.ws + WS_DAI); const unsigned char* gK = (const unsigned char*)(a.ws + WS_DKT);
    const bf16* gU = (const bf16*)(a.ws + WS_DUT); const float* gGL = (const float*)(a.ws + WS_DGL);
    for (int it = F.vcu; it < (2 * LAT_B + CTX_B) * 2 * NH; it += F.G) {
        int tid_ = F.tid; asm volatile("" : "+v"(tid_));
        const int lane = tid_ & 63, fr = lane & 15, fq = lane >> 4;
        const int r4 = lane >> 4, s16 = lane & 15, r8 = lane >> 3, s8 = lane & 7;
        int seq, dir, h, half = 0;
        if (it < 2 * LAT_B * 2 * NH) { half = it & 1; const int j = it >> 1; seq = CTX_B + j / (2 * NH); dir = (j / NH) & 1; h = j % NH; }
        else { const int j = it - 2 * LAT_B * 2 * NH; seq = j / (2 * NH); dir = (j / NH) & 1; h = j % NH; }
        const bool lat = seq >= CTX_B;
        const bool active = lat ? (wave < 4) : true;
        const int dvc = (lat ? half * 64 : 0) + (wave & (lat ? 3 : 7)) * 16 + fr;
        const int Ls = lat ? LAT_L : CTX_L, row0 = lat ? NCTX + (seq - CTX_B) * LAT_L : seq * CTX_L, nch = Ls / 64;
        const int cbase = lat ? 64 + (seq - CTX_B) * 16 : seq * 4;
        f32x4 S[8];
        if (lat) {
            const float* s0 = a.in[I_STATE] + ((((size_t)(seq - CTX_B) * 2 + e) * 2 + dir) * NH + h) * 128 * 128;
#pragma unroll
            for (int mf = 0; mf < 8; ++mf)
#pragma unroll
                for (int r = 0; r < 4; ++r) S[mf][r] = s0[(size_t)(mf * 16 + 4 * fq + r) * 128 + dvc];
        } else {
#pragma unroll
            for (int mf = 0; mf < 8; ++mf) S[mf] = (f32x4){0.f, 0.f, 0.f, 0.f};
        }
        float* O = (float*)(a.ws + (dir ? WS_OB : WS_OF));
#define DN_STAGE(bufi, rec_) do { LAS unsigned char* sb_ = L + (bufi) * BUF; const size_t ro_ = (size_t)(rec_); \
        _Pragma("unroll") for (int p_ = 0; p_ < 2; ++p_) { const int pc_ = wave + 8 * p_; const int rw_ = pc_ * 4 + r4; const int so_ = rw_ * 256 + ((s16 ^ (rw_ & 15)) << 4); \
            __builtin_amdgcn_global_load_lds((const unsigned*)(gW + ro_ * 16384 + so_), (LAS unsigned*)(sb_ + oW + pc_ * 1024), 16, 0, 0); \
            __builtin_amdgcn_global_load_lds((const unsigned*)(gQ + ro_ * 16384 + so_), (LAS unsigned*)(sb_ + oQ + pc_ * 1024), 16, 0, 0); \
            const int rk_ = pc_ * 8 + r8; const int sk_ = rk_ * 128 + ((s8 ^ ((rk_ >> 1) & 7)) << 4); \
            __builtin_amdgcn_global_load_lds((const unsigned*)(gK + ro_ * 16384 + sk_), (LAS unsigned*)(sb_ + oK + pc_ * 1024), 16, 0, 0); } \
        { const int ra_ = wave * 8 + r8; const int sa_ = ra_ * 128 + ((s8 ^ ((ra_ >> 1) & 7)) << 4); \
            __builtin_amdgcn_global_load_lds((const unsigned*)(gA + ro_ * 8192 + sa_), (LAS unsigned*)(sb_ + oA + wave * 1024), 16, 0, 0); } } while (0)
        __syncthreads();
        int rec = (cbase * NH + h) * 2 + dir;
        DN_STAGE(0, rec);
        u32x2 un[4]; float gln;
#pragma unroll
        for (int mf = 0; mf < 4; ++mf) un[mf] = *(const u32x2*)(gU + (size_t)rec * 8192 + dvc * 64 + mf * 16 + 4 * fq);
        gln = gGL[rec];
        for (int c = 0; c < nch; ++c) {
            asm volatile("s_waitcnt vmcnt(0)" ::: "memory");
            __syncthreads();
            u32x2 uc[4]; const float gl = gln;
#pragma unroll
            for (int mf = 0; mf < 4; ++mf) uc[mf] = un[mf];
            if (c + 1 < nch) {
                const int rn = rec + 2 * NH;
                DN_STAGE((c + 1) & 1, rn);
#pragma unroll
                for (int mf = 0; mf < 4; ++mf) un[mf] = *(const u32x2*)(gU + (size_t)rn * 8192 + dvc * 64 + mf * 16 + 4 * fq);
                gln = gGL[rn];
            }
            if (active) {
            LAS unsigned char* sb = L + (c & 1) * BUF;
            bf16x8 Sb[4];
#pragma unroll
            for (int ks = 0; ks < 4; ++ks) {
                u32x4 t; t.x = pk2(S[2 * ks][0], S[2 * ks][1]); t.y = pk2(S[2 * ks][2], S[2 * ks][3]); t.z = pk2(S[2 * ks + 1][0], S[2 * ks + 1][1]); t.w = pk2(S[2 * ks + 1][2], S[2 * ks + 1][3]);
                Sb[ks] = __builtin_bit_cast(bf16x8, t);
            }
            f32x4 vn[4], o[4];
#pragma unroll
            for (int mf = 0; mf < 4; ++mf) {
                vn[mf][0] = __builtin_bit_cast(float, uc[mf].x << 16); vn[mf][1] = __builtin_bit_cast(float, uc[mf].x & 0xffff0000u);
                vn[mf][2] = __builtin_bit_cast(float, uc[mf].y << 16); vn[mf][3] = __builtin_bit_cast(float, uc[mf].y & 0xffff0000u);
                o[mf] = (f32x4){0.f, 0.f, 0.f, 0.f};
#pragma unroll
                for (int ks = 0; ks < 4; ++ks) {
                    const bf16x8 wf = *(const LAS bf16x8*)(sb + oW + sw256(mf * 16 + fr, ks * 4 + fq));
                    const bf16x8 qf = *(const LAS bf16x8*)(sb + oQ + sw256(mf * 16 + fr, ks * 4 + fq));
                    vn[mf] = MFMA16(wf, Sb[ks], vn[mf]);
                    o[mf] = MFMA16(qf, Sb[ks], o[mf]);
                }
            }
            bf16x8 Vb[2];
#pragma unroll
            for (int ks = 0; ks < 2; ++ks) {
                u32x4 t; t.x = pk2(vn[2 * ks][0], vn[2 * ks][1]); t.y = pk2(vn[2 * ks][2], vn[2 * ks][3]); t.z = pk2(vn[2 * ks + 1][0], vn[2 * ks + 1][1]); t.w = pk2(vn[2 * ks + 1][2], vn[2 * ks + 1][3]);
                Vb[ks] = __builtin_bit_cast(bf16x8, t);
            }
#pragma unroll
            for (int mf = 0; mf < 4; ++mf)
#pragma unroll
                for (int ks = 0; ks < 2; ++ks) {
                    const bf16x8 af = *(const LAS bf16x8*)(sb + oA + sw128(mf * 16 + fr, ks * 4 + fq));
                    o[mf] = MFMA16(af, Vb[ks], o[mf]);
                }
#pragma unroll
            for (int mf = 0; mf < 8; ++mf) {
                S[mf] = S[mf] * gl;
#pragma unroll
                for (int ks = 0; ks < 2; ++ks) {
                    const bf16x8 kf = *(const LAS bf16x8*)(sb + oK + sw128(mf * 16 + fr, ks * 4 + fq));
                    S[mf] = MFMA16(kf, Vb[ks], S[mf]);
                }
            }
#pragma unroll
            for (int mf = 0; mf < 4; ++mf)
#pragma unroll
                for (int r = 0; r < 4; ++r) {
                    const int step = c * 64 + mf * 16 + 4 * fq + r, row = row0 + (dir ? (Ls - 1 - step) : step);
                    O[(size_t)row * 768 + h * 128 + dvc] = o[mf][r];
                }
            }
            rec += 2 * NH;
        }
#undef DN_STAGE
        if (!lat) {
            float* so = a.out + (size_t)M * D + ((((size_t)seq * 2 + e) * 2 + dir) * NH + h) * 128 * 128;
#pragma unroll
            for (int mf = 0; mf < 8; ++mf)
#pragma unroll
                for (int r = 0; r < 4; ++r) so[(size_t)(mf * 16 + 4 * fq + r) * 128 + dvc] = S[mf][r];
        }
    }
    __syncthreads();
}

__device__ __forceinline__ void phase_dn_fin(Frame& F, int e) {
    const CAS Args& a = *F.a;
    const bf16* P = (const bf16*)(a.ws + WS_P);
    const float* OF = (const float*)(a.ws + WS_OF); const float* OB = (const float*)(a.ws + WS_OB);
    bf16* Y = (bf16*)(a.ws + WS_Y);
    const float* nw = a.in[I_DNNW] + e * 128;
    const int gw = F.vcu * 8 + F.wave, NGW = F.G * 8;
    for (int it = gw; it < M * NH; it += NGW) {
        const int row = it / NH, h = it % NH, c2 = F.lane * 2;
        const size_t o = (size_t)row * 768 + h * 128 + c2;
        const f32x2 v = *(const f32x2*)(OF + o) + *(const f32x2*)(OB + o);
        const float ms = wave_sum(v[0] * v[0] + v[1] * v[1]) * (1.f / 128.f);
        const float rs = rsq_f(ms + EPS);
        const unsigned zr = *(const unsigned*)(P + (size_t)row * LDP + 2560 + h * 128 + c2);
        const f32x2 z = {__builtin_bit_cast(float, zr << 16), __builtin_bit_cast(float, zr & 0xffff0000u)};
        const f32x2 w = *(const f32x2*)(nw + c2);
        *(unsigned*)(Y + (size_t)row * D + 256 + h * 128 + c2) = pk2(v[0] * rs * w[0] * silu_f(z[0]), v[1] * rs * w[1] * silu_f(z[1]));
    }
    const float* pw = a.in[I_POOLW] + (size_t)e * 4 * 64 * 64; const float* ps = a.in[I_POOLS] + e * 256;
    LAS float* xs = (LAS float*)F.lds;
    LAS float* dl = xs + 80 * 64;
    LAS float* wl = dl + 64 * 65;
    for (int it = F.vcu; it < (M / 64) * 4; it += F.G) {
        const int blk = it >> 2, g = it & 3, r0 = blk * 64; int s0, Ls; seq_of_row(r0, s0, Ls);
        __syncthreads();
        for (int i = F.tid; i < 80 * 16; i += 512) {
            const int rr = i >> 4, c4 = (i & 15) * 4, row = r0 - 8 + rr;
            const bool in = (row >= s0) && (row < s0 + Ls);
            const u32x2 pr = in ? *(const u32x2*)(P + (size_t)row * LDP + g * 64 + c4) : (u32x2){0, 0};
            *(LAS f32x4*)(xs + rr * 64 + c4) = (f32x4){__builtin_bit_cast(float, pr.x << 16), __builtin_bit_cast(float, pr.x & 0xffff0000u), __builtin_bit_cast(float, pr.y << 16), __builtin_bit_cast(float, pr.y & 0xffff0000u)};
        }
        for (int i = F.tid; i < 1024; i += 512) *(LAS f32x4*)(wl + i * 4) = *(const f32x4*)(pw + g * 4096 + i * 4);
        __syncthreads();
        {
            const int t = F.tid >> 3, c8 = (F.tid & 7) * 8, row = r0 + t, tl = row - s0, half = 1 << g;
            const int lo = max(tl - half, 0), hi = min(tl + half, Ls);
            float sum[8];
#pragma unroll
            for (int q = 0; q < 8; ++q) sum[q] = 0.f;
            for (int p = lo; p < hi; ++p) {
                const LAS float* xr = xs + (p - tl + t + 8) * 64 + c8;
                const f32x4 a0 = *(const LAS f32x4*)xr, a1 = *(const LAS f32x4*)(xr + 4);
#pragma unroll
                for (int q = 0; q < 4; ++q) { sum[q] += a0[q]; sum[4 + q] += a1[q]; }
            }
            const float inv = 1.0f / (float)(hi - lo);
            const LAS float* xc = xs + (t + 8) * 64 + c8;
#pragma unroll
            for (int q = 0; q < 8; ++q) dl[t * 65 + c8 + q] = sum[q] * inv - xc[q];
        }
        __syncthreads();
        {
            const int t = F.tid >> 3, e8 = (F.tid & 7) * 8;
            float y[8];
#pragma unroll
            for (int q = 0; q < 8; ++q) y[q] = 0.f;
            for (int c = 0; c < 64; ++c) {
                const float d = dl[t * 65 + c];
                const f32x4 w0 = *(const LAS f32x4*)(wl + c * 64 + e8), w1 = *(const LAS f32x4*)(wl + c * 64 + e8 + 4);
#pragma unroll
                for (int q = 0; q < 4; ++q) { y[q] += d * w0[q]; y[4 + q] += d * w1[q]; }
            }
            const f32x4 s0v = *(const f32x4*)(ps + g * 64 + e8), s1v = *(const f32x4*)(ps + g * 64 + e8 + 4);
            u32x4 o; o.x = pk2(y[0] * s0v[0], y[1] * s0v[1]); o.y = pk2(y[2] * s0v[2], y[3] * s0v[3]); o.z = pk2(y[4] * s1v[0], y[5] * s1v[1]); o.w = pk2(y[6] * s1v[2], y[7] * s1v[3]);
            *(u32x4*)(Y + (size_t)(r0 + t) * D + g * 64 + e8) = o;
        }
    }
    __syncthreads();
}

struct EpiOdd {
    bf16* G; float* ZR; float* ZI; float* ST; Pre pre;
    template <int NFRAG> __device__ __forceinline__ void operator()(f32x4 (&acc)[3][NFRAG], int row, int colq, int fq) const {
        const int ct = colq >> 8;
        if (ct < 6) {
#pragma unroll
            for (int mf = 0; mf < 3; ++mf) {
                const int rr = row + mf * 16; float s1 = 0.f, s2 = 0.f;
                const float rs = pre_rstd(pre, rr); const float* bp = pre.bias + cond_of_row(rr) * NBMAX + colq;
#pragma unroll
                for (int nf = 0; nf < NFRAG; ++nf) {
                    const f32x4 v = acc[mf][nf] * rs + *(const f32x4*)(bp + nf * 16);
                    const float g0 = gelu_tanh(v[0]), g1 = gelu_tanh(v[1]), g2 = gelu_tanh(v[2]), g3 = gelu_tanh(v[3]);
                    u32x2 w; w.x = pk2(g0, g1); w.y = pk2(g2, g3);
                    *(u32x2*)(G + (size_t)rr * 1536 + colq + nf * 16) = w;
                    s1 += (g0 + g1) + (g2 + g3); s2 += (g0 * g0 + g1 * g1) + (g2 * g2 + g3 * g3);
                }
                if (ct >= 3) {
                    s1 += __shfl_xor(s1, 16); s1 += __shfl_xor(s1, 32); s2 += __shfl_xor(s2, 16); s2 += __shfl_xor(s2, 32);
                    if (fq == 0) { atomicAdd(ST + (size_t)rr * 2, s1); atomicAdd(ST + (size_t)rr * 2 + 1, s2); }
                }
            }
        } else {
            float* Z = (ct == 6) ? ZR : ZI; const int cb = colq - ct * 256;
#pragma unroll
            for (int mf = 0; mf < 3; ++mf) {
                const int rr = row + mf * 16; const float rs = pre_rstd(pre, rr); const float* bp = pre.bias + cond_of_row(rr) * NBMAX + colq;
#pragma unroll
                for (int nf = 0; nf < NFRAG; ++nf) *(f32x4*)(Z + (size_t)rr * 256 + cb + nf * 16) = acc[mf][nf] * rs + *(const f32x4*)(bp + nf * 16);
            }
        }
    }
};

template <int R>
__device__ __forceinline__ void fourier_a_item(const float* ZR, const float* ZI, float* BR, float* BI, int row0, int n2, const LAS float* twR, const LAS float* twN, int tid) {
    const int col = tid & 255, hf = tid >> 8;
    float zr[R], zi[R];
#pragma unroll
    for (int n1 = 0; n1 < R; ++n1) { const size_t o = (size_t)(row0 + R * n1 + n2) * 256 + col; zr[n1] = ZR[o]; zi[n1] = ZI[o]; }
#pragma unroll 1
    for (int kk = 0; kk < R / 2; ++kk) {
        const int k1 = hf * (R / 2) + kk;
        float ar = 0.f, ai = 0.f;
#pragma unroll
        for (int n1 = 0; n1 < R; ++n1) { const int idx = (k1 * n1) & (R - 1); const float c = twR[idx], s = twR[R + idx]; ar += c * zr[n1] + s * zi[n1]; ai += c * zi[n1] - s * zr[n1]; }
        const int t = k1 * n2; const float c = twN[t], s = twN[R * R + t];
        const size_t o = (size_t)(row0 + k1 * R + n2) * 256 + col;
        BR[o] = c * ar + s * ai; BI[o] = c * ai - s * ar;
    }
}
template <int R>
__device__ __forceinline__ void fourier_c_item(const float* BR, const float* BI, bf16* Y, int row0, int k1, const LAS float* twR, int tid) {
    const int col = tid & 255, hf = tid >> 8;
    float br[R], bi[R];
#pragma unroll
    for (int n2 = 0; n2 < R; ++n2) { const size_t o = (size_t)(row0 + k1 * R + n2) * 256 + col; br[n2] = BR[o]; bi[n2] = BI[o]; }
    const float sc = 1.0f / (float)R;
#pragma unroll 1
    for (int kk = 0; kk < R / 2; ++kk) {
        const int k2 = hf * (R / 2) + kk;
        float x = 0.f;
#pragma unroll
        for (int n2 = 0; n2 < R; ++n2) { const int idx = (k2 * n2) & (R - 1); x += twR[idx] * br[n2] + twR[R + idx] * bi[n2]; }
        Y[(size_t)(row0 + k1 + R * k2) * D + 768 + col] = (bf16)f2bf(x * sc);
    }
}
__device__ __forceinline__ void fourier_tables(LAS float* tw, int tid) {
    for (int i = tid; i < 1024; i += 512) { const float x = (float)i * (1.f / 512.f); tw[64 + i] = cospif(x); tw[64 + 1024 + i] = sinpif(x); }
    if (tid < 256) { const float x = (float)tid * (1.f / 128.f); tw[2144 + tid] = cospif(x); tw[2144 + 256 + tid] = sinpif(x); }
    if (tid < 32) { const float x = (float)tid * (1.f / 16.f); tw[tid] = cospif(x); tw[32 + tid] = sinpif(x); }
    if (tid < 16) { const float x = (float)tid * (1.f / 8.f); tw[2112 + tid] = cospif(x); tw[2112 + 16 + tid] = sinpif(x); }
}

__device__ __forceinline__ void phase_odd_mix(Frame& F, int j) {
    const CAS Args& a = *F.a;
    const bf16* G = (const bf16*)(a.ws + WS_P); bf16* Y = (bf16*)(a.ws + WS_Y);
    const float* ZR = (const float*)(a.ws + WS_ZR); const float* ZI = (const float*)(a.ws + WS_ZI);
    float* BR = (float*)(a.ws + WS_QN); float* BI = (float*)(a.ws + WS_KN);
    const float* ST = (const float*)(a.ws + WS_CTL + CTL_ST_OFF) + (size_t)j * M * 2;
    LAS unsigned char* L = F.lds;
    LAS float* tw = (LAS float*)(L + 65536);
    fourier_tables(tw, F.tid);
    __syncthreads();
    const int wave = F.wave;
    constexpr int NA_LAT = LAT_B * 32, NSGU = (M / 128) * NH, NA_CTX = CTX_B * 16;
    for (int it = F.vcu; it < NA_LAT + NSGU + NA_CTX; it += F.G) {
        int tid_ = F.tid; asm volatile("" : "+v"(tid_));
        if (it < NA_LAT) { fourier_a_item<32>(ZR, ZI, BR, BI, NCTX + (it >> 5) * LAT_L, it & 31, tw, tw + 64, tid_); continue; }
        if (it >= NA_LAT + NSGU) { const int q = it - NA_LAT - NSGU; fourier_a_item<16>(ZR, ZI, BR, BI, (q >> 4) * CTX_L, q & 15, tw + 2112, tw + 2144, tid_); continue; }
        const int q = it - NA_LAT, ch = q / NH, h = q % NH, r0 = ch * 128;
        const int lane = tid_ & 63, fr = lane & 15, fq = lane >> 4;
        __syncthreads();
        {
            const int s = tid_ >> 2, cq = tid_ & 3, row = r0 + s;
            const float s1 = ST[(size_t)row * 2], s2 = ST[(size_t)row * 2 + 1];
            const float mu = s1 * (1.f / 768.f), var = s2 * (1.f / 768.f) - mu * mu, rstd = rsq_f(fmaxf(var, 0.f) + EPS);
            const bf16* gp = G + (size_t)row * 1536 + 768 + h * 128 + cq * 32;
            const float* nw = a.in[I_SGUN] + j * 768 + h * 128 + cq * 32;
#pragma unroll
            for (int v8 = 0; v8 < 4; ++v8) {
                const u32x4 raw = *(const u32x4*)(gp + v8 * 8);
                const unsigned wds[4] = {raw.x, raw.y, raw.z, raw.w};
#pragma unroll
                for (int e2 = 0; e2 < 4; ++e2) {
                    const float g0 = __builtin_bit_cast(float, wds[e2] << 16), g1 = __builtin_bit_cast(float, wds[e2] & 0xffff0000u);
                    const int c0 = cq * 32 + v8 * 8 + e2 * 2;
                    const float v0 = (g0 - mu) * rstd * nw[v8 * 8 + e2 * 2], v1 = (g1 - mu) * rstd * nw[v8 * 8 + e2 * 2 + 1];
                    *(LAS bf16*)(L + c0 * 256 + (((s >> 3) ^ (c0 & 15)) << 4) + (s & 7) * 2) = (bf16)f2bf(v0);
                    *(LAS bf16*)(L + (c0 + 1) * 256 + (((s >> 3) ^ ((c0 + 1) & 15)) << 4) + (s & 7) * 2) = (bf16)f2bf(v1);
                }
            }
        }
        __syncthreads();
        {
            const bf16* Wb = (const bf16*)(a.ws + WS_SGUW) + ((size_t)j * NH + h) * 16384;
            f32x4 acc[8];
#pragma unroll
            for (int pf = 0; pf < 8; ++pf) acc[pf] = (f32x4){0.f, 0.f, 0.f, 0.f};
#pragma unroll
            for (int ks = 0; ks < 4; ++ks) {
                const bf16x8 av = *(const LAS bf16x8*)(L + (wave * 16 + fr) * 256 + (((ks * 4 + fq) ^ fr) << 4));
#pragma unroll
                for (int pf = 0; pf < 8; ++pf) {
                    const bf16x8 bw = *(const bf16x8*)(Wb + (pf * 16 + fr) * 128 + ks * 32 + fq * 8);
                    acc[pf] = MFMA16(av, bw, acc[pf]);
                }
            }
            const float* bs = a.in[I_SGUB] + ((size_t)j * NH + h) * 128;
#pragma unroll
            for (int pf = 0; pf < 8; ++pf) {
                const int p = pf * 16 + fr, row = r0 + p, c = wave * 16 + 4 * fq; const float b = bs[p];
                const u32x2 gu = *(const u32x2*)(G + (size_t)row * 1536 + h * 128 + c);
                const float u0 = __builtin_bit_cast(float, gu.x << 16), u1 = __builtin_bit_cast(float, gu.x & 0xffff0000u), u2 = __builtin_bit_cast(float, gu.y << 16), u3 = __builtin_bit_cast(float, gu.y & 0xffff0000u);
                u32x2 o; o.x = pk2(u0 * (acc[pf][0] + b), u1 * (acc[pf][1] + b)); o.y = pk2(u2 * (acc[pf][2] + b), u3 * (acc[pf][3] + b));
                *(u32x2*)(Y + (size_t)row * D + h * 128 + c) = o;
            }
        }
    }
    __syncthreads();
}
__device__ __forceinline__ void phase_odd_fc(Frame& F) {
    const CAS Args& a = *F.a;
    const float* BR = (const float*)(a.ws + WS_QN); const float* BI = (const float*)(a.ws + WS_KN); bf16* Y = (bf16*)(a.ws + WS_Y);
    LAS float* tw = (LAS float*)(F.lds + 65536);
    fourier_tables(tw, F.tid);
    __syncthreads();
    constexpr int NC_LAT = LAT_B * 32, NC_CTX = CTX_B * 16;
    for (int it = F.vcu; it < NC_LAT + NC_CTX; it += F.G) {
        int tid_ = F.tid; asm volatile("" : "+v"(tid_));
        if (it < NC_LAT) fourier_c_item<32>(BR, BI, Y, NCTX + (it >> 5) * LAT_L, it & 31, tw, tid_);
        else { const int q = it - NC_LAT; fourier_c_item<16>(BR, BI, Y, (q >> 4) * CTX_L, q & 15, tw + 2112, tid_); }
    }
    __syncthreads();
}

constexpr int STEPS = 9, N_PHASES = 2 + DEPTH * STEPS + 1;
__device__ __forceinline__ bool phase_active(int ph) {
    if (ph < 2 || ph == N_PHASES - 1) return true;
    const int l = (ph - 2) / STEPS, st = (ph - 2) % STEPS;
    return !((l & 1) && st == 5);
}
__device__ __forceinline__ void run_phase(Frame& F, int ph) {
    const CAS Args& a = *F.a; unsigned char* ws = a.ws;
    if (ph == 0) { phase_setup(F); return; }
    if (ph == 1) { phase_init(F); return; }
    if (ph == N_PHASES - 1) { phase_final(F); return; }
    const int l = (ph - 2) / STEPS, st = (ph - 2) % STEPS, e = l >> 1;
    bf16* XS = (bf16*)(ws + WS_HN); bf16* HH = (bf16*)(ws + WS_HH); float* X = (float*)(ws + WS_X); float* P = (float*)(ws + WS_P);
    const bf16* Y = (const bf16*)(ws + WS_Y); const float* mod = (const float*)(ws + WS_MOD);
    float* ssb = (float*)(ws + WS_CTL + CTL_SS_OFF); const float* biasb = (const float*)(ws + WS_BIAS);
#define PRE_OF(s_) Pre{ssb + (size_t)(s_) * M, biasb + (size_t)(s_) * 3 * NBMAX}
    switch (st) {
        case 0: { EpiUp E{HH, PRE_OF(3 * l)}; gemm_phase<11, EpiUp>(F, XS, (const bf16*)(ws + WS_WUP + (size_t)(l * 2) * WUP_SZ), D, NUP, E); } break;
        case 1: { EpiRes E{X, mod, l, 2, 0.5f, XS, ssb + (size_t)(3 * l + 1) * M, a.in[I_MIXN] + l * D, l, 1}; gemm_phase<4, EpiRes>(F, HH, (const bf16*)(ws + WS_WDN + (size_t)(l * 2) * WDN_SZ), FF, D, E); } break;
        case 2: { if ((l & 1) == 0) { EpiStore E{(bf16*)(ws + WS_P), (float*)(ws + WS_AG), PRE_OF(3 * l + 1)}; gemm_phase<7, EpiStore>(F, XS, (const bf16*)(ws + WS_EVIN + (size_t)e * EVIN_SZ), D, P_EVEN_PAD, E); }
                  else { EpiOdd EO{(bf16*)(ws + WS_P), (float*)(ws + WS_ZR), (float*)(ws + WS_ZI), (float*)(ws + WS_CTL + CTL_ST_OFF) + (size_t)e * M * 2, PRE_OF(3 * l + 1)};
                         gemm_phase<8, EpiOdd>(F, XS, (const bf16*)(ws + WS_ODIN + (size_t)e * ODIN_SZ), D, 2048, EO); } } break;
        case 3: if ((l & 1) == 0) phase_dn_prep(F, e); else phase_odd_mix(F, e); break;
        case 4: if ((l & 1) == 0) phase_dn_scan(F, e); else phase_odd_fc(F); break;
        case 5: if ((l & 1) == 0) phase_dn_fin(F, e); break;
        case 6: { EpiRes E{X, mod, l, 5, 1.0f, XS, ssb + (size_t)(3 * l + 2) * M, a.in[I_F2N] + l * D, l, 2}; gemm_phase<4, EpiRes>(F, Y, (const bf16*)(ws + ((l & 1) ? WS_ODOUT : WS_EVOUT) + (size_t)e * SQ_SZ), D, D, E); } break;
        case 7: { EpiUp E{HH, PRE_OF(3 * l + 2)}; gemm_phase<11, EpiUp>(F, XS, (const bf16*)(ws + WS_WUP + (size_t)(l * 2 + 1) * WUP_SZ), D, NUP, E); } break;
        case 8: { const bool last = (l == DEPTH - 1);
                  EpiRes E{X, mod, l, 8, 0.5f, XS, last ? nullptr : ssb + (size_t)(3 * l + 3) * M, a.in[I_F1N] + (last ? l : l + 1) * D, last ? l : l + 1, 0};
                  gemm_phase<4, EpiRes>(F, HH, (const bf16*)(ws + WS_WDN + (size_t)(l * 2 + 1) * WDN_SZ), FF, D, E); } break;
    }
#undef PRE_OF
}

__global__ void __launch_bounds__(512, 2) mk_fwd(Args args) {
    extern __shared__ __attribute__((aligned(16))) unsigned char lds_raw[];
    Frame F;
    F.lds = (LAS unsigned char*)lds_raw;
    F.tid = threadIdx.x; F.lane = F.tid & 63; F.wave = __builtin_amdgcn_readfirstlane(F.tid >> 6);
    F.G = gridDim.x; { const int bx = blockIdx.x; F.vcu = (F.G % 8 == 0) ? (bx % 8) * (F.G / 8) + bx / 8 : bx; }
    const CAS Args* ap = (const CAS Args*)__builtin_amdgcn_kernarg_segment_ptr();
    F.a = ap;
    const int ph_lo = ap->ph_lo, ph_hi = ap->ph_hi;
    unsigned char* ws0 = ap->ws;
    volatile LAS unsigned* MISC = (volatile LAS unsigned*)(F.lds + LDS_MISC);
    if (F.tid < 64) MISC[F.tid] = 0u;
    __syncthreads();
    const bool multi = (ph_hi - ph_lo) > 1;
    XcdBarrier bar; bar.bar = (unsigned*)(ws0 + WS_CTL) + CW_BAR; bar.x = 0; bar.st = MISC + 8;
    if (multi) bar = xcd_barrier_post((unsigned*)(ws0 + WS_CTL) + CW_BAR, MISC + 8);
    for (int ph = ph_lo; ph < ph_hi; ++ph) {
        { const CAS Args* a2 = ap; asm volatile("" : "+s"(a2)); F.a = a2; }
        { int t_ = threadIdx.x; asm volatile("" : "+v"(t_)); F.tid = t_; F.lane = t_ & 63; F.wave = __builtin_amdgcn_readfirstlane(t_ >> 6); }
        if (!phase_active(ph)) continue;
        run_phase(F, ph);
        if (ph + 1 < ph_hi) xcd_barrier(bar);
    }
}

extern "C" void kernel_launch(void* const* d_in, const int* in_sizes, int n_in, void* d_out, int out_size, void* d_ws, size_t ws_size, hipStream_t stream) {
    static int grid = 0;
    if (grid == 0) {
        if (n_in != 31 || ws_size < WS_END) { fprintf(stderr, "kernel_launch: unexpected n_in %d or ws_size %zu (need %zu)\n", n_in, ws_size, (size_t)WS_END); grid = -1; return; }
        int dev = 0, cus = 0;
        if (hipGetDevice(&dev) != hipSuccess || hipDeviceGetAttribute(&cus, hipDeviceAttributeMultiprocessorCount, dev) != hipSuccess) { grid = -1; return; }
        if (hipFuncSetAttribute((const void*)mk_fwd, hipFuncAttributeMaxDynamicSharedMemorySize, LDS_BYTES) != hipSuccess) { fprintf(stderr, "kernel_launch: hipFuncSetAttribute failed\n"); grid = -1; return; }
        (void)hipGetLastError();
        grid = cus;
    }
    if (grid < 0) return;
    (void)hipMemsetAsync((char*)d_ws + WS_CTL, 0, CTL_BYTES, stream);
    (void)hipMemsetAsync((char*)d_ws + WS_BIAS, 0, (size_t)12 * 3 * NBMAX * 4, stream);
    Args a{};
    for (int i = 0; i < 31; ++i) a.in[i] = (const float*)d_in[i];
    a.out = (float*)d_out; a.ws = (unsigned char*)d_ws;
#if ONE_LAUNCH
    a.ph_lo = 0; a.ph_hi = N_PHASES;
    hipLaunchKernelGGL(mk_fwd, dim3(grid), dim3(512), LDS_BYTES, stream, a);
#else
    for (int ph = 0; ph < N_PHASES; ++ph) {
        a.ph_lo = ph; a.ph_hi = ph + 1;
        hipLaunchKernelGGL(mk_fwd, dim3(grid), dim3(512), LDS_BYTES, stream, a);
    }
#endif
}
```

```cpp
#include <hip/hip_runtime.h>
#include <cstdio>
#include <cstdint>

#ifndef ONE_LAUNCH
#define ONE_LAUNCH 1
#endif

#define GAS __attribute__((address_space(1)))
#define LAS __attribute__((address_space(3)))
#define CAS __attribute__((address_space(4)))
typedef unsigned short bf16;
typedef float f32x4 __attribute__((ext_vector_type(4)));
typedef float f32x2 __attribute__((ext_vector_type(2)));
typedef short bf16x8 __attribute__((ext_vector_type(8)));
typedef unsigned u32x4 __attribute__((ext_vector_type(4)));
typedef unsigned u32x2 __attribute__((ext_vector_type(2)));

constexpr int D = 1024, NCTX = 4096, NLAT = 2048, M = 6144, FF = 2816, DEPTH = 4;
constexpr int CTX_B = 16, CTX_L = 256, LAT_B = 2, LAT_L = 1024;
constexpr int NUP = 2 * FF;
constexpr int P_EVEN = 3352, P_EVEN_PAD = 3584, P_ODD = 1792;
constexpr int LDP = 3584;
constexpr int NH = 6, DK = 128;
constexpr float EPS = 1e-6f;
constexpr int NSEQ = CTX_B + LAT_B;

constexpr size_t MiB = 1u << 20;
constexpr size_t WS_CTL = 0, CTL_BYTES = 1 * MiB;
constexpr size_t WS_MOD = 1 * MiB;
constexpr size_t WS_WUP = 2 * MiB, WUP_SZ = 11 * MiB;
constexpr size_t WS_WDN = 90 * MiB, WDN_SZ = 5632 * 1024;
constexpr size_t WS_EVIN = 134 * MiB, EVIN_SZ = 7 * MiB;
constexpr size_t WS_EVOUT = 148 * MiB, SQ_SZ = 2 * MiB;
constexpr size_t WS_ODIN = 152 * MiB, ODIN_SZ = 4 * MiB;
constexpr size_t WS_ODOUT = 160 * MiB;
constexpr size_t WS_X = 164 * MiB;
constexpr size_t WS_HN = 188 * MiB;
constexpr size_t WS_HH = 200 * MiB;
constexpr size_t WS_P = 233 * MiB;
constexpr size_t WS_Y = 317 * MiB;
constexpr size_t WS_QN = 329 * MiB, WS_KN = 347 * MiB, WS_VV = 365 * MiB, WS_OF = 383 * MiB, WS_OB = 401 * MiB;
constexpr size_t WS_AG = 419 * MiB, WS_BT = 420 * MiB;
constexpr size_t WS_ZR = 421 * MiB, WS_ZI = 427 * MiB, WS_SPEC = 433 * MiB;
constexpr size_t WS_DW = 439 * MiB, WS_DQ = 457 * MiB, WS_DAI = 475 * MiB, WS_DKT = 484 * MiB, WS_DUT = 502 * MiB, WS_DGL = 520 * MiB;
constexpr size_t WS_BIAS = 521 * MiB;
constexpr size_t WS_END = 522 * MiB;

constexpr size_t CTL_ST_OFF = 262144;
constexpr size_t CTL_SS_OFF = 524288;
constexpr int NBMAX = 5632;
constexpr size_t WS_SGUW = 1 * MiB + 512 * 1024;
constexpr int CW_BAR = 4096;

constexpr int LDS_MAIN = 160768;
constexpr int LDS_MISC = LDS_MAIN;
constexpr int LDS_BYTES = LDS_MAIN + 1024;

__device__ __forceinline__ float wave_sum(float v) {
#pragma unroll
    for (int o = 1; o < 64; o <<= 1) v += __shfl_xor(v, o);
    return v;
}
typedef __bf16 bf16x2_t __attribute__((ext_vector_type(2)));
__device__ __forceinline__ unsigned pk2(float lo, float hi) { const f32x2 v = {lo, hi}; const bf16x2_t b = __builtin_convertvector(v, bf16x2_t); return __builtin_bit_cast(unsigned, b); }
__device__ __forceinline__ unsigned f2bf(float f) { return pk2(f, 0.f) & 0xffffu; }
__device__ __forceinline__ float rcp_f(float x) { return __builtin_amdgcn_rcpf(x); }
__device__ __forceinline__ float rsq_f(float x) { return __builtin_amdgcn_rsqf(x); }
__device__ __forceinline__ float silu_f(float x) { return x * rcp_f(1.f + __expf(-x)); }
__device__ __forceinline__ float sigmoid_f(float x) { return rcp_f(1.f + __expf(-x)); }
__device__ __forceinline__ float gelu_tanh(float x) { const float u2 = 1.5957691216057308f * (x + 0.044715f * x * x * x); return x * rcp_f(1.f + __expf(-u2)); }
__device__ __forceinline__ float softplus_f(float x) { return x > 20.f ? x : log1pf(expf(x)); }
__device__ __forceinline__ int cond_of_row(int r) { return r < NCTX ? 0 : (r < NCTX + LAT_L ? 1 : 2); }
__device__ __forceinline__ void seq_of_row(int r, int& s0, int& L) { if (r < NCTX) { s0 = r & ~(CTX_L - 1); L = CTX_L; } else { s0 = NCTX + ((r - NCTX) & ~(LAT_L - 1)); L = LAT_L; } }

#define XB_TMO      128
#define XB_XCNT(j)  (256  + 64 * (j))
#define XB_XSUB(j)  (1280 + 64 * (j))
#define XB_XGEN(j)  (2304 + 64 * (j))
#define XB_TOP      3328
#define XB_TOPGEN   3392
#define XCD_BAR_WORDS 3456
#define XB_SPIN_CAP (1u << 18)
__device__ __forceinline__ unsigned xb_ld(unsigned* p)              { return __hip_atomic_load(p, __ATOMIC_RELAXED, __HIP_MEMORY_SCOPE_AGENT); }
__device__ __forceinline__ unsigned xb_add(unsigned* p, unsigned v) { return __hip_atomic_fetch_add(p, v, __ATOMIC_RELAXED, __HIP_MEMORY_SCOPE_AGENT); }
__device__ __forceinline__ unsigned xb_xcc_id() { return (unsigned)__builtin_amdgcn_s_getreg((3 << 11) | 20) & 0xFu; }
#define XB_SPIN(cond, bar) do { unsigned _sp = 0; while (cond) { __builtin_amdgcn_s_sleep(1); \
    if ((++_sp & 255u) == 0u) { if (xb_ld(&(bar)[XB_TMO])) break; if (_sp > XB_SPIN_CAP) { atomicAdd(&(bar)[XB_TMO], 1u); break; } } } } while (0)
struct XcdBarrier { unsigned* bar; unsigned x; volatile LAS unsigned* st; };
__device__ __forceinline__ XcdBarrier xcd_barrier_post(unsigned* bar, volatile LAS unsigned* st) {
    XcdBarrier b; b.bar = bar; b.x = xb_xcc_id(); b.st = st;
    if (threadIdx.x == 0) (void)xb_add(&bar[XB_XCNT(b.x)], 1u);
    return b;
}
__device__ __forceinline__ void xcd_barrier_complete(unsigned* bar, unsigned x, unsigned& nloc, unsigned& nx) {
    const unsigned G = gridDim.x * gridDim.y * gridDim.z;
    unsigned sum, cnt, mine, sp = 0u;
    for (;;) {
        sum = 0u; cnt = 0u; mine = 0u;
#pragma unroll
        for (unsigned j = 0; j < 16; ++j) { const unsigned c = xb_ld(&bar[XB_XCNT(j)]); sum += c; cnt += (c > 0u) ? 1u : 0u; mine = (j == x) ? c : mine; }
        if (sum == G) break;
        __builtin_amdgcn_s_sleep(1);
        if ((++sp & 255u) == 0u) { if (xb_ld(&bar[XB_TMO])) break; if (sp > XB_SPIN_CAP) { atomicAdd(&bar[XB_TMO], 1u); break; } }
    }
    nloc = mine > 0u ? mine : 1u; nx = cnt > 0u ? cnt : 1u;
}
__device__ __forceinline__ void xcd_barrier(const XcdBarrier& b) {
    asm volatile("s_waitcnt vmcnt(0)" ::: "memory");
    __syncthreads();
    if (threadIdx.x == 0) {
        unsigned* bar = b.bar;
        __builtin_amdgcn_s_waitcnt(0);
        unsigned nloc = b.st[0], nx = b.st[1];
        if (nloc == 0u) { xcd_barrier_complete(bar, b.x, nloc, nx); b.st[0] = nloc; b.st[1] = nx; }
        const unsigned old = xb_add(&bar[XB_XSUB(b.x)], 1u);
        const unsigned gen = old / nloc;
        if (old + 1u == (gen + 1u) * nloc) {
            __builtin_amdgcn_fence(__ATOMIC_RELEASE, "agent");
            asm volatile("s_waitcnt vmcnt(0)" ::: "memory");
            const unsigned og = xb_add(&bar[XB_TOP], 1u);
            const unsigned tg = og / nx;
            if (og + 1u == (tg + 1u) * nx) xb_add(&bar[XB_TOPGEN], 1u);
            else XB_SPIN(xb_ld(&bar[XB_TOPGEN]) == tg, bar);
            __builtin_amdgcn_fence(__ATOMIC_ACQUIRE, "agent");
            xb_add(&bar[XB_XGEN(b.x)], 1u);
            asm volatile("s_waitcnt vmcnt(0)" ::: "memory");
        } else {
            XB_SPIN(xb_ld(&bar[XB_XGEN(b.x)]) == gen, bar);
            __builtin_amdgcn_fence(__ATOMIC_ACQUIRE, "agent");
            asm volatile("s_waitcnt vmcnt(0)" ::: "memory");
        }
    }
    __syncthreads();
}

struct Args { const float* in[31]; float* out; unsigned char* ws; int ph_lo, ph_hi; };
enum { I_XP = 0, I_XS, I_STATE, I_C, I_CCTX, I_F1N, I_F1G, I_F1U, I_F1D, I_MIXN, I_F2N, I_F2G, I_F2U, I_F2D, I_ADAW, I_ADAB, I_EVIN, I_EVOUT,
       I_POOLW, I_POOLS, I_CONVW, I_ALOG, I_DTB, I_DNNW, I_ODIN, I_ODOUT, I_SGUN, I_SGUW, I_SGUB, I_FNETW, I_FINN };

struct Frame {
    LAS unsigned char* lds;
    int tid, lane, wave, vcu, G;
    const CAS Args* a;
};

#define DS_READ128(dst, addr) asm volatile("ds_read_b128 %0, %1" : "=v"(dst) : "v"((unsigned)(addr)))
__device__ __forceinline__ void lgkm_wait(int n) {
    switch (n) { case 0: asm volatile("s_waitcnt lgkmcnt(0)" ::: "memory"); break; case 1: asm volatile("s_waitcnt lgkmcnt(1)" ::: "memory"); break;
                 case 2: asm volatile("s_waitcnt lgkmcnt(2)" ::: "memory"); break; default: asm volatile("s_waitcnt lgkmcnt(3)" ::: "memory"); break; }
}
__device__ __forceinline__ void vm_wait(int n) {
    switch (n) { case 0: asm volatile("s_waitcnt vmcnt(0)" ::: "memory"); break; case 4: asm volatile("s_waitcnt vmcnt(4)" ::: "memory"); break;
                 case 5: asm volatile("s_waitcnt vmcnt(5)" ::: "memory"); break; case 6: asm volatile("s_waitcnt vmcnt(6)" ::: "memory"); break;
                 case 7: asm volatile("s_waitcnt vmcnt(7)" ::: "memory"); break; case 8: asm volatile("s_waitcnt vmcnt(8)" ::: "memory"); break;
                 case 9: asm volatile("s_waitcnt vmcnt(9)" ::: "memory"); break; default: asm volatile("s_waitcnt vmcnt(0)" ::: "memory"); break; }
}
template <int NFRAG, class Epi>
__device__ __forceinline__ void gemm_tile(LAS unsigned char* lds, const int tid, const bf16* A, const bf16* Bt, int K, int row0, int col0, const Epi& E) {
    constexpr int BN = 32 * NFRAG, NPB = BN / 8, A_BYTES = 192 * 128, B_BYTES = BN * 128, STAGE = A_BYTES + B_BYTES, NBI = (NPB + 7) / 8;
    constexpr int NS = (3 * STAGE <= LDS_MAIN) ? 3 : 2;
    static_assert(NS * STAGE <= LDS_MAIN, "LDS");
    const int lane = tid & 63, wid = __builtin_amdgcn_readfirstlane(tid >> 6), wm = wid >> 1, wn = wid & 1, fr = lane & 15, fq = lane >> 4;
    const int r = lane >> 3, slot = lane & 7;
    const int srow = wid * 8 + r;
    const int chunk = slot ^ ((srow >> 1) & 7);
    const char* gA = (const char*)(A + (size_t)(row0 + srow) * K) + chunk * 16;
    const char* gB = (const char*)(Bt + (size_t)(col0 + srow) * K) + chunk * 16;
    const size_t pstep = (size_t)64 * K * 2;
    const int nt = K / 64;
    const int nbw = (NPB - wid + 7) / 8;
    const unsigned ldsb = (unsigned)(uintptr_t)lds;
    const int rowA0 = wm * 48 + fr, rowB0 = wn * NFRAG * 16 + fr;
    int offA[2], offB[2];
#pragma unroll
    for (int kk = 0; kk < 2; ++kk) {
        offA[kk] = rowA0 * 128 + (((kk * 4 + fq) ^ ((rowA0 >> 1) & 7)) << 4);
        offB[kk] = A_BYTES + rowB0 * 128 + (((kk * 4 + fq) ^ ((rowB0 >> 1) & 7)) << 4);
    }
    f32x4 acc[3][NFRAG];
#pragma unroll
    for (int i = 0; i < 3; ++i)
#pragma unroll
        for (int j = 0; j < NFRAG; ++j) acc[i][j] = (f32x4){0.f, 0.f, 0.f, 0.f};

#define GEMM_STAGE(buf, t) do { LAS unsigned char* sA_ = lds + (buf) * STAGE + wid * 1024; \
        _Pragma("unroll") for (int i_ = 0; i_ < 3; ++i_) \
            __builtin_amdgcn_global_load_lds((const unsigned*)(gA + i_ * pstep + (size_t)(t) * 128), (LAS unsigned*)(sA_ + i_ * 8192), 16, 0, 0); \
        _Pragma("unroll") for (int i_ = 0; i_ < NBI; ++i_) if (wid + 8 * i_ < NPB) \
            __builtin_amdgcn_global_load_lds((const unsigned*)(gB + i_ * pstep + (size_t)(t) * 128), (LAS unsigned*)(sA_ + A_BYTES + i_ * 8192), 16, 0, 0); } while (0)

    GEMM_STAGE(0, 0);
    if (NS == 3) GEMM_STAGE(1, 1);
    int sbuf = 0;
    for (int t = 0; t < nt; ++t) {
        if (NS == 3) {
            if (t + 1 < nt) { if (nbw == NBI) vm_wait(3 + NBI); else vm_wait(3 + NBI - 1); } else vm_wait(0);
            __builtin_amdgcn_s_barrier();
            if (t + 2 < nt) { const int nb_ = (sbuf >= 1) ? sbuf - 1 : 2; GEMM_STAGE(nb_, t + 2); }
        } else {
            asm volatile("s_waitcnt vmcnt(0)" ::: "memory");
            __syncthreads();
            if (t + 1 < nt) GEMM_STAGE((t + 1) & 1, t + 1);
        }
        {
            const unsigned sbo = (unsigned)sbuf * STAGE;
            const unsigned aA0 = ldsb + sbo + offA[0], aA1 = ldsb + sbo + offA[1], aB0 = ldsb + sbo + offB[0], aB1 = ldsb + sbo + offB[1];
            bf16x8 af[2][3], bq[4];
#pragma unroll
            for (int mf = 0; mf < 3; ++mf) { DS_READ128(af[0][mf], aA0 + mf * 2048); }
#pragma unroll
            for (int mf = 0; mf < 3; ++mf) { DS_READ128(af[1][mf], aA1 + mf * 2048); }
            constexpr int TOT = 2 * NFRAG;
#pragma unroll
            for (int f = 0; f < 3; ++f) { DS_READ128(bq[f], aB0 + f * 2048); }
#pragma unroll
            for (int f = 0; f < TOT; ++f) {
                if (f + 3 < TOT) { const int g = f + 3; DS_READ128(bq[g & 3], ((g >= NFRAG) ? aB1 + (g - NFRAG) * 2048 : aB0 + g * 2048)); }
                const int outstanding = (f + 3 < TOT) ? 3 : (TOT - 1 - f);
                lgkm_wait(outstanding);
                asm volatile("" : "+v"(bq[f & 3]));
                __builtin_amdgcn_sched_barrier(0);
                const int kk = (f >= NFRAG) ? 1 : 0, nf = f - kk * NFRAG;
#pragma unroll
                for (int mf = 0; mf < 3; ++mf) acc[mf][nf] = __builtin_amdgcn_mfma_f32_16x16x32_bf16(bq[f & 3], af[kk][mf], acc[mf][nf], 0, 0, 0);
            }
        }
        sbuf = (sbuf + 1 == NS) ? 0 : sbuf + 1;
    }
#undef GEMM_STAGE
    __syncthreads();
    E.stage((LAS float*)lds, tid, row0, col0, BN);
    __syncthreads();
    E.template operator()<NFRAG>(acc, row0 + wm * 48 + fr, col0 + wn * NFRAG * 16 + fq * 4, fq, (const LAS float*)lds, wm * 48 + fr, wn * NFRAG * 16 + fq * 4);
    asm volatile("s_waitcnt vmcnt(0)" ::: "memory");
    __syncthreads();
}

struct Pre { const float* ss; const float* bias; };
__device__ __forceinline__ void pre_stage(const Pre& p, LAS float* sc, int tid, int row0, int col0, int BN) {
    if (tid < 192) sc[tid] = rsq_f(p.ss[row0 + tid] * (1.f / D) + EPS);
    for (int i = tid; i < 3 * BN; i += 512) { const int c = i / BN, j = i - c * BN; sc[256 + i] = p.bias[c * NBMAX + col0 + j]; }
}
struct EpiUp {
    bf16* H; Pre pre;
    __device__ __forceinline__ void stage(LAS float* sc, int tid, int row0, int col0, int BN) const { pre_stage(pre, sc, tid, row0, col0, BN); }
    template <int NFRAG> __device__ __forceinline__ void operator()(f32x4 (&acc)[3][NFRAG], int row, int colq, int, const LAS float* sc, int lrow, int lcol) const {
#pragma unroll
        for (int mf = 0; mf < 3; ++mf) {
            const int rr = row + mf * 16; const float rs = sc[lrow + mf * 16];
            const LAS float* bp = sc + 256 + cond_of_row(rr) * (32 * NFRAG) + lcol;
#pragma unroll
            for (int nf = 0; nf < NFRAG; ++nf) {
                const f32x4 v = acc[mf][nf] * rs + *(const LAS f32x4*)(bp + nf * 16);
                *(unsigned*)(H + (size_t)rr * FF + ((colq + nf * 16) >> 1)) = pk2(silu_f(v[0]) * v[2], silu_f(v[1]) * v[3]);
            }
        }
    }
};
struct EpiRes {
    float* X; const float* mod; int layer, gidx; float scale;
    bf16* XS; float* ssn; const float* nwn; int ln, wn;
    __device__ __forceinline__ void stage(LAS float* sc, int tid, int, int col0, int BN) const {
        for (int i = tid; i < 3 * BN; i += 512) {
            const int c = i / BN, j = i - c * BN;
            sc[256 + i] = mod[((size_t)(layer * 3 + c) * 9 + gidx) * 1024 + col0 + j] * scale;
            sc[256 + 3 * BN + i] = nwn[col0 + j] * (mod[((size_t)(ln * 3 + c) * 9 + wn * 3 + 1) * 1024 + col0 + j] + 1.0f);
        }
    }
    template <int NFRAG> __device__ __forceinline__ void operator()(f32x4 (&acc)[3][NFRAG], int row, int colq, int fq, const LAS float* sc, int, int lcol) const {
        constexpr int BN = 32 * NFRAG;
        f32x4 xv[3][NFRAG];
#pragma unroll
        for (int mf = 0; mf < 3; ++mf)
#pragma unroll
            for (int nf = 0; nf < NFRAG; ++nf) xv[mf][nf] = *(const f32x4*)(X + (size_t)(row + mf * 16) * D + colq + nf * 16);
#pragma unroll
        for (int mf = 0; mf < 3; ++mf) {
            const int rr = row + mf * 16, cnd = cond_of_row(rr);
            const LAS float* gp = sc + 256 + cnd * BN + lcol; const LAS float* cp = sc + 256 + 3 * BN + cnd * BN + lcol;
            float ssq = 0.f;
#pragma unroll
            for (int nf = 0; nf < NFRAG; ++nf) {
                const int c = colq + nf * 16;
                const f32x4 x = xv[mf][nf] + acc[mf][nf] * *(const LAS f32x4*)(gp + nf * 16);
                *(f32x4*)(X + (size_t)rr * D + c) = x;
                if (ssn) {
                    const f32x4 hs = x * *(const LAS f32x4*)(cp + nf * 16);
                    u32x2 w; w.x = pk2(hs[0], hs[1]); w.y = pk2(hs[2], hs[3]);
                    *(u32x2*)(XS + (size_t)rr * D + c) = w;
                    ssq += (x[0] * x[0] + x[1] * x[1]) + (x[2] * x[2] + x[3] * x[3]);
                }
            }
            if (ssn) { ssq += __shfl_xor(ssq, 16); ssq += __shfl_xor(ssq, 32); if (fq == 0) atomicAdd(ssn + rr, ssq); }
        }
    }
};
struct EpiStore {
    bf16* P; float* GT; Pre pre;
    __device__ __forceinline__ void stage(LAS float* sc, int tid, int row0, int col0, int BN) const { pre_stage(pre, sc, tid, row0, col0, BN); }
    template <int NFRAG> __device__ __forceinline__ void operator()(f32x4 (&acc)[3][NFRAG], int row, int colq, int, const LAS float* sc, int lrow, int lcol) const {
#pragma unroll
        for (int mf = 0; mf < 3; ++mf) {
            const int rr = row + mf * 16; const float rs = sc[lrow + mf * 16];
            const LAS float* bp = sc + 256 + cond_of_row(rr) * (32 * NFRAG) + lcol;
#pragma unroll
            for (int nf = 0; nf < NFRAG; ++nf) {
                const f32x4 v = acc[mf][nf] * rs + *(const LAS f32x4*)(bp + nf * 16);
                const int c = colq + nf * 16;
                u32x2 w; w.x = pk2(v[0], v[1]); w.y = pk2(v[2], v[3]);
                *(u32x2*)(P + (size_t)rr * LDP + c) = w;
                if (c >= 3328 && c < 3352) *(f32x4*)(GT + (size_t)rr * 24 + (c - 3328)) = v;
            }
        }
    }
};

template <int NFRAG, class Epi>
__device__ __forceinline__ void gemm_phase(Frame& F, const bf16* A, const bf16* Bt, int K, int N, const Epi& E) {
    constexpr int BN = 32 * NFRAG;
    const int NT = N / BN, nitems = 32 * NT;
    for (int i = F.vcu; i < nitems; i += F.G) {
        const int panel = (i >> 3) & 31, ct = (i & 7) + 8 * (i >> 8);
        gemm_tile<NFRAG, Epi>(F.lds, F.tid, A, Bt, K, panel * 192, ct * BN, E);
    }
}

__device__ __forceinline__ void transpose_item(const float* W, int K, int N, int ldw, bf16* WT, int mode, LAS float* scr, int item, int lane, const float* shp, float* biasp) {
    const int nblk = (N + 63) / 64, kb = item / nblk, nb = item % nblk, k0 = 64 * kb, n0 = 64 * nb;
    const int lc = (lane & 15) * 4, lr = lane >> 4;
    f32x4 v[16];
#pragma unroll
    for (int i = 0; i < 16; ++i) v[i] = (n0 + lc < N) ? *(const f32x4*)(W + (size_t)(k0 + 4 * i + lr) * ldw + n0 + lc) : (f32x4){0.f, 0.f, 0.f, 0.f};
    float sh0 = 0.f, sh1 = 0.f, sh2 = 0.f;
    if (biasp) { sh0 = shp[k0 + lane]; sh1 = shp[9216 + k0 + lane]; sh2 = shp[2 * 9216 + k0 + lane]; }
#pragma unroll
    for (int i = 0; i < 16; ++i) { LAS float* p = scr + (4 * i + lr) * 65 + lc; p[0] = v[i][0]; p[1] = v[i][1]; p[2] = v[i][2]; p[3] = v[i][3]; }
    asm volatile("s_waitcnt lgkmcnt(0)" ::: "memory");
    const int c = lane & 7;
#pragma unroll
    for (int j = 0; j < 8; ++j) {
        const int nl = (lane >> 3) + 8 * j, n = n0 + nl; const LAS float* s = scr + (8 * c) * 65 + nl;
        u32x4 o; o.x = pk2(s[0 * 65], s[1 * 65]); o.y = pk2(s[2 * 65], s[3 * 65]); o.z = pk2(s[4 * 65], s[5 * 65]); o.w = pk2(s[6 * 65], s[7 * 65]);
        const int dr = (mode == 0) ? n : ((n >> 1) * 4 + (n & 1) + (mode == 2 ? 2 : 0));
        if (n < N) *(u32x4*)(WT + (size_t)dr * K + k0 + 8 * c) = o;
    }
    if (biasp) {
        float b0 = 0.f, b1 = 0.f, b2 = 0.f;
#pragma unroll
        for (int kk = 0; kk < 64; ++kk) {
            const float w = scr[kk * 65 + lane];
            b0 += w * __builtin_bit_cast(float, __builtin_amdgcn_readlane(__builtin_bit_cast(int, sh0), kk));
            b1 += w * __builtin_bit_cast(float, __builtin_amdgcn_readlane(__builtin_bit_cast(int, sh1), kk));
            b2 += w * __builtin_bit_cast(float, __builtin_amdgcn_readlane(__builtin_bit_cast(int, sh2), kk));
        }
        const int n = n0 + lane, dr = (mode == 0) ? n : ((n >> 1) * 4 + (n & 1) + (mode == 2 ? 2 : 0));
        if (n < N) { atomicAdd(biasp + dr, b0); atomicAdd(biasp + NBMAX + dr, b1); atomicAdd(biasp + 2 * NBMAX + dr, b2); }
    }
    asm volatile("s_waitcnt lgkmcnt(0)" ::: "memory");
}

__device__ __forceinline__ void phase_setup(Frame& F) {
    const CAS Args& a = *F.a;
    unsigned char* ws = a.ws;
    {
        LAS float* sc = (LAS float*)F.lds;
        LAS float* red = sc + 3 * 1024;
        for (int i = F.tid; i < 3 * 1024; i += 512) { const int c = i >> 10, k = i & 1023; const float v = (c == 0) ? a.in[I_CCTX][k] : a.in[I_C][(c - 1) * 1024 + k]; sc[i] = silu_f(v); }
        __syncthreads();
        float* mod = (float*)(ws + WS_MOD);
        for (int it = F.vcu; it < 4 * 72; it += F.G) {
            const int l = it / 72, cb = it % 72, q = F.tid & 31, kg = F.tid >> 5;
            const float* W = a.in[I_ADAW] + (size_t)l * 1024 * 9216 + cb * 128 + q * 4;
            f32x4 s0 = {0, 0, 0, 0}, s1 = s0, s2 = s0;
#pragma unroll 4
            for (int k = kg * 64; k < kg * 64 + 64; ++k) {
                const f32x4 w = *(const f32x4*)(W + (size_t)k * 9216);
                s0 += w * sc[k]; s1 += w * sc[1024 + k]; s2 += w * sc[2048 + k];
            }
            LAS float* rp = red + (kg * 32 + q) * 12;
#pragma unroll
            for (int j = 0; j < 4; ++j) { rp[j] = s0[j]; rp[4 + j] = s1[j]; rp[8 + j] = s2[j]; }
            __syncthreads();
            if (F.tid < 384) {
                const int qq = F.tid / 12, v = F.tid % 12; float s = 0.f;
#pragma unroll
                for (int g = 0; g < 16; ++g) s += red[(g * 32 + qq) * 12 + v];
                const int c = v >> 2, j = v & 3, n = cb * 128 + qq * 4 + j;
                mod[(size_t)(l * 3 + c) * 9216 + n] = s + a.in[I_ADAB][l * 9216 + n];
            }
            __syncthreads();
        }
        __syncthreads();
    }
    {
        const int gw = F.vcu * 8 + F.wave, NGW = F.G * 8;
        for (int it = gw; it < 2 * NH * 16384 / 512; it += NGW) {
            const float* sp = a.in[I_SGUW] + (size_t)it * 512 + F.lane * 8;
            const f32x4 x0 = *(const f32x4*)sp, x1 = *(const f32x4*)(sp + 4);
            u32x4 o; o.x = pk2(x0[0], x0[1]); o.y = pk2(x0[2], x0[3]); o.z = pk2(x1[0], x1[1]); o.w = pk2(x1[2], x1[3]);
            *(u32x4*)((bf16*)(ws + WS_SGUW) + (size_t)it * 512 + F.lane * 8) = o;
        }
        __syncthreads();
    }
    {
        const int gw = F.vcu * 8 + F.wave, NGW = F.G * 8;
        for (int it = gw; it < 2 * (P_EVEN_PAD - P_EVEN); it += NGW) {
            const int e = it / (P_EVEN_PAD - P_EVEN), rr = P_EVEN + it % (P_EVEN_PAD - P_EVEN);
            u32x4* p = (u32x4*)((bf16*)(ws + WS_EVIN + (size_t)e * EVIN_SZ) + (size_t)rr * D);
            p[F.lane] = (u32x4){0, 0, 0, 0}; p[64 + F.lane] = (u32x4){0, 0, 0, 0};
        }
        float* X = (float*)(ws + WS_X);
        for (int row = gw; row < M; row += NGW) {
            float* xo = X + (size_t)row * D;
            if (row < NCTX) {
                const f32x4* src = (const f32x4*)(a.in[I_XP] + (size_t)row * D);
#pragma unroll
                for (int j = 0; j < 4; ++j) ((f32x4*)xo)[j * 64 + F.lane] = src[j * 64 + F.lane];
            } else {
                const int t = (row - NCTX) & (LAT_L - 1); const float pr = (float)(t >> 6), pc = (float)(t & 63);
                const float* src = a.in[I_XS] + (size_t)(row - NCTX) * D;
#pragma unroll
                for (int j = 0; j < 16; ++j) {
                    const int ch = j * 64 + F.lane, seg = ch >> 8, i = ch & 255;
                    const float freq = expf(-9.210340371976184f * (float)i * (1.0f / 256.0f));
                    const float ang = ((seg < 2) ? pr : pc) * freq;
                    const float pe = (seg & 1) ? cosf(ang) : sinf(ang);
                    xo[ch] = src[ch] + pe;
                }
            }
        }
    }
}

__device__ __forceinline__ const bf16* sub_weight(unsigned char* ws, int s, int& N) {
    const int l = s / 3, which = s % 3, e = l >> 1;
    if (which != 1) { N = NUP; return (const bf16*)(ws + WS_WUP + (size_t)(l * 2 + (which == 2 ? 1 : 0)) * WUP_SZ); }
    if ((l & 1) == 0) { N = P_EVEN_PAD; return (const bf16*)(ws + WS_EVIN + (size_t)e * EVIN_SZ); }
    N = 2048; return (const bf16*)(ws + WS_ODIN + (size_t)e * ODIN_SZ);
}
__device__ __forceinline__ void phase_init(Frame& F) {
    const CAS Args& a = *F.a; unsigned char* ws = a.ws;
    const float* mod = (const float*)(ws + WS_MOD);
    const int gw = F.vcu * 8 + F.wave, NGW = F.G * 8;
    {
        LAS float* T = (LAS float*)F.lds;
        LAS float* wt = T + 64 * 128;
        LAS float* tw = wt + 64 * 65;
        if (F.tid < 64) { tw[F.tid] = cospif((float)F.tid * (1.f / 32.f)); tw[64 + F.tid] = sinpif((float)F.tid * (1.f / 32.f)); }
        __syncthreads();
        for (int it = F.vcu; it < 2 * 4 * 16; it += F.G) {
            const int j = it >> 6, g = (it >> 4) & 3, k0 = (it & 15) * 64;
            const float* Wg = a.in[I_FNETW] + ((size_t)j * 4 + g) * 4096;
            {
                const int c = F.tid >> 3, eb = (F.tid & 7) * 8;
                float ac[8], as[8];
#pragma unroll
                for (int q = 0; q < 8; ++q) { ac[q] = 0.f; as[q] = 0.f; }
                for (int m = 0; m < 64; ++m) {
                    const int idx = (m * c) & 63; const float cs = tw[idx], sn = tw[64 + idx];
                    const f32x4 w0 = *(const f32x4*)(Wg + m * 64 + eb), w1 = *(const f32x4*)(Wg + m * 64 + eb + 4);
#pragma unroll
                    for (int q = 0; q < 4; ++q) { ac[q] += cs * w0[q]; ac[4 + q] += cs * w1[q]; as[q] -= sn * w0[q]; as[4 + q] -= sn * w1[q]; }
                }
#pragma unroll
                for (int q = 0; q < 8; ++q) { T[c * 128 + eb + q] = ac[q] * 0.125f; T[c * 128 + 64 + eb + q] = as[q] * 0.125f; }
                const int kk = F.tid >> 3, c8 = (F.tid & 7) * 8;
                const float* wp = a.in[I_ODIN] + (size_t)j * D * P_ODD + (size_t)(k0 + kk) * P_ODD + 1536 + g * 64 + c8;
                const f32x4 x0 = *(const f32x4*)wp, x1 = *(const f32x4*)(wp + 4);
#pragma unroll
                for (int q = 0; q < 4; ++q) { wt[kk * 65 + c8 + q] = x0[q]; wt[kk * 65 + c8 + 4 + q] = x1[q]; }
            }
            __syncthreads();
            {
                const int col = F.tid & 127, kq = F.tid >> 7;
                float acc[16];
#pragma unroll
                for (int q = 0; q < 16; ++q) acc[q] = 0.f;
                for (int c = 0; c < 64; ++c) {
                    const float t = T[c * 128 + col];
#pragma unroll
                    for (int q = 0; q < 16; ++q) acc[q] += wt[(kq * 16 + q) * 65 + c] * t;
                }
                const int drow = 1536 + ((col < 64) ? (g * 64 + col) : (256 + g * 64 + col - 64));
                bf16* dst = (bf16*)(ws + WS_ODIN + (size_t)j * ODIN_SZ) + (size_t)drow * D + k0 + kq * 16;
                u32x4 o0, o1;
                o0.x = pk2(acc[0], acc[1]); o0.y = pk2(acc[2], acc[3]); o0.z = pk2(acc[4], acc[5]); o0.w = pk2(acc[6], acc[7]);
                o1.x = pk2(acc[8], acc[9]); o1.y = pk2(acc[10], acc[11]); o1.z = pk2(acc[12], acc[13]); o1.w = pk2(acc[14], acc[15]);
                *(u32x4*)dst = o0; *(u32x4*)(dst + 8) = o1;
                const float* shp = (const float*)(ws + WS_MOD) + ((size_t)((2 * j + 1) * 3) * 9 + 3) * 1024 + k0 + kq * 16 + (F.lane & 15);
                const float s0v = shp[0], s1v = shp[9216], s2v = shp[2 * 9216];
                float b0 = 0.f, b1 = 0.f, b2 = 0.f;
#pragma unroll
                for (int q = 0; q < 16; ++q) {
                    b0 += acc[q] * __builtin_bit_cast(float, __builtin_amdgcn_readlane(__builtin_bit_cast(int, s0v), q));
                    b1 += acc[q] * __builtin_bit_cast(float, __builtin_amdgcn_readlane(__builtin_bit_cast(int, s1v), q));
                    b2 += acc[q] * __builtin_bit_cast(float, __builtin_amdgcn_readlane(__builtin_bit_cast(int, s2v), q));
                }
                float* bp = (float*)(ws + WS_BIAS) + (size_t)(3 * (2 * j + 1) + 1) * 3 * NBMAX + drow;
                atomicAdd(bp, b0); atomicAdd(bp + NBMAX, b1); atomicAdd(bp + 2 * NBMAX, b2);
            }
            __syncthreads();
        }
    }
    {
        LAS float* scr = (LAS float*)(F.lds + F.wave * 16640);
        const int gw = F.vcu * 8 + F.wave, NGW = F.G * 8;
        constexpr int IT_G = 16 * 44, IT_D = 44 * 16, IT_EVIN = 16 * 53, IT_SQ = 16 * 16, IT_ODIN = 16 * 24;
        static_assert(IT_G == IT_D, "decode");
        constexpr int PER_FFN = 2 * IT_G + IT_D;
        constexpr int TOT = 8 * PER_FFN + 2 * (IT_EVIN + IT_SQ + IT_ODIN + IT_SQ);
        for (int it = gw; it < TOT; it += NGW) {
            int r = it; const float* W; bf16* WT; int K, N, mode, ldw = 0, sub_s = -1;
            if (r < 8 * PER_FFN) {
                const int f = r / PER_FFN, l = f >> 1, s = f & 1; r -= f * PER_FFN;
                const int sub = r / IT_G; r -= sub * IT_G;
                const int idx = (sub == 0) ? (s ? I_F2G : I_F1G) : ((sub == 1) ? (s ? I_F2U : I_F1U) : (s ? I_F2D : I_F1D));
                W = a.in[idx] + (size_t)l * D * FF;
                WT = (sub == 2) ? (bf16*)(ws + WS_WDN + (size_t)f * WDN_SZ) : (bf16*)(ws + WS_WUP + (size_t)f * WUP_SZ);
                K = (sub == 2) ? FF : D; N = (sub == 2) ? D : FF; mode = (sub == 2) ? 0 : sub + 1;
                if (sub != 2) sub_s = 3 * l + (s ? 2 : 0);
            } else {
                r -= 8 * PER_FFN;
                constexpr int PER_E = IT_EVIN + IT_SQ + IT_ODIN + IT_SQ;
                const int e = r / PER_E; r -= e * PER_E;
                K = D; mode = 0;
                if (r < IT_EVIN) { W = a.in[I_EVIN] + (size_t)e * D * P_EVEN; N = P_EVEN; WT = (bf16*)(ws + WS_EVIN + (size_t)e * EVIN_SZ); sub_s = 3 * (2 * e) + 1; }
                else if (r < IT_EVIN + IT_SQ) { r -= IT_EVIN; W = a.in[I_EVOUT] + (size_t)e * D * D; N = D; WT = (bf16*)(ws + WS_EVOUT + (size_t)e * SQ_SZ); }
                else if (r < IT_EVIN + IT_SQ + IT_ODIN) { r -= IT_EVIN + IT_SQ; W = a.in[I_ODIN] + (size_t)e * D * P_ODD; N = 1536; ldw = P_ODD; WT = (bf16*)(ws + WS_ODIN + (size_t)e * ODIN_SZ); sub_s = 3 * (2 * e + 1) + 1; }
                else { r -= IT_EVIN + IT_SQ + IT_ODIN; W = a.in[I_ODOUT] + (size_t)e * D * D; N = D; WT = (bf16*)(ws + WS_ODOUT + (size_t)e * SQ_SZ); }
            }
            const float* shp = nullptr; float* biasp = nullptr;
            if (sub_s >= 0) { shp = (const float*)(ws + WS_MOD) + ((size_t)((sub_s / 3) * 3) * 9 + (sub_s % 3) * 3) * 1024; biasp = (float*)(ws + WS_BIAS) + (size_t)sub_s * 3 * NBMAX; }
            transpose_item(W, K, N, ldw ? ldw : N, WT, mode, scr, r, F.lane, shp, biasp);
        }
    }
    {
        const float* X = (const float*)(ws + WS_X); bf16* XS = (bf16*)(ws + WS_HN);
        float* ss = (float*)(ws + WS_CTL + CTL_SS_OFF);
        const float* nw = a.in[I_F1N];
        for (int row = gw; row < M; row += NGW) {
            const f32x4* xr = (const f32x4*)(X + (size_t)row * D) + F.lane;
            f32x4 v[4]; float s = 0.f;
#pragma unroll
            for (int j = 0; j < 4; ++j) { v[j] = xr[64 * j]; s += v[j][0] * v[j][0] + v[j][1] * v[j][1] + v[j][2] * v[j][2] + v[j][3] * v[j][3]; }
            s = wave_sum(s);
            if (F.lane == 0) ss[row] = s;
            const float* mb = mod + ((size_t)(0 * 3 + cond_of_row(row)) * 9 + 1) * 1024;
            u32x2* o = (u32x2*)(XS + (size_t)row * D) + F.lane;
#pragma unroll
            for (int j = 0; j < 4; ++j) {
                const int k = (64 * j + F.lane) * 4;
                const f32x4 h = v[j] * *(const f32x4*)(nw + k) * (*(const f32x4*)(mb + k) + 1.0f);
                u32x2 pkd; pkd.x = pk2(h[0], h[1]); pkd.y = pk2(h[2], h[3]);
                o[64 * j] = pkd;
            }
        }
    }
}

__device__ __forceinline__ void phase_final(Frame& F) {
    const CAS Args& a = *F.a;
    const float* X = (const float*)(a.ws + WS_X);
    const float* nw = a.in[I_FINN];
    const int gw = F.vcu * 8 + F.wave, NGW = F.G * 8;
    for (int row = gw; row < M; row += NGW) {
        const f32x4* xr = (const f32x4*)(X + (size_t)row * D) + F.lane;
        f32x4 v[4]; float s = 0.f;
#pragma unroll
        for (int j = 0; j < 4; ++j) { v[j] = xr[64 * j]; s += v[j][0] * v[j][0] + v[j][1] * v[j][1] + v[j][2] * v[j][2] + v[j][3] * v[j][3]; }
        const float rstd = 1.0f / sqrtf(wave_sum(s) * (1.f / D) + EPS);
        f32x4* o = (f32x4*)(a.out + (size_t)row * D) + F.lane;
#pragma unroll
        for (int j = 0; j < 4; ++j) { const f32x4 w = *(const f32x4*)(nw + (64 * j + F.lane) * 4); o[64 * j] = v[j] * rstd * w; }
    }
}

__device__ __forceinline__ float wave_matvec64(float d, const float* W, int lane) {
    float y = 0.f;
#pragma unroll
    for (int c = 0; c < 64; ++c) { const float dc = __builtin_bit_cast(float, __builtin_amdgcn_readlane(__builtin_bit_cast(int, d), c)); y += dc * W[c * 64 + lane]; }
    return y;
}

__device__ __forceinline__ int perm32(int x) { return (x & ~31) | ((x & 12) << 1) | ((x & 16) >> 2) | (x & 3); }
__device__ __forceinline__ int sw256(int row, int c16) { return row * 256 + ((c16 ^ (row & 15)) << 4); }
__device__ __forceinline__ int sw128(int row, int c8) { return row * 128 + ((c8 ^ ((row >> 1) & 7)) << 4); }
__device__ __forceinline__ int e128(int row, int col) { return sw128(row, col >> 3) + (col & 7) * 2; }
__device__ __forceinline__ void dn_item_decode(int cc, int& row0, int& L, int& c) {
    if (cc < 64) { row0 = (cc >> 2) * CTX_L; L = CTX_L; c = cc & 3; } else { const int q = cc - 64; row0 = NCTX + (q >> 4) * LAT_L; L = LAT_L; c = q & 15; }
}
#define MFMA16(a, b, c) __builtin_amdgcn_mfma_f32_16x16x32_bf16((a), (b), (c), 0, 0, 0)

__device__ __forceinline__ void phase_dn_prep(Frame& F, int e) {
    const CAS Args& a = *F.a;
    const bf16* P = (const bf16*)(a.ws + WS_P); const float* GT = (const float*)(a.ws + WS_AG);
    const float* cw = a.in[I_CONVW] + (size_t)e * 3 * 2304;
    LAS unsigned char* L = F.lds;
    constexpr int CWL = 114688;
    constexpr int KB = 0, QB = 16384, VBT = 32768, KGT = 49152, KDT = 65536, AIo = 81920, MM = 90112, TT = 98304, TN = 106496, MD = 114688, XT = 118784, SM = 139264, VB16 = 140288;
    LAS float* sm = (LAS float*)(L + SM);
    const int wave = F.wave;
    for (int rec = F.vcu; rec < 1152; rec += F.G) {
        int tid_ = F.tid; asm volatile("" : "+v"(tid_));
        const int lane = tid_ & 63, fr = lane & 15, fq = lane >> 4;
        const int dir = rec & 1, h = (rec >> 1) % NH, cc = rec / (2 * NH);
        int row0, Ls, c; dn_item_decode(cc, row0, Ls, c);
        __syncthreads();
        for (int i_ = tid_; i_ < 1152; i_ += 512) { const int part = i_ / 384, r_ = i_ % 384, tap = r_ >> 7, ch = r_ & 127; ((LAS float*)(L + CWL))[i_] = cw[tap * 2304 + part * 768 + h * 128 + ch]; }
        if (wave == 0) {
            const int row = row0 + (dir ? (Ls - 1 - (c * 64 + lane)) : (c * 64 + lane));
            const float araw = GT[(size_t)row * 24 + 12 + dir * 6 + h], braw = GT[(size_t)row * 24 + dir * 6 + h];
            const float al = a.in[I_ALOG][(e * 2 + dir) * 6 + h], dtb = a.in[I_DTB][(e * 2 + dir) * 6 + h];
            float x = -expf(al) * softplus_f(araw + dtb); const float b = sigmoid_f(braw);
#pragma unroll
            for (int o = 1; o < 64; o <<= 1) { const float t = __shfl_up(x, o); if (lane >= o) x += t; }
            const float gl = __shfl(x, 63);
            sm[lane] = x; sm[64 + lane] = b; sm[128 + lane] = expf(x); sm[192 + lane] = expf(gl - x);
            if (lane == 63) ((float*)(a.ws + WS_DGL))[rec] = expf(x);
        }
        __syncthreads();
        {
            const int i = tid_ >> 3, cg = tid_ & 7;
            const int row = row0 + (dir ? (Ls - 1 - (c * 64 + i)) : (c * 64 + i));
            const int tl = row - row0; const bool hp = tl > 0, hn = tl < Ls - 1;
            float kf[16], qf[16], vf[16];
#pragma unroll
            for (int part = 0; part < 3; ++part) {
                const int pc = 256 + part * 768 + h * 128 + cg * 16;
                const bf16* p1 = P + (size_t)row * LDP + pc;
                const LAS float* wl = (const LAS float*)(L + CWL) + part * 384 + cg * 16;
                float out[16];
#pragma unroll
                for (int q8 = 0; q8 < 2; ++q8) {
                    const u32x4 r1 = *(const u32x4*)(p1 + q8 * 8);
                    const u32x4 r0 = hp ? *(const u32x4*)(p1 - LDP + q8 * 8) : (u32x4){0, 0, 0, 0};
                    const u32x4 r2 = hn ? *(const u32x4*)(p1 + LDP + q8 * 8) : (u32x4){0, 0, 0, 0};
                    const unsigned a0[4] = {r0.x, r0.y, r0.z, r0.w}, a1[4] = {r1.x, r1.y, r1.z, r1.w}, a2[4] = {r2.x, r2.y, r2.z, r2.w};
#pragma unroll
                    for (int d = 0; d < 4; ++d) {
#pragma unroll
                        for (int hh = 0; hh < 2; ++hh) {
                            const int j = q8 * 8 + d * 2 + hh;
                            const float x0 = __builtin_bit_cast(float, hh ? (a0[d] & 0xffff0000u) : (a0[d] << 16));
                            const float x1 = __builtin_bit_cast(float, hh ? (a1[d] & 0xffff0000u) : (a1[d] << 16));
                            const float x2 = __builtin_bit_cast(float, hh ? (a2[d] & 0xffff0000u) : (a2[d] << 16));
                            out[j] = silu_f(x0 * wl[j] + x1 * wl[128 + j] + x2 * wl[256 + j]);
                        }
                    }
                }
                if (part < 2) {
                    float ssq = 0.f;
#pragma unroll
                    for (int j = 0; j < 16; ++j) ssq += out[j] * out[j];
                    ssq += __shfl_xor(ssq, 1); ssq += __shfl_xor(ssq, 2); ssq += __shfl_xor(ssq, 4);
                    const float rs = rsq_f(ssq + EPS) * (part == 0 ? 0.08838834764831845f : 1.0f);
#pragma unroll
                    for (int j = 0; j < 16; ++j) { if (part == 0) qf[j] = out[j] * rs; else kf[j] = out[j] * rs; }
                } else {
#pragma unroll
                    for (int j = 0; j < 16; ++j) vf[j] = out[j];
                }
            }
            const float eg = sm[128 + i];
#pragma unroll
            for (int hf = 0; hf < 2; ++hf) {
                u32x4 kk, qq, vv;
                kk.x = pk2(kf[hf * 8 + 0], kf[hf * 8 + 1]); kk.y = pk2(kf[hf * 8 + 2], kf[hf * 8 + 3]); kk.z = pk2(kf[hf * 8 + 4], kf[hf * 8 + 5]); kk.w = pk2(kf[hf * 8 + 6], kf[hf * 8 + 7]);
                qq.x = pk2(qf[hf * 8 + 0], qf[hf * 8 + 1]); qq.y = pk2(qf[hf * 8 + 2], qf[hf * 8 + 3]); qq.z = pk2(qf[hf * 8 + 4], qf[hf * 8 + 5]); qq.w = pk2(qf[hf * 8 + 6], qf[hf * 8 + 7]);
                vv.x = pk2(vf[hf * 8 + 0], vf[hf * 8 + 1]); vv.y = pk2(vf[hf * 8 + 2], vf[hf * 8 + 3]); vv.z = pk2(vf[hf * 8 + 4], vf[hf * 8 + 5]); vv.w = pk2(vf[hf * 8 + 6], vf[hf * 8 + 7]);
                *(LAS u32x4*)(L + KB + sw256(i, cg * 2 + hf)) = kk;
                *(LAS u32x4*)(L + QB + sw256(i, cg * 2 + hf)) = qq;
                *(LAS u32x4*)(L + VB16 + sw256(i, cg * 2 + hf)) = vv;
            }
            bf16* QD = (bf16*)(a.ws + WS_DQ) + (size_t)rec * 8192 + i * 128;
#pragma unroll
            for (int qq = 0; qq < 4; ++qq) {
                const int pos = perm32(cg * 16 + 4 * qq);
                u32x2 w; w.x = pk2(qf[4 * qq] * eg, qf[4 * qq + 1] * eg); w.y = pk2(qf[4 * qq + 2] * eg, qf[4 * qq + 3] * eg);
                *(u32x2*)(QD + pos) = w;
            }
        }
        __syncthreads();
        {
            const int kdl = lane & 15, ipl = lane >> 4;
#pragma unroll 2
            for (int it8 = 0; it8 < 8; ++it8) {
                const int combo = wave * 8 + it8, kd = (combo & 7) * 16 + kdl, i0 = 2 * ((combo >> 3) * 4 + ipl);
                const int a0 = sw256(i0, kd >> 3) + (kd & 7) * 2, a1 = sw256(i0 + 1, kd >> 3) + (kd & 7) * 2;
                const float k0 = __builtin_bit_cast(float, (unsigned)(*(const LAS bf16*)(L + KB + a0)) << 16), k1 = __builtin_bit_cast(float, (unsigned)(*(const LAS bf16*)(L + KB + a1)) << 16);
                const float v0 = __builtin_bit_cast(float, (unsigned)(*(const LAS bf16*)(L + VB16 + a0)) << 16), v1 = __builtin_bit_cast(float, (unsigned)(*(const LAS bf16*)(L + VB16 + a1)) << 16);
                const float be0 = sm[64 + i0], be1 = sm[65 + i0], eg0 = sm[128 + i0], eg1 = sm[129 + i0], ek0 = sm[192 + i0], ek1 = sm[193 + i0];
                *(LAS unsigned*)(L + VBT + e128(kd, i0)) = pk2(v0 * be0, v1 * be1);
                *(LAS unsigned*)(L + KGT + e128(kd, i0)) = pk2(k0 * be0 * eg0, k1 * be1 * eg1);
                *(LAS unsigned*)(L + KDT + e128(kd, perm32(i0))) = pk2(k0 * ek0, k1 * ek1);
            }
        }
        __syncthreads();
        const int mi = wave >> 1;
#pragma unroll
        for (int f = 0; f < 2; ++f) {
            const int nj = (wave & 1) * 2 + f;
            f32x4 kkacc = {0.f, 0.f, 0.f, 0.f}, qkacc = {0.f, 0.f, 0.f, 0.f};
            if (nj <= mi) {
#pragma unroll
                for (int ks = 0; ks < 4; ++ks) {
                    const bf16x8 ak = *(const LAS bf16x8*)(L + KB + sw256(mi * 16 + fr, ks * 4 + fq));
                    const bf16x8 aq = *(const LAS bf16x8*)(L + QB + sw256(mi * 16 + fr, ks * 4 + fq));
                    const bf16x8 bk = *(const LAS bf16x8*)(L + KB + sw256(nj * 16 + fr, ks * 4 + fq));
                    kkacc = MFMA16(ak, bk, kkacc); qkacc = MFMA16(aq, bk, qkacc);
                }
            }
            const int j = nj * 16 + fr, i0 = mi * 16 + 4 * fq; const float gcj = sm[j];
#pragma unroll
            for (int r = 0; r < 4; ++r) {
                const int i = i0 + r; const float dec = (i >= j) ? __expf(sm[i] - gcj) : 0.f;
                const float mv = (i > j) ? (sm[64 + i] * kkacc[r] * dec) : 0.f;
                if (nj <= mi) *(LAS bf16*)(L + MM + e128(i, j)) = (bf16)f2bf(mv);
                if (nj == mi) *(LAS float*)(L + MD + ((mi * 16 + 4 * fq + r) * 16 + fr) * 4) = mv;
                if (nj > mi) *(LAS bf16*)(L + TN + e128(i, j)) = (bf16)0;
                *(LAS bf16*)(L + AIo + e128(i, perm32(j))) = (bf16)f2bf(qkacc[r] * dec);
            }
        }
        __syncthreads();
        if (wave == 0) {
            const int b = lane >> 4, cc_ = lane & 15;
            const LAS float* md = (const LAS float*)(L + MD) + b * 256;
            float T[16];
#pragma unroll
            for (int i = 0; i < 16; ++i) {
                float s = (i == cc_) ? 1.f : 0.f;
#pragma unroll
                for (int jj = 0; jj < i; ++jj) s -= md[i * 16 + jj] * T[jj];
                T[i] = s;
            }
#pragma unroll
            for (int i = 0; i < 16; ++i) *(LAS bf16*)(L + TN + e128(16 * b + i, 16 * b + cc_)) = (bf16)f2bf(T[i]);
#pragma unroll
            for (int hf = 0; hf < 2; ++hf) {
                u32x4 t; t.x = pk2(T[hf * 8 + 0], T[hf * 8 + 1]); t.y = pk2(T[hf * 8 + 2], T[hf * 8 + 3]); t.z = pk2(T[hf * 8 + 4], T[hf * 8 + 5]); t.w = pk2(T[hf * 8 + 6], T[hf * 8 + 7]);
                *(LAS u32x4*)(L + TT + sw128(16 * b + cc_, 2 * b + hf)) = t;
            }
        }
        __syncthreads();
#pragma unroll
        for (int lvl = 1; lvl <= 3; ++lvl) {
            if (wave < 4 - lvl) {
                const int J = wave, I = wave + lvl;
                f32x4 x = {0.f, 0.f, 0.f, 0.f};
                const bf16x8 zero8 = {0, 0, 0, 0, 0, 0, 0, 0};
#pragma unroll
                for (int ks = 0; ks < (lvl == 3 ? 2 : 1); ++ks) {
                    const bf16x8 am = *(const LAS bf16x8*)(L + MM + sw128(16 * I + fr, 2 * J + 4 * ks + fq));
                    bf16x8 bt = *(const LAS bf16x8*)(L + TT + sw128(16 * J + fr, 2 * J + 4 * ks + fq));
                    if (4 * ks + fq >= 2 * lvl) bt = zero8;
                    x = MFMA16(am, bt, x);
                }
                LAS unsigned char* xt = L + XT + wave * 512;
                { u32x2 t; t.x = pk2(x[0], x[1]); t.y = pk2(x[2], x[3]); *(LAS u32x2*)(xt + fr * 32 + fq * 8) = t; }
                const bf16x8 ad = *(const LAS bf16x8*)(L + TN + sw128(16 * I + fr, 2 * I + (fq & 1)));
                bf16x8 bx = *(const LAS bf16x8*)(xt + fr * 32 + (fq & 1) * 16);
                if (fq >= 2) bx = zero8;
                f32x4 t4 = {0.f, 0.f, 0.f, 0.f};
                t4 = MFMA16(ad, bx, t4);
#pragma unroll
                for (int r = 0; r < 4; ++r) *(LAS bf16*)(L + TN + e128(16 * I + 4 * fq + r, 16 * J + fr)) = (bf16)f2bf(-t4[r]);
                { u32x2 t; t.x = pk2(-t4[0], -t4[1]); t.y = pk2(-t4[2], -t4[3]); *(LAS u32x2*)(L + TT + e128(16 * J + fr, 16 * I + 4 * fq)) = t; }
            }
            __syncthreads();
        }
        {
            bf16* UT = (bf16*)(a.ws + WS_DUT) + (size_t)rec * 8192;
            bf16* Wn = (bf16*)(a.ws + WS_DW) + (size_t)rec * 8192;
            const int ui = wave & 3;
#pragma unroll
            for (int f = 0; f < 4; ++f) {
                const int dvf = (wave >> 2) * 4 + f;
                f32x4 acc = {0.f, 0.f, 0.f, 0.f};
#pragma unroll
                for (int ks = 0; ks < 2; ++ks) {
                    const bf16x8 ta = *(const LAS bf16x8*)(L + TN + sw128(ui * 16 + fr, ks * 4 + fq));
                    const bf16x8 vb = *(const LAS bf16x8*)(L + VBT + sw128(dvf * 16 + fr, ks * 4 + fq));
                    acc = MFMA16(ta, vb, acc);
                }
                u32x2 t; t.x = pk2(acc[0], acc[1]); t.y = pk2(acc[2], acc[3]);
                *(u32x2*)(UT + (dvf * 16 + fr) * 64 + ui * 16 + 4 * fq) = t;
            }
#pragma unroll
            for (int f = 0; f < 4; ++f) {
                f32x4 acc = {0.f, 0.f, 0.f, 0.f};
#pragma unroll
                for (int ks = 0; ks < 2; ++ks) {
                    const bf16x8 ka = *(const LAS bf16x8*)(L + KGT + sw128(wave * 16 + fr, ks * 4 + fq));
                    const bf16x8 tb = *(const LAS bf16x8*)(L + TN + sw128(f * 16 + fr, ks * 4 + fq));
                    acc = MFMA16(ka, tb, acc);
                }
                u32x2 t; t.x = pk2(-acc[0], -acc[1]); t.y = pk2(-acc[2], -acc[3]);
                *(u32x2*)(Wn + (f * 16 + fr) * 128 + perm32(wave * 16 + 4 * fq)) = t;
            }
            {
                const int rw = tid_ >> 3, c8 = tid_ & 7;
                *(u32x4*)((unsigned char*)(a.ws + WS_DAI) + (size_t)rec * 8192 + rw * 128 + c8 * 16) = *(const LAS u32x4*)(L + AIo + sw128(rw, c8));
#pragma unroll
                for (int k2 = 0; k2 < 2; ++k2) {
                    const int rr = rw + 64 * k2;
                    *(u32x4*)((unsigned char*)(a.ws + WS_DKT) + (size_t)rec * 16384 + rr * 128 + c8 * 16) = *(const LAS u32x4*)(L + KDT + sw128(rr, c8));
                }
            }
        }
    }
    __syncthreads();
}

__device__ __forceinline__ void phase_dn_scan(Frame& F, int e) {
    const CAS Args& a = *F.a;
    LAS unsigned char* L = F.lds;
    constexpr int BUF = 57344, oW = 0, oQ = 16384, oA = 32768, oK = 40960;
    const int wave = F.wave;
    const unsigned char* gW = (const unsigned char*)(a.ws + WS_DW); const unsigned char* gQ = (const unsigned char*)(a.ws + WS_DQ);
    const unsigned char* gA = (const unsigned char*)(a.ws + WS_DAI); const unsigned char* gK = (const unsigned char*)(a.ws + WS_DKT);
    const bf16* gU = (const bf16*)(a.ws + WS_DUT); const float* gGL = (const float*)(a.ws + WS_DGL);
    for (int it = F.vcu; it < (2 * LAT_B + CTX_B) * 2 * NH; it += F.G) {
        int tid_ = F.tid; asm volatile("" : "+v"(tid_));
        const int lane = tid_ & 63, fr = lane & 15, fq = lane >> 4;
        const int r4 = lane >> 4, s16 = lane & 15, r8 = lane >> 3, s8 = lane & 7;
        int seq, dir, h, half = 0;
        if (it < 2 * LAT_B * 2 * NH) { half = it & 1; const int j = it >> 1; seq = CTX_B + j / (2 * NH); dir = (j / NH) & 1; h = j % NH; }
        else { const int j = it - 2 * LAT_B * 2 * NH; seq = j / (2 * NH); dir = (j / NH) & 1; h = j % NH; }
        const bool lat = seq >= CTX_B;
        const bool active = lat ? (wave < 4) : true;
        const int dvc = (lat ? half * 64 : 0) + (wave & (lat ? 3 : 7)) * 16 + fr;
        const int Ls = lat ? LAT_L : CTX_L, row0 = lat ? NCTX + (seq - CTX_B) * LAT_L : seq * CTX_L, nch = Ls / 64;
        const int cbase = lat ? 64 + (seq - CTX_B) * 16 : seq * 4;
        f32x4 S[8];
        if (lat) {
            const float* s0 = a.in[I_STATE] + ((((size_t)(seq - CTX_B) * 2 + e) * 2 + dir) * NH + h) * 128 * 128;
#pragma unroll
            for (int mf = 0; mf < 8; ++mf)
#pragma unroll
                for (int r = 0; r < 4; ++r) S[mf][r] = s0[(size_t)(mf * 16 + 4 * fq + r) * 128 + dvc];
        } else {
#pragma unroll
            for (int mf = 0; mf < 8; ++mf) S[mf] = (f32x4){0.f, 0.f, 0.f, 0.f};
        }
        float* O = (float*)(a.ws + (dir ? WS_OB : WS_OF));
#define DN_STAGE(bufi, rec_) do { LAS unsigned char* sb_ = L + (bufi) * BUF; const size_t ro_ = (size_t)(rec_); \
        _Pragma("unroll") for (int p_ = 0; p_ < 2; ++p_) { const int pc_ = wave + 8 * p_; const int rw_ = pc_ * 4 + r4; const int so_ = rw_ * 256 + ((s16 ^ (rw_ & 15)) << 4); \
            __builtin_amdgcn_global_load_lds((const unsigned*)(gW + ro_ * 16384 + so_), (LAS unsigned*)(sb_ + oW + pc_ * 1024), 16, 0, 0); \
            __builtin_amdgcn_global_load_lds((const unsigned*)(gQ + ro_ * 16384 + so_), (LAS unsigned*)(sb_ + oQ + pc_ * 1024), 16, 0, 0); \
            const int rk_ = pc_ * 8 + r8; const int sk_ = rk_ * 128 + ((s8 ^ ((rk_ >> 1) & 7)) << 4); \
            __builtin_amdgcn_global_load_lds((const unsigned*)(gK + ro_ * 16384 + sk_), (LAS unsigned*)(sb_ + oK + pc_ * 1024), 16, 0, 0); } \
        { const int ra_ = wave * 8 + r8; const int sa_ = ra_ * 128 + ((s8 ^ ((ra_ >> 1) & 7)) << 4); \
            __builtin_amdgcn_global_load_lds((const unsigned*)(gA + ro_ * 8192 + sa_), (LAS unsigned*)(sb_ + oA + wave * 1024), 16, 0, 0); } } while (0)
        __syncthreads();
        int rec = (cbase * NH + h) * 2 + dir;
        DN_STAGE(0, rec);
        u32x2 un[4]; float gln;
#pragma unroll
        for (int mf = 0; mf < 4; ++mf) un[mf] = *(const u32x2*)(gU + (size_t)rec * 8192 + dvc * 64 + mf * 16 + 4 * fq);
        gln = gGL[rec];
        for (int c = 0; c < nch; ++c) {
            asm volatile("s_waitcnt vmcnt(0)" ::: "memory");
            __syncthreads();
            u32x2 uc[4]; const float gl = gln;
#pragma unroll
            for (int mf = 0; mf < 4; ++mf) uc[mf] = un[mf];
            if (c + 1 < nch) {
                const int rn = rec + 2 * NH;
                DN_STAGE((c + 1) & 1, rn);
#pragma unroll
                for (int mf = 0; mf < 4; ++mf) un[mf] = *(const u32x2*)(gU + (size_t)rn * 8192 + dvc * 64 + mf * 16 + 4 * fq);
                gln = gGL[rn];
            }
            if (active) {
            LAS unsigned char* sb = L + (c & 1) * BUF;
            bf16x8 Sb[4];
#pragma unroll
            for (int ks = 0; ks < 4; ++ks) {
                u32x4 t; t.x = pk2(S[2 * ks][0], S[2 * ks][1]); t.y = pk2(S[2 * ks][2], S[2 * ks][3]); t.z = pk2(S[2 * ks + 1][0], S[2 * ks + 1][1]); t.w = pk2(S[2 * ks + 1][2], S[2 * ks + 1][3]);
                Sb[ks] = __builtin_bit_cast(bf16x8, t);
            }
            f32x4 vn[4], o[4];
#pragma unroll
            for (int mf = 0; mf < 4; ++mf) {
                vn[mf][0] = __builtin_bit_cast(float, uc[mf].x << 16); vn[mf][1] = __builtin_bit_cast(float, uc[mf].x & 0xffff0000u);
                vn[mf][2] = __builtin_bit_cast(float, uc[mf].y << 16); vn[mf][3] = __builtin_bit_cast(float, uc[mf].y & 0xffff0000u);
                o[mf] = (f32x4){0.f, 0.f, 0.f, 0.f};
#pragma unroll
                for (int ks = 0; ks < 4; ++ks) {
                    const bf16x8 wf = *(const LAS bf16x8*)(sb + oW + sw256(mf * 16 + fr, ks * 4 + fq));
                    const bf16x8 qf = *(const LAS bf16x8*)(sb + oQ + sw256(mf * 16 + fr, ks * 4 + fq));
                    vn[mf] = MFMA16(wf, Sb[ks], vn[mf]);
                    o[mf] = MFMA16(qf, Sb[ks], o[mf]);
                }
            }
            bf16x8 Vb[2];
#pragma unroll
            for (int ks = 0; ks < 2; ++ks) {
                u32x4 t; t.x = pk2(vn[2 * ks][0], vn[2 * ks][1]); t.y = pk2(vn[2 * ks][2], vn[2 * ks][3]); t.z = pk2(vn[2 * ks + 1][0], vn[2 * ks + 1][1]); t.w = pk2(vn[2 * ks + 1][2], vn[2 * ks + 1][3]);
                Vb[ks] = __builtin_bit_cast(bf16x8, t);
            }
#pragma unroll
            for (int mf = 0; mf < 4; ++mf)
#pragma unroll
                for (int ks = 0; ks < 2; ++ks) {
                    const bf16x8 af = *(const LAS bf16x8*)(sb + oA + sw128(mf * 16 + fr, ks * 4 + fq));
                    o[mf] = MFMA16(af, Vb[ks], o[mf]);
                }
#pragma unroll
            for (int mf = 0; mf < 8; ++mf) {
                S[mf] = S[mf] * gl;
#pragma unroll
                for (int ks = 0; ks < 2; ++ks) {
                    const bf16x8 kf = *(const LAS bf16x8*)(sb + oK + sw128(mf * 16 + fr, ks * 4 + fq));
                    S[mf] = MFMA16(kf, Vb[ks], S[mf]);
                }
            }
#pragma unroll
            for (int mf = 0; mf < 4; ++mf)
#pragma unroll
                for (int r = 0; r < 4; ++r) {
                    const int step = c * 64 + mf * 16 + 4 * fq + r, row = row0 + (dir ? (Ls - 1 - step) : step);
                    O[(size_t)row * 768 + h * 128 + dvc] = o[mf][r];
                }
            }
            rec += 2 * NH;
        }
#undef DN_STAGE
        if (!lat) {
            float* so = a.out + (size_t)M * D + ((((size_t)seq * 2 + e) * 2 + dir) * NH + h) * 128 * 128;
#pragma unroll
            for (int mf = 0; mf < 8; ++mf)
#pragma unroll
                for (int r = 0; r < 4; ++r) so[(size_t)(mf * 16 + 4 * fq + r) * 128 + dvc] = S[mf][r];
        }
    }
    __syncthreads();
}

__device__ __forceinline__ void phase_dn_fin(Frame& F, int e) {
    const CAS Args& a = *F.a;
    const bf16* P = (const bf16*)(a.ws + WS_P);
    const float* OF = (const float*)(a.ws + WS_OF); const float* OB = (const float*)(a.ws + WS_OB);
    bf16* Y = (bf16*)(a.ws + WS_Y);
    const float* nw = a.in[I_DNNW] + e * 128;
    const int gw = F.vcu * 8 + F.wave, NGW = F.G * 8;
    for (int it = gw; it < M * NH; it += NGW) {
        const int row = it / NH, h = it % NH, c2 = F.lane * 2;
        const size_t o = (size_t)row * 768 + h * 128 + c2;
        const f32x2 v = *(const f32x2*)(OF + o) + *(const f32x2*)(OB + o);
        const float ms = wave_sum(v[0] * v[0] + v[1] * v[1]) * (1.f / 128.f);
        const float rs = rsq_f(ms + EPS);
        const unsigned zr = *(const unsigned*)(P + (size_t)row * LDP + 2560 + h * 128 + c2);
        const f32x2 z = {__builtin_bit_cast(float, zr << 16), __builtin_bit_cast(float, zr & 0xffff0000u)};
        const f32x2 w = *(const f32x2*)(nw + c2);
        *(unsigned*)(Y + (size_t)row * D + 256 + h * 128 + c2) = pk2(v[0] * rs * w[0] * silu_f(z[0]), v[1] * rs * w[1] * silu_f(z[1]));
    }
    const float* pw = a.in[I_POOLW] + (size_t)e * 4 * 64 * 64; const float* ps = a.in[I_POOLS] + e * 256;
    LAS float* xs = (LAS float*)F.lds;
    LAS float* dl = xs + 80 * 64;
    LAS float* wl = dl + 64 * 65;
    for (int it = F.vcu; it < (M / 64) * 4; it += F.G) {
        const int blk = it >> 2, g = it & 3, r0 = blk * 64; int s0, Ls; seq_of_row(r0, s0, Ls);
        __syncthreads();
        for (int i = F.tid; i < 80 * 16; i += 512) {
            const int rr = i >> 4, c4 = (i & 15) * 4, row = r0 - 8 + rr;
            const bool in = (row >= s0) && (row < s0 + Ls);
            const u32x2 pr = in ? *(const u32x2*)(P + (size_t)row * LDP + g * 64 + c4) : (u32x2){0, 0};
            *(LAS f32x4*)(xs + rr * 64 + c4) = (f32x4){__builtin_bit_cast(float, pr.x << 16), __builtin_bit_cast(float, pr.x & 0xffff0000u), __builtin_bit_cast(float, pr.y << 16), __builtin_bit_cast(float, pr.y & 0xffff0000u)};
        }
        for (int i = F.tid; i < 1024; i += 512) *(LAS f32x4*)(wl + i * 4) = *(const f32x4*)(pw + g * 4096 + i * 4);
        __syncthreads();
        {
            const int t = F.tid >> 3, c8 = (F.tid & 7) * 8, row = r0 + t, tl = row - s0, half = 1 << g;
            const int lo = max(tl - half, 0), hi = min(tl + half, Ls);
            float sum[8];
#pragma unroll
            for (int q = 0; q < 8; ++q) sum[q] = 0.f;
            for (int p = lo; p < hi; ++p) {
                const LAS float* xr = xs + (p - tl + t + 8) * 64 + c8;
                const f32x4 a0 = *(const LAS f32x4*)xr, a1 = *(const LAS f32x4*)(xr + 4);
#pragma unroll
                for (int q = 0; q < 4; ++q) { sum[q] += a0[q]; sum[4 + q] += a1[q]; }
            }
            const float inv = 1.0f / (float)(hi - lo);
            const LAS float* xc = xs + (t + 8) * 64 + c8;
#pragma unroll
            for (int q = 0; q < 8; ++q) dl[t * 65 + c8 + q] = sum[q] * inv - xc[q];
        }
        __syncthreads();
        {
            const int t = F.tid >> 3, e8 = (F.tid & 7) * 8;
            float y[8];
#pragma unroll
            for (int q = 0; q < 8; ++q) y[q] = 0.f;
            for (int c = 0; c < 64; ++c) {
                const float d = dl[t * 65 + c];
                const f32x4 w0 = *(const LAS f32x4*)(wl + c * 64 + e8), w1 = *(const LAS f32x4*)(wl + c * 64 + e8 + 4);
#pragma unroll
                for (int q = 0; q < 4; ++q) { y[q] += d * w0[q]; y[4 + q] += d * w1[q]; }
            }
            const f32x4 s0v = *(const f32x4*)(ps + g * 64 + e8), s1v = *(const f32x4*)(ps + g * 64 + e8 + 4);
            u32x4 o; o.x = pk2(y[0] * s0v[0], y[1] * s0v[1]); o.y = pk2(y[2] * s0v[2], y[3] * s0v[3]); o.z = pk2(y[4] * s1v[0], y[5] * s1v[1]); o.w = pk2(y[6] * s1v[2], y[7] * s1v[3]);
            *(u32x4*)(Y + (size_t)(r0 + t) * D + g * 64 + e8) = o;
        }
    }
    __syncthreads();
}

struct EpiOdd {
    bf16* G; float* ZR; float* ZI; float* ST; Pre pre;
    __device__ __forceinline__ void stage(LAS float* sc, int tid, int row0, int col0, int BN) const { pre_stage(pre, sc, tid, row0, col0, BN); }
    template <int NFRAG> __device__ __forceinline__ void operator()(f32x4 (&acc)[3][NFRAG], int row, int colq, int fq, const LAS float* sc, int lrow, int lcol) const {
        const int ct = colq >> 8;
        if (ct < 6) {
#pragma unroll
            for (int mf = 0; mf < 3; ++mf) {
                const int rr = row + mf * 16; float s1 = 0.f, s2 = 0.f;
                const float rs = sc[lrow + mf * 16]; const LAS float* bp = sc + 256 + cond_of_row(rr) * (32 * NFRAG) + lcol;
#pragma unroll
                for (int nf = 0; nf < NFRAG; ++nf) {
                    const f32x4 v = acc[mf][nf] * rs + *(const LAS f32x4*)(bp + nf * 16);
                    const float g0 = gelu_tanh(v[0]), g1 = gelu_tanh(v[1]), g2 = gelu_tanh(v[2]), g3 = gelu_tanh(v[3]);
                    u32x2 w; w.x = pk2(g0, g1); w.y = pk2(g2, g3);
                    *(u32x2*)(G + (size_t)rr * 1536 + colq + nf * 16) = w;
                    s1 += (g0 + g1) + (g2 + g3); s2 += (g0 * g0 + g1 * g1) + (g2 * g2 + g3 * g3);
                }
                if (ct >= 3) {
                    s1 += __shfl_xor(s1, 16); s1 += __shfl_xor(s1, 32); s2 += __shfl_xor(s2, 16); s2 += __shfl_xor(s2, 32);
                    if (fq == 0) { atomicAdd(ST + (size_t)rr * 2, s1); atomicAdd(ST + (size_t)rr * 2 + 1, s2); }
                }
            }
        } else {
            float* Z = (ct == 6) ? ZR : ZI; const int cb = colq - ct * 256;
#pragma unroll
            for (int mf = 0; mf < 3; ++mf) {
                const int rr = row + mf * 16; const float rs = sc[lrow + mf * 16]; const LAS float* bp = sc + 256 + cond_of_row(rr) * (32 * NFRAG) + lcol;
#pragma unroll
                for (int nf = 0; nf < NFRAG; ++nf) *(f32x4*)(Z + (size_t)rr * 256 + cb + nf * 16) = acc[mf][nf] * rs + *(const LAS f32x4*)(bp + nf * 16);
            }
        }
    }
};

constexpr double c_pi = 3.14159265358979323846;
constexpr double c_sin_poly(double x) { double t = x, s = x; for (int i = 1; i < 14; ++i) { t *= -x * x / ((2 * i) * (2 * i + 1)); s += t; } return s; }
constexpr double c_cos_poly(double x) { double t = 1, s = 1; for (int i = 1; i < 14; ++i) { t *= -x * x / ((2 * i - 1) * (2 * i)); s += t; } return s; }
constexpr int c_bitrev(int x, int n) { int r = 0; for (int b = 1; b < n; b <<= 1) { r = (r << 1) | (x & 1); x >>= 1; } return r; }
template <int N, int HALF, int BASE, int J>
__device__ __forceinline__ void fft_bf(float (&re)[N], float (&im)[N]) {
    constexpr int ia = BASE + J, ib = ia + HALF;
    constexpr float c = (float)c_cos_poly(c_pi * J / HALF), s = (float)c_sin_poly(c_pi * J / HALF);
    const float ar = re[ia], ai = im[ia], br = re[ib], bi = im[ib];
    re[ia] = ar + br; im[ia] = ai + bi;
    const float dr = ar - br, di = ai - bi;
    if constexpr (J == 0) { re[ib] = dr; im[ib] = di; }
    else if constexpr (2 * J == HALF) { re[ib] = di; im[ib] = -dr; }
    else { re[ib] = dr * c + di * s; im[ib] = di * c - dr * s; }
    if constexpr (J + 1 < HALF) fft_bf<N, HALF, BASE, J + 1>(re, im);
    else if constexpr (BASE + 2 * HALF < N) fft_bf<N, HALF, BASE + 2 * HALF, 0>(re, im);
    else if constexpr (HALF > 1) fft_bf<N, HALF / 2, 0, 0>(re, im);
}
template <int R, int P>
__device__ __forceinline__ void fa_store(const float (&zr)[R], const float (&zi)[R], float* BR, float* BI, int row0, int n2, int col, const LAS float* twN) {
    constexpr int k1 = c_bitrev(P, R);
    const int t = k1 * n2; const float c = twN[t], s = twN[R * R + t];
    const size_t o = (size_t)(row0 + k1 * R + n2) * 256 + col;
    BR[o] = c * zr[P] + s * zi[P]; BI[o] = c * zi[P] - s * zr[P];
    if constexpr (P + 1 < R) fa_store<R, P + 1>(zr, zi, BR, BI, row0, n2, col, twN);
}
template <int R>
__device__ __forceinline__ void fourier_a_item(const float* ZR, const float* ZI, float* BR, float* BI, int row0, int n2, const LAS float* twN, int col) {
    float zr[R], zi[R];
#pragma unroll
    for (int n1 = 0; n1 < R; ++n1) { const size_t o = (size_t)(row0 + R * n1 + n2) * 256 + col; zr[n1] = ZR[o]; zi[n1] = ZI[o]; }
    fft_bf<R, R / 2, 0, 0>(zr, zi);
    fa_store<R, 0>(zr, zi, BR, BI, row0, n2, col, twN);
}
template <int R, int P>
__device__ __forceinline__ void fc_store(const float (&br)[R], bf16* Y, int row0, int k1, int col) {
    constexpr int k2 = c_bitrev(P, R);
    Y[(size_t)(row0 + k1 + R * k2) * D + 768 + col] = (bf16)f2bf(br[P] * (1.0f / R));
    if constexpr (P + 1 < R) fc_store<R, P + 1>(br, Y, row0, k1, col);
}
template <int R>
__device__ __forceinline__ void fourier_c_item(const float* BR, const float* BI, bf16* Y, int row0, int k1, int col) {
    float br[R], bi[R];
#pragma unroll
    for (int n2 = 0; n2 < R; ++n2) { const size_t o = (size_t)(row0 + k1 * R + n2) * 256 + col; br[n2] = BR[o]; bi[n2] = BI[o]; }
    fft_bf<R, R / 2, 0, 0>(br, bi);
    fc_store<R, 0>(br, Y, row0, k1, col);
}
__device__ __forceinline__ void fourier_tables(LAS float* tw, int tid) {
    for (int i = tid; i < 1024; i += 512) { const float x = (float)i * (1.f / 512.f); tw[64 + i] = cospif(x); tw[64 + 1024 + i] = sinpif(x); }
    if (tid < 256) { const float x = (float)tid * (1.f / 128.f); tw[2144 + tid] = cospif(x); tw[2144 + 256 + tid] = sinpif(x); }
    if (tid < 32) { const float x = (float)tid * (1.f / 16.f); tw[tid] = cospif(x); tw[32 + tid] = sinpif(x); }
    if (tid < 16) { const float x = (float)tid * (1.f / 8.f); tw[2112 + tid] = cospif(x); tw[2112 + 16 + tid] = sinpif(x); }
}

__device__ __forceinline__ void phase_odd_mix(Frame& F, int j) {
    const CAS Args& a = *F.a;
    const bf16* G = (const bf16*)(a.ws + WS_P); bf16* Y = (bf16*)(a.ws + WS_Y);
    const float* ZR = (const float*)(a.ws + WS_ZR); const float* ZI = (const float*)(a.ws + WS_ZI);
    float* BR = (float*)(a.ws + WS_QN); float* BI = (float*)(a.ws + WS_KN);
    const float* ST = (const float*)(a.ws + WS_CTL + CTL_ST_OFF) + (size_t)j * M * 2;
    LAS unsigned char* L = F.lds;
    LAS float* tw = (LAS float*)(L + 65536);
    fourier_tables(tw, F.tid);
    __syncthreads();
    const int wave = F.wave;
    constexpr int NA_LAT = LAT_B * 32 / 2, NSGU = (M / 128) * NH, NA_CTX = CTX_B * 16 / 2;
    for (int it = F.vcu; it < NA_LAT + NSGU + NA_CTX; it += F.G) {
        int tid_ = F.tid; asm volatile("" : "+v"(tid_));
        if (it < NA_LAT) { const int q = it * 2 + (tid_ >> 8); fourier_a_item<32>(ZR, ZI, BR, BI, NCTX + (q >> 5) * LAT_L, q & 31, tw + 64, tid_ & 255); continue; }
        if (it >= NA_LAT + NSGU) { const int q = (it - NA_LAT - NSGU) * 2 + (tid_ >> 8); fourier_a_item<16>(ZR, ZI, BR, BI, (q >> 4) * CTX_L, q & 15, tw + 2144, tid_ & 255); continue; }
        const int q = it - NA_LAT, ch = q / NH, h = q % NH, r0 = ch * 128;
        const int lane = tid_ & 63, fr = lane & 15, fq = lane >> 4;
        __syncthreads();
        {
            const int s = tid_ >> 2, cq = tid_ & 3, row = r0 + s;
            const float s1 = ST[(size_t)row * 2], s2 = ST[(size_t)row * 2 + 1];
            const float mu = s1 * (1.f / 768.f), var = s2 * (1.f / 768.f) - mu * mu, rstd = rsq_f(fmaxf(var, 0.f) + EPS);
            const bf16* gp = G + (size_t)row * 1536 + 768 + h * 128 + cq * 32;
            const float* nw = a.in[I_SGUN] + j * 768 + h * 128 + cq * 32;
#pragma unroll
            for (int v8 = 0; v8 < 4; ++v8) {
                const u32x4 raw = *(const u32x4*)(gp + v8 * 8);
                const unsigned wds[4] = {raw.x, raw.y, raw.z, raw.w};
#pragma unroll
                for (int e2 = 0; e2 < 4; ++e2) {
                    const float g0 = __builtin_bit_cast(float, wds[e2] << 16), g1 = __builtin_bit_cast(float, wds[e2] & 0xffff0000u);
                    const int c0 = cq * 32 + v8 * 8 + e2 * 2;
                    const float v0 = (g0 - mu) * rstd * nw[v8 * 8 + e2 * 2], v1 = (g1 - mu) * rstd * nw[v8 * 8 + e2 * 2 + 1];
                    *(LAS bf16*)(L + c0 * 256 + (((s >> 3) ^ (c0 & 15)) << 4) + (s & 7) * 2) = (bf16)f2bf(v0);
                    *(LAS bf16*)(L + (c0 + 1) * 256 + (((s >> 3) ^ ((c0 + 1) & 15)) << 4) + (s & 7) * 2) = (bf16)f2bf(v1);
                }
            }
        }
        __syncthreads();
        {
            const bf16* Wb = (const bf16*)(a.ws + WS_SGUW) + ((size_t)j * NH + h) * 16384;
            f32x4 acc[8];
#pragma unroll
            for (int pf = 0; pf < 8; ++pf) acc[pf] = (f32x4){0.f, 0.f, 0.f, 0.f};
#pragma unroll
            for (int ks = 0; ks < 4; ++ks) {
                const bf16x8 av = *(const LAS bf16x8*)(L + (wave * 16 + fr) * 256 + (((ks * 4 + fq) ^ fr) << 4));
#pragma unroll
                for (int pf = 0; pf < 8; ++pf) {
                    const bf16x8 bw = *(const bf16x8*)(Wb + (pf * 16 + fr) * 128 + ks * 32 + fq * 8);
                    acc[pf] = MFMA16(av, bw, acc[pf]);
                }
            }
            const float* bs = a.in[I_SGUB] + ((size_t)j * NH + h) * 128;
#pragma unroll
            for (int pf = 0; pf < 8; ++pf) {
                const int p = pf * 16 + fr, row = r0 + p, c = wave * 16 + 4 * fq; const float b = bs[p];
                const u32x2 gu = *(const u32x2*)(G + (size_t)row * 1536 + h * 128 + c);
                const float u0 = __builtin_bit_cast(float, gu.x << 16), u1 = __builtin_bit_cast(float, gu.x & 0xffff0000u), u2 = __builtin_bit_cast(float, gu.y << 16), u3 = __builtin_bit_cast(float, gu.y & 0xffff0000u);
                u32x2 o; o.x = pk2(u0 * (acc[pf][0] + b), u1 * (acc[pf][1] + b)); o.y = pk2(u2 * (acc[pf][2] + b), u3 * (acc[pf][3] + b));
                *(u32x2*)(Y + (size_t)row * D + h * 128 + c) = o;
            }
        }
    }
    __syncthreads();
}
__device__ __forceinline__ void phase_odd_fc(Frame& F) {
    const CAS Args& a = *F.a;
    const float* BR = (const float*)(a.ws + WS_QN); const float* BI = (const float*)(a.ws + WS_KN); bf16* Y = (bf16*)(a.ws + WS_Y);
    constexpr int NC_LAT = LAT_B * 32 / 2, NC_CTX = CTX_B * 16 / 2;
    for (int it = F.vcu; it < NC_LAT + NC_CTX; it += F.G) {
        int tid_ = F.tid; asm volatile("" : "+v"(tid_));
        if (it < NC_LAT) { const int q = it * 2 + (tid_ >> 8); fourier_c_item<32>(BR, BI, Y, NCTX + (q >> 5) * LAT_L, q & 31, tid_ & 255); }
        else { const int q = (it - NC_LAT) * 2 + (tid_ >> 8); fourier_c_item<16>(BR, BI, Y, (q >> 4) * CTX_L, q & 15, tid_ & 255); }
    }
    __syncthreads();
}

constexpr int STEPS = 9, N_PHASES = 2 + DEPTH * STEPS + 1;
__device__ __forceinline__ bool phase_active(int ph) {
    if (ph < 2 || ph == N_PHASES - 1) return true;
    const int l = (ph - 2) / STEPS, st = (ph - 2) % STEPS;
    return !((l & 1) && st == 5);
}
__device__ __forceinline__ void run_phase(Frame& F, int ph) {
    const CAS Args& a = *F.a; unsigned char* ws = a.ws;
    if (ph == 0) { phase_setup(F); return; }
    if (ph == 1) { phase_init(F); return; }
    if (ph == N_PHASES - 1) { phase_final(F); return; }
    const int l = (ph - 2) / STEPS, st = (ph - 2) % STEPS, e = l >> 1;
    bf16* XS = (bf16*)(ws + WS_HN); bf16* HH = (bf16*)(ws + WS_HH); float* X = (float*)(ws + WS_X); float* P = (float*)(ws + WS_P);
    const bf16* Y = (const bf16*)(ws + WS_Y); const float* mod = (const float*)(ws + WS_MOD);
    float* ssb = (float*)(ws + WS_CTL + CTL_SS_OFF); const float* biasb = (const float*)(ws + WS_BIAS);
#define PRE_OF(s_) Pre{ssb + (size_t)(s_) * M, biasb + (size_t)(s_) * 3 * NBMAX}
    switch (st) {
        case 0: { EpiUp E{HH, PRE_OF(3 * l)}; gemm_phase<11, EpiUp>(F, XS, (const bf16*)(ws + WS_WUP + (size_t)(l * 2) * WUP_SZ), D, NUP, E); } break;
        case 1: { EpiRes E{X, mod, l, 2, 0.5f, XS, ssb + (size_t)(3 * l + 1) * M, a.in[I_MIXN] + l * D, l, 1}; gemm_phase<4, EpiRes>(F, HH, (const bf16*)(ws + WS_WDN + (size_t)(l * 2) * WDN_SZ), FF, D, E); } break;
        case 2: { if ((l & 1) == 0) { EpiStore E{(bf16*)(ws + WS_P), (float*)(ws + WS_AG), PRE_OF(3 * l + 1)}; gemm_phase<7, EpiStore>(F, XS, (const bf16*)(ws + WS_EVIN + (size_t)e * EVIN_SZ), D, P_EVEN_PAD, E); }
                  else { EpiOdd EO{(bf16*)(ws + WS_P), (float*)(ws + WS_ZR), (float*)(ws + WS_ZI), (float*)(ws + WS_CTL + CTL_ST_OFF) + (size_t)e * M * 2, PRE_OF(3 * l + 1)};
                         gemm_phase<8, EpiOdd>(F, XS, (const bf16*)(ws + WS_ODIN + (size_t)e * ODIN_SZ), D, 2048, EO); } } break;
        case 3: if ((l & 1) == 0) phase_dn_prep(F, e); else phase_odd_mix(F, e); break;
        case 4: if ((l & 1) == 0) phase_dn_scan(F, e); else phase_odd_fc(F); break;
        case 5: if ((l & 1) == 0) phase_dn_fin(F, e); break;
        case 6: { EpiRes E{X, mod, l, 5, 1.0f, XS, ssb + (size_t)(3 * l + 2) * M, a.in[I_F2N] + l * D, l, 2}; gemm_phase<4, EpiRes>(F, Y, (const bf16*)(ws + ((l & 1) ? WS_ODOUT : WS_EVOUT) + (size_t)e * SQ_SZ), D, D, E); } break;
        case 7: { EpiUp E{HH, PRE_OF(3 * l + 2)}; gemm_phase<11, EpiUp>(F, XS, (const bf16*)(ws + WS_WUP + (size_t)(l * 2 + 1) * WUP_SZ), D, NUP, E); } break;
        case 8: { const bool last = (l == DEPTH - 1);
                  EpiRes E{X, mod, l, 8, 0.5f, XS, last ? nullptr : ssb + (size_t)(3 * l + 3) * M, a.in[I_F1N] + (last ? l : l + 1) * D, last ? l : l + 1, 0};
                  gemm_phase<4, EpiRes>(F, HH, (const bf16*)(ws + WS_WDN + (size_t)(l * 2 + 1) * WDN_SZ), FF, D, E); } break;
    }
#undef PRE_OF
}

__global__ void __launch_bounds__(512, 2) mk_fwd(Args args) {
    extern __shared__ __attribute__((aligned(16))) unsigned char lds_raw[];
    Frame F;
    F.lds = (LAS unsigned char*)lds_raw;
    F.tid = threadIdx.x; F.lane = F.tid & 63; F.wave = __builtin_amdgcn_readfirstlane(F.tid >> 6);
    F.G = gridDim.x; { const int bx = blockIdx.x; F.vcu = (F.G % 8 == 0) ? (bx % 8) * (F.G / 8) + bx / 8 : bx; }
    const CAS Args* ap = (const CAS Args*)__builtin_amdgcn_kernarg_segment_ptr();
    F.a = ap;
    const int ph_lo = ap->ph_lo, ph_hi = ap->ph_hi;
    unsigned char* ws0 = ap->ws;
    volatile LAS unsigned* MISC = (volatile LAS unsigned*)(F.lds + LDS_MISC);
    if (F.tid < 64) MISC[F.tid] = 0u;
    __syncthreads();
    const bool multi = (ph_hi - ph_lo) > 1;
    XcdBarrier bar; bar.bar = (unsigned*)(ws0 + WS_CTL) + CW_BAR; bar.x = 0; bar.st = MISC + 8;
    if (multi) bar = xcd_barrier_post((unsigned*)(ws0 + WS_CTL) + CW_BAR, MISC + 8);
    for (int ph = ph_lo; ph < ph_hi; ++ph) {
        { const CAS Args* a2 = ap; asm volatile("" : "+s"(a2)); F.a = a2; }
        { int t_ = threadIdx.x; asm volatile("" : "+v"(t_)); F.tid = t_; F.lane = t_ & 63; F.wave = __builtin_amdgcn_readfirstlane(t_ >> 6); }
        if (!phase_active(ph)) continue;
        run_phase(F, ph);
        if (ph + 1 < ph_hi) xcd_barrier(bar);
    }
}

extern "C" void kernel_launch(void* const* d_in, const int* in_sizes, int n_in, void* d_out, int out_size, void* d_ws, size_t ws_size, hipStream_t stream) {
    static int grid = 0;
    if (grid == 0) {
        if (n_in != 31 || ws_size < WS_END) { fprintf(stderr, "kernel_launch: unexpected n_in %d or ws_size %zu (need %zu)\n", n_in, ws_size, (size_t)WS_END); grid = -1; return; }
        int dev = 0, cus = 0;
        if (hipGetDevice(&dev) != hipSuccess || hipDeviceGetAttribute(&cus, hipDeviceAttributeMultiprocessorCount, dev) != hipSuccess) { grid = -1; return; }
        if (hipFuncSetAttribute((const void*)mk_fwd, hipFuncAttributeMaxDynamicSharedMemorySize, LDS_BYTES) != hipSuccess) { fprintf(stderr, "kernel_launch: hipFuncSetAttribute failed\n"); grid = -1; return; }
        (void)hipGetLastError();
        grid = cus;
    }
    if (grid < 0) return;
    (void)hipMemsetAsync((char*)d_ws + WS_CTL, 0, CTL_BYTES, stream);
    (void)hipMemsetAsync((char*)d_ws + WS_BIAS, 0, (size_t)12 * 3 * NBMAX * 4, stream);
    Args a{};
    for (int i = 0; i < 31; ++i) a.in[i] = (const float*)d_in[i];
    a.out = (float*)d_out; a.ws = (unsigned char*)d_ws;
#if ONE_LAUNCH
    a.ph_lo = 0; a.ph_hi = N_PHASES;
    hipLaunchKernelGGL(mk_fwd, dim3(grid), dim3(512), LDS_BYTES, stream, a);
#else
    for (int ph = 0; ph < N_PHASES; ++ph) {
        a.ph_lo = ph; a.ph_hi = ph + 1;
        hipLaunchKernelGGL(mk_fwd, dim3(grid), dim3(512), LDS_BYTES, stream, a);
    }
#endif
}
```

```cpp
#include <hip/hip_runtime.h>
#include <cstdio>
#include <cstdint>

#ifndef ONE_LAUNCH
#define ONE_LAUNCH 1
#endif

#define GAS __attribute__((address_space(1)))
#define LAS __attribute__((address_space(3)))
#define CAS __attribute__((address_space(4)))
typedef unsigned short bf16;
typedef float f32x4 __attribute__((ext_vector_type(4)));
typedef float f32x2 __attribute__((ext_vector_type(2)));
typedef short bf16x8 __attribute__((ext_vector_type(8)));
typedef unsigned u32x4 __attribute__((ext_vector_type(4)));
typedef unsigned u32x2 __attribute__((ext_vector_type(2)));

constexpr int D = 1024, NCTX = 4096, NLAT = 2048, M = 6144, FF = 2816, DEPTH = 4;
constexpr int CTX_B = 16, CTX_L = 256, LAT_B = 2, LAT_L = 1024;
constexpr int NUP = 2 * FF;
constexpr int P_EVEN = 3352, P_EVEN_PAD = 3584, P_ODD = 1792;
constexpr int LDP = 3584;
constexpr int NH = 6, DK = 128;
constexpr float EPS = 1e-6f;
constexpr int NSEQ = CTX_B + LAT_B;

constexpr size_t MiB = 1u << 20;
constexpr size_t WS_CTL = 0, CTL_BYTES = 1 * MiB;
constexpr size_t WS_MOD = 1 * MiB;
constexpr size_t WS_WUP = 2 * MiB, WUP_SZ = 11 * MiB;
constexpr size_t WS_WDN = 90 * MiB, WDN_SZ = 5632 * 1024;
constexpr size_t WS_EVIN = 134 * MiB, EVIN_SZ = 7 * MiB;
constexpr size_t WS_EVOUT = 148 * MiB, SQ_SZ = 2 * MiB;
constexpr size_t WS_ODIN = 152 * MiB, ODIN_SZ = 4 * MiB;
constexpr size_t WS_ODOUT = 160 * MiB;
constexpr size_t WS_X = 164 * MiB;
constexpr size_t WS_HN = 188 * MiB;
constexpr size_t WS_HH = 200 * MiB;
constexpr size_t WS_P = 233 * MiB;
constexpr size_t WS_Y = 317 * MiB;
constexpr size_t WS_QN = 329 * MiB, WS_KN = 347 * MiB, WS_VV = 365 * MiB, WS_OF = 383 * MiB, WS_OB = 401 * MiB;
constexpr size_t WS_AG = 419 * MiB, WS_BT = 420 * MiB;
constexpr size_t WS_ZR = 421 * MiB, WS_ZI = 427 * MiB, WS_SPEC = 433 * MiB;
constexpr size_t WS_DW = 439 * MiB, WS_DQ = 457 * MiB, WS_DAI = 475 * MiB, WS_DKT = 484 * MiB, WS_DUT = 502 * MiB, WS_DGL = 520 * MiB;
constexpr size_t WS_BIAS = 521 * MiB;
constexpr size_t WS_END = 522 * MiB;

constexpr size_t CTL_ST_OFF = 262144;
constexpr size_t CTL_SS_OFF = 524288;
constexpr int NBMAX = 5632;
constexpr size_t WS_SGUW = 1 * MiB + 512 * 1024;
constexpr int CW_BAR = 4096;

constexpr int LDS_MAIN = 160768;
constexpr int LDS_MISC = LDS_MAIN;
constexpr int LDS_BYTES = LDS_MAIN + 1024;

__device__ __forceinline__ float wave_sum(float v) {
#pragma unroll
    for (int o = 1; o < 64; o <<= 1) v += __shfl_xor(v, o);
    return v;
}
typedef __bf16 bf16x2_t __attribute__((ext_vector_type(2)));
__device__ __forceinline__ unsigned pk2(float lo, float hi) { const f32x2 v = {lo, hi}; const bf16x2_t b = __builtin_convertvector(v, bf16x2_t); return __builtin_bit_cast(unsigned, b); }
__device__ __forceinline__ unsigned f2bf(float f) { return pk2(f, 0.f) & 0xffffu; }
__device__ __forceinline__ float rcp_f(float x) { return __builtin_amdgcn_rcpf(x); }
__device__ __forceinline__ float rsq_f(float x) { return __builtin_amdgcn_rsqf(x); }
__device__ __forceinline__ float silu_f(float x) { return x * rcp_f(1.f + __expf(-x)); }
__device__ __forceinline__ float sigmoid_f(float x) { return rcp_f(1.f + __expf(-x)); }
__device__ __forceinline__ float gelu_tanh(float x) { const float u2 = 1.5957691216057308f * (x + 0.044715f * x * x * x); return x * rcp_f(1.f + __expf(-u2)); }
__device__ __forceinline__ float softplus_f(float x) { return x > 20.f ? x : log1pf(expf(x)); }
__device__ __forceinline__ int cond_of_row(int r) { return r < NCTX ? 0 : (r < NCTX + LAT_L ? 1 : 2); }
__device__ __forceinline__ void seq_of_row(int r, int& s0, int& L) { if (r < NCTX) { s0 = r & ~(CTX_L - 1); L = CTX_L; } else { s0 = NCTX + ((r - NCTX) & ~(LAT_L - 1)); L = LAT_L; } }

#define XB_TMO      128
#define XB_XCNT(j)  (256  + 64 * (j))
#define XB_XSUB(j)  (1280 + 64 * (j))
#define XB_XGEN(j)  (2304 + 64 * (j))
#define XB_TOP      3328
#define XB_TOPGEN   3392
#define XCD_BAR_WORDS 3456
#define XB_SPIN_CAP (1u << 18)
__device__ __forceinline__ unsigned xb_ld(unsigned* p)              { return __hip_atomic_load(p, __ATOMIC_RELAXED, __HIP_MEMORY_SCOPE_AGENT); }
__device__ __forceinline__ unsigned xb_add(unsigned* p, unsigned v) { return __hip_atomic_fetch_add(p, v, __ATOMIC_RELAXED, __HIP_MEMORY_SCOPE_AGENT); }
__device__ __forceinline__ unsigned xb_xcc_id() { return (unsigned)__builtin_amdgcn_s_getreg((3 << 11) | 20) & 0xFu; }
#define XB_SPIN(cond, bar) do { unsigned _sp = 0; while (cond) { __builtin_amdgcn_s_sleep(1); \
    if ((++_sp & 255u) == 0u) { if (xb_ld(&(bar)[XB_TMO])) break; if (_sp > XB_SPIN_CAP) { atomicAdd(&(bar)[XB_TMO], 1u); break; } } } } while (0)
struct XcdBarrier { unsigned* bar; unsigned x; volatile LAS unsigned* st; };
__device__ __forceinline__ XcdBarrier xcd_barrier_post(unsigned* bar, volatile LAS unsigned* st) {
    XcdBarrier b; b.bar = bar; b.x = xb_xcc_id(); b.st = st;
    if (threadIdx.x == 0) (void)xb_add(&bar[XB_XCNT(b.x)], 1u);
    return b;
}
__device__ __forceinline__ void xcd_barrier_complete(unsigned* bar, unsigned x, unsigned& nloc, unsigned& nx) {
    const unsigned G = gridDim.x * gridDim.y * gridDim.z;
    unsigned sum, cnt, mine, sp = 0u;
    for (;;) {
        sum = 0u; cnt = 0u; mine = 0u;
#pragma unroll
        for (unsigned j = 0; j < 16; ++j) { const unsigned c = xb_ld(&bar[XB_XCNT(j)]); sum += c; cnt += (c > 0u) ? 1u : 0u; mine = (j == x) ? c : mine; }
        if (sum == G) break;
        __builtin_amdgcn_s_sleep(1);
        if ((++sp & 255u) == 0u) { if (xb_ld(&bar[XB_TMO])) break; if (sp > XB_SPIN_CAP) { atomicAdd(&bar[XB_TMO], 1u); break; } }
    }
    nloc = mine > 0u ? mine : 1u; nx = cnt > 0u ? cnt : 1u;
}
__device__ __forceinline__ void xcd_barrier(const XcdBarrier& b) {
    asm volatile("s_waitcnt vmcnt(0)" ::: "memory");
    __syncthreads();
    if (threadIdx.x == 0) {
        unsigned* bar = b.bar;
        __builtin_amdgcn_s_waitcnt(0);
        unsigned nloc = b.st[0], nx = b.st[1];
        if (nloc == 0u) { xcd_barrier_complete(bar, b.x, nloc, nx); b.st[0] = nloc; b.st[1] = nx; }
        const unsigned old = xb_add(&bar[XB_XSUB(b.x)], 1u);
        const unsigned gen = old / nloc;
        if (old + 1u == (gen + 1u) * nloc) {
            __builtin_amdgcn_fence(__ATOMIC_RELEASE, "agent");
            asm volatile("s_waitcnt vmcnt(0)" ::: "memory");
            const unsigned og = xb_add(&bar[XB_TOP], 1u);
            const unsigned tg = og / nx;
            if (og + 1u == (tg + 1u) * nx) xb_add(&bar[XB_TOPGEN], 1u);
            else XB_SPIN(xb_ld(&bar[XB_TOPGEN]) == tg, bar);
            __builtin_amdgcn_fence(__ATOMIC_ACQUIRE, "agent");
            xb_add(&bar[XB_XGEN(b.x)], 1u);
            asm volatile("s_waitcnt vmcnt(0)" ::: "memory");
        } else {
            XB_SPIN(xb_ld(&bar[XB_XGEN(b.x)]) == gen, bar);
            __builtin_amdgcn_fence(__ATOMIC_ACQUIRE, "agent");
            asm volatile("s_waitcnt vmcnt(0)" ::: "memory");
        }
    }
    __syncthreads();
}

struct Args { const float* in[31]; float* out; unsigned char* ws; int ph_lo, ph_hi; };
enum { I_XP = 0, I_XS, I_STATE, I_C, I_CCTX, I_F1N, I_F1G, I_F1U, I_F1D, I_MIXN, I_F2N, I_F2G, I_F2U, I_F2D, I_ADAW, I_ADAB, I_EVIN, I_EVOUT,
       I_POOLW, I_POOLS, I_CONVW, I_ALOG, I_DTB, I_DNNW, I_ODIN, I_ODOUT, I_SGUN, I_SGUW, I_SGUB, I_FNETW, I_FINN };

struct Frame {
    LAS unsigned char* lds;
    int tid, lane, wave, vcu, G;
    const CAS Args* a;
};

#define DS_READ128(dst, addr) asm volatile("ds_read_b128 %0, %1" : "=v"(dst) : "v"((unsigned)(addr)))
__device__ __forceinline__ void lgkm_wait(int n) {
    switch (n) { case 0: asm volatile("s_waitcnt lgkmcnt(0)" ::: "memory"); break; case 1: asm volatile("s_waitcnt lgkmcnt(1)" ::: "memory"); break;
                 case 2: asm volatile("s_waitcnt lgkmcnt(2)" ::: "memory"); break; default: asm volatile("s_waitcnt lgkmcnt(3)" ::: "memory"); break; }
}
__device__ __forceinline__ void vm_wait(int n) {
    switch (n) { case 0: asm volatile("s_waitcnt vmcnt(0)" ::: "memory"); break; case 4: asm volatile("s_waitcnt vmcnt(4)" ::: "memory"); break;
                 case 5: asm volatile("s_waitcnt vmcnt(5)" ::: "memory"); break; case 6: asm volatile("s_waitcnt vmcnt(6)" ::: "memory"); break;
                 case 7: asm volatile("s_waitcnt vmcnt(7)" ::: "memory"); break; case 8: asm volatile("s_waitcnt vmcnt(8)" ::: "memory"); break;
                 case 9: asm volatile("s_waitcnt vmcnt(9)" ::: "memory"); break; default: asm volatile("s_waitcnt vmcnt(0)" ::: "memory"); break; }
}
template <int NFRAG, class Epi>
__device__ __forceinline__ void gemm_tile(LAS unsigned char* lds, const int tid, const bf16* A, const bf16* Bt, int K, int row0, int col0, const Epi& E) {
    constexpr int BN = 32 * NFRAG, NPB = BN / 8, A_BYTES = 192 * 128, B_BYTES = BN * 128, STAGE = A_BYTES + B_BYTES, NBI = (NPB + 7) / 8;
    constexpr int NS = (3 * STAGE <= LDS_MAIN) ? 3 : 2;
    static_assert(NS * STAGE <= LDS_MAIN, "LDS");
    const int lane = tid & 63, wid = __builtin_amdgcn_readfirstlane(tid >> 6), wm = wid >> 1, wn = wid & 1, fr = lane & 15, fq = lane >> 4;
    const int r = lane >> 3, slot = lane & 7;
    const int srow = wid * 8 + r;
    const int chunk = slot ^ ((srow >> 1) & 7);
    const char* gA = (const char*)(A + (size_t)(row0 + srow) * K) + chunk * 16;
    const char* gB = (const char*)(Bt + (size_t)(col0 + srow) * K) + chunk * 16;
    const size_t pstep = (size_t)64 * K * 2;
    const int nt = K / 64;
    const int nbw = (NPB - wid + 7) / 8;
    const unsigned ldsb = (unsigned)(uintptr_t)lds;
    const int rowA0 = wm * 48 + fr, rowB0 = wn * NFRAG * 16 + fr;
    int offA[2], offB[2];
#pragma unroll
    for (int kk = 0; kk < 2; ++kk) {
        offA[kk] = rowA0 * 128 + (((kk * 4 + fq) ^ ((rowA0 >> 1) & 7)) << 4);
        offB[kk] = A_BYTES + rowB0 * 128 + (((kk * 4 + fq) ^ ((rowB0 >> 1) & 7)) << 4);
    }
    f32x4 acc[3][NFRAG];
#pragma unroll
    for (int i = 0; i < 3; ++i)
#pragma unroll
        for (int j = 0; j < NFRAG; ++j) acc[i][j] = (f32x4){0.f, 0.f, 0.f, 0.f};
    typename Epi::template Hold<NFRAG> hold;
    E.template preload<NFRAG>(hold, row0 + wm * 48 + fr, col0 + wn * NFRAG * 16 + fq * 4, tid, row0, col0);

#define GEMM_STAGE(buf, t) do { LAS unsigned char* sA_ = lds + (buf) * STAGE + wid * 1024; \
        _Pragma("unroll") for (int i_ = 0; i_ < 3; ++i_) \
            __builtin_amdgcn_global_load_lds((const unsigned*)(gA + i_ * pstep + (size_t)(t) * 128), (LAS unsigned*)(sA_ + i_ * 8192), 16, 0, 0); \
        _Pragma("unroll") for (int i_ = 0; i_ < NBI; ++i_) if (wid + 8 * i_ < NPB) \
            __builtin_amdgcn_global_load_lds((const unsigned*)(gB + i_ * pstep + (size_t)(t) * 128), (LAS unsigned*)(sA_ + A_BYTES + i_ * 8192), 16, 0, 0); } while (0)

    GEMM_STAGE(0, 0);
    if (NS == 3) GEMM_STAGE(1, 1);
    int sbuf = 0;
    for (int t = 0; t < nt; ++t) {
        if (NS == 3) {
            if (t + 1 < nt) { if (nbw == NBI) vm_wait(3 + NBI); else vm_wait(3 + NBI - 1); } else vm_wait(0);
            __builtin_amdgcn_s_barrier();
            if (t + 2 < nt) { const int nb_ = (sbuf >= 1) ? sbuf - 1 : 2; GEMM_STAGE(nb_, t + 2); }
        } else {
            asm volatile("s_waitcnt vmcnt(0)" ::: "memory");
            __syncthreads();
            if (t + 1 < nt) GEMM_STAGE((t + 1) & 1, t + 1);
        }
        {
            const unsigned sbo = (unsigned)sbuf * STAGE;
            const unsigned aA0 = ldsb + sbo + offA[0], aA1 = ldsb + sbo + offA[1], aB0 = ldsb + sbo + offB[0], aB1 = ldsb + sbo + offB[1];
            bf16x8 af[2][3], bq[4];
#pragma unroll
            for (int mf = 0; mf < 3; ++mf) { DS_READ128(af[0][mf], aA0 + mf * 2048); }
#pragma unroll
            for (int mf = 0; mf < 3; ++mf) { DS_READ128(af[1][mf], aA1 + mf * 2048); }
            constexpr int TOT = 2 * NFRAG;
#pragma unroll
            for (int f = 0; f < 3; ++f) { DS_READ128(bq[f], aB0 + f * 2048); }
#pragma unroll
            for (int f = 0; f < TOT; ++f) {
                if (f + 3 < TOT) { const int g = f + 3; DS_READ128(bq[g & 3], ((g >= NFRAG) ? aB1 + (g - NFRAG) * 2048 : aB0 + g * 2048)); }
                const int outstanding = (f + 3 < TOT) ? 3 : (TOT - 1 - f);
                lgkm_wait(outstanding);
                asm volatile("" : "+v"(bq[f & 3]));
                __builtin_amdgcn_sched_barrier(0);
                const int kk = (f >= NFRAG) ? 1 : 0, nf = f - kk * NFRAG;
#pragma unroll
                for (int mf = 0; mf < 3; ++mf) acc[mf][nf] = __builtin_amdgcn_mfma_f32_16x16x32_bf16(bq[f & 3], af[kk][mf], acc[mf][nf], 0, 0, 0);
            }
        }
        sbuf = (sbuf + 1 == NS) ? 0 : sbuf + 1;
    }
#undef GEMM_STAGE
    __syncthreads();
    E.template stage<NFRAG>(hold, (LAS float*)lds, tid);
    __syncthreads();
    E.template operator()<NFRAG>(acc, hold, row0 + wm * 48 + fr, col0 + wn * NFRAG * 16 + fq * 4, fq, (const LAS float*)lds, wm * 48 + fr, wn * NFRAG * 16 + fq * 4);
    asm volatile("s_waitcnt vmcnt(0)" ::: "memory");
    __syncthreads();
}

template <int RB, int PITCH>
__device__ __forceinline__ void image_store(const LAS unsigned char* img, unsigned char* dst, size_t ldb, int lane) {
    constexpr int CPR = RB / 16, TOT = 48 * CPR;
#pragma unroll
    for (int j = 0; j < (TOT + 63) / 64; ++j) {
        const int ci = lane + 64 * j;
        if (ci < TOT) { const int r = ci / CPR, ch = ci - r * CPR; *(u32x4*)(dst + (size_t)r * ldb + ch * 16) = *(const LAS u32x4*)(img + r * PITCH + ch * 16); }
    }
}
struct Pre { const float* ss; const float* bias; };
struct PreHold { float rs, b[3]; };
__device__ __forceinline__ void pre_fetch(const Pre& p, PreHold& h, int tid, int row0, int col0, int BN) {
    h.rs = (tid < 192) ? p.ss[row0 + tid] : 0.f;
#pragma unroll
    for (int q = 0; q < 3; ++q) { const int i = tid + 512 * q; const int c = i / BN, j = i - c * BN; h.b[q] = (i < 3 * BN) ? p.bias[c * NBMAX + col0 + j] : 0.f; }
}
__device__ __forceinline__ void pre_write(const PreHold& h, LAS float* sc, int tid, int BN) {
    if (tid < 192) sc[tid] = rsq_f(h.rs * (1.f / D) + EPS);
#pragma unroll
    for (int q = 0; q < 3; ++q) { const int i = tid + 512 * q; if (i < 3 * BN) sc[256 + i] = h.b[q]; }
}
struct EpiUp {
    bf16* H; Pre pre;
    template <int NFRAG> struct Hold { PreHold ph; };
    template <int NFRAG> __device__ __forceinline__ void preload(Hold<NFRAG>& h, int, int, int tid, int row0, int col0) const { pre_fetch(pre, h.ph, tid, row0, col0, 32 * NFRAG); }
    template <int NFRAG> __device__ __forceinline__ void stage(const Hold<NFRAG>& h, LAS float* sc, int tid) const { pre_write(h.ph, sc, tid, 32 * NFRAG); }
    template <int NFRAG> __device__ __forceinline__ void operator()(f32x4 (&acc)[3][NFRAG], const Hold<NFRAG>&, int row, int colq, int fq, const LAS float* sc, int lrow, int lcol) const {
        constexpr int RB = 16 * NFRAG;
        const int wm = lrow / 48, wn = lcol / (16 * NFRAG), fr = lrow - wm * 48;
        LAS unsigned char* img = (LAS unsigned char*)sc + 8192 + (wm * 2 + wn) * (48 * RB);
#pragma unroll
        for (int mf = 0; mf < 3; ++mf) {
            const int rr = row + mf * 16; const float rs = sc[lrow + mf * 16];
            const LAS float* bp = sc + 256 + cond_of_row(rr) * (32 * NFRAG) + lcol;
#pragma unroll
            for (int nf = 0; nf < NFRAG; ++nf) {
                const f32x4 v = acc[mf][nf] * rs + *(const LAS f32x4*)(bp + nf * 16);
                *(LAS unsigned*)(img + (mf * 16 + fr) * RB + nf * 16 + fq * 4) = pk2(silu_f(v[0]) * v[2], silu_f(v[1]) * v[3]);
            }
        }
        const int lane = fq * 16 + fr;
        bf16* hb = H + (size_t)(row - fr) * FF + ((colq - fq * 4) >> 1);
#pragma unroll
        for (int j = 0; j < (48 * NFRAG + 63) / 64; ++j) {
            const int ci = lane + 64 * j;
            if (ci < 48 * NFRAG) { const int r = ci / NFRAG, ch = ci - r * NFRAG; *(u32x4*)(hb + (size_t)r * FF + ch * 8) = *(const LAS u32x4*)(img + r * RB + ch * 16); }
        }
    }
};
struct EpiRes {
    float* X; const float* mod; int layer, gidx; float scale;
    bf16* XS; float* ssn; const float* nwn; int ln, wn;
    template <int NFRAG> struct Hold { f32x4 xv[3][NFRAG]; float g, c; };
    template <int NFRAG> __device__ __forceinline__ void preload(Hold<NFRAG>& h, int row, int colq, int tid, int, int col0) const {
        constexpr int BN = 32 * NFRAG; static_assert(3 * BN <= 512, "one vector element per thread");
#pragma unroll
        for (int mf = 0; mf < 3; ++mf)
#pragma unroll
            for (int nf = 0; nf < NFRAG; ++nf) h.xv[mf][nf] = *(const f32x4*)(X + (size_t)(row + mf * 16) * D + colq + nf * 16);
        const int c = tid / BN, j = tid - c * BN; h.g = 0.f; h.c = 0.f;
        if (tid < 3 * BN) {
            h.g = mod[((size_t)(layer * 3 + c) * 9 + gidx) * 1024 + col0 + j] * scale;
            h.c = nwn[col0 + j] * (mod[((size_t)(ln * 3 + c) * 9 + wn * 3 + 1) * 1024 + col0 + j] + 1.0f);
        }
    }
    template <int NFRAG> __device__ __forceinline__ void stage(const Hold<NFRAG>& h, LAS float* sc, int tid) const {
        constexpr int BN = 32 * NFRAG;
        if (tid < 3 * BN) { sc[256 + tid] = h.g; sc[256 + 3 * BN + tid] = h.c; }
    }
    template <int NFRAG> __device__ __forceinline__ void operator()(f32x4 (&acc)[3][NFRAG], const Hold<NFRAG>& h, int row, int colq, int fq, const LAS float* sc, int lrow, int lcol) const {
        constexpr int BN = 32 * NFRAG, RBX = 64 * NFRAG, RBS = 32 * NFRAG, PX = RBX + 16, PS = RBS + 16;
        const int wm = lrow / 48, wn = lcol / (16 * NFRAG), fr = lrow - wm * 48, lane = fq * 16 + fr;
        LAS unsigned char* imx = (LAS unsigned char*)sc + 8192 + (wm * 2 + wn) * (48 * PX);
        u32x2 hsw[3][NFRAG];
#pragma unroll
        for (int mf = 0; mf < 3; ++mf) {
            const int rr = row + mf * 16, cnd = cond_of_row(rr);
            const LAS float* gp = sc + 256 + cnd * BN + lcol; const LAS float* cp = sc + 256 + 3 * BN + cnd * BN + lcol;
            float ssq = 0.f;
#pragma unroll
            for (int nf = 0; nf < NFRAG; ++nf) {
                const f32x4 x = h.xv[mf][nf] + acc[mf][nf] * *(const LAS f32x4*)(gp + nf * 16);
                *(LAS f32x4*)(imx + (mf * 16 + fr) * PX + nf * 64 + fq * 16) = x;
                if (ssn) {
                    const f32x4 hs = x * *(const LAS f32x4*)(cp + nf * 16);
                    hsw[mf][nf].x = pk2(hs[0], hs[1]); hsw[mf][nf].y = pk2(hs[2], hs[3]);
                    ssq += (x[0] * x[0] + x[1] * x[1]) + (x[2] * x[2] + x[3] * x[3]);
                }
            }
            if (ssn) { ssq += __shfl_xor(ssq, 16); ssq += __shfl_xor(ssq, 32); if (fq == 0) atomicAdd(ssn + rr, ssq); }
        }
        const size_t o0 = (size_t)(row - fr) * D + (colq - fq * 4);
        image_store<RBX, PX>(imx, (unsigned char*)(X + o0), (size_t)D * 4, lane);
        if (ssn) {
#pragma unroll
            for (int mf = 0; mf < 3; ++mf)
#pragma unroll
                for (int nf = 0; nf < NFRAG; ++nf) *(LAS u32x2*)(imx + (mf * 16 + fr) * PS + nf * 32 + fq * 8) = hsw[mf][nf];
            image_store<RBS, PS>(imx, (unsigned char*)(XS + o0), (size_t)D * 2, lane);
        }
    }
};
struct EpiStore {
    bf16* P; float* GT; Pre pre;
    template <int NFRAG> struct Hold { PreHold ph; };
    template <int NFRAG> __device__ __forceinline__ void preload(Hold<NFRAG>& h, int, int, int tid, int row0, int col0) const { pre_fetch(pre, h.ph, tid, row0, col0, 32 * NFRAG); }
    template <int NFRAG> __device__ __forceinline__ void stage(const Hold<NFRAG>& h, LAS float* sc, int tid) const { pre_write(h.ph, sc, tid, 32 * NFRAG); }
    template <int NFRAG> __device__ __forceinline__ void operator()(f32x4 (&acc)[3][NFRAG], const Hold<NFRAG>&, int row, int colq, int fq, const LAS float* sc, int lrow, int lcol) const {
        constexpr int RB = 32 * NFRAG, PB = RB + 16;
        const int wm = lrow / 48, wn = lcol / (16 * NFRAG), fr = lrow - wm * 48, lane = fq * 16 + fr;
        LAS unsigned char* img = (LAS unsigned char*)sc + 8192 + (wm * 2 + wn) * (48 * PB);
#pragma unroll
        for (int mf = 0; mf < 3; ++mf) {
            const int rr = row + mf * 16; const float rs = sc[lrow + mf * 16];
            const LAS float* bp = sc + 256 + cond_of_row(rr) * (32 * NFRAG) + lcol;
#pragma unroll
            for (int nf = 0; nf < NFRAG; ++nf) {
                const f32x4 v = acc[mf][nf] * rs + *(const LAS f32x4*)(bp + nf * 16);
                const int c = colq + nf * 16;
                u32x2 w; w.x = pk2(v[0], v[1]); w.y = pk2(v[2], v[3]);
                *(LAS u32x2*)(img + (mf * 16 + fr) * PB + nf * 32 + fq * 8) = w;
                if (c >= 3328 && c < 3352) *(f32x4*)(GT + (size_t)rr * 24 + (c - 3328)) = v;
            }
        }
        image_store<RB, PB>(img, (unsigned char*)(P + (size_t)(row - fr) * LDP + (colq - fq * 4)), (size_t)LDP * 2, lane);
    }
};

template <int NFRAG, class Epi>
__device__ __forceinline__ void gemm_phase(Frame& F, const bf16* A, const bf16* Bt, int K, int N, const Epi& E) {
    constexpr int BN = 32 * NFRAG;
    const int NT = N / BN, nitems = 32 * NT;
    for (int i = F.vcu; i < nitems; i += F.G) {
        const int panel = (i >> 3) & 31, ct = (i & 7) + 8 * (i >> 8);
        gemm_tile<NFRAG, Epi>(F.lds, F.tid, A, Bt, K, panel * 192, ct * BN, E);
    }
}

__device__ __forceinline__ void transpose_item(const float* W, int K, int N, int ldw, bf16* WT, int mode, LAS float* scr, int item, int lane, const float* shp, float* biasp) {
    const int nblk = (N + 63) / 64, kb = item / nblk, nb = item % nblk, k0 = 64 * kb, n0 = 64 * nb;
    const int lc = (lane & 15) * 4, lr = lane >> 4;
    f32x4 v[16];
#pragma unroll
    for (int i = 0; i < 16; ++i) v[i] = (n0 + lc < N) ? *(const f32x4*)(W + (size_t)(k0 + 4 * i + lr) * ldw + n0 + lc) : (f32x4){0.f, 0.f, 0.f, 0.f};
    float sh0 = 0.f, sh1 = 0.f, sh2 = 0.f;
    if (biasp) { sh0 = shp[k0 + lane]; sh1 = shp[9216 + k0 + lane]; sh2 = shp[2 * 9216 + k0 + lane]; }
#pragma unroll
    for (int i = 0; i < 16; ++i) { LAS float* p = scr + (4 * i + lr) * 65 + lc; p[0] = v[i][0]; p[1] = v[i][1]; p[2] = v[i][2]; p[3] = v[i][3]; }
    asm volatile("s_waitcnt lgkmcnt(0)" ::: "memory");
    const int c = lane & 7;
#pragma unroll
    for (int j = 0; j < 8; ++j) {
        const int nl = (lane >> 3) + 8 * j, n = n0 + nl; const LAS float* s = scr + (8 * c) * 65 + nl;
        u32x4 o; o.x = pk2(s[0 * 65], s[1 * 65]); o.y = pk2(s[2 * 65], s[3 * 65]); o.z = pk2(s[4 * 65], s[5 * 65]); o.w = pk2(s[6 * 65], s[7 * 65]);
        const int dr = (mode == 0) ? n : ((n >> 1) * 4 + (n & 1) + (mode == 2 ? 2 : 0));
        if (n < N) *(u32x4*)(WT + (size_t)dr * K + k0 + 8 * c) = o;
    }
    if (biasp) {
        float b0 = 0.f, b1 = 0.f, b2 = 0.f;
#pragma unroll
        for (int kk = 0; kk < 64; ++kk) {
            const float w = scr[kk * 65 + lane];
            b0 += w * __builtin_bit_cast(float, __builtin_amdgcn_readlane(__builtin_bit_cast(int, sh0), kk));
            b1 += w * __builtin_bit_cast(float, __builtin_amdgcn_readlane(__builtin_bit_cast(int, sh1), kk));
            b2 += w * __builtin_bit_cast(float, __builtin_amdgcn_readlane(__builtin_bit_cast(int, sh2), kk));
        }
        const int n = n0 + lane, dr = (mode == 0) ? n : ((n >> 1) * 4 + (n & 1) + (mode == 2 ? 2 : 0));
        if (n < N) { atomicAdd(biasp + dr, b0); atomicAdd(biasp + NBMAX + dr, b1); atomicAdd(biasp + 2 * NBMAX + dr, b2); }
    }
    asm volatile("s_waitcnt lgkmcnt(0)" ::: "memory");
}

__device__ __forceinline__ void phase_setup(Frame& F) {
    const CAS Args& a = *F.a;
    unsigned char* ws = a.ws;
    {
        LAS float* sc = (LAS float*)F.lds;
        LAS float* red = sc + 3 * 1024;
        for (int i = F.tid; i < 3 * 1024; i += 512) { const int c = i >> 10, k = i & 1023; const float v = (c == 0) ? a.in[I_CCTX][k] : a.in[I_C][(c - 1) * 1024 + k]; sc[i] = silu_f(v); }
        __syncthreads();
        float* mod = (float*)(ws + WS_MOD);
        for (int it = F.vcu; it < 4 * 288; it += F.G) {
            const int l = it / 288, r_ = it % 288, kr = r_ / 36, seg = r_ % 36;
            const int k0 = kr * 128 + F.wave * 16;
            const float* W = a.in[I_ADAW] + (size_t)l * 1024 * 9216 + (size_t)k0 * 9216 + seg * 256 + F.lane * 4;
            f32x4 w[16];
#pragma unroll
            for (int k = 0; k < 16; ++k) w[k] = *(const f32x4*)(W + (size_t)k * 9216);
            f32x4 s0 = {0, 0, 0, 0}, s1 = s0, s2 = s0;
#pragma unroll
            for (int k = 0; k < 16; ++k) { s0 += w[k] * sc[k0 + k]; s1 += w[k] * sc[1024 + k0 + k]; s2 += w[k] * sc[2048 + k0 + k]; }
            LAS float* rp = red + (F.wave * 64 + F.lane) * 12;
#pragma unroll
            for (int j = 0; j < 4; ++j) { rp[j] = s0[j]; rp[4 + j] = s1[j]; rp[8 + j] = s2[j]; }
            __syncthreads();
            if (F.tid < 256) {
                const int ln = F.tid >> 2, j = F.tid & 3, n = seg * 256 + F.tid;
#pragma unroll
                for (int c = 0; c < 3; ++c) {
                    float s = 0.f;
#pragma unroll
                    for (int wv = 0; wv < 8; ++wv) s += red[(wv * 64 + ln) * 12 + c * 4 + j];
                    if (kr == 0) s += a.in[I_ADAB][l * 9216 + n];
                    atomicAdd(mod + (size_t)(l * 3 + c) * 9216 + n, s);
                }
            }
            __syncthreads();
        }
        __syncthreads();
    }
    {
        const int gw = F.vcu * 8 + F.wave, NGW = F.G * 8;
        for (int it = gw; it < 2 * NH * 16384 / 512; it += NGW) {
            const float* sp = a.in[I_SGUW] + (size_t)it * 512 + F.lane * 8;
            const f32x4 x0 = *(const f32x4*)sp, x1 = *(const f32x4*)(sp + 4);
            u32x4 o; o.x = pk2(x0[0], x0[1]); o.y = pk2(x0[2], x0[3]); o.z = pk2(x1[0], x1[1]); o.w = pk2(x1[2], x1[3]);
            *(u32x4*)((bf16*)(ws + WS_SGUW) + (size_t)it * 512 + F.lane * 8) = o;
        }
        __syncthreads();
    }
    {
        const int gw = F.vcu * 8 + F.wave, NGW = F.G * 8;
        for (int it = gw; it < 2 * (P_EVEN_PAD - P_EVEN); it += NGW) {
            const int e = it / (P_EVEN_PAD - P_EVEN), rr = P_EVEN + it % (P_EVEN_PAD - P_EVEN);
            u32x4* p = (u32x4*)((bf16*)(ws + WS_EVIN + (size_t)e * EVIN_SZ) + (size_t)rr * D);
            p[F.lane] = (u32x4){0, 0, 0, 0}; p[64 + F.lane] = (u32x4){0, 0, 0, 0};
        }
        float* X = (float*)(ws + WS_X);
        for (int row = gw; row < M; row += NGW) {
            float* xo = X + (size_t)row * D;
            if (row < NCTX) {
                const f32x4* src = (const f32x4*)(a.in[I_XP] + (size_t)row * D);
#pragma unroll
                for (int j = 0; j < 4; ++j) ((f32x4*)xo)[j * 64 + F.lane] = src[j * 64 + F.lane];
            } else {
                const int t = (row - NCTX) & (LAT_L - 1); const float pr = (float)(t >> 6), pc = (float)(t & 63);
                const float* src = a.in[I_XS] + (size_t)(row - NCTX) * D;
#pragma unroll
                for (int j = 0; j < 16; ++j) {
                    const int ch = j * 64 + F.lane, seg = ch >> 8, i = ch & 255;
                    const float freq = expf(-9.210340371976184f * (float)i * (1.0f / 256.0f));
                    const float ang = ((seg < 2) ? pr : pc) * freq;
                    const float pe = (seg & 1) ? cosf(ang) : sinf(ang);
                    xo[ch] = src[ch] + pe;
                }
            }
        }
    }
}

__device__ __forceinline__ const bf16* sub_weight(unsigned char* ws, int s, int& N) {
    const int l = s / 3, which = s % 3, e = l >> 1;
    if (which != 1) { N = NUP; return (const bf16*)(ws + WS_WUP + (size_t)(l * 2 + (which == 2 ? 1 : 0)) * WUP_SZ); }
    if ((l & 1) == 0) { N = P_EVEN_PAD; return (const bf16*)(ws + WS_EVIN + (size_t)e * EVIN_SZ); }
    N = 2048; return (const bf16*)(ws + WS_ODIN + (size_t)e * ODIN_SZ);
}
__device__ __forceinline__ void phase_init(Frame& F) {
    const CAS Args& a = *F.a; unsigned char* ws = a.ws;
    const float* mod = (const float*)(ws + WS_MOD);
    const int gw = F.vcu * 8 + F.wave, NGW = F.G * 8;
    {
        LAS float* T = (LAS float*)F.lds;
        LAS float* wt = T + 64 * 128;
        LAS float* tw = wt + 64 * 65;
        if (F.tid < 64) { tw[F.tid] = cospif((float)F.tid * (1.f / 32.f)); tw[64 + F.tid] = sinpif((float)F.tid * (1.f / 32.f)); }
        __syncthreads();
        for (int it = F.vcu; it < 2 * 4 * 16; it += F.G) {
            const int j = it >> 6, g = (it >> 4) & 3, k0 = (it & 15) * 64;
            const float* Wg = a.in[I_FNETW] + ((size_t)j * 4 + g) * 4096;
            {
                const int c = F.tid >> 3, eb = (F.tid & 7) * 8;
                float ac[8], as[8];
#pragma unroll
                for (int q = 0; q < 8; ++q) { ac[q] = 0.f; as[q] = 0.f; }
                for (int m = 0; m < 64; ++m) {
                    const int idx = (m * c) & 63; const float cs = tw[idx], sn = tw[64 + idx];
                    const f32x4 w0 = *(const f32x4*)(Wg + m * 64 + eb), w1 = *(const f32x4*)(Wg + m * 64 + eb + 4);
#pragma unroll
                    for (int q = 0; q < 4; ++q) { ac[q] += cs * w0[q]; ac[4 + q] += cs * w1[q]; as[q] -= sn * w0[q]; as[4 + q] -= sn * w1[q]; }
                }
#pragma unroll
                for (int q = 0; q < 8; ++q) { T[c * 128 + eb + q] = ac[q] * 0.125f; T[c * 128 + 64 + eb + q] = as[q] * 0.125f; }
                const int kk = F.tid >> 3, c8 = (F.tid & 7) * 8;
                const float* wp = a.in[I_ODIN] + (size_t)j * D * P_ODD + (size_t)(k0 + kk) * P_ODD + 1536 + g * 64 + c8;
                const f32x4 x0 = *(const f32x4*)wp, x1 = *(const f32x4*)(wp + 4);
#pragma unroll
                for (int q = 0; q < 4; ++q) { wt[kk * 65 + c8 + q] = x0[q]; wt[kk * 65 + c8 + 4 + q] = x1[q]; }
            }
            __syncthreads();
            {
                const int col = F.tid & 127, kq = F.tid >> 7;
                float acc[16];
#pragma unroll
                for (int q = 0; q < 16; ++q) acc[q] = 0.f;
                for (int c = 0; c < 64; ++c) {
                    const float t = T[c * 128 + col];
#pragma unroll
                    for (int q = 0; q < 16; ++q) acc[q] += wt[(kq * 16 + q) * 65 + c] * t;
                }
                const int drow = 1536 + ((col < 64) ? (g * 64 + col) : (256 + g * 64 + col - 64));
                bf16* dst = (bf16*)(ws + WS_ODIN + (size_t)j * ODIN_SZ) + (size_t)drow * D + k0 + kq * 16;
                u32x4 o0, o1;
                o0.x = pk2(acc[0], acc[1]); o0.y = pk2(acc[2], acc[3]); o0.z = pk2(acc[4], acc[5]); o0.w = pk2(acc[6], acc[7]);
                o1.x = pk2(acc[8], acc[9]); o1.y = pk2(acc[10], acc[11]); o1.z = pk2(acc[12], acc[13]); o1.w = pk2(acc[14], acc[15]);
                *(u32x4*)dst = o0; *(u32x4*)(dst + 8) = o1;
                const float* shp = (const float*)(ws + WS_MOD) + ((size_t)((2 * j + 1) * 3) * 9 + 3) * 1024 + k0 + kq * 16 + (F.lane & 15);
                const float s0v = shp[0], s1v = shp[9216], s2v = shp[2 * 9216];
                float b0 = 0.f, b1 = 0.f, b2 = 0.f;
#pragma unroll
                for (int q = 0; q < 16; ++q) {
                    b0 += acc[q] * __builtin_bit_cast(float, __builtin_amdgcn_readlane(__builtin_bit_cast(int, s0v), q));
                    b1 += acc[q] * __builtin_bit_cast(float, __builtin_amdgcn_readlane(__builtin_bit_cast(int, s1v), q));
                    b2 += acc[q] * __builtin_bit_cast(float, __builtin_amdgcn_readlane(__builtin_bit_cast(int, s2v), q));
                }
                float* bp = (float*)(ws + WS_BIAS) + (size_t)(3 * (2 * j + 1) + 1) * 3 * NBMAX + drow;
                atomicAdd(bp, b0); atomicAdd(bp + NBMAX, b1); atomicAdd(bp + 2 * NBMAX, b2);
            }
            __syncthreads();
        }
    }
    {
        LAS float* scr = (LAS float*)(F.lds + F.wave * 16640);
        const int gw = F.vcu * 8 + F.wave, NGW = F.G * 8;
        constexpr int IT_G = 16 * 44, IT_D = 44 * 16, IT_EVIN = 16 * 53, IT_SQ = 16 * 16, IT_ODIN = 16 * 24;
        static_assert(IT_G == IT_D, "decode");
        constexpr int PER_FFN = 2 * IT_G + IT_D;
        constexpr int TOT = 8 * PER_FFN + 2 * (IT_EVIN + IT_SQ + IT_ODIN + IT_SQ);
        for (int it = gw; it < TOT; it += NGW) {
            int r = it; const float* W; bf16* WT; int K, N, mode, ldw = 0, sub_s = -1;
            if (r < 8 * PER_FFN) {
                const int f = r / PER_FFN, l = f >> 1, s = f & 1; r -= f * PER_FFN;
                const int sub = r / IT_G; r -= sub * IT_G;
                const int idx = (sub == 0) ? (s ? I_F2G : I_F1G) : ((sub == 1) ? (s ? I_F2U : I_F1U) : (s ? I_F2D : I_F1D));
                W = a.in[idx] + (size_t)l * D * FF;
                WT = (sub == 2) ? (bf16*)(ws + WS_WDN + (size_t)f * WDN_SZ) : (bf16*)(ws + WS_WUP + (size_t)f * WUP_SZ);
                K = (sub == 2) ? FF : D; N = (sub == 2) ? D : FF; mode = (sub == 2) ? 0 : sub + 1;
                if (sub != 2) sub_s = 3 * l + (s ? 2 : 0);
            } else {
                r -= 8 * PER_FFN;
                constexpr int PER_E = IT_EVIN + IT_SQ + IT_ODIN + IT_SQ;
                const int e = r / PER_E; r -= e * PER_E;
                K = D; mode = 0;
                if (r < IT_EVIN) { W = a.in[I_EVIN] + (size_t)e * D * P_EVEN; N = P_EVEN; WT = (bf16*)(ws + WS_EVIN + (size_t)e * EVIN_SZ); sub_s = 3 * (2 * e) + 1; }
                else if (r < IT_EVIN + IT_SQ) { r -= IT_EVIN; W = a.in[I_EVOUT] + (size_t)e * D * D; N = D; WT = (bf16*)(ws + WS_EVOUT + (size_t)e * SQ_SZ); }
                else if (r < IT_EVIN + IT_SQ + IT_ODIN) { r -= IT_EVIN + IT_SQ; W = a.in[I_ODIN] + (size_t)e * D * P_ODD; N = 1536; ldw = P_ODD; WT = (bf16*)(ws + WS_ODIN + (size_t)e * ODIN_SZ); sub_s = 3 * (2 * e + 1) + 1; }
                else { r -= IT_EVIN + IT_SQ + IT_ODIN; W = a.in[I_ODOUT] + (size_t)e * D * D; N = D; WT = (bf16*)(ws + WS_ODOUT + (size_t)e * SQ_SZ); }
            }
            const float* shp = nullptr; float* biasp = nullptr;
            if (sub_s >= 0) { shp = (const float*)(ws + WS_MOD) + ((size_t)((sub_s / 3) * 3) * 9 + (sub_s % 3) * 3) * 1024; biasp = (float*)(ws + WS_BIAS) + (size_t)sub_s * 3 * NBMAX; }
            transpose_item(W, K, N, ldw ? ldw : N, WT, mode, scr, r, F.lane, shp, biasp);
        }
    }
    {
        const float* X = (const float*)(ws + WS_X); bf16* XS = (bf16*)(ws + WS_HN);
        float* ss = (float*)(ws + WS_CTL + CTL_SS_OFF);
        const float* nw = a.in[I_F1N];
        for (int row = gw; row < M; row += NGW) {
            const f32x4* xr = (const f32x4*)(X + (size_t)row * D) + F.lane;
            f32x4 v[4]; float s = 0.f;
#pragma unroll
            for (int j = 0; j < 4; ++j) { v[j] = xr[64 * j]; s += v[j][0] * v[j][0] + v[j][1] * v[j][1] + v[j][2] * v[j][2] + v[j][3] * v[j][3]; }
            s = wave_sum(s);
            if (F.lane == 0) ss[row] = s;
            const float* mb = mod + ((size_t)(0 * 3 + cond_of_row(row)) * 9 + 1) * 1024;
            u32x2* o = (u32x2*)(XS + (size_t)row * D) + F.lane;
#pragma unroll
            for (int j = 0; j < 4; ++j) {
                const int k = (64 * j + F.lane) * 4;
                const f32x4 h = v[j] * *(const f32x4*)(nw + k) * (*(const f32x4*)(mb + k) + 1.0f);
                u32x2 pkd; pkd.x = pk2(h[0], h[1]); pkd.y = pk2(h[2], h[3]);
                o[64 * j] = pkd;
            }
        }
    }
}

__device__ __forceinline__ void phase_final(Frame& F) {
    const CAS Args& a = *F.a;
    const float* X = (const float*)(a.ws + WS_X);
    const float* nw = a.in[I_FINN];
    const int gw = F.vcu * 8 + F.wave, NGW = F.G * 8;
    for (int row = gw; row < M; row += NGW) {
        const f32x4* xr = (const f32x4*)(X + (size_t)row * D) + F.lane;
        f32x4 v[4]; float s = 0.f;
#pragma unroll
        for (int j = 0; j < 4; ++j) { v[j] = xr[64 * j]; s += v[j][0] * v[j][0] + v[j][1] * v[j][1] + v[j][2] * v[j][2] + v[j][3] * v[j][3]; }
        const float rstd = 1.0f / sqrtf(wave_sum(s) * (1.f / D) + EPS);
        f32x4* o = (f32x4*)(a.out + (size_t)row * D) + F.lane;
#pragma unroll
        for (int j = 0; j < 4; ++j) { const f32x4 w = *(const f32x4*)(nw + (64 * j + F.lane) * 4); o[64 * j] = v[j] * rstd * w; }
    }
}

__device__ __forceinline__ float wave_matvec64(float d, const float* W, int lane) {
    float y = 0.f;
#pragma unroll
    for (int c = 0; c < 64; ++c) { const float dc = __builtin_bit_cast(float, __builtin_amdgcn_readlane(__builtin_bit_cast(int, d), c)); y += dc * W[c * 64 + lane]; }
    return y;
}

__device__ __forceinline__ int perm32(int x) { return (x & ~31) | ((x & 12) << 1) | ((x & 16) >> 2) | (x & 3); }
__device__ __forceinline__ int sw256(int row, int c16) { return row * 256 + ((c16 ^ (row & 15)) << 4); }
__device__ __forceinline__ int sw128(int row, int c8) { return row * 128 + ((c8 ^ ((row >> 1) & 7)) << 4); }
__device__ __forceinline__ int e128(int row, int col) { return sw128(row, col >> 3) + (col & 7) * 2; }
__device__ __forceinline__ void dn_item_decode(int cc, int& row0, int& L, int& c) {
    if (cc < 64) { row0 = (cc >> 2) * CTX_L; L = CTX_L; c = cc & 3; } else { const int q = cc - 64; row0 = NCTX + (q >> 4) * LAT_L; L = LAT_L; c = q & 15; }
}
#define MFMA16(a, b, c) __builtin_amdgcn_mfma_f32_16x16x32_bf16((a), (b), (c), 0, 0, 0)

__device__ __forceinline__ void phase_dn_prep(Frame& F, int e) {
    const CAS Args& a = *F.a;
    const bf16* P = (const bf16*)(a.ws + WS_P); const float* GT = (const float*)(a.ws + WS_AG);
    const float* cw = a.in[I_CONVW] + (size_t)e * 3 * 2304;
    LAS unsigned char* L = F.lds;
    constexpr int CWL = 114688;
    constexpr int KB = 0, QB = 16384, VBT = 32768, KGT = 49152, KDT = 65536, AIo = 81920, MM = 90112, TT = 98304, TN = 106496, MD = 114688, XT = 118784, SM = 139264, VB16 = 140288;
    LAS float* sm = (LAS float*)(L + SM);
    const int wave = F.wave;
    for (int rec = F.vcu; rec < 1152; rec += F.G) {
        int tid_ = F.tid; asm volatile("" : "+v"(tid_));
        const int lane = tid_ & 63, fr = lane & 15, fq = lane >> 4;
        const int dir = rec & 1, h = (rec >> 1) % NH, cc = rec / (2 * NH);
        int row0, Ls, c; dn_item_decode(cc, row0, Ls, c);
        __syncthreads();
        for (int i_ = tid_; i_ < 1152; i_ += 512) { const int part = i_ / 384, r_ = i_ % 384, tap = r_ >> 7, ch = r_ & 127; ((LAS float*)(L + CWL))[i_] = cw[tap * 2304 + part * 768 + h * 128 + ch]; }
        if (wave == 0) {
            const int row = row0 + (dir ? (Ls - 1 - (c * 64 + lane)) : (c * 64 + lane));
            const float araw = GT[(size_t)row * 24 + 12 + dir * 6 + h], braw = GT[(size_t)row * 24 + dir * 6 + h];
            const float al = a.in[I_ALOG][(e * 2 + dir) * 6 + h], dtb = a.in[I_DTB][(e * 2 + dir) * 6 + h];
            float x = -expf(al) * softplus_f(araw + dtb); const float b = sigmoid_f(braw);
#pragma unroll
            for (int o = 1; o < 64; o <<= 1) { const float t = __shfl_up(x, o); if (lane >= o) x += t; }
            const float gl = __shfl(x, 63);
            sm[lane] = x; sm[64 + lane] = b; sm[128 + lane] = expf(x); sm[192 + lane] = expf(gl - x);
            if (lane == 63) ((float*)(a.ws + WS_DGL))[rec] = expf(x);
        }
        __syncthreads();
        {
            const int i = tid_ >> 3, cg = tid_ & 7;
            const int row = row0 + (dir ? (Ls - 1 - (c * 64 + i)) : (c * 64 + i));
            const int tl = row - row0; const bool hp = tl > 0, hn = tl < Ls - 1;
            float kf[16], qf[16], vf[16];
#pragma unroll
            for (int part = 0; part < 3; ++part) {
                const int pc = 256 + part * 768 + h * 128 + cg * 16;
                const bf16* p1 = P + (size_t)row * LDP + pc;
                const LAS float* wl = (const LAS float*)(L + CWL) + part * 384 + cg * 16;
                float out[16];
#pragma unroll
                for (int q8 = 0; q8 < 2; ++q8) {
                    const u32x4 r1 = *(const u32x4*)(p1 + q8 * 8);
                    const u32x4 r0 = hp ? *(const u32x4*)(p1 - LDP + q8 * 8) : (u32x4){0, 0, 0, 0};
                    const u32x4 r2 = hn ? *(const u32x4*)(p1 + LDP + q8 * 8) : (u32x4){0, 0, 0, 0};
                    const unsigned a0[4] = {r0.x, r0.y, r0.z, r0.w}, a1[4] = {r1.x, r1.y, r1.z, r1.w}, a2[4] = {r2.x, r2.y, r2.z, r2.w};
#pragma unroll
                    for (int d = 0; d < 4; ++d) {
#pragma unroll
                        for (int hh = 0; hh < 2; ++hh) {
                            const int j = q8 * 8 + d * 2 + hh;
                            const float x0 = __builtin_bit_cast(float, hh ? (a0[d] & 0xffff0000u) : (a0[d] << 16));
                            const float x1 = __builtin_bit_cast(float, hh ? (a1[d] & 0xffff0000u) : (a1[d] << 16));
                            const float x2 = __builtin_bit_cast(float, hh ? (a2[d] & 0xffff0000u) : (a2[d] << 16));
                            out[j] = silu_f(x0 * wl[j] + x1 * wl[128 + j] + x2 * wl[256 + j]);
                        }
                    }
                }
                if (part < 2) {
                    float ssq = 0.f;
#pragma unroll
                    for (int j = 0; j < 16; ++j) ssq += out[j] * out[j];
                    ssq += __shfl_xor(ssq, 1); ssq += __shfl_xor(ssq, 2); ssq += __shfl_xor(ssq, 4);
                    const float rs = rsq_f(ssq + EPS) * (part == 0 ? 0.08838834764831845f : 1.0f);
#pragma unroll
                    for (int j = 0; j < 16; ++j) { if (part == 0) qf[j] = out[j] * rs; else kf[j] = out[j] * rs; }
                } else {
#pragma unroll
                    for (int j = 0; j < 16; ++j) vf[j] = out[j];
                }
            }
            const float eg = sm[128 + i];
#pragma unroll
            for (int hf = 0; hf < 2; ++hf) {
                u32x4 kk, qq, vv;
                kk.x = pk2(kf[hf * 8 + 0], kf[hf * 8 + 1]); kk.y = pk2(kf[hf * 8 + 2], kf[hf * 8 + 3]); kk.z = pk2(kf[hf * 8 + 4], kf[hf * 8 + 5]); kk.w = pk2(kf[hf * 8 + 6], kf[hf * 8 + 7]);
                qq.x = pk2(qf[hf * 8 + 0], qf[hf * 8 + 1]); qq.y = pk2(qf[hf * 8 + 2], qf[hf * 8 + 3]); qq.z = pk2(qf[hf * 8 + 4], qf[hf * 8 + 5]); qq.w = pk2(qf[hf * 8 + 6], qf[hf * 8 + 7]);
                vv.x = pk2(vf[hf * 8 + 0], vf[hf * 8 + 1]); vv.y = pk2(vf[hf * 8 + 2], vf[hf * 8 + 3]); vv.z = pk2(vf[hf * 8 + 4], vf[hf * 8 + 5]); vv.w = pk2(vf[hf * 8 + 6], vf[hf * 8 + 7]);
                *(LAS u32x4*)(L + KB + sw256(i, cg * 2 + hf)) = kk;
                *(LAS u32x4*)(L + QB + sw256(i, cg * 2 + hf)) = qq;
                *(LAS u32x4*)(L + VB16 + sw256(i, cg * 2 + hf)) = vv;
            }
            bf16* QD = (bf16*)(a.ws + WS_DQ) + (size_t)rec * 8192 + i * 128;
#pragma unroll
            for (int qq = 0; qq < 4; ++qq) {
                const int pos = perm32(cg * 16 + 4 * qq);
                u32x2 w; w.x = pk2(qf[4 * qq] * eg, qf[4 * qq + 1] * eg); w.y = pk2(qf[4 * qq + 2] * eg, qf[4 * qq + 3] * eg);
                *(u32x2*)(QD + pos) = w;
            }
        }
        __syncthreads();
        {
            const int kdl = lane & 15, ipl = lane >> 4;
#pragma unroll 2
            for (int it8 = 0; it8 < 8; ++it8) {
                const int combo = wave * 8 + it8, kd = (combo & 7) * 16 + kdl, i0 = 2 * ((combo >> 3) * 4 + ipl);
                const int a0 = sw256(i0, kd >> 3) + (kd & 7) * 2, a1 = sw256(i0 + 1, kd >> 3) + (kd & 7) * 2;
                const float k0 = __builtin_bit_cast(float, (unsigned)(*(const LAS bf16*)(L + KB + a0)) << 16), k1 = __builtin_bit_cast(float, (unsigned)(*(const LAS bf16*)(L + KB + a1)) << 16);
                const float v0 = __builtin_bit_cast(float, (unsigned)(*(const LAS bf16*)(L + VB16 + a0)) << 16), v1 = __builtin_bit_cast(float, (unsigned)(*(const LAS bf16*)(L + VB16 + a1)) << 16);
                const float be0 = sm[64 + i0], be1 = sm[65 + i0], eg0 = sm[128 + i0], eg1 = sm[129 + i0], ek0 = sm[192 + i0], ek1 = sm[193 + i0];
                *(LAS unsigned*)(L + VBT + e128(kd, i0)) = pk2(v0 * be0, v1 * be1);
                *(LAS unsigned*)(L + KGT + e128(kd, i0)) = pk2(k0 * be0 * eg0, k1 * be1 * eg1);
                *(LAS unsigned*)(L + KDT + e128(kd, perm32(i0))) = pk2(k0 * ek0, k1 * ek1);
            }
        }
        __syncthreads();
        const int mi = wave >> 1;
#pragma unroll
        for (int f = 0; f < 2; ++f) {
            const int nj = (wave & 1) * 2 + f;
            f32x4 kkacc = {0.f, 0.f, 0.f, 0.f}, qkacc = {0.f, 0.f, 0.f, 0.f};
            if (nj <= mi) {
#pragma unroll
                for (int ks = 0; ks < 4; ++ks) {
                    const bf16x8 ak = *(const LAS bf16x8*)(L + KB + sw256(mi * 16 + fr, ks * 4 + fq));
                    const bf16x8 aq = *(const LAS bf16x8*)(L + QB + sw256(mi * 16 + fr, ks * 4 + fq));
                    const bf16x8 bk = *(const LAS bf16x8*)(L + KB + sw256(nj * 16 + fr, ks * 4 + fq));
                    kkacc = MFMA16(ak, bk, kkacc); qkacc = MFMA16(aq, bk, qkacc);
                }
            }
            const int j = nj * 16 + fr, i0 = mi * 16 + 4 * fq; const float gcj = sm[j];
#pragma unroll
            for (int r = 0; r < 4; ++r) {
                const int i = i0 + r; const float dec = (i >= j) ? __expf(sm[i] - gcj) : 0.f;
                const float mv = (i > j) ? (sm[64 + i] * kkacc[r] * dec) : 0.f;
                if (nj <= mi) *(LAS bf16*)(L + MM + e128(i, j)) = (bf16)f2bf(mv);
                if (nj == mi) *(LAS float*)(L + MD + ((mi * 16 + 4 * fq + r) * 16 + fr) * 4) = mv;
                if (nj > mi) *(LAS bf16*)(L + TN + e128(i, j)) = (bf16)0;
                *(LAS bf16*)(L + AIo + e128(i, perm32(j))) = (bf16)f2bf(qkacc[r] * dec);
            }
        }
        __syncthreads();
        if (wave == 0) {
            const int b = lane >> 4, cc_ = lane & 15;
            const LAS float* md = (const LAS float*)(L + MD) + b * 256;
            float T[16];
#pragma unroll
            for (int i = 0; i < 16; ++i) {
                float s = (i == cc_) ? 1.f : 0.f;
#pragma unroll
                for (int jj = 0; jj < i; ++jj) s -= md[i * 16 + jj] * T[jj];
                T[i] = s;
            }
#pragma unroll
            for (int i = 0; i < 16; ++i) *(LAS bf16*)(L + TN + e128(16 * b + i, 16 * b + cc_)) = (bf16)f2bf(T[i]);
#pragma unroll
            for (int hf = 0; hf < 2; ++hf) {
                u32x4 t; t.x = pk2(T[hf * 8 + 0], T[hf * 8 + 1]); t.y = pk2(T[hf * 8 + 2], T[hf * 8 + 3]); t.z = pk2(T[hf * 8 + 4], T[hf * 8 + 5]); t.w = pk2(T[hf * 8 + 6], T[hf * 8 + 7]);
                *(LAS u32x4*)(L + TT + sw128(16 * b + cc_, 2 * b + hf)) = t;
            }
        }
        __syncthreads();
#pragma unroll
        for (int lvl = 1; lvl <= 3; ++lvl) {
            if (wave < 4 - lvl) {
                const int J = wave, I = wave + lvl;
                f32x4 x = {0.f, 0.f, 0.f, 0.f};
                const bf16x8 zero8 = {0, 0, 0, 0, 0, 0, 0, 0};
#pragma unroll
                for (int ks = 0; ks < (lvl == 3 ? 2 : 1); ++ks) {
                    const bf16x8 am = *(const LAS bf16x8*)(L + MM + sw128(16 * I + fr, 2 * J + 4 * ks + fq));
                    bf16x8 bt = *(const LAS bf16x8*)(L + TT + sw128(16 * J + fr, 2 * J + 4 * ks + fq));
                    if (4 * ks + fq >= 2 * lvl) bt = zero8;
                    x = MFMA16(am, bt, x);
                }
                LAS unsigned char* xt = L + XT + wave * 512;
                { u32x2 t; t.x = pk2(x[0], x[1]); t.y = pk2(x[2], x[3]); *(LAS u32x2*)(xt + fr * 32 + fq * 8) = t; }
                const bf16x8 ad = *(const LAS bf16x8*)(L + TN + sw128(16 * I + fr, 2 * I + (fq & 1)));
                bf16x8 bx = *(const LAS bf16x8*)(xt + fr * 32 + (fq & 1) * 16);
                if (fq >= 2) bx = zero8;
                f32x4 t4 = {0.f, 0.f, 0.f, 0.f};
                t4 = MFMA16(ad, bx, t4);
#pragma unroll
                for (int r = 0; r < 4; ++r) *(LAS bf16*)(L + TN + e128(16 * I + 4 * fq + r, 16 * J + fr)) = (bf16)f2bf(-t4[r]);
                { u32x2 t; t.x = pk2(-t4[0], -t4[1]); t.y = pk2(-t4[2], -t4[3]); *(LAS u32x2*)(L + TT + e128(16 * J + fr, 16 * I + 4 * fq)) = t; }
            }
            __syncthreads();
        }
        {
            bf16* UT = (bf16*)(a.ws + WS_DUT) + (size_t)rec * 8192;
            bf16* Wn = (bf16*)(a.ws + WS_DW) + (size_t)rec * 8192;
            const int ui = wave & 3;
#pragma unroll
            for (int f = 0; f < 4; ++f) {
                const int dvf = (wave >> 2) * 4 + f;
                f32x4 acc = {0.f, 0.f, 0.f, 0.f};
#pragma unroll
                for (int ks = 0; ks < 2; ++ks) {
                    const bf16x8 ta = *(const LAS bf16x8*)(L + TN + sw128(ui * 16 + fr, ks * 4 + fq));
                    const bf16x8 vb = *(const LAS bf16x8*)(L + VBT + sw128(dvf * 16 + fr, ks * 4 + fq));
                    acc = MFMA16(ta, vb, acc);
                }
                u32x2 t; t.x = pk2(acc[0], acc[1]); t.y = pk2(acc[2], acc[3]);
                *(u32x2*)(UT + (dvf * 16 + fr) * 64 + ui * 16 + 4 * fq) = t;
            }
#pragma unroll
            for (int f = 0; f < 4; ++f) {
                f32x4 acc = {0.f, 0.f, 0.f, 0.f};
#pragma unroll
                for (int ks = 0; ks < 2; ++ks) {
                    const bf16x8 ka = *(const LAS bf16x8*)(L + KGT + sw128(wave * 16 + fr, ks * 4 + fq));
                    const bf16x8 tb = *(const LAS bf16x8*)(L + TN + sw128(f * 16 + fr, ks * 4 + fq));
                    acc = MFMA16(ka, tb, acc);
                }
                u32x2 t; t.x = pk2(-acc[0], -acc[1]); t.y = pk2(-acc[2], -acc[3]);
                *(u32x2*)(Wn + (f * 16 + fr) * 128 + perm32(wave * 16 + 4 * fq)) = t;
            }
            {
                const int rw = tid_ >> 3, c8 = tid_ & 7;
                *(u32x4*)((unsigned char*)(a.ws + WS_DAI) + (size_t)rec * 8192 + rw * 128 + c8 * 16) = *(const LAS u32x4*)(L + AIo + sw128(rw, c8));
#pragma unroll
                for (int k2 = 0; k2 < 2; ++k2) {
                    const int rr = rw + 64 * k2;
                    *(u32x4*)((unsigned char*)(a.ws + WS_DKT) + (size_t)rec * 16384 + rr * 128 + c8 * 16) = *(const LAS u32x4*)(L + KDT + sw128(rr, c8));
                }
            }
        }
    }
    __syncthreads();
}

__device__ __forceinline__ void phase_dn_scan(Frame& F, int e) {
    const CAS Args& a = *F.a;
    LAS unsigned char* L = F.lds;
    constexpr int BUF = 57344, oW = 0, oQ = 16384, oA = 32768, oK = 40960;
    const int wave = F.wave;
    const unsigned char* gW = (const unsigned char*)(a.ws + WS_DW); const unsigned char* gQ = (const unsigned char*)(a.ws + WS_DQ);
    const unsigned char* gA = (const unsigned char*)(a.ws + WS_DAI); const unsigned char* gK = (const unsigned char*)(a.ws + WS_DKT);
    const bf16* gU = (const bf16*)(a.ws + WS_DUT); const float* gGL = (const float*)(a.ws + WS_DGL);
    for (int it = F.vcu; it < (2 * LAT_B + CTX_B) * 2 * NH; it += F.G) {
        int tid_ = F.tid; asm volatile("" : "+v"(tid_));
        const int lane = tid_ & 63, fr = lane & 15, fq = lane >> 4;
        const int r4 = lane >> 4, s16 = lane & 15, r8 = lane >> 3, s8 = lane & 7;
        int seq, dir, h, half = 0;
        if (it < 2 * LAT_B * 2 * NH) { half = it & 1; const int j = it >> 1; seq = CTX_B + j / (2 * NH); dir = (j / NH) & 1; h = j % NH; }
        else { const int j = it - 2 * LAT_B * 2 * NH; seq = j / (2 * NH); dir = (j / NH) & 1; h = j % NH; }
        const bool lat = seq >= CTX_B;
        const bool active = lat ? (wave < 4) : true;
        const int dvc = (lat ? half * 64 : 0) + (wave & (lat ? 3 : 7)) * 16 + fr;
        const int Ls = lat ? LAT_L : CTX_L, row0 = lat ? NCTX + (seq - CTX_B) * LAT_L : seq * CTX_L, nch = Ls / 64;
        const int cbase = lat ? 64 + (seq - CTX_B) * 16 : seq * 4;
        f32x4 S[8];
        if (lat) {
            const float* s0 = a.in[I_STATE] + ((((size_t)(seq - CTX_B) * 2 + e) * 2 + dir) * NH + h) * 128 * 128;
#pragma unroll
            for (int mf = 0; mf < 8; ++mf)
#pragma unroll
                for (int r = 0; r < 4; ++r) S[mf][r] = s0[(size_t)(mf * 16 + 4 * fq + r) * 128 + dvc];
        } else {
#pragma unroll
            for (int mf = 0; mf < 8; ++mf) S[mf] = (f32x4){0.f, 0.f, 0.f, 0.f};
        }
        float* O = (float*)(a.ws + (dir ? WS_OB : WS_OF));
#define DN_STAGE(bufi, rec_) do { LAS unsigned char* sb_ = L + (bufi) * BUF; const size_t ro_ = (size_t)(rec_); \
        _Pragma("unroll") for (int p_ = 0; p_ < 2; ++p_) { const int pc_ = wave + 8 * p_; const int rw_ = pc_ * 4 + r4; const int so_ = rw_ * 256 + ((s16 ^ (rw_ & 15)) << 4); \
            __builtin_amdgcn_global_load_lds((const unsigned*)(gW + ro_ * 16384 + so_), (LAS unsigned*)(sb_ + oW + pc_ * 1024), 16, 0, 0); \
            __builtin_amdgcn_global_load_lds((const unsigned*)(gQ + ro_ * 16384 + so_), (LAS unsigned*)(sb_ + oQ + pc_ * 1024), 16, 0, 0); \
            const int rk_ = pc_ * 8 + r8; const int sk_ = rk_ * 128 + ((s8 ^ ((rk_ >> 1) & 7)) << 4); \
            __builtin_amdgcn_global_load_lds((const unsigned*)(gK + ro_ * 16384 + sk_), (LAS unsigned*)(sb_ + oK + pc_ * 1024), 16, 0, 0); } \
        { const int ra_ = wave * 8 + r8; const int sa_ = ra_ * 128 + ((s8 ^ ((ra_ >> 1) & 7)) << 4); \
            __builtin_amdgcn_global_load_lds((const unsigned*)(gA + ro_ * 8192 + sa_), (LAS unsigned*)(sb_ + oA + wave * 1024), 16, 0, 0); } } while (0)
        __syncthreads();
        int rec = (cbase * NH + h) * 2 + dir;
        DN_STAGE(0, rec);
        u32x2 un[4]; float gln;
#pragma unroll
        for (int mf = 0; mf < 4; ++mf) un[mf] = *(const u32x2*)(gU + (size_t)rec * 8192 + dvc * 64 + mf * 16 + 4 * fq);
        gln = gGL[rec];
        for (int c = 0; c < nch; ++c) {
            asm volatile("s_waitcnt vmcnt(0)" ::: "memory");
            __syncthreads();
            u32x2 uc[4]; const float gl = gln;
#pragma unroll
            for (int mf = 0; mf < 4; ++mf) uc[mf] = un[mf];
            if (c + 1 < nch) {
                const int rn = rec + 2 * NH;
                DN_STAGE((c + 1) & 1, rn);
#pragma unroll
                for (int mf = 0; mf < 4; ++mf) un[mf] = *(const u32x2*)(gU + (size_t)rn * 8192 + dvc * 64 + mf * 16 + 4 * fq);
                gln = gGL[rn];
            }
            if (active) {
            LAS unsigned char* sb = L + (c & 1) * BUF;
            bf16x8 Sb[4];
#pragma unroll
            for (int ks = 0; ks < 4; ++ks) {
                u32x4 t; t.x = pk2(S[2 * ks][0], S[2 * ks][1]); t.y = pk2(S[2 * ks][2], S[2 * ks][3]); t.z = pk2(S[2 * ks + 1][0], S[2 * ks + 1][1]); t.w = pk2(S[2 * ks + 1][2], S[2 * ks + 1][3]);
                Sb[ks] = __builtin_bit_cast(bf16x8, t);
            }
            f32x4 vn[4], o[4];
#pragma unroll
            for (int mf = 0; mf < 4; ++mf) {
                vn[mf][0] = __builtin_bit_cast(float, uc[mf].x << 16); vn[mf][1] = __builtin_bit_cast(float, uc[mf].x & 0xffff0000u);
                vn[mf][2] = __builtin_bit_cast(float, uc[mf].y << 16); vn[mf][3] = __builtin_bit_cast(float, uc[mf].y & 0xffff0000u);
                o[mf] = (f32x4){0.f, 0.f, 0.f, 0.f};
#pragma unroll
                for (int ks = 0; ks < 4; ++ks) {
                    const bf16x8 wf = *(const LAS bf16x8*)(sb + oW + sw256(mf * 16 + fr, ks * 4 + fq));
                    const bf16x8 qf = *(const LAS bf16x8*)(sb + oQ + sw256(mf * 16 + fr, ks * 4 + fq));
                    vn[mf] = MFMA16(wf, Sb[ks], vn[mf]);
                    o[mf] = MFMA16(qf, Sb[ks], o[mf]);
                }
            }
            bf16x8 Vb[2];
#pragma unroll
            for (int ks = 0; ks < 2; ++ks) {
                u32x4 t; t.x = pk2(vn[2 * ks][0], vn[2 * ks][1]); t.y = pk2(vn[2 * ks][2], vn[2 * ks][3]); t.z = pk2(vn[2 * ks + 1][0], vn[2 * ks + 1][1]); t.w = pk2(vn[2 * ks + 1][2], vn[2 * ks + 1][3]);
                Vb[ks] = __builtin_bit_cast(bf16x8, t);
            }
#pragma unroll
            for (int mf = 0; mf < 4; ++mf)
#pragma unroll
                for (int ks = 0; ks < 2; ++ks) {
                    const bf16x8 af = *(const LAS bf16x8*)(sb + oA + sw128(mf * 16 + fr, ks * 4 + fq));
                    o[mf] = MFMA16(af, Vb[ks], o[mf]);
                }
#pragma unroll
            for (int mf = 0; mf < 8; ++mf) {
                S[mf] = S[mf] * gl;
#pragma unroll
                for (int ks = 0; ks < 2; ++ks) {
                    const bf16x8 kf = *(const LAS bf16x8*)(sb + oK + sw128(mf * 16 + fr, ks * 4 + fq));
                    S[mf] = MFMA16(kf, Vb[ks], S[mf]);
                }
            }
#pragma unroll
            for (int mf = 0; mf < 4; ++mf)
#pragma unroll
                for (int r = 0; r < 4; ++r) {
                    const int step = c * 64 + mf * 16 + 4 * fq + r, row = row0 + (dir ? (Ls - 1 - step) : step);
                    O[(size_t)row * 768 + h * 128 + dvc] = o[mf][r];
                }
            }
            rec += 2 * NH;
        }
#undef DN_STAGE
        if (!lat) {
            float* so = a.out + (size_t)M * D + ((((size_t)seq * 2 + e) * 2 + dir) * NH + h) * 128 * 128;
#pragma unroll
            for (int mf = 0; mf < 8; ++mf)
#pragma unroll
                for (int r = 0; r < 4; ++r) so[(size_t)(mf * 16 + 4 * fq + r) * 128 + dvc] = S[mf][r];
        }
    }
    __syncthreads();
}

__device__ __forceinline__ void phase_dn_fin(Frame& F, int e) {
    const CAS Args& a = *F.a;
    const bf16* P = (const bf16*)(a.ws + WS_P);
    const float* OF = (const float*)(a.ws + WS_OF); const float* OB = (const float*)(a.ws + WS_OB);
    bf16* Y = (bf16*)(a.ws + WS_Y);
    const float* nw = a.in[I_DNNW] + e * 128;
    const int gw = F.vcu * 8 + F.wave, NGW = F.G * 8;
    for (int it = gw; it < M * NH; it += NGW) {
        const int row = it / NH, h = it % NH, c2 = F.lane * 2;
        const size_t o = (size_t)row * 768 + h * 128 + c2;
        const f32x2 v = *(const f32x2*)(OF + o) + *(const f32x2*)(OB + o);
        const float ms = wave_sum(v[0] * v[0] + v[1] * v[1]) * (1.f / 128.f);
        const float rs = rsq_f(ms + EPS);
        const unsigned zr = *(const unsigned*)(P + (size_t)row * LDP + 2560 + h * 128 + c2);
        const f32x2 z = {__builtin_bit_cast(float, zr << 16), __builtin_bit_cast(float, zr & 0xffff0000u)};
        const f32x2 w = *(const f32x2*)(nw + c2);
        *(unsigned*)(Y + (size_t)row * D + 256 + h * 128 + c2) = pk2(v[0] * rs * w[0] * silu_f(z[0]), v[1] * rs * w[1] * silu_f(z[1]));
    }
    const float* pw = a.in[I_POOLW] + (size_t)e * 4 * 64 * 64; const float* ps = a.in[I_POOLS] + e * 256;
    LAS float* xs = (LAS float*)F.lds;
    LAS float* dl = xs + 80 * 64;
    LAS float* wl = dl + 64 * 65;
    for (int it = F.vcu; it < (M / 64) * 4; it += F.G) {
        const int blk = it >> 2, g = it & 3, r0 = blk * 64; int s0, Ls; seq_of_row(r0, s0, Ls);
        __syncthreads();
        for (int i = F.tid; i < 80 * 16; i += 512) {
            const int rr = i >> 4, c4 = (i & 15) * 4, row = r0 - 8 + rr;
            const bool in = (row >= s0) && (row < s0 + Ls);
            const u32x2 pr = in ? *(const u32x2*)(P + (size_t)row * LDP + g * 64 + c4) : (u32x2){0, 0};
            *(LAS f32x4*)(xs + rr * 64 + c4) = (f32x4){__builtin_bit_cast(float, pr.x << 16), __builtin_bit_cast(float, pr.x & 0xffff0000u), __builtin_bit_cast(float, pr.y << 16), __builtin_bit_cast(float, pr.y & 0xffff0000u)};
        }
        for (int i = F.tid; i < 1024; i += 512) *(LAS f32x4*)(wl + i * 4) = *(const f32x4*)(pw + g * 4096 + i * 4);
        __syncthreads();
        {
            const int t = F.tid >> 3, c8 = (F.tid & 7) * 8, row = r0 + t, tl = row - s0, half = 1 << g;
            const int lo = max(tl - half, 0), hi = min(tl + half, Ls);
            float sum[8];
#pragma unroll
            for (int q = 0; q < 8; ++q) sum[q] = 0.f;
            for (int p = lo; p < hi; ++p) {
                const LAS float* xr = xs + (p - tl + t + 8) * 64 + c8;
                const f32x4 a0 = *(const LAS f32x4*)xr, a1 = *(const LAS f32x4*)(xr + 4);
#pragma unroll
                for (int q = 0; q < 4; ++q) { sum[q] += a0[q]; sum[4 + q] += a1[q]; }
            }
            const float inv = 1.0f / (float)(hi - lo);
            const LAS float* xc = xs + (t + 8) * 64 + c8;
#pragma unroll
            for (int q = 0; q < 8; ++q) dl[t * 65 + c8 + q] = sum[q] * inv - xc[q];
        }
        __syncthreads();
        {
            const int t = F.tid >> 3, e8 = (F.tid & 7) * 8;
            float y[8];
#pragma unroll
            for (int q = 0; q < 8; ++q) y[q] = 0.f;
            for (int c = 0; c < 64; ++c) {
                const float d = dl[t * 65 + c];
                const f32x4 w0 = *(const LAS f32x4*)(wl + c * 64 + e8), w1 = *(const LAS f32x4*)(wl + c * 64 + e8 + 4);
#pragma unroll
                for (int q = 0; q < 4; ++q) { y[q] += d * w0[q]; y[4 + q] += d * w1[q]; }
            }
            const f32x4 s0v = *(const f32x4*)(ps + g * 64 + e8), s1v = *(const f32x4*)(ps + g * 64 + e8 + 4);
            u32x4 o; o.x = pk2(y[0] * s0v[0], y[1] * s0v[1]); o.y = pk2(y[2] * s0v[2], y[3] * s0v[3]); o.z = pk2(y[4] * s1v[0], y[5] * s1v[1]); o.w = pk2(y[6] * s1v[2], y[7] * s1v[3]);
            *(u32x4*)(Y + (size_t)(r0 + t) * D + g * 64 + e8) = o;
        }
    }
    __syncthreads();
}

struct EpiOdd {
    bf16* G; float* ZR; float* ZI; float* ST; Pre pre;
    template <int NFRAG> struct Hold { PreHold ph; };
    template <int NFRAG> __device__ __forceinline__ void preload(Hold<NFRAG>& h, int, int, int tid, int row0, int col0) const { pre_fetch(pre, h.ph, tid, row0, col0, 32 * NFRAG); }
    template <int NFRAG> __device__ __forceinline__ void stage(const Hold<NFRAG>& h, LAS float* sc, int tid) const { pre_write(h.ph, sc, tid, 32 * NFRAG); }
    template <int NFRAG> __device__ __forceinline__ void operator()(f32x4 (&acc)[3][NFRAG], const Hold<NFRAG>&, int row, int colq, int fq, const LAS float* sc, int lrow, int lcol) const {
        const int ct = colq >> 8;
        constexpr int RB = 32 * NFRAG, PB = RB + 16;
        const int wm = lrow / 48, wn = lcol / (16 * NFRAG), fr = lrow - wm * 48, lane = fq * 16 + fr;
        LAS unsigned char* img = (LAS unsigned char*)sc + 8192 + (wm * 2 + wn) * (48 * PB);
        if (ct < 6) {
#pragma unroll
            for (int mf = 0; mf < 3; ++mf) {
                const int rr = row + mf * 16; float s1 = 0.f, s2 = 0.f;
                const float rs = sc[lrow + mf * 16]; const LAS float* bp = sc + 256 + cond_of_row(rr) * (32 * NFRAG) + lcol;
#pragma unroll
                for (int nf = 0; nf < NFRAG; ++nf) {
                    const f32x4 v = acc[mf][nf] * rs + *(const LAS f32x4*)(bp + nf * 16);
                    const float g0 = gelu_tanh(v[0]), g1 = gelu_tanh(v[1]), g2 = gelu_tanh(v[2]), g3 = gelu_tanh(v[3]);
                    u32x2 w; w.x = pk2(g0, g1); w.y = pk2(g2, g3);
                    *(LAS u32x2*)(img + (mf * 16 + fr) * PB + nf * 32 + fq * 8) = w;
                    s1 += (g0 + g1) + (g2 + g3); s2 += (g0 * g0 + g1 * g1) + (g2 * g2 + g3 * g3);
                }
                if (ct >= 3) {
                    s1 += __shfl_xor(s1, 16); s1 += __shfl_xor(s1, 32); s2 += __shfl_xor(s2, 16); s2 += __shfl_xor(s2, 32);
                    if (fq == 0) { atomicAdd(ST + (size_t)rr * 2, s1); atomicAdd(ST + (size_t)rr * 2 + 1, s2); }
                }
            }
            image_store<RB, PB>(img, (unsigned char*)(G + (size_t)(row - fr) * 1536 + (colq - fq * 4)), (size_t)1536 * 2, lane);
        } else {
            float* Z = (ct == 6) ? ZR : ZI; const int cb = colq - ct * 256;
#pragma unroll
            for (int mf = 0; mf < 3; ++mf) {
                const int rr = row + mf * 16; const float rs = sc[lrow + mf * 16]; const LAS float* bp = sc + 256 + cond_of_row(rr) * (32 * NFRAG) + lcol;
#pragma unroll
                for (int nf = 0; nf < NFRAG; ++nf) *(f32x4*)(Z + (size_t)rr * 256 + cb + nf * 16) = acc[mf][nf] * rs + *(const LAS f32x4*)(bp + nf * 16);
            }
        }
    }
};

constexpr double c_pi = 3.14159265358979323846;
constexpr double c_sin_poly(double x) { double t = x, s = x; for (int i = 1; i < 14; ++i) { t *= -x * x / ((2 * i) * (2 * i + 1)); s += t; } return s; }
constexpr double c_cos_poly(double x) { double t = 1, s = 1; for (int i = 1; i < 14; ++i) { t *= -x * x / ((2 * i - 1) * (2 * i)); s += t; } return s; }
constexpr int c_bitrev(int x, int n) { int r = 0; for (int b = 1; b < n; b <<= 1) { r = (r << 1) | (x & 1); x >>= 1; } return r; }
template <int N, int HALF, int BASE, int J>
__device__ __forceinline__ void fft_bf(float (&re)[N], float (&im)[N]) {
    constexpr int ia = BASE + J, ib = ia + HALF;
    constexpr float c = (float)c_cos_poly(c_pi * J / HALF), s = (float)c_sin_poly(c_pi * J / HALF);
    const float ar = re[ia], ai = im[ia], br = re[ib], bi = im[ib];
    re[ia] = ar + br; im[ia] = ai + bi;
    const float dr = ar - br, di = ai - bi;
    if constexpr (J == 0) { re[ib] = dr; im[ib] = di; }
    else if constexpr (2 * J == HALF) { re[ib] = di; im[ib] = -dr; }
    else { re[ib] = dr * c + di * s; im[ib] = di * c - dr * s; }
    if constexpr (J + 1 < HALF) fft_bf<N, HALF, BASE, J + 1>(re, im);
    else if constexpr (BASE + 2 * HALF < N) fft_bf<N, HALF, BASE + 2 * HALF, 0>(re, im);
    else if constexpr (HALF > 1) fft_bf<N, HALF / 2, 0, 0>(re, im);
}
template <int R, int P>
__device__ __forceinline__ void fa_store(const float (&zr)[R], const float (&zi)[R], float* BR, float* BI, int row0, int n2, int col, const LAS float* twN) {
    constexpr int k1 = c_bitrev(P, R);
    const int t = k1 * n2; const float c = twN[t], s = twN[R * R + t];
    const size_t o = (size_t)(row0 + k1 * R + n2) * 256 + col;
    BR[o] = c * zr[P] + s * zi[P]; BI[o] = c * zi[P] - s * zr[P];
    if constexpr (P + 1 < R) fa_store<R, P + 1>(zr, zi, BR, BI, row0, n2, col, twN);
}
template <int R>
__device__ __forceinline__ void fourier_a_item(const float* ZR, const float* ZI, float* BR, float* BI, int row0, int n2, const LAS float* twN, int col) {
    float zr[R], zi[R];
#pragma unroll
    for (int n1 = 0; n1 < R; ++n1) { const size_t o = (size_t)(row0 + R * n1 + n2) * 256 + col; zr[n1] = ZR[o]; zi[n1] = ZI[o]; }
    fft_bf<R, R / 2, 0, 0>(zr, zi);
    fa_store<R, 0>(zr, zi, BR, BI, row0, n2, col, twN);
}
template <int R, int P>
__device__ __forceinline__ void fc_store(const float (&br)[R], bf16* Y, int row0, int k1, int col) {
    constexpr int k2 = c_bitrev(P, R);
    Y[(size_t)(row0 + k1 + R * k2) * D + 768 + col] = (bf16)f2bf(br[P] * (1.0f / R));
    if constexpr (P + 1 < R) fc_store<R, P + 1>(br, Y, row0, k1, col);
}
template <int R>
__device__ __forceinline__ void fourier_c_item(const float* BR, const float* BI, bf16* Y, int row0, int k1, int col) {
    float br[R], bi[R];
#pragma unroll
    for (int n2 = 0; n2 < R; ++n2) { const size_t o = (size_t)(row0 + k1 * R + n2) * 256 + col; br[n2] = BR[o]; bi[n2] = BI[o]; }
    fft_bf<R, R / 2, 0, 0>(br, bi);
    fc_store<R, 0>(br, Y, row0, k1, col);
}
__device__ __forceinline__ void fourier_tables(LAS float* tw, int tid) {
    for (int i = tid; i < 1024; i += 512) { const float x = (float)i * (1.f / 512.f); tw[64 + i] = cospif(x); tw[64 + 1024 + i] = sinpif(x); }
    if (tid < 256) { const float x = (float)tid * (1.f / 128.f); tw[2144 + tid] = cospif(x); tw[2144 + 256 + tid] = sinpif(x); }
    if (tid < 32) { const float x = (float)tid * (1.f / 16.f); tw[tid] = cospif(x); tw[32 + tid] = sinpif(x); }
    if (tid < 16) { const float x = (float)tid * (1.f / 8.f); tw[2112 + tid] = cospif(x); tw[2112 + 16 + tid] = sinpif(x); }
}

__device__ __forceinline__ void phase_odd_mix(Frame& F, int j) {
    const CAS Args& a = *F.a;
    const bf16* G = (const bf16*)(a.ws + WS_P); bf16* Y = (bf16*)(a.ws + WS_Y);
    const float* ZR = (const float*)(a.ws + WS_ZR); const float* ZI = (const float*)(a.ws + WS_ZI);
    float* BR = (float*)(a.ws + WS_QN); float* BI = (float*)(a.ws + WS_KN);
    const float* ST = (const float*)(a.ws + WS_CTL + CTL_ST_OFF) + (size_t)j * M * 2;
    LAS unsigned char* L = F.lds;
    LAS float* tw = (LAS float*)(L + 65536);
    fourier_tables(tw, F.tid);
    __syncthreads();
    const int wave = F.wave;
    constexpr int NA_LAT = LAT_B * 32 / 2, NSGU = (M / 128) * NH, NA_CTX = CTX_B * 16 / 2;
    for (int it = F.vcu; it < NA_LAT + NSGU + NA_CTX; it += F.G) {
        int tid_ = F.tid; asm volatile("" : "+v"(tid_));
        if (it < NA_LAT) { const int q = it * 2 + (tid_ >> 8); fourier_a_item<32>(ZR, ZI, BR, BI, NCTX + (q >> 5) * LAT_L, q & 31, tw + 64, tid_ & 255); continue; }
        if (it >= NA_LAT + NSGU) { const int q = (it - NA_LAT - NSGU) * 2 + (tid_ >> 8); fourier_a_item<16>(ZR, ZI, BR, BI, (q >> 4) * CTX_L, q & 15, tw + 2144, tid_ & 255); continue; }
        const int q = it - NA_LAT, ch = q / NH, h = q % NH, r0 = ch * 128;
        const int lane = tid_ & 63, fr = lane & 15, fq = lane >> 4;
        __syncthreads();
        {
            const int s = tid_ >> 2, cq = tid_ & 3, row = r0 + s;
            const float s1 = ST[(size_t)row * 2], s2 = ST[(size_t)row * 2 + 1];
            const float mu = s1 * (1.f / 768.f), var = s2 * (1.f / 768.f) - mu * mu, rstd = rsq_f(fmaxf(var, 0.f) + EPS);
            const bf16* gp = G + (size_t)row * 1536 + 768 + h * 128 + cq * 32;
            const float* nw = a.in[I_SGUN] + j * 768 + h * 128 + cq * 32;
#pragma unroll
            for (int v8 = 0; v8 < 4; ++v8) {
                const u32x4 raw = *(const u32x4*)(gp + v8 * 8);
                const unsigned wds[4] = {raw.x, raw.y, raw.z, raw.w};
#pragma unroll
                for (int e2 = 0; e2 < 4; ++e2) {
                    const float g0 = __builtin_bit_cast(float, wds[e2] << 16), g1 = __builtin_bit_cast(float, wds[e2] & 0xffff0000u);
                    const int c0 = cq * 32 + v8 * 8 + e2 * 2;
                    const float v0 = (g0 - mu) * rstd * nw[v8 * 8 + e2 * 2], v1 = (g1 - mu) * rstd * nw[v8 * 8 + e2 * 2 + 1];
                    *(LAS bf16*)(L + c0 * 256 + (((s >> 3) ^ (c0 & 15)) << 4) + (s & 7) * 2) = (bf16)f2bf(v0);
                    *(LAS bf16*)(L + (c0 + 1) * 256 + (((s >> 3) ^ ((c0 + 1) & 15)) << 4) + (s & 7) * 2) = (bf16)f2bf(v1);
                }
            }
        }
        __syncthreads();
        {
            const bf16* Wb = (const bf16*)(a.ws + WS_SGUW) + ((size_t)j * NH + h) * 16384;
            f32x4 acc[8];
#pragma unroll
            for (int pf = 0; pf < 8; ++pf) acc[pf] = (f32x4){0.f, 0.f, 0.f, 0.f};
#pragma unroll
            for (int ks = 0; ks < 4; ++ks) {
                const bf16x8 av = *(const LAS bf16x8*)(L + (wave * 16 + fr) * 256 + (((ks * 4 + fq) ^ fr) << 4));
#pragma unroll
                for (int pf = 0; pf < 8; ++pf) {
                    const bf16x8 bw = *(const bf16x8*)(Wb + (pf * 16 + fr) * 128 + ks * 32 + fq * 8);
                    acc[pf] = MFMA16(av, bw, acc[pf]);
                }
            }
            const float* bs = a.in[I_SGUB] + ((size_t)j * NH + h) * 128;
#pragma unroll
            for (int pf = 0; pf < 8; ++pf) {
                const int p = pf * 16 + fr, row = r0 + p, c = wave * 16 + 4 * fq; const float b = bs[p];
                const u32x2 gu = *(const u32x2*)(G + (size_t)row * 1536 + h * 128 + c);
                const float u0 = __builtin_bit_cast(float, gu.x << 16), u1 = __builtin_bit_cast(float, gu.x & 0xffff0000u), u2 = __builtin_bit_cast(float, gu.y << 16), u3 = __builtin_bit_cast(float, gu.y & 0xffff0000u);
                u32x2 o; o.x = pk2(u0 * (acc[pf][0] + b), u1 * (acc[pf][1] + b)); o.y = pk2(u2 * (acc[pf][2] + b), u3 * (acc[pf][3] + b));
                *(u32x2*)(Y + (size_t)row * D + h * 128 + c) = o;
            }
        }
    }
    __syncthreads();
}
__device__ __forceinline__ void phase_odd_fc(Frame& F) {
    const CAS Args& a = *F.a;
    const float* BR = (const float*)(a.ws + WS_QN); const float* BI = (const float*)(a.ws + WS_KN); bf16* Y = (bf16*)(a.ws + WS_Y);
    constexpr int NC_LAT = LAT_B * 32 / 2, NC_CTX = CTX_B * 16 / 2;
    for (int it = F.vcu; it < NC_LAT + NC_CTX; it += F.G) {
        int tid_ = F.tid; asm volatile("" : "+v"(tid_));
        if (it < NC_LAT) { const int q = it * 2 + (tid_ >> 8); fourier_c_item<32>(BR, BI, Y, NCTX + (q >> 5) * LAT_L, q & 31, tid_ & 255); }
        else { const int q = (it - NC_LAT) * 2 + (tid_ >> 8); fourier_c_item<16>(BR, BI, Y, (q >> 4) * CTX_L, q & 15, tid_ & 255); }
    }
    __syncthreads();
}

constexpr int STEPS = 9, N_PHASES = 2 + DEPTH * STEPS + 1;
__device__ __forceinline__ bool phase_active(int ph) {
    if (ph < 2 || ph == N_PHASES - 1) return true;
    const int l = (ph - 2) / STEPS, st = (ph - 2) % STEPS;
    return !((l & 1) && st == 5);
}
__device__ __forceinline__ void run_phase(Frame& F, int ph) {
    const CAS Args& a = *F.a; unsigned char* ws = a.ws;
    if (ph == 0) { phase_setup(F); return; }
    if (ph == 1) { phase_init(F); return; }
    if (ph == N_PHASES - 1) { phase_final(F); return; }
    const int l = (ph - 2) / STEPS, st = (ph - 2) % STEPS, e = l >> 1;
    bf16* XS = (bf16*)(ws + WS_HN); bf16* HH = (bf16*)(ws + WS_HH); float* X = (float*)(ws + WS_X); float* P = (float*)(ws + WS_P);
    const bf16* Y = (const bf16*)(ws + WS_Y); const float* mod = (const float*)(ws + WS_MOD);
    float* ssb = (float*)(ws + WS_CTL + CTL_SS_OFF); const float* biasb = (const float*)(ws + WS_BIAS);
#define PRE_OF(s_) Pre{ssb + (size_t)(s_) * M, biasb + (size_t)(s_) * 3 * NBMAX}
    switch (st) {
        case 0: { EpiUp E{HH, PRE_OF(3 * l)}; gemm_phase<11, EpiUp>(F, XS, (const bf16*)(ws + WS_WUP + (size_t)(l * 2) * WUP_SZ), D, NUP, E); } break;
        case 1: { EpiRes E{X, mod, l, 2, 0.5f, XS, ssb + (size_t)(3 * l + 1) * M, a.in[I_MIXN] + l * D, l, 1}; gemm_phase<4, EpiRes>(F, HH, (const bf16*)(ws + WS_WDN + (size_t)(l * 2) * WDN_SZ), FF, D, E); } break;
        case 2: { if ((l & 1) == 0) { EpiStore E{(bf16*)(ws + WS_P), (float*)(ws + WS_AG), PRE_OF(3 * l + 1)}; gemm_phase<7, EpiStore>(F, XS, (const bf16*)(ws + WS_EVIN + (size_t)e * EVIN_SZ), D, P_EVEN_PAD, E); }
                  else { EpiOdd EO{(bf16*)(ws + WS_P), (float*)(ws + WS_ZR), (float*)(ws + WS_ZI), (float*)(ws + WS_CTL + CTL_ST_OFF) + (size_t)e * M * 2, PRE_OF(3 * l + 1)};
                         gemm_phase<8, EpiOdd>(F, XS, (const bf16*)(ws + WS_ODIN + (size_t)e * ODIN_SZ), D, 2048, EO); } } break;
        case 3: if ((l & 1) == 0) phase_dn_prep(F, e); else phase_odd_mix(F, e); break;
        case 4: if ((l & 1) == 0) phase_dn_scan(F, e); else phase_odd_fc(F); break;
        case 5: if ((l & 1) == 0) phase_dn_fin(F, e); break;
        case 6: { EpiRes E{X, mod, l, 5, 1.0f, XS, ssb + (size_t)(3 * l + 2) * M, a.in[I_F2N] + l * D, l, 2}; gemm_phase<4, EpiRes>(F, Y, (const bf16*)(ws + ((l & 1) ? WS_ODOUT : WS_EVOUT) + (size_t)e * SQ_SZ), D, D, E); } break;
        case 7: { EpiUp E{HH, PRE_OF(3 * l + 2)}; gemm_phase<11, EpiUp>(F, XS, (const bf16*)(ws + WS_WUP + (size_t)(l * 2 + 1) * WUP_SZ), D, NUP, E); } break;
        case 8: { const bool last = (l == DEPTH - 1);
                  EpiRes E{X, mod, l, 8, 0.5f, XS, last ? nullptr : ssb + (size_t)(3 * l + 3) * M, a.in[I_F1N] + (last ? l : l + 1) * D, last ? l : l + 1, 0};
                  gemm_phase<4, EpiRes>(F, HH, (const bf16*)(ws + WS_WDN + (size_t)(l * 2 + 1) * WDN_SZ), FF, D, E); } break;
    }
#undef PRE_OF
}

__global__ void __launch_bounds__(512, 2) mk_fwd(Args args) {
    extern __shared__ __attribute__((aligned(16))) unsigned char lds_raw[];
    Frame F;
    F.lds = (LAS unsigned char*)lds_raw;
    F.tid = threadIdx.x; F.lane = F.tid & 63; F.wave = __builtin_amdgcn_readfirstlane(F.tid >> 6);
    F.G = gridDim.x; { const int bx = blockIdx.x; F.vcu = (F.G % 8 == 0) ? (bx % 8) * (F.G / 8) + bx / 8 : bx; }
    const CAS Args* ap = (const CAS Args*)__builtin_amdgcn_kernarg_segment_ptr();
    F.a = ap;
    const int ph_lo = ap->ph_lo, ph_hi = ap->ph_hi;
    unsigned char* ws0 = ap->ws;
    volatile LAS unsigned* MISC = (volatile LAS unsigned*)(F.lds + LDS_MISC);
    if (F.tid < 64) MISC[F.tid] = 0u;
    __syncthreads();
    const bool multi = (ph_hi - ph_lo) > 1;
    XcdBarrier bar; bar.bar = (unsigned*)(ws0 + WS_CTL) + CW_BAR; bar.x = 0; bar.st = MISC + 8;
    if (multi) bar = xcd_barrier_post((unsigned*)(ws0 + WS_CTL) + CW_BAR, MISC + 8);
    for (int ph = ph_lo; ph < ph_hi; ++ph) {
        { const CAS Args* a2 = ap; asm volatile("" : "+s"(a2)); F.a = a2; }
        { int t_ = threadIdx.x; asm volatile("" : "+v"(t_)); F.tid = t_; F.lane = t_ & 63; F.wave = __builtin_amdgcn_readfirstlane(t_ >> 6); }
        if (!phase_active(ph)) continue;
        run_phase(F, ph);
        if (ph + 1 < ph_hi) xcd_barrier(bar);
    }
}

extern "C" void kernel_launch(void* const* d_in, const int* in_sizes, int n_in, void* d_out, int out_size, void* d_ws, size_t ws_size, hipStream_t stream) {
    static int grid = 0;
    if (grid == 0) {
        if (n_in != 31 || ws_size < WS_END) { fprintf(stderr, "kernel_launch: unexpected n_in %d or ws_size %zu (need %zu)\n", n_in, ws_size, (size_t)WS_END); grid = -1; return; }
        int dev = 0, cus = 0;
        if (hipGetDevice(&dev) != hipSuccess || hipDeviceGetAttribute(&cus, hipDeviceAttributeMultiprocessorCount, dev) != hipSuccess) { grid = -1; return; }
        if (hipFuncSetAttribute((const void*)mk_fwd, hipFuncAttributeMaxDynamicSharedMemorySize, LDS_BYTES) != hipSuccess) { fprintf(stderr, "kernel_launch: hipFuncSetAttribute failed\n"); grid = -1; return; }
        (void)hipGetLastError();
        grid = cus;
    }
    if (grid < 0) return;
    (void)hipMemsetAsync((char*)d_ws + WS_CTL, 0, CTL_BYTES, stream);
    (void)hipMemsetAsync((char*)d_ws + WS_MOD, 0, (size_t)4 * 3 * 9216 * 4, stream);
    (void)hipMemsetAsync((char*)d_ws + WS_BIAS, 0, (size_t)12 * 3 * NBMAX * 4, stream);
    Args a{};
    for (int i = 0; i < 31; ++i) a.in[i] = (const float*)d_in[i];
    a.out = (float*)d_out; a.ws = (unsigned char*)d_ws;
#if ONE_LAUNCH
    a.ph_lo = 0; a.ph_hi = N_PHASES;
    hipLaunchKernelGGL(mk_fwd, dim3(grid), dim3(512), LDS_BYTES, stream, a);
#else
    for (int ph = 0; ph < N_PHASES; ++ph) {
        a.ph_lo = ph; a.ph_hi = ph + 1;
        hipLaunchKernelGGL(mk_fwd, dim3(grid), dim3(512), LDS_BYTES, stream, a);
    }
#endif
}
```

```cpp
#include <hip/hip_runtime.h>
#include <cstdio>
#include <cstdint>

#ifndef ONE_LAUNCH
#define ONE_LAUNCH 1
#endif

#define GAS __attribute__((address_space(1)))
#define LAS __attribute__((address_space(3)))
#define CAS __attribute__((address_space(4)))
typedef unsigned short bf16;
typedef float f32x4 __attribute__((ext_vector_type(4)));
typedef float f32x2 __attribute__((ext_vector_type(2)));
typedef short bf16x8 __attribute__((ext_vector_type(8)));
typedef unsigned u32x4 __attribute__((ext_vector_type(4)));
typedef unsigned u32x2 __attribute__((ext_vector_type(2)));

constexpr int D = 1024, NCTX = 4096, NLAT = 2048, M = 6144, FF = 2816, DEPTH = 4;
constexpr int CTX_B = 16, CTX_L = 256, LAT_B = 2, LAT_L = 1024;
constexpr int NUP = 2 * FF;
constexpr int P_EVEN = 3352, P_EVEN_PAD = 3584, P_ODD = 1792;
constexpr int LDP = 3584;
constexpr int NH = 6, DK = 128;
constexpr float EPS = 1e-6f;
constexpr int NSEQ = CTX_B + LAT_B;

constexpr size_t MiB = 1u << 20;
constexpr size_t WS_CTL = 0, CTL_BYTES = 1 * MiB;
constexpr size_t WS_MOD = 1 * MiB;
constexpr size_t WS_WUP = 2 * MiB, WUP_SZ = 11 * MiB;
constexpr size_t WS_WDN = 90 * MiB, WDN_SZ = 5632 * 1024;
constexpr size_t WS_EVIN = 134 * MiB, EVIN_SZ = 7 * MiB;
constexpr size_t WS_EVOUT = 148 * MiB, SQ_SZ = 2 * MiB;
constexpr size_t WS_ODIN = 152 * MiB, ODIN_SZ = 4 * MiB;
constexpr size_t WS_ODOUT = 160 * MiB;
constexpr size_t WS_X = 164 * MiB;
constexpr size_t WS_HN = 188 * MiB;
constexpr size_t WS_HH = 200 * MiB;
constexpr size_t WS_P = 233 * MiB;
constexpr size_t WS_Y = 317 * MiB;
constexpr size_t WS_QN = 329 * MiB, WS_KN = 347 * MiB, WS_VV = 365 * MiB, WS_OF = 383 * MiB, WS_OB = 401 * MiB;
constexpr size_t WS_AG = 419 * MiB, WS_BT = 420 * MiB;
constexpr size_t WS_ZR = 421 * MiB, WS_ZI = 427 * MiB, WS_SPEC = 433 * MiB;
constexpr size_t WS_DW = 439 * MiB, WS_DQ = 457 * MiB, WS_DAI = 475 * MiB, WS_DKT = 484 * MiB, WS_DUT = 502 * MiB, WS_DGL = 520 * MiB;
constexpr size_t WS_BIAS = 521 * MiB;
constexpr size_t WS_END = 522 * MiB;

constexpr size_t CTL_ST_OFF = 262144;
constexpr size_t CTL_SS_OFF = 524288;
constexpr int NBMAX = 5632;
constexpr size_t WS_SGUW = 1 * MiB + 512 * 1024;
constexpr int CW_GXCC = 8192;
constexpr int CW_GCNT = 16384;
constexpr int CW_BAR = 4096;

constexpr int LDS_MAIN = 160768;
constexpr int LDS_MISC = LDS_MAIN;
constexpr int LDS_BYTES = LDS_MAIN + 1024;

__device__ __forceinline__ float wave_sum(float v) {
#pragma unroll
    for (int o = 1; o < 64; o <<= 1) v += __shfl_xor(v, o);
    return v;
}
typedef __bf16 bf16x2_t __attribute__((ext_vector_type(2)));
__device__ __forceinline__ unsigned pk2(float lo, float hi) { const f32x2 v = {lo, hi}; const bf16x2_t b = __builtin_convertvector(v, bf16x2_t); return __builtin_bit_cast(unsigned, b); }
__device__ __forceinline__ unsigned f2bf(float f) { return pk2(f, 0.f) & 0xffffu; }
__device__ __forceinline__ float rcp_f(float x) { return __builtin_amdgcn_rcpf(x); }
__device__ __forceinline__ float rsq_f(float x) { return __builtin_amdgcn_rsqf(x); }
__device__ __forceinline__ float silu_f(float x) { return x * rcp_f(1.f + __expf(-x)); }
__device__ __forceinline__ float sigmoid_f(float x) { return rcp_f(1.f + __expf(-x)); }
__device__ __forceinline__ float gelu_tanh(float x) { const float u2 = 1.5957691216057308f * (x + 0.044715f * x * x * x); return x * rcp_f(1.f + __expf(-u2)); }
__device__ __forceinline__ float softplus_f(float x) { return x > 20.f ? x : log1pf(expf(x)); }
__device__ __forceinline__ int cond_of_row(int r) { return r < NCTX ? 0 : (r < NCTX + LAT_L ? 1 : 2); }
__device__ __forceinline__ void seq_of_row(int r, int& s0, int& L) { if (r < NCTX) { s0 = r & ~(CTX_L - 1); L = CTX_L; } else { s0 = NCTX + ((r - NCTX) & ~(LAT_L - 1)); L = LAT_L; } }

#define XB_TMO      128
#define XB_XCNT(j)  (256  + 64 * (j))
#define XB_XSUB(j)  (1280 + 64 * (j))
#define XB_XGEN(j)  (2304 + 64 * (j))
#define XB_TOP      3328
#define XB_TOPGEN   3392
#define XCD_BAR_WORDS 3456
#define XB_SPIN_CAP (1u << 18)
__device__ __forceinline__ unsigned xb_ld(unsigned* p)              { return __hip_atomic_load(p, __ATOMIC_RELAXED, __HIP_MEMORY_SCOPE_AGENT); }
__device__ __forceinline__ unsigned xb_add(unsigned* p, unsigned v) { return __hip_atomic_fetch_add(p, v, __ATOMIC_RELAXED, __HIP_MEMORY_SCOPE_AGENT); }
__device__ __forceinline__ unsigned xb_xcc_id() { return (unsigned)__builtin_amdgcn_s_getreg((3 << 11) | 20) & 0xFu; }
#define XB_SPIN(cond, bar) do { unsigned _sp = 0; while (cond) { __builtin_amdgcn_s_sleep(1); \
    if ((++_sp & 255u) == 0u) { if (xb_ld(&(bar)[XB_TMO])) break; if (_sp > XB_SPIN_CAP) { atomicAdd(&(bar)[XB_TMO], 1u); break; } } } } while (0)
struct XcdBarrier { unsigned* bar; unsigned x; volatile LAS unsigned* st; };
__device__ __forceinline__ XcdBarrier xcd_barrier_post(unsigned* bar, volatile LAS unsigned* st) {
    XcdBarrier b; b.bar = bar; b.x = xb_xcc_id(); b.st = st;
    if (threadIdx.x == 0) (void)xb_add(&bar[XB_XCNT(b.x)], 1u);
    return b;
}
__device__ __forceinline__ void xcd_barrier_complete(unsigned* bar, unsigned x, unsigned& nloc, unsigned& nx) {
    const unsigned G = gridDim.x * gridDim.y * gridDim.z;
    unsigned sum, cnt, mine, sp = 0u;
    for (;;) {
        sum = 0u; cnt = 0u; mine = 0u;
#pragma unroll
        for (unsigned j = 0; j < 16; ++j) { const unsigned c = xb_ld(&bar[XB_XCNT(j)]); sum += c; cnt += (c > 0u) ? 1u : 0u; mine = (j == x) ? c : mine; }
        if (sum == G) break;
        __builtin_amdgcn_s_sleep(1);
        if ((++sp & 255u) == 0u) { if (xb_ld(&bar[XB_TMO])) break; if (sp > XB_SPIN_CAP) { atomicAdd(&bar[XB_TMO], 1u); break; } }
    }
    nloc = mine > 0u ? mine : 1u; nx = cnt > 0u ? cnt : 1u;
}
__device__ __forceinline__ void xcd_barrier(const XcdBarrier& b) {
    asm volatile("s_waitcnt vmcnt(0)" ::: "memory");
    __syncthreads();
    if (threadIdx.x == 0) {
        unsigned* bar = b.bar;
        __builtin_amdgcn_s_waitcnt(0);
        unsigned nloc = b.st[0], nx = b.st[1];
        if (nloc == 0u) { xcd_barrier_complete(bar, b.x, nloc, nx); b.st[0] = nloc; b.st[1] = nx; }
        const unsigned old = xb_add(&bar[XB_XSUB(b.x)], 1u);
        const unsigned gen = old / nloc;
        if (old + 1u == (gen + 1u) * nloc) {
            __builtin_amdgcn_fence(__ATOMIC_RELEASE, "agent");
            asm volatile("s_waitcnt vmcnt(0)" ::: "memory");
            const unsigned og = xb_add(&bar[XB_TOP], 1u);
            const unsigned tg = og / nx;
            if (og + 1u == (tg + 1u) * nx) xb_add(&bar[XB_TOPGEN], 1u);
            else XB_SPIN(xb_ld(&bar[XB_TOPGEN]) == tg, bar);
            __builtin_amdgcn_fence(__ATOMIC_ACQUIRE, "agent");
            xb_add(&bar[XB_XGEN(b.x)], 1u);
            asm volatile("s_waitcnt vmcnt(0)" ::: "memory");
        } else {
            XB_SPIN(xb_ld(&bar[XB_XGEN(b.x)]) == gen, bar);
            __builtin_amdgcn_fence(__ATOMIC_ACQUIRE, "agent");
            asm volatile("s_waitcnt vmcnt(0)" ::: "memory");
        }
    }
    __syncthreads();
}

__device__ __forceinline__ void group_barrier(unsigned* ctl, int group) {
    asm volatile("s_waitcnt vmcnt(0)" ::: "memory");
    __syncthreads();
    if (threadIdx.x == 0) {
        unsigned* cnt = ctl + CW_GCNT + 64 * group;
        __builtin_amdgcn_s_waitcnt(0);
        const unsigned old = xb_add(cnt, 1u), target = (old / 8u + 1u) * 8u;
        unsigned sp = 0;
        while (xb_ld(cnt) < target) { __builtin_amdgcn_s_sleep(1); if (++sp > (1u << 22)) break; }
        __builtin_amdgcn_fence(__ATOMIC_ACQUIRE, "agent");
        asm volatile("s_waitcnt vmcnt(0)" ::: "memory");
    }
    __syncthreads();
}
struct Args { const float* in[31]; float* out; unsigned char* ws; int ph_lo, ph_hi; };
enum { I_XP = 0, I_XS, I_STATE, I_C, I_CCTX, I_F1N, I_F1G, I_F1U, I_F1D, I_MIXN, I_F2N, I_F2G, I_F2U, I_F2D, I_ADAW, I_ADAB, I_EVIN, I_EVOUT,
       I_POOLW, I_POOLS, I_CONVW, I_ALOG, I_DTB, I_DNNW, I_ODIN, I_ODOUT, I_SGUN, I_SGUW, I_SGUB, I_FNETW, I_FINN };

struct Frame {
    LAS unsigned char* lds;
    int tid, lane, wave, vcu, G;
    bool grp;
    const CAS Args* a;
};

#define DS_READ128(dst, addr) asm volatile("ds_read_b128 %0, %1" : "=v"(dst) : "v"((unsigned)(addr)))
__device__ __forceinline__ void lgkm_wait(int n) {
    switch (n) { case 0: asm volatile("s_waitcnt lgkmcnt(0)" ::: "memory"); break; case 1: asm volatile("s_waitcnt lgkmcnt(1)" ::: "memory"); break;
                 case 2: asm volatile("s_waitcnt lgkmcnt(2)" ::: "memory"); break; case 3: asm volatile("s_waitcnt lgkmcnt(3)" ::: "memory"); break;
                 case 4: asm volatile("s_waitcnt lgkmcnt(4)" ::: "memory"); break; case 5: asm volatile("s_waitcnt lgkmcnt(5)" ::: "memory"); break;
                 case 6: asm volatile("s_waitcnt lgkmcnt(6)" ::: "memory"); break; default: asm volatile("s_waitcnt lgkmcnt(7)" ::: "memory"); break; }
}
__device__ __forceinline__ void vm_wait(int n) {
    switch (n) { case 0: asm volatile("s_waitcnt vmcnt(0)" ::: "memory"); break; case 4: asm volatile("s_waitcnt vmcnt(4)" ::: "memory"); break;
                 case 5: asm volatile("s_waitcnt vmcnt(5)" ::: "memory"); break; case 6: asm volatile("s_waitcnt vmcnt(6)" ::: "memory"); break;
                 case 7: asm volatile("s_waitcnt vmcnt(7)" ::: "memory"); break; case 8: asm volatile("s_waitcnt vmcnt(8)" ::: "memory"); break;
                 case 9: asm volatile("s_waitcnt vmcnt(9)" ::: "memory"); break; default: asm volatile("s_waitcnt vmcnt(0)" ::: "memory"); break; }
}
template <int NFRAG, class Epi>
__device__ __forceinline__ void gemm_tile(LAS unsigned char* lds, const int tid, const bf16* A, const bf16* Bt, int K, int row0, int col0, const Epi& E) {
    constexpr int BN = 32 * NFRAG, NPB = BN / 8, A_BYTES = 192 * 128, B_BYTES = BN * 128, STAGE = A_BYTES + B_BYTES, NBI = (NPB + 7) / 8;
    constexpr int NS = (3 * STAGE <= LDS_MAIN) ? 3 : 2;
    static_assert(NS * STAGE <= LDS_MAIN, "LDS");
    const int lane = tid & 63, wid = __builtin_amdgcn_readfirstlane(tid >> 6), wm = wid >> 1, wn = wid & 1, fr = lane & 15, fq = lane >> 4;
    const int r = lane >> 3, slot = lane & 7;
    const int srow = wid * 8 + r;
    const int chunk = slot ^ ((srow >> 1) & 7);
    const char* gA = (const char*)(A + (size_t)(row0 + srow) * K) + chunk * 16;
    const char* gB = (const char*)(Bt + (size_t)(col0 + srow) * K) + chunk * 16;
    const size_t pstep = (size_t)64 * K * 2;
    const int nt = K / 64;
    const int nbw = (NPB - wid + 7) / 8;
    const unsigned ldsb = (unsigned)(uintptr_t)lds;
    const int rowA0 = wm * 48 + fr, rowB0 = wn * NFRAG * 16 + fr;
    int offA[2], offB[2];
#pragma unroll
    for (int kk = 0; kk < 2; ++kk) {
        offA[kk] = rowA0 * 128 + (((kk * 4 + fq) ^ ((rowA0 >> 1) & 7)) << 4);
        offB[kk] = A_BYTES + rowB0 * 128 + (((kk * 4 + fq) ^ ((rowB0 >> 1) & 7)) << 4);
    }
    f32x4 acc[3][NFRAG];
#pragma unroll
    for (int i = 0; i < 3; ++i)
#pragma unroll
        for (int j = 0; j < NFRAG; ++j) acc[i][j] = (f32x4){0.f, 0.f, 0.f, 0.f};
    typename Epi::template Hold<NFRAG> hold;
    E.template preload<NFRAG>(hold, row0 + wm * 48 + fr, col0 + wn * NFRAG * 16 + fq * 4, tid, row0, col0);

#define GEMM_STAGE(buf, t) do { LAS unsigned char* sA_ = lds + (buf) * STAGE + wid * 1024; \
        _Pragma("unroll") for (int i_ = 0; i_ < 3; ++i_) \
            __builtin_amdgcn_global_load_lds((const unsigned*)(gA + i_ * pstep + (size_t)(t) * 128), (LAS unsigned*)(sA_ + i_ * 8192), 16, 0, 0); \
        _Pragma("unroll") for (int i_ = 0; i_ < NBI; ++i_) if (wid + 8 * i_ < NPB) \
            __builtin_amdgcn_global_load_lds((const unsigned*)(gB + i_ * pstep + (size_t)(t) * 128), (LAS unsigned*)(sA_ + A_BYTES + i_ * 8192), 16, 0, 0); } while (0)

    GEMM_STAGE(0, 0);
    if (NS == 3) GEMM_STAGE(1, 1);
    int sbuf = 0;
    for (int t = 0; t < nt; ++t) {
        if (NS == 3) {
            if (t + 1 < nt) { if (nbw == NBI) vm_wait(3 + NBI); else vm_wait(3 + NBI - 1); } else vm_wait(0);
            __builtin_amdgcn_s_barrier();
            if (t + 2 < nt) { const int nb_ = (sbuf >= 1) ? sbuf - 1 : 2; GEMM_STAGE(nb_, t + 2); }
        } else {
            asm volatile("s_waitcnt vmcnt(0)" ::: "memory");
            __syncthreads();
            if (t + 1 < nt) GEMM_STAGE((t + 1) & 1, t + 1);
        }
        {
            const unsigned sbo = (unsigned)sbuf * STAGE;
            const unsigned aA0 = ldsb + sbo + offA[0], aA1 = ldsb + sbo + offA[1], aB0 = ldsb + sbo + offB[0], aB1 = ldsb + sbo + offB[1];
            bf16x8 af[2][3], bq[4];
#pragma unroll
            for (int mf = 0; mf < 3; ++mf) { DS_READ128(af[0][mf], aA0 + mf * 2048); }
#pragma unroll
            for (int mf = 0; mf < 3; ++mf) { DS_READ128(af[1][mf], aA1 + mf * 2048); }
            constexpr int TOT = 2 * NFRAG;
#pragma unroll
            for (int f = 0; f < 3; ++f) { DS_READ128(bq[f], aB0 + f * 2048); }
#pragma unroll
            for (int f = 0; f < TOT; ++f) {
                if (f + 3 < TOT) { const int g = f + 3; DS_READ128(bq[g & 3], ((g >= NFRAG) ? aB1 + (g - NFRAG) * 2048 : aB0 + g * 2048)); }
                const int outstanding = (f + 3 < TOT) ? 3 : (TOT - 1 - f);
                lgkm_wait(outstanding);
                asm volatile("" : "+v"(bq[f & 3]));
                __builtin_amdgcn_sched_barrier(0);
                const int kk = (f >= NFRAG) ? 1 : 0, nf = f - kk * NFRAG;
#pragma unroll
                for (int mf = 0; mf < 3; ++mf) acc[mf][nf] = __builtin_amdgcn_mfma_f32_16x16x32_bf16(bq[f & 3], af[kk][mf], acc[mf][nf], 0, 0, 0);
            }
        }
        sbuf = (sbuf + 1 == NS) ? 0 : sbuf + 1;
    }
#undef GEMM_STAGE
    __syncthreads();
    E.template stage<NFRAG>(hold, (LAS float*)lds, tid);
    __syncthreads();
    E.template operator()<NFRAG>(acc, hold, row0 + wm * 48 + fr, col0 + wn * NFRAG * 16 + fq * 4, fq, (const LAS float*)lds, wm * 48 + fr, wn * NFRAG * 16 + fq * 4);
    asm volatile("s_waitcnt vmcnt(0)" ::: "memory");
    __syncthreads();
}

template <int RB, int PITCH>
__device__ __forceinline__ void image_store(const LAS unsigned char* img, unsigned char* dst, size_t ldb, int lane) {
    constexpr int CPR = RB / 16, TOT = 48 * CPR;
#pragma unroll
    for (int j = 0; j < (TOT + 63) / 64; ++j) {
        const int ci = lane + 64 * j;
        if (ci < TOT) { const int r = ci / CPR, ch = ci - r * CPR; *(u32x4*)(dst + (size_t)r * ldb + ch * 16) = *(const LAS u32x4*)(img + r * PITCH + ch * 16); }
    }
}
struct Pre { const float* ss; const float* bias; };
struct PreHold { float rs, b[3]; };
__device__ __forceinline__ void pre_fetch(const Pre& p, PreHold& h, int tid, int row0, int col0, int BN) {
    h.rs = (tid < 192) ? p.ss[row0 + tid] : 0.f;
#pragma unroll
    for (int q = 0; q < 3; ++q) { const int i = tid + 512 * q; const int c = i / BN, j = i - c * BN; h.b[q] = (i < 3 * BN) ? p.bias[c * NBMAX + col0 + j] : 0.f; }
}
__device__ __forceinline__ void pre_write(const PreHold& h, LAS float* sc, int tid, int BN) {
    if (tid < 192) sc[tid] = rsq_f(h.rs * (1.f / D) + EPS);
#pragma unroll
    for (int q = 0; q < 3; ++q) { const int i = tid + 512 * q; if (i < 3 * BN) sc[256 + i] = h.b[q]; }
}
struct EpiUp {
    bf16* H; Pre pre;
    template <int NFRAG> struct Hold { PreHold ph; };
    template <int NFRAG> __device__ __forceinline__ void preload(Hold<NFRAG>& h, int, int, int tid, int row0, int col0) const { pre_fetch(pre, h.ph, tid, row0, col0, 32 * NFRAG); }
    template <int NFRAG> __device__ __forceinline__ void stage(const Hold<NFRAG>& h, LAS float* sc, int tid) const { pre_write(h.ph, sc, tid, 32 * NFRAG); }
    template <int NFRAG> __device__ __forceinline__ void operator()(f32x4 (&acc)[3][NFRAG], const Hold<NFRAG>&, int row, int colq, int fq, const LAS float* sc, int lrow, int lcol) const {
        constexpr int RB = 16 * NFRAG;
        const int wm = lrow / 48, wn = lcol / (16 * NFRAG), fr = lrow - wm * 48;
        LAS unsigned char* img = (LAS unsigned char*)sc + 8192 + (wm * 2 + wn) * (48 * RB);
#pragma unroll
        for (int mf = 0; mf < 3; ++mf) {
            const int rr = row + mf * 16; const float rs = sc[lrow + mf * 16];
            const LAS float* bp = sc + 256 + cond_of_row(rr) * (32 * NFRAG) + lcol;
#pragma unroll
            for (int nf = 0; nf < NFRAG; ++nf) {
                const f32x4 v = acc[mf][nf] * rs + *(const LAS f32x4*)(bp + nf * 16);
                *(LAS unsigned*)(img + (mf * 16 + fr) * RB + nf * 16 + fq * 4) = pk2(silu_f(v[0]) * v[2], silu_f(v[1]) * v[3]);
            }
        }
        const int lane = fq * 16 + fr;
        bf16* hb = H + (size_t)(row - fr) * FF + ((colq - fq * 4) >> 1);
#pragma unroll
        for (int j = 0; j < (48 * NFRAG + 63) / 64; ++j) {
            const int ci = lane + 64 * j;
            if (ci < 48 * NFRAG) { const int r = ci / NFRAG, ch = ci - r * NFRAG; *(u32x4*)(hb + (size_t)r * FF + ch * 8) = *(const LAS u32x4*)(img + r * RB + ch * 16); }
        }
    }
};
struct EpiRes {
    float* X; const float* mod; int layer, gidx; float scale;
    bf16* XS; float* ssn; const float* nwn; int ln, wn;
    template <int NFRAG> struct Hold { f32x4 xv[3][NFRAG]; float g, c; };
    template <int NFRAG> __device__ __forceinline__ void preload(Hold<NFRAG>& h, int row, int colq, int tid, int, int col0) const {
        constexpr int BN = 32 * NFRAG; static_assert(3 * BN <= 512, "one vector element per thread");
#pragma unroll
        for (int mf = 0; mf < 3; ++mf)
#pragma unroll
            for (int nf = 0; nf < NFRAG; ++nf) h.xv[mf][nf] = *(const f32x4*)(X + (size_t)(row + mf * 16) * D + colq + nf * 16);
        const int c = tid / BN, j = tid - c * BN; h.g = 0.f; h.c = 0.f;
        if (tid < 3 * BN) {
            h.g = mod[((size_t)(layer * 3 + c) * 9 + gidx) * 1024 + col0 + j] * scale;
            h.c = nwn[col0 + j] * (mod[((size_t)(ln * 3 + c) * 9 + wn * 3 + 1) * 1024 + col0 + j] + 1.0f);
        }
    }
    template <int NFRAG> __device__ __forceinline__ void stage(const Hold<NFRAG>& h, LAS float* sc, int tid) const {
        constexpr int BN = 32 * NFRAG;
        if (tid < 3 * BN) { sc[256 + tid] = h.g; sc[256 + 3 * BN + tid] = h.c; }
    }
    template <int NFRAG> __device__ __forceinline__ void operator()(f32x4 (&acc)[3][NFRAG], const Hold<NFRAG>& h, int row, int colq, int fq, const LAS float* sc, int lrow, int lcol) const {
        constexpr int BN = 32 * NFRAG, RBX = 64 * NFRAG, RBS = 32 * NFRAG, PX = RBX + 16, PS = RBS + 16;
        const int wm = lrow / 48, wn = lcol / (16 * NFRAG), fr = lrow - wm * 48, lane = fq * 16 + fr;
        LAS unsigned char* imx = (LAS unsigned char*)sc + 8192 + (wm * 2 + wn) * (48 * PX);
        u32x2 hsw[3][NFRAG];
#pragma unroll
        for (int mf = 0; mf < 3; ++mf) {
            const int rr = row + mf * 16, cnd = cond_of_row(rr);
            const LAS float* gp = sc + 256 + cnd * BN + lcol; const LAS float* cp = sc + 256 + 3 * BN + cnd * BN + lcol;
            float ssq = 0.f;
#pragma unroll
            for (int nf = 0; nf < NFRAG; ++nf) {
                const f32x4 x = h.xv[mf][nf] + acc[mf][nf] * *(const LAS f32x4*)(gp + nf * 16);
                *(LAS f32x4*)(imx + (mf * 16 + fr) * PX + nf * 64 + fq * 16) = x;
                if (ssn) {
                    const f32x4 hs = x * *(const LAS f32x4*)(cp + nf * 16);
                    hsw[mf][nf].x = pk2(hs[0], hs[1]); hsw[mf][nf].y = pk2(hs[2], hs[3]);
                    ssq += (x[0] * x[0] + x[1] * x[1]) + (x[2] * x[2] + x[3] * x[3]);
                }
            }
            if (ssn) { ssq += __shfl_xor(ssq, 16); ssq += __shfl_xor(ssq, 32); if (fq == 0) atomicAdd(ssn + rr, ssq); }
        }
        const size_t o0 = (size_t)(row - fr) * D + (colq - fq * 4);
        image_store<RBX, PX>(imx, (unsigned char*)(X + o0), (size_t)D * 4, lane);
        if (ssn) {
#pragma unroll
            for (int mf = 0; mf < 3; ++mf)
#pragma unroll
                for (int nf = 0; nf < NFRAG; ++nf) *(LAS u32x2*)(imx + (mf * 16 + fr) * PS + nf * 32 + fq * 8) = hsw[mf][nf];
            image_store<RBS, PS>(imx, (unsigned char*)(XS + o0), (size_t)D * 2, lane);
        }
    }
};
struct EpiStore {
    bf16* P; float* GT; Pre pre;
    template <int NFRAG> struct Hold { PreHold ph; };
    template <int NFRAG> __device__ __forceinline__ void preload(Hold<NFRAG>& h, int, int, int tid, int row0, int col0) const { pre_fetch(pre, h.ph, tid, row0, col0, 32 * NFRAG); }
    template <int NFRAG> __device__ __forceinline__ void stage(const Hold<NFRAG>& h, LAS float* sc, int tid) const { pre_write(h.ph, sc, tid, 32 * NFRAG); }
    template <int NFRAG> __device__ __forceinline__ void operator()(f32x4 (&acc)[3][NFRAG], const Hold<NFRAG>&, int row, int colq, int fq, const LAS float* sc, int lrow, int lcol) const {
        constexpr int RB = 32 * NFRAG, PB = RB + 16;
        const int wm = lrow / 48, wn = lcol / (16 * NFRAG), fr = lrow - wm * 48, lane = fq * 16 + fr;
        LAS unsigned char* img = (LAS unsigned char*)sc + 8192 + (wm * 2 + wn) * (48 * PB);
#pragma unroll
        for (int mf = 0; mf < 3; ++mf) {
            const int rr = row + mf * 16; const float rs = sc[lrow + mf * 16];
            const LAS float* bp = sc + 256 + cond_of_row(rr) * (32 * NFRAG) + lcol;
#pragma unroll
            for (int nf = 0; nf < NFRAG; ++nf) {
                const f32x4 v = acc[mf][nf] * rs + *(const LAS f32x4*)(bp + nf * 16);
                const int c = colq + nf * 16;
                u32x2 w; w.x = pk2(v[0], v[1]); w.y = pk2(v[2], v[3]);
                *(LAS u32x2*)(img + (mf * 16 + fr) * PB + nf * 32 + fq * 8) = w;
                if (c >= 3328 && c < 3352) *(f32x4*)(GT + (size_t)rr * 24 + (c - 3328)) = v;
            }
        }
        image_store<RB, PB>(img, (unsigned char*)(P + (size_t)(row - fr) * LDP + (colq - fq * 4)), (size_t)LDP * 2, lane);
    }
};

template <int NFRAG, class Epi>
__device__ __forceinline__ void gemm_phase(Frame& F, const bf16* A, const bf16* Bt, int K, int N, const Epi& E) {
    constexpr int BN = 32 * NFRAG;
    const int NT = N / BN, nitems = 32 * NT;
    for (int i = F.vcu; i < nitems; i += F.G) {
        const int panel = (i >> 3) & 31, ct = (i & 7) + 8 * (i >> 8);
        gemm_tile<NFRAG, Epi>(F.lds, F.tid, A, Bt, K, panel * 192, ct * BN, E);
    }
}

__device__ __forceinline__ void transpose_item(const float* W, int K, int N, int ldw, bf16* WT, int mode, LAS float* scr, int item, int lane, const float* shp, float* biasp) {
    const int nblk = (N + 63) / 64, kb = item / nblk, nb = item % nblk, k0 = 64 * kb, n0 = 64 * nb;
    const int lc = (lane & 15) * 4, lr = lane >> 4;
    f32x4 v[16];
#pragma unroll
    for (int i = 0; i < 16; ++i) v[i] = (n0 + lc < N) ? *(const f32x4*)(W + (size_t)(k0 + 4 * i + lr) * ldw + n0 + lc) : (f32x4){0.f, 0.f, 0.f, 0.f};
    float sh0 = 0.f, sh1 = 0.f, sh2 = 0.f;
    if (biasp) { sh0 = shp[k0 + lane]; sh1 = shp[9216 + k0 + lane]; sh2 = shp[2 * 9216 + k0 + lane]; }
#pragma unroll
    for (int i = 0; i < 16; ++i) { LAS float* p = scr + (4 * i + lr) * 65 + lc; p[0] = v[i][0]; p[1] = v[i][1]; p[2] = v[i][2]; p[3] = v[i][3]; }
    asm volatile("s_waitcnt lgkmcnt(0)" ::: "memory");
    const int c = lane & 7;
#pragma unroll
    for (int j = 0; j < 8; ++j) {
        const int nl = (lane >> 3) + 8 * j, n = n0 + nl; const LAS float* s = scr + (8 * c) * 65 + nl;
        u32x4 o; o.x = pk2(s[0 * 65], s[1 * 65]); o.y = pk2(s[2 * 65], s[3 * 65]); o.z = pk2(s[4 * 65], s[5 * 65]); o.w = pk2(s[6 * 65], s[7 * 65]);
        const int dr = (mode == 0) ? n : ((n >> 1) * 4 + (n & 1) + (mode == 2 ? 2 : 0));
        if (n < N) *(u32x4*)(WT + (size_t)dr * K + k0 + 8 * c) = o;
    }
    if (biasp) {
        float b0 = 0.f, b1 = 0.f, b2 = 0.f;
#pragma unroll
        for (int kk = 0; kk < 64; ++kk) {
            const float w = scr[kk * 65 + lane];
            b0 += w * __builtin_bit_cast(float, __builtin_amdgcn_readlane(__builtin_bit_cast(int, sh0), kk));
            b1 += w * __builtin_bit_cast(float, __builtin_amdgcn_readlane(__builtin_bit_cast(int, sh1), kk));
            b2 += w * __builtin_bit_cast(float, __builtin_amdgcn_readlane(__builtin_bit_cast(int, sh2), kk));
        }
        const int n = n0 + lane, dr = (mode == 0) ? n : ((n >> 1) * 4 + (n & 1) + (mode == 2 ? 2 : 0));
        if (n < N) { atomicAdd(biasp + dr, b0); atomicAdd(biasp + NBMAX + dr, b1); atomicAdd(biasp + 2 * NBMAX + dr, b2); }
    }
    asm volatile("s_waitcnt lgkmcnt(0)" ::: "memory");
}

__device__ __forceinline__ void phase_setup(Frame& F) {
    const CAS Args& a = *F.a;
    unsigned char* ws = a.ws;
    {
        LAS float* sc = (LAS float*)F.lds;
        LAS float* red = sc + 3 * 1024;
        for (int i = F.tid; i < 3 * 1024; i += 512) { const int c = i >> 10, k = i & 1023; const float v = (c == 0) ? a.in[I_CCTX][k] : a.in[I_C][(c - 1) * 1024 + k]; sc[i] = silu_f(v); }
        __syncthreads();
        float* mod = (float*)(ws + WS_MOD);
        for (int it = F.vcu; it < 4 * 288; it += F.G) {
            const int l = it / 288, r_ = it % 288, kr = r_ / 36, seg = r_ % 36;
            const int k0 = kr * 128 + F.wave * 16;
            const float* W = a.in[I_ADAW] + (size_t)l * 1024 * 9216 + (size_t)k0 * 9216 + seg * 256 + F.lane * 4;
            f32x4 w[16];
#pragma unroll
            for (int k = 0; k < 16; ++k) w[k] = *(const f32x4*)(W + (size_t)k * 9216);
            f32x4 s0 = {0, 0, 0, 0}, s1 = s0, s2 = s0;
#pragma unroll
            for (int k = 0; k < 16; ++k) { s0 += w[k] * sc[k0 + k]; s1 += w[k] * sc[1024 + k0 + k]; s2 += w[k] * sc[2048 + k0 + k]; }
            LAS float* rp = red + (F.wave * 64 + F.lane) * 12;
#pragma unroll
            for (int j = 0; j < 4; ++j) { rp[j] = s0[j]; rp[4 + j] = s1[j]; rp[8 + j] = s2[j]; }
            __syncthreads();
            if (F.tid < 256) {
                const int ln = F.tid >> 2, j = F.tid & 3, n = seg * 256 + F.tid;
#pragma unroll
                for (int c = 0; c < 3; ++c) {
                    float s = 0.f;
#pragma unroll
                    for (int wv = 0; wv < 8; ++wv) s += red[(wv * 64 + ln) * 12 + c * 4 + j];
                    if (kr == 0) s += a.in[I_ADAB][l * 9216 + n];
                    atomicAdd(mod + (size_t)(l * 3 + c) * 9216 + n, s);
                }
            }
            __syncthreads();
        }
        __syncthreads();
    }
    {
        const int gw = F.vcu * 8 + F.wave, NGW = F.G * 8;
        for (int it = gw; it < 2 * NH * 16384 / 512; it += NGW) {
            const float* sp = a.in[I_SGUW] + (size_t)it * 512 + F.lane * 8;
            const f32x4 x0 = *(const f32x4*)sp, x1 = *(const f32x4*)(sp + 4);
            u32x4 o; o.x = pk2(x0[0], x0[1]); o.y = pk2(x0[2], x0[3]); o.z = pk2(x1[0], x1[1]); o.w = pk2(x1[2], x1[3]);
            *(u32x4*)((bf16*)(ws + WS_SGUW) + (size_t)it * 512 + F.lane * 8) = o;
        }
        __syncthreads();
    }
    {
        const int gw = F.vcu * 8 + F.wave, NGW = F.G * 8;
        for (int it = gw; it < 2 * (P_EVEN_PAD - P_EVEN); it += NGW) {
            const int e = it / (P_EVEN_PAD - P_EVEN), rr = P_EVEN + it % (P_EVEN_PAD - P_EVEN);
            u32x4* p = (u32x4*)((bf16*)(ws + WS_EVIN + (size_t)e * EVIN_SZ) + (size_t)rr * D);
            p[F.lane] = (u32x4){0, 0, 0, 0}; p[64 + F.lane] = (u32x4){0, 0, 0, 0};
        }
        float* X = (float*)(ws + WS_X);
        for (int row = gw; row < M; row += NGW) {
            float* xo = X + (size_t)row * D;
            if (row < NCTX) {
                const f32x4* src = (const f32x4*)(a.in[I_XP] + (size_t)row * D);
#pragma unroll
                for (int j = 0; j < 4; ++j) ((f32x4*)xo)[j * 64 + F.lane] = src[j * 64 + F.lane];
            } else {
                const int t = (row - NCTX) & (LAT_L - 1); const float pr = (float)(t >> 6), pc = (float)(t & 63);
                const float* src = a.in[I_XS] + (size_t)(row - NCTX) * D;
#pragma unroll
                for (int j = 0; j < 16; ++j) {
                    const int ch = j * 64 + F.lane, seg = ch >> 8, i = ch & 255;
                    const float freq = expf(-9.210340371976184f * (float)i * (1.0f / 256.0f));
                    const float ang = ((seg < 2) ? pr : pc) * freq;
                    const float pe = (seg & 1) ? cosf(ang) : sinf(ang);
                    xo[ch] = src[ch] + pe;
                }
            }
        }
    }
}

__device__ __forceinline__ const bf16* sub_weight(unsigned char* ws, int s, int& N) {
    const int l = s / 3, which = s % 3, e = l >> 1;
    if (which != 1) { N = NUP; return (const bf16*)(ws + WS_WUP + (size_t)(l * 2 + (which == 2 ? 1 : 0)) * WUP_SZ); }
    if ((l & 1) == 0) { N = P_EVEN_PAD; return (const bf16*)(ws + WS_EVIN + (size_t)e * EVIN_SZ); }
    N = 2048; return (const bf16*)(ws + WS_ODIN + (size_t)e * ODIN_SZ);
}
__device__ __forceinline__ void phase_init(Frame& F) {
    const CAS Args& a = *F.a; unsigned char* ws = a.ws;
    const float* mod = (const float*)(ws + WS_MOD);
    const int gw = F.vcu * 8 + F.wave, NGW = F.G * 8;
    {
        LAS float* T = (LAS float*)F.lds;
        LAS float* wt = T + 64 * 128;
        LAS float* tw = wt + 64 * 65;
        if (F.tid < 64) { tw[F.tid] = cospif((float)F.tid * (1.f / 32.f)); tw[64 + F.tid] = sinpif((float)F.tid * (1.f / 32.f)); }
        __syncthreads();
        for (int it = F.vcu; it < 2 * 4 * 16; it += F.G) {
            const int j = it >> 6, g = (it >> 4) & 3, k0 = (it & 15) * 64;
            const float* Wg = a.in[I_FNETW] + ((size_t)j * 4 + g) * 4096;
            {
                const int c = F.tid >> 3, eb = (F.tid & 7) * 8;
                float ac[8], as[8];
#pragma unroll
                for (int q = 0; q < 8; ++q) { ac[q] = 0.f; as[q] = 0.f; }
                for (int m = 0; m < 64; ++m) {
                    const int idx = (m * c) & 63; const float cs = tw[idx], sn = tw[64 + idx];
                    const f32x4 w0 = *(const f32x4*)(Wg + m * 64 + eb), w1 = *(const f32x4*)(Wg + m * 64 + eb + 4);
#pragma unroll
                    for (int q = 0; q < 4; ++q) { ac[q] += cs * w0[q]; ac[4 + q] += cs * w1[q]; as[q] -= sn * w0[q]; as[4 + q] -= sn * w1[q]; }
                }
#pragma unroll
                for (int q = 0; q < 8; ++q) { T[c * 128 + eb + q] = ac[q] * 0.125f; T[c * 128 + 64 + eb + q] = as[q] * 0.125f; }
                const int kk = F.tid >> 3, c8 = (F.tid & 7) * 8;
                const float* wp = a.in[I_ODIN] + (size_t)j * D * P_ODD + (size_t)(k0 + kk) * P_ODD + 1536 + g * 64 + c8;
                const f32x4 x0 = *(const f32x4*)wp, x1 = *(const f32x4*)(wp + 4);
#pragma unroll
                for (int q = 0; q < 4; ++q) { wt[kk * 65 + c8 + q] = x0[q]; wt[kk * 65 + c8 + 4 + q] = x1[q]; }
            }
            __syncthreads();
            {
                const int col = F.tid & 127, kq = F.tid >> 7;
                float acc[16];
#pragma unroll
                for (int q = 0; q < 16; ++q) acc[q] = 0.f;
                for (int c = 0; c < 64; ++c) {
                    const float t = T[c * 128 + col];
#pragma unroll
                    for (int q = 0; q < 16; ++q) acc[q] += wt[(kq * 16 + q) * 65 + c] * t;
                }
                const int drow = 1536 + ((col < 64) ? (g * 64 + col) : (256 + g * 64 + col - 64));
                bf16* dst = (bf16*)(ws + WS_ODIN + (size_t)j * ODIN_SZ) + (size_t)drow * D + k0 + kq * 16;
                u32x4 o0, o1;
                o0.x = pk2(acc[0], acc[1]); o0.y = pk2(acc[2], acc[3]); o0.z = pk2(acc[4], acc[5]); o0.w = pk2(acc[6], acc[7]);
                o1.x = pk2(acc[8], acc[9]); o1.y = pk2(acc[10], acc[11]); o1.z = pk2(acc[12], acc[13]); o1.w = pk2(acc[14], acc[15]);
                *(u32x4*)dst = o0; *(u32x4*)(dst + 8) = o1;
                const float* shp = (const float*)(ws + WS_MOD) + ((size_t)((2 * j + 1) * 3) * 9 + 3) * 1024 + k0 + kq * 16 + (F.lane & 15);
                const float s0v = shp[0], s1v = shp[9216], s2v = shp[2 * 9216];
                float b0 = 0.f, b1 = 0.f, b2 = 0.f;
#pragma unroll
                for (int q = 0; q < 16; ++q) {
                    b0 += acc[q] * __builtin_bit_cast(float, __builtin_amdgcn_readlane(__builtin_bit_cast(int, s0v), q));
                    b1 += acc[q] * __builtin_bit_cast(float, __builtin_amdgcn_readlane(__builtin_bit_cast(int, s1v), q));
                    b2 += acc[q] * __builtin_bit_cast(float, __builtin_amdgcn_readlane(__builtin_bit_cast(int, s2v), q));
                }
                float* bp = (float*)(ws + WS_BIAS) + (size_t)(3 * (2 * j + 1) + 1) * 3 * NBMAX + drow;
                atomicAdd(bp, b0); atomicAdd(bp + NBMAX, b1); atomicAdd(bp + 2 * NBMAX, b2);
            }
            __syncthreads();
        }
    }
    {
        LAS float* scr = (LAS float*)(F.lds + F.wave * 16640);
        const int gw = F.vcu * 8 + F.wave, NGW = F.G * 8;
        constexpr int IT_G = 16 * 44, IT_D = 44 * 16, IT_EVIN = 16 * 53, IT_SQ = 16 * 16, IT_ODIN = 16 * 24;
        static_assert(IT_G == IT_D, "decode");
        constexpr int PER_FFN = 2 * IT_G + IT_D;
        constexpr int TOT = 8 * PER_FFN + 2 * (IT_EVIN + IT_SQ + IT_ODIN + IT_SQ);
        for (int it = gw; it < TOT; it += NGW) {
            int r = it; const float* W; bf16* WT; int K, N, mode, ldw = 0, sub_s = -1;
            if (r < 8 * PER_FFN) {
                const int f = r / PER_FFN, l = f >> 1, s = f & 1; r -= f * PER_FFN;
                const int sub = r / IT_G; r -= sub * IT_G;
                const int idx = (sub == 0) ? (s ? I_F2G : I_F1G) : ((sub == 1) ? (s ? I_F2U : I_F1U) : (s ? I_F2D : I_F1D));
                W = a.in[idx] + (size_t)l * D * FF;
                WT = (sub == 2) ? (bf16*)(ws + WS_WDN + (size_t)f * WDN_SZ) : (bf16*)(ws + WS_WUP + (size_t)f * WUP_SZ);
                K = (sub == 2) ? FF : D; N = (sub == 2) ? D : FF; mode = (sub == 2) ? 0 : sub + 1;
                if (sub != 2) sub_s = 3 * l + (s ? 2 : 0);
            } else {
                r -= 8 * PER_FFN;
                constexpr int PER_E = IT_EVIN + IT_SQ + IT_ODIN + IT_SQ;
                const int e = r / PER_E; r -= e * PER_E;
                K = D; mode = 0;
                if (r < IT_EVIN) { W = a.in[I_EVIN] + (size_t)e * D * P_EVEN; N = P_EVEN; WT = (bf16*)(ws + WS_EVIN + (size_t)e * EVIN_SZ); sub_s = 3 * (2 * e) + 1; }
                else if (r < IT_EVIN + IT_SQ) { r -= IT_EVIN; W = a.in[I_EVOUT] + (size_t)e * D * D; N = D; WT = (bf16*)(ws + WS_EVOUT + (size_t)e * SQ_SZ); }
                else if (r < IT_EVIN + IT_SQ + IT_ODIN) { r -= IT_EVIN + IT_SQ; W = a.in[I_ODIN] + (size_t)e * D * P_ODD; N = 1536; ldw = P_ODD; WT = (bf16*)(ws + WS_ODIN + (size_t)e * ODIN_SZ); sub_s = 3 * (2 * e + 1) + 1; }
                else { r -= IT_EVIN + IT_SQ + IT_ODIN; W = a.in[I_ODOUT] + (size_t)e * D * D; N = D; WT = (bf16*)(ws + WS_ODOUT + (size_t)e * SQ_SZ); }
            }
            const float* shp = nullptr; float* biasp = nullptr;
            if (sub_s >= 0) { shp = (const float*)(ws + WS_MOD) + ((size_t)((sub_s / 3) * 3) * 9 + (sub_s % 3) * 3) * 1024; biasp = (float*)(ws + WS_BIAS) + (size_t)sub_s * 3 * NBMAX; }
            transpose_item(W, K, N, ldw ? ldw : N, WT, mode, scr, r, F.lane, shp, biasp);
        }
    }
    {
        const float* X = (const float*)(ws + WS_X); bf16* XS = (bf16*)(ws + WS_HN);
        float* ss = (float*)(ws + WS_CTL + CTL_SS_OFF);
        const float* nw = a.in[I_F1N];
        for (int row = gw; row < M; row += NGW) {
            const f32x4* xr = (const f32x4*)(X + (size_t)row * D) + F.lane;
            f32x4 v[4]; float s = 0.f;
#pragma unroll
            for (int j = 0; j < 4; ++j) { v[j] = xr[64 * j]; s += v[j][0] * v[j][0] + v[j][1] * v[j][1] + v[j][2] * v[j][2] + v[j][3] * v[j][3]; }
            s = wave_sum(s);
            if (F.lane == 0) ss[row] = s;
            const float* mb = mod + ((size_t)(0 * 3 + cond_of_row(row)) * 9 + 1) * 1024;
            u32x2* o = (u32x2*)(XS + (size_t)row * D) + F.lane;
#pragma unroll
            for (int j = 0; j < 4; ++j) {
                const int k = (64 * j + F.lane) * 4;
                const f32x4 h = v[j] * *(const f32x4*)(nw + k) * (*(const f32x4*)(mb + k) + 1.0f);
                u32x2 pkd; pkd.x = pk2(h[0], h[1]); pkd.y = pk2(h[2], h[3]);
                o[64 * j] = pkd;
            }
        }
    }
}

__device__ __forceinline__ void phase_final(Frame& F, bool panel_local) {
    const CAS Args& a = *F.a;
    const float* X = (const float*)(a.ws + WS_X);
    const float* nw = a.in[I_FINN];
    const int gw = panel_local ? (F.vcu & 7) * 8 + F.wave : F.vcu * 8 + F.wave, NGW = panel_local ? 64 : F.G * 8;
    const int rbeg = panel_local ? (F.vcu >> 3) * 192 : 0, rend = panel_local ? rbeg + 192 : M;
    for (int row = rbeg + gw; row < rend; row += NGW) {
        const f32x4* xr = (const f32x4*)(X + (size_t)row * D) + F.lane;
        f32x4 v[4]; float s = 0.f;
#pragma unroll
        for (int j = 0; j < 4; ++j) { v[j] = xr[64 * j]; s += v[j][0] * v[j][0] + v[j][1] * v[j][1] + v[j][2] * v[j][2] + v[j][3] * v[j][3]; }
        const float rstd = 1.0f / sqrtf(wave_sum(s) * (1.f / D) + EPS);
        f32x4* o = (f32x4*)(a.out + (size_t)row * D) + F.lane;
#pragma unroll
        for (int j = 0; j < 4; ++j) { const f32x4 w = *(const f32x4*)(nw + (64 * j + F.lane) * 4); o[64 * j] = v[j] * rstd * w; }
    }
}

__device__ __forceinline__ float wave_matvec64(float d, const float* W, int lane) {
    float y = 0.f;
#pragma unroll
    for (int c = 0; c < 64; ++c) { const float dc = __builtin_bit_cast(float, __builtin_amdgcn_readlane(__builtin_bit_cast(int, d), c)); y += dc * W[c * 64 + lane]; }
    return y;
}

__device__ __forceinline__ int perm32(int x) { return (x & ~31) | ((x & 12) << 1) | ((x & 16) >> 2) | (x & 3); }
__device__ __forceinline__ int sw256(int row, int c16) { return row * 256 + ((c16 ^ (row & 15)) << 4); }
__device__ __forceinline__ int sw128(int row, int c8) { return row * 128 + ((c8 ^ ((row >> 1) & 7)) << 4); }
__device__ __forceinline__ int e128(int row, int col) { return sw128(row, col >> 3) + (col & 7) * 2; }
__device__ __forceinline__ void dn_item_decode(int cc, int& row0, int& L, int& c) {
    if (cc < 64) { row0 = (cc >> 2) * CTX_L; L = CTX_L; c = cc & 3; } else { const int q = cc - 64; row0 = NCTX + (q >> 4) * LAT_L; L = LAT_L; c = q & 15; }
}
#define MFMA16(a, b, c) __builtin_amdgcn_mfma_f32_16x16x32_bf16((a), (b), (c), 0, 0, 0)

__device__ __forceinline__ void phase_dn_prep(Frame& F, int e) {
    const CAS Args& a = *F.a;
    const bf16* P = (const bf16*)(a.ws + WS_P); const float* GT = (const float*)(a.ws + WS_AG);
    const float* cw = a.in[I_CONVW] + (size_t)e * 3 * 2304;
    LAS unsigned char* L = F.lds;
    constexpr int CWL = 114688;
    constexpr int KB = 0, QB = 16384, VBT = 32768, KGT = 49152, KDT = 65536, AIo = 81920, MM = 90112, TT = 98304, TN = 106496, MD = 114688, XT = 118784, SM = 139264, VB16 = 140288;
    LAS float* sm = (LAS float*)(L + SM);
    const int wave = F.wave;
    for (int rec = F.vcu; rec < 1152; rec += F.G) {
        int tid_ = F.tid; asm volatile("" : "+v"(tid_));
        const int lane = tid_ & 63, fr = lane & 15, fq = lane >> 4;
        const int dir = rec & 1, h = (rec >> 1) % NH, cc = rec / (2 * NH);
        int row0, Ls, c; dn_item_decode(cc, row0, Ls, c);
        __syncthreads();
        for (int i_ = tid_; i_ < 1152; i_ += 512) { const int part = i_ / 384, r_ = i_ % 384, tap = r_ >> 7, ch = r_ & 127; ((LAS float*)(L + CWL))[i_] = cw[tap * 2304 + part * 768 + h * 128 + ch]; }
        if (wave == 0) {
            const int row = row0 + (dir ? (Ls - 1 - (c * 64 + lane)) : (c * 64 + lane));
            const float araw = GT[(size_t)row * 24 + 12 + dir * 6 + h], braw = GT[(size_t)row * 24 + dir * 6 + h];
            const float al = a.in[I_ALOG][(e * 2 + dir) * 6 + h], dtb = a.in[I_DTB][(e * 2 + dir) * 6 + h];
            float x = -expf(al) * softplus_f(araw + dtb); const float b = sigmoid_f(braw);
#pragma unroll
            for (int o = 1; o < 64; o <<= 1) { const float t = __shfl_up(x, o); if (lane >= o) x += t; }
            const float gl = __shfl(x, 63);
            sm[lane] = x; sm[64 + lane] = b; sm[128 + lane] = expf(x); sm[192 + lane] = expf(gl - x);
            if (lane == 63) ((float*)(a.ws + WS_DGL))[rec] = expf(x);
        }
        __syncthreads();
        {
            const int i = tid_ >> 3, cg = tid_ & 7;
            const int row = row0 + (dir ? (Ls - 1 - (c * 64 + i)) : (c * 64 + i));
            const int tl = row - row0; const bool hp = tl > 0, hn = tl < Ls - 1;
            float kf[16], qf[16], vf[16];
#pragma unroll
            for (int part = 0; part < 3; ++part) {
                const int pc = 256 + part * 768 + h * 128 + cg * 16;
                const bf16* p1 = P + (size_t)row * LDP + pc;
                const LAS float* wl = (const LAS float*)(L + CWL) + part * 384 + cg * 16;
                float out[16];
#pragma unroll
                for (int q8 = 0; q8 < 2; ++q8) {
                    const u32x4 r1 = *(const u32x4*)(p1 + q8 * 8);
                    const u32x4 r0 = hp ? *(const u32x4*)(p1 - LDP + q8 * 8) : (u32x4){0, 0, 0, 0};
                    const u32x4 r2 = hn ? *(const u32x4*)(p1 + LDP + q8 * 8) : (u32x4){0, 0, 0, 0};
                    const unsigned a0[4] = {r0.x, r0.y, r0.z, r0.w}, a1[4] = {r1.x, r1.y, r1.z, r1.w}, a2[4] = {r2.x, r2.y, r2.z, r2.w};
#pragma unroll
                    for (int d = 0; d < 4; ++d) {
#pragma unroll
                        for (int hh = 0; hh < 2; ++hh) {
                            const int j = q8 * 8 + d * 2 + hh;
                            const float x0 = __builtin_bit_cast(float, hh ? (a0[d] & 0xffff0000u) : (a0[d] << 16));
                            const float x1 = __builtin_bit_cast(float, hh ? (a1[d] & 0xffff0000u) : (a1[d] << 16));
                            const float x2 = __builtin_bit_cast(float, hh ? (a2[d] & 0xffff0000u) : (a2[d] << 16));
                            out[j] = silu_f(x0 * wl[j] + x1 * wl[128 + j] + x2 * wl[256 + j]);
                        }
                    }
                }
                if (part < 2) {
                    float ssq = 0.f;
#pragma unroll
                    for (int j = 0; j < 16; ++j) ssq += out[j] * out[j];
                    ssq += __shfl_xor(ssq, 1); ssq += __shfl_xor(ssq, 2); ssq += __shfl_xor(ssq, 4);
                    const float rs = rsq_f(ssq + EPS) * (part == 0 ? 0.08838834764831845f : 1.0f);
#pragma unroll
                    for (int j = 0; j < 16; ++j) { if (part == 0) qf[j] = out[j] * rs; else kf[j] = out[j] * rs; }
                } else {
#pragma unroll
                    for (int j = 0; j < 16; ++j) vf[j] = out[j];
                }
            }
            const float eg = sm[128 + i];
#pragma unroll
            for (int hf = 0; hf < 2; ++hf) {
                u32x4 kk, qq, vv;
                kk.x = pk2(kf[hf * 8 + 0], kf[hf * 8 + 1]); kk.y = pk2(kf[hf * 8 + 2], kf[hf * 8 + 3]); kk.z = pk2(kf[hf * 8 + 4], kf[hf * 8 + 5]); kk.w = pk2(kf[hf * 8 + 6], kf[hf * 8 + 7]);
                qq.x = pk2(qf[hf * 8 + 0], qf[hf * 8 + 1]); qq.y = pk2(qf[hf * 8 + 2], qf[hf * 8 + 3]); qq.z = pk2(qf[hf * 8 + 4], qf[hf * 8 + 5]); qq.w = pk2(qf[hf * 8 + 6], qf[hf * 8 + 7]);
                vv.x = pk2(vf[hf * 8 + 0], vf[hf * 8 + 1]); vv.y = pk2(vf[hf * 8 + 2], vf[hf * 8 + 3]); vv.z = pk2(vf[hf * 8 + 4], vf[hf * 8 + 5]); vv.w = pk2(vf[hf * 8 + 6], vf[hf * 8 + 7]);
                *(LAS u32x4*)(L + KB + sw256(i, cg * 2 + hf)) = kk;
                *(LAS u32x4*)(L + QB + sw256(i, cg * 2 + hf)) = qq;
                *(LAS u32x4*)(L + VB16 + sw256(i, cg * 2 + hf)) = vv;
            }
            bf16* QD = (bf16*)(a.ws + WS_DQ) + (size_t)rec * 8192 + i * 128;
#pragma unroll
            for (int qq = 0; qq < 4; ++qq) {
                const int pos = perm32(cg * 16 + 4 * qq);
                u32x2 w; w.x = pk2(qf[4 * qq] * eg, qf[4 * qq + 1] * eg); w.y = pk2(qf[4 * qq + 2] * eg, qf[4 * qq + 3] * eg);
                *(u32x2*)(QD + pos) = w;
            }
        }
        __syncthreads();
        {
            const int kdl = lane & 15, ipl = lane >> 4;
#pragma unroll 2
            for (int it8 = 0; it8 < 8; ++it8) {
                const int combo = wave * 8 + it8, kd = (combo & 7) * 16 + kdl, i0 = 2 * ((combo >> 3) * 4 + ipl);
                const int a0 = sw256(i0, kd >> 3) + (kd & 7) * 2, a1 = sw256(i0 + 1, kd >> 3) + (kd & 7) * 2;
                const float k0 = __builtin_bit_cast(float, (unsigned)(*(const LAS bf16*)(L + KB + a0)) << 16), k1 = __builtin_bit_cast(float, (unsigned)(*(const LAS bf16*)(L + KB + a1)) << 16);
                const float v0 = __builtin_bit_cast(float, (unsigned)(*(const LAS bf16*)(L + VB16 + a0)) << 16), v1 = __builtin_bit_cast(float, (unsigned)(*(const LAS bf16*)(L + VB16 + a1)) << 16);
                const float be0 = sm[64 + i0], be1 = sm[65 + i0], eg0 = sm[128 + i0], eg1 = sm[129 + i0], ek0 = sm[192 + i0], ek1 = sm[193 + i0];
                *(LAS unsigned*)(L + VBT + e128(kd, i0)) = pk2(v0 * be0, v1 * be1);
                *(LAS unsigned*)(L + KGT + e128(kd, i0)) = pk2(k0 * be0 * eg0, k1 * be1 * eg1);
                *(LAS unsigned*)(L + KDT + e128(kd, perm32(i0))) = pk2(k0 * ek0, k1 * ek1);
            }
        }
        __syncthreads();
        const int mi = wave >> 1;
#pragma unroll
        for (int f = 0; f < 2; ++f) {
            const int nj = (wave & 1) * 2 + f;
            f32x4 kkacc = {0.f, 0.f, 0.f, 0.f}, qkacc = {0.f, 0.f, 0.f, 0.f};
            if (nj <= mi) {
#pragma unroll
                for (int ks = 0; ks < 4; ++ks) {
                    const bf16x8 ak = *(const LAS bf16x8*)(L + KB + sw256(mi * 16 + fr, ks * 4 + fq));
                    const bf16x8 aq = *(const LAS bf16x8*)(L + QB + sw256(mi * 16 + fr, ks * 4 + fq));
                    const bf16x8 bk = *(const LAS bf16x8*)(L + KB + sw256(nj * 16 + fr, ks * 4 + fq));
                    kkacc = MFMA16(ak, bk, kkacc); qkacc = MFMA16(aq, bk, qkacc);
                }
            }
            const int j = nj * 16 + fr, i0 = mi * 16 + 4 * fq; const float gcj = sm[j];
#pragma unroll
            for (int r = 0; r < 4; ++r) {
                const int i = i0 + r; const float dec = (i >= j) ? __expf(sm[i] - gcj) : 0.f;
                const float mv = (i > j) ? (sm[64 + i] * kkacc[r] * dec) : 0.f;
                if (nj <= mi) *(LAS bf16*)(L + MM + e128(i, j)) = (bf16)f2bf(mv);
                if (nj == mi) *(LAS float*)(L + MD + ((mi * 16 + 4 * fq + r) * 16 + fr) * 4) = mv;
                if (nj > mi) *(LAS bf16*)(L + TN + e128(i, j)) = (bf16)0;
                *(LAS bf16*)(L + AIo + e128(i, perm32(j))) = (bf16)f2bf(qkacc[r] * dec);
            }
        }
        __syncthreads();
        if (wave == 0) {
            const int b = lane >> 4, cc_ = lane & 15;
            const LAS float* md = (const LAS float*)(L + MD) + b * 256;
            float T[16];
#pragma unroll
            for (int i = 0; i < 16; ++i) {
                float s = (i == cc_) ? 1.f : 0.f;
#pragma unroll
                for (int jj = 0; jj < i; ++jj) s -= md[i * 16 + jj] * T[jj];
                T[i] = s;
            }
#pragma unroll
            for (int i = 0; i < 16; ++i) *(LAS bf16*)(L + TN + e128(16 * b + i, 16 * b + cc_)) = (bf16)f2bf(T[i]);
#pragma unroll
            for (int hf = 0; hf < 2; ++hf) {
                u32x4 t; t.x = pk2(T[hf * 8 + 0], T[hf * 8 + 1]); t.y = pk2(T[hf * 8 + 2], T[hf * 8 + 3]); t.z = pk2(T[hf * 8 + 4], T[hf * 8 + 5]); t.w = pk2(T[hf * 8 + 6], T[hf * 8 + 7]);
                *(LAS u32x4*)(L + TT + sw128(16 * b + cc_, 2 * b + hf)) = t;
            }
        }
        __syncthreads();
#pragma unroll
        for (int lvl = 1; lvl <= 3; ++lvl) {
            if (wave < 4 - lvl) {
                const int J = wave, I = wave + lvl;
                f32x4 x = {0.f, 0.f, 0.f, 0.f};
                const bf16x8 zero8 = {0, 0, 0, 0, 0, 0, 0, 0};
#pragma unroll
                for (int ks = 0; ks < (lvl == 3 ? 2 : 1); ++ks) {
                    const bf16x8 am = *(const LAS bf16x8*)(L + MM + sw128(16 * I + fr, 2 * J + 4 * ks + fq));
                    bf16x8 bt = *(const LAS bf16x8*)(L + TT + sw128(16 * J + fr, 2 * J + 4 * ks + fq));
                    if (4 * ks + fq >= 2 * lvl) bt = zero8;
                    x = MFMA16(am, bt, x);
                }
                LAS unsigned char* xt = L + XT + wave * 512;
                { u32x2 t; t.x = pk2(x[0], x[1]); t.y = pk2(x[2], x[3]); *(LAS u32x2*)(xt + fr * 32 + fq * 8) = t; }
                const bf16x8 ad = *(const LAS bf16x8*)(L + TN + sw128(16 * I + fr, 2 * I + (fq & 1)));
                bf16x8 bx = *(const LAS bf16x8*)(xt + fr * 32 + (fq & 1) * 16);
                if (fq >= 2) bx = zero8;
                f32x4 t4 = {0.f, 0.f, 0.f, 0.f};
                t4 = MFMA16(ad, bx, t4);
#pragma unroll
                for (int r = 0; r < 4; ++r) *(LAS bf16*)(L + TN + e128(16 * I + 4 * fq + r, 16 * J + fr)) = (bf16)f2bf(-t4[r]);
                { u32x2 t; t.x = pk2(-t4[0], -t4[1]); t.y = pk2(-t4[2], -t4[3]); *(LAS u32x2*)(L + TT + e128(16 * J + fr, 16 * I + 4 * fq)) = t; }
            }
            __syncthreads();
        }
        {
            bf16* UT = (bf16*)(a.ws + WS_DUT) + (size_t)rec * 8192;
            bf16* Wn = (bf16*)(a.ws + WS_DW) + (size_t)rec * 8192;
            const int ui = wave & 3;
#pragma unroll
            for (int f = 0; f < 4; ++f) {
                const int dvf = (wave >> 2) * 4 + f;
                f32x4 acc = {0.f, 0.f, 0.f, 0.f};
#pragma unroll
                for (int ks = 0; ks < 2; ++ks) {
                    const bf16x8 ta = *(const LAS bf16x8*)(L + TN + sw128(ui * 16 + fr, ks * 4 + fq));
                    const bf16x8 vb = *(const LAS bf16x8*)(L + VBT + sw128(dvf * 16 + fr, ks * 4 + fq));
                    acc = MFMA16(ta, vb, acc);
                }
                u32x2 t; t.x = pk2(acc[0], acc[1]); t.y = pk2(acc[2], acc[3]);
                *(u32x2*)(UT + (dvf * 16 + fr) * 64 + ui * 16 + 4 * fq) = t;
            }
#pragma unroll
            for (int f = 0; f < 4; ++f) {
                f32x4 acc = {0.f, 0.f, 0.f, 0.f};
#pragma unroll
                for (int ks = 0; ks < 2; ++ks) {
                    const bf16x8 ka = *(const LAS bf16x8*)(L + KGT + sw128(wave * 16 + fr, ks * 4 + fq));
                    const bf16x8 tb = *(const LAS bf16x8*)(L + TN + sw128(f * 16 + fr, ks * 4 + fq));
                    acc = MFMA16(ka, tb, acc);
                }
                u32x2 t; t.x = pk2(-acc[0], -acc[1]); t.y = pk2(-acc[2], -acc[3]);
                *(u32x2*)(Wn + (f * 16 + fr) * 128 + perm32(wave * 16 + 4 * fq)) = t;
            }
            {
                const int rw = tid_ >> 3, c8 = tid_ & 7;
                *(u32x4*)((unsigned char*)(a.ws + WS_DAI) + (size_t)rec * 8192 + rw * 128 + c8 * 16) = *(const LAS u32x4*)(L + AIo + sw128(rw, c8));
#pragma unroll
                for (int k2 = 0; k2 < 2; ++k2) {
                    const int rr = rw + 64 * k2;
                    *(u32x4*)((unsigned char*)(a.ws + WS_DKT) + (size_t)rec * 16384 + rr * 128 + c8 * 16) = *(const LAS u32x4*)(L + KDT + sw128(rr, c8));
                }
            }
        }
    }
    __syncthreads();
}

__device__ __forceinline__ void phase_dn_scan(Frame& F, int e) {
    const CAS Args& a = *F.a;
    LAS unsigned char* L = F.lds;
    constexpr int BUF = 57344, oW = 0, oQ = 16384, oA = 32768, oK = 40960;
    const int wave = F.wave;
    const unsigned char* gW = (const unsigned char*)(a.ws + WS_DW); const unsigned char* gQ = (const unsigned char*)(a.ws + WS_DQ);
    const unsigned char* gA = (const unsigned char*)(a.ws + WS_DAI); const unsigned char* gK = (const unsigned char*)(a.ws + WS_DKT);
    const bf16* gU = (const bf16*)(a.ws + WS_DUT); const float* gGL = (const float*)(a.ws + WS_DGL);
    for (int it = F.vcu; it < (2 * LAT_B + CTX_B) * 2 * NH; it += F.G) {
        int tid_ = F.tid; asm volatile("" : "+v"(tid_));
        const int lane = tid_ & 63, fr = lane & 15, fq = lane >> 4;
        const int r4 = lane >> 4, s16 = lane & 15, r8 = lane >> 3, s8 = lane & 7;
        int seq, dir, h, half = 0;
        if (it < 2 * LAT_B * 2 * NH) { half = it & 1; const int j = it >> 1; seq = CTX_B + j / (2 * NH); dir = (j / NH) & 1; h = j % NH; }
        else { const int j = it - 2 * LAT_B * 2 * NH; seq = j / (2 * NH); dir = (j / NH) & 1; h = j % NH; }
        const bool lat = seq >= CTX_B;
        const bool active = lat ? (wave < 4) : true;
        const int dvc = (lat ? half * 64 : 0) + (wave & (lat ? 3 : 7)) * 16 + fr;
        const int Ls = lat ? LAT_L : CTX_L, row0 = lat ? NCTX + (seq - CTX_B) * LAT_L : seq * CTX_L, nch = Ls / 64;
        const int cbase = lat ? 64 + (seq - CTX_B) * 16 : seq * 4;
        f32x4 S[8];
        if (lat) {
            const float* s0 = a.in[I_STATE] + ((((size_t)(seq - CTX_B) * 2 + e) * 2 + dir) * NH + h) * 128 * 128;
#pragma unroll
            for (int mf = 0; mf < 8; ++mf)
#pragma unroll
                for (int r = 0; r < 4; ++r) S[mf][r] = s0[(size_t)(mf * 16 + 4 * fq + r) * 128 + dvc];
        } else {
#pragma unroll
            for (int mf = 0; mf < 8; ++mf) S[mf] = (f32x4){0.f, 0.f, 0.f, 0.f};
        }
        float* O = (float*)(a.ws + (dir ? WS_OB : WS_OF));
#define DN_STAGE(bufi, rec_) do { LAS unsigned char* sb_ = L + (bufi) * BUF; const size_t ro_ = (size_t)(rec_); \
        _Pragma("unroll") for (int p_ = 0; p_ < 2; ++p_) { const int pc_ = wave + 8 * p_; const int rw_ = pc_ * 4 + r4; const int so_ = rw_ * 256 + ((s16 ^ (rw_ & 15)) << 4); \
            __builtin_amdgcn_global_load_lds((const unsigned*)(gW + ro_ * 16384 + so_), (LAS unsigned*)(sb_ + oW + pc_ * 1024), 16, 0, 0); \
            __builtin_amdgcn_global_load_lds((const unsigned*)(gQ + ro_ * 16384 + so_), (LAS unsigned*)(sb_ + oQ + pc_ * 1024), 16, 0, 0); \
            const int rk_ = pc_ * 8 + r8; const int sk_ = rk_ * 128 + ((s8 ^ ((rk_ >> 1) & 7)) << 4); \
            __builtin_amdgcn_global_load_lds((const unsigned*)(gK + ro_ * 16384 + sk_), (LAS unsigned*)(sb_ + oK + pc_ * 1024), 16, 0, 0); } \
        { const int ra_ = wave * 8 + r8; const int sa_ = ra_ * 128 + ((s8 ^ ((ra_ >> 1) & 7)) << 4); \
            __builtin_amdgcn_global_load_lds((const unsigned*)(gA + ro_ * 8192 + sa_), (LAS unsigned*)(sb_ + oA + wave * 1024), 16, 0, 0); } } while (0)
        __syncthreads();
        int rec = (cbase * NH + h) * 2 + dir;
        DN_STAGE(0, rec);
        u32x2 un[4]; float gln;
#pragma unroll
        for (int mf = 0; mf < 4; ++mf) un[mf] = *(const u32x2*)(gU + (size_t)rec * 8192 + dvc * 64 + mf * 16 + 4 * fq);
        gln = gGL[rec];
        for (int c = 0; c < nch; ++c) {
            asm volatile("s_waitcnt vmcnt(0)" ::: "memory");
            __syncthreads();
            u32x2 uc[4]; const float gl = gln;
#pragma unroll
            for (int mf = 0; mf < 4; ++mf) uc[mf] = un[mf];
            if (c + 1 < nch) {
                const int rn = rec + 2 * NH;
                DN_STAGE((c + 1) & 1, rn);
#pragma unroll
                for (int mf = 0; mf < 4; ++mf) un[mf] = *(const u32x2*)(gU + (size_t)rn * 8192 + dvc * 64 + mf * 16 + 4 * fq);
                gln = gGL[rn];
            }
            if (active) {
            bf16x8 Sb[4];
#pragma unroll
            for (int ks = 0; ks < 4; ++ks) {
                u32x4 t; t.x = pk2(S[2 * ks][0], S[2 * ks][1]); t.y = pk2(S[2 * ks][2], S[2 * ks][3]); t.z = pk2(S[2 * ks + 1][0], S[2 * ks + 1][1]); t.w = pk2(S[2 * ks + 1][2], S[2 * ks + 1][3]);
                Sb[ks] = __builtin_bit_cast(bf16x8, t);
            }
#pragma unroll
            for (int mf = 0; mf < 8; ++mf) S[mf] = S[mf] * gl;
            f32x4 vn[4], o[4];
#pragma unroll
            for (int mf = 0; mf < 4; ++mf) {
                vn[mf][0] = __builtin_bit_cast(float, uc[mf].x << 16); vn[mf][1] = __builtin_bit_cast(float, uc[mf].x & 0xffff0000u);
                vn[mf][2] = __builtin_bit_cast(float, uc[mf].y << 16); vn[mf][3] = __builtin_bit_cast(float, uc[mf].y & 0xffff0000u);
                o[mf] = (f32x4){0.f, 0.f, 0.f, 0.f};
            }
            const unsigned sbb = (unsigned)(uintptr_t)L + (unsigned)(c & 1) * BUF;
            const unsigned aWQ = sbb + fr * 256, aAK = sbb + fr * 128;
            unsigned xw[4], xa[2];
#pragma unroll
            for (int ks = 0; ks < 4; ++ks) xw[ks] = (unsigned)(((ks * 4 + fq) ^ fr) << 4);
#pragma unroll
            for (int ks = 0; ks < 2; ++ks) xa[ks] = (unsigned)(((ks * 4 + fq) ^ ((fr >> 1) & 7)) << 4);
#define DN_FADDR(f) (((f) < 32) ? (aWQ + ((((f) & 7) < 4) ? oW : oQ) + ((f) >> 3) * 4096 + xw[(f) & 3]) : (((f) < 40) ? (aAK + oA + (((f) - 32) >> 1) * 2048 + xa[((f) - 32) & 1]) : (aAK + oK + (((f) - 40) >> 1) * 2048 + xa[((f) - 40) & 1])))
            bf16x8 ring[8], Vb[2];
#pragma unroll
            for (int f = 0; f < 7; ++f) { DS_READ128(ring[f], DN_FADDR(f)); }
#pragma unroll
            for (int f = 0; f < 56; ++f) {
                if (f + 7 < 56) { DS_READ128(ring[(f + 7) & 7], DN_FADDR(f + 7)); }
                lgkm_wait((f + 7 < 56) ? 7 : (55 - f));
                asm volatile("" : "+v"(ring[f & 7]));
                __builtin_amdgcn_sched_barrier(0);
                if (f == 32) {
#pragma unroll
                    for (int ks = 0; ks < 2; ++ks) {
                        u32x4 t; t.x = pk2(vn[2 * ks][0], vn[2 * ks][1]); t.y = pk2(vn[2 * ks][2], vn[2 * ks][3]); t.z = pk2(vn[2 * ks + 1][0], vn[2 * ks + 1][1]); t.w = pk2(vn[2 * ks + 1][2], vn[2 * ks + 1][3]);
                        Vb[ks] = __builtin_bit_cast(bf16x8, t);
                    }
                }
                if (f < 32) { const int mf = f >> 3, j = f & 7; if (j < 4) vn[mf] = MFMA16(ring[f & 7], Sb[j], vn[mf]); else o[mf] = MFMA16(ring[f & 7], Sb[j - 4], o[mf]); }
                else if (f < 40) { const int g = f - 32; o[g >> 1] = MFMA16(ring[f & 7], Vb[g & 1], o[g >> 1]); }
                else { const int g = f - 40; S[g >> 1] = MFMA16(ring[f & 7], Vb[g & 1], S[g >> 1]); }
            }
#undef DN_FADDR
#pragma unroll
            for (int mf = 0; mf < 4; ++mf)
#pragma unroll
                for (int r = 0; r < 4; ++r) {
                    const int step = c * 64 + mf * 16 + 4 * fq + r, row = row0 + (dir ? (Ls - 1 - step) : step);
                    O[(size_t)row * 768 + h * 128 + dvc] = o[mf][r];
                }
            }
            rec += 2 * NH;
        }
#undef DN_STAGE
        if (!lat) {
            float* so = a.out + (size_t)M * D + ((((size_t)seq * 2 + e) * 2 + dir) * NH + h) * 128 * 128;
#pragma unroll
            for (int mf = 0; mf < 8; ++mf)
#pragma unroll
                for (int r = 0; r < 4; ++r) so[(size_t)(mf * 16 + 4 * fq + r) * 128 + dvc] = S[mf][r];
        }
    }
    __syncthreads();
}

__device__ __forceinline__ void phase_dn_fin(Frame& F, int e) {
    const CAS Args& a = *F.a;
    const bf16* P = (const bf16*)(a.ws + WS_P);
    const float* OF = (const float*)(a.ws + WS_OF); const float* OB = (const float*)(a.ws + WS_OB);
    bf16* Y = (bf16*)(a.ws + WS_Y);
    const float* nw = a.in[I_DNNW] + e * 128;
    const int gw = F.vcu * 8 + F.wave, NGW = F.G * 8;
    for (int it = gw; it < M * NH; it += NGW) {
        const int row = it / NH, h = it % NH, c2 = F.lane * 2;
        const size_t o = (size_t)row * 768 + h * 128 + c2;
        const f32x2 v = *(const f32x2*)(OF + o) + *(const f32x2*)(OB + o);
        const float ms = wave_sum(v[0] * v[0] + v[1] * v[1]) * (1.f / 128.f);
        const float rs = rsq_f(ms + EPS);
        const unsigned zr = *(const unsigned*)(P + (size_t)row * LDP + 2560 + h * 128 + c2);
        const f32x2 z = {__builtin_bit_cast(float, zr << 16), __builtin_bit_cast(float, zr & 0xffff0000u)};
        const f32x2 w = *(const f32x2*)(nw + c2);
        *(unsigned*)(Y + (size_t)row * D + 256 + h * 128 + c2) = pk2(v[0] * rs * w[0] * silu_f(z[0]), v[1] * rs * w[1] * silu_f(z[1]));
    }
    const float* pw = a.in[I_POOLW] + (size_t)e * 4 * 64 * 64; const float* ps = a.in[I_POOLS] + e * 256;
    LAS float* xs = (LAS float*)F.lds;
    LAS float* dl = xs + 80 * 64;
    LAS float* wl = dl + 64 * 65;
    for (int it = F.vcu; it < (M / 64) * 4; it += F.G) {
        const int blk = it >> 2, g = it & 3, r0 = blk * 64; int s0, Ls; seq_of_row(r0, s0, Ls);
        __syncthreads();
        for (int i = F.tid; i < 80 * 16; i += 512) {
            const int rr = i >> 4, c4 = (i & 15) * 4, row = r0 - 8 + rr;
            const bool in = (row >= s0) && (row < s0 + Ls);
            const u32x2 pr = in ? *(const u32x2*)(P + (size_t)row * LDP + g * 64 + c4) : (u32x2){0, 0};
            *(LAS f32x4*)(xs + rr * 64 + c4) = (f32x4){__builtin_bit_cast(float, pr.x << 16), __builtin_bit_cast(float, pr.x & 0xffff0000u), __builtin_bit_cast(float, pr.y << 16), __builtin_bit_cast(float, pr.y & 0xffff0000u)};
        }
        for (int i = F.tid; i < 1024; i += 512) *(LAS f32x4*)(wl + i * 4) = *(const f32x4*)(pw + g * 4096 + i * 4);
        __syncthreads();
        {
            const int t = F.tid >> 3, c8 = (F.tid & 7) * 8, row = r0 + t, tl = row - s0, half = 1 << g;
            const int lo = max(tl - half, 0), hi = min(tl + half, Ls);
            float sum[8];
#pragma unroll
            for (int q = 0; q < 8; ++q) sum[q] = 0.f;
            for (int p = lo; p < hi; ++p) {
                const LAS float* xr = xs + (p - tl + t + 8) * 64 + c8;
                const f32x4 a0 = *(const LAS f32x4*)xr, a1 = *(const LAS f32x4*)(xr + 4);
#pragma unroll
                for (int q = 0; q < 4; ++q) { sum[q] += a0[q]; sum[4 + q] += a1[q]; }
            }
            const float inv = 1.0f / (float)(hi - lo);
            const LAS float* xc = xs + (t + 8) * 64 + c8;
#pragma unroll
            for (int q = 0; q < 8; ++q) dl[t * 65 + c8 + q] = sum[q] * inv - xc[q];
        }
        __syncthreads();
        {
            const int t = F.tid >> 3, e8 = (F.tid & 7) * 8;
            float y[8];
#pragma unroll
            for (int q = 0; q < 8; ++q) y[q] = 0.f;
            for (int c = 0; c < 64; ++c) {
                const float d = dl[t * 65 + c];
                const f32x4 w0 = *(const LAS f32x4*)(wl + c * 64 + e8), w1 = *(const LAS f32x4*)(wl + c * 64 + e8 + 4);
#pragma unroll
                for (int q = 0; q < 4; ++q) { y[q] += d * w0[q]; y[4 + q] += d * w1[q]; }
            }
            const f32x4 s0v = *(const f32x4*)(ps + g * 64 + e8), s1v = *(const f32x4*)(ps + g * 64 + e8 + 4);
            u32x4 o; o.x = pk2(y[0] * s0v[0], y[1] * s0v[1]); o.y = pk2(y[2] * s0v[2], y[3] * s0v[3]); o.z = pk2(y[4] * s1v[0], y[5] * s1v[1]); o.w = pk2(y[6] * s1v[2], y[7] * s1v[3]);
            *(u32x4*)(Y + (size_t)(r0 + t) * D + g * 64 + e8) = o;
        }
    }
    __syncthreads();
}

struct EpiOdd {
    bf16* G; float* ZR; float* ZI; float* ST; Pre pre;
    template <int NFRAG> struct Hold { PreHold ph; };
    template <int NFRAG> __device__ __forceinline__ void preload(Hold<NFRAG>& h, int, int, int tid, int row0, int col0) const { pre_fetch(pre, h.ph, tid, row0, col0, 32 * NFRAG); }
    template <int NFRAG> __device__ __forceinline__ void stage(const Hold<NFRAG>& h, LAS float* sc, int tid) const { pre_write(h.ph, sc, tid, 32 * NFRAG); }
    template <int NFRAG> __device__ __forceinline__ void operator()(f32x4 (&acc)[3][NFRAG], const Hold<NFRAG>&, int row, int colq, int fq, const LAS float* sc, int lrow, int lcol) const {
        const int ct = colq >> 8;
        constexpr int RB = 32 * NFRAG, PB = RB + 16;
        const int wm = lrow / 48, wn = lcol / (16 * NFRAG), fr = lrow - wm * 48, lane = fq * 16 + fr;
        LAS unsigned char* img = (LAS unsigned char*)sc + 8192 + (wm * 2 + wn) * (48 * PB);
        if (ct < 6) {
#pragma unroll
            for (int mf = 0; mf < 3; ++mf) {
                const int rr = row + mf * 16; float s1 = 0.f, s2 = 0.f;
                const float rs = sc[lrow + mf * 16]; const LAS float* bp = sc + 256 + cond_of_row(rr) * (32 * NFRAG) + lcol;
#pragma unroll
                for (int nf = 0; nf < NFRAG; ++nf) {
                    const f32x4 v = acc[mf][nf] * rs + *(const LAS f32x4*)(bp + nf * 16);
                    const float g0 = gelu_tanh(v[0]), g1 = gelu_tanh(v[1]), g2 = gelu_tanh(v[2]), g3 = gelu_tanh(v[3]);
                    u32x2 w; w.x = pk2(g0, g1); w.y = pk2(g2, g3);
                    *(LAS u32x2*)(img + (mf * 16 + fr) * PB + nf * 32 + fq * 8) = w;
                    s1 += (g0 + g1) + (g2 + g3); s2 += (g0 * g0 + g1 * g1) + (g2 * g2 + g3 * g3);
                }
                if (ct >= 3) {
                    s1 += __shfl_xor(s1, 16); s1 += __shfl_xor(s1, 32); s2 += __shfl_xor(s2, 16); s2 += __shfl_xor(s2, 32);
                    if (fq == 0) { atomicAdd(ST + (size_t)rr * 2, s1); atomicAdd(ST + (size_t)rr * 2 + 1, s2); }
                }
            }
            image_store<RB, PB>(img, (unsigned char*)(G + (size_t)(row - fr) * 1536 + (colq - fq * 4)), (size_t)1536 * 2, lane);
        } else {
            float* Z = (ct == 6) ? ZR : ZI; const int cb = colq - ct * 256;
#pragma unroll
            for (int mf = 0; mf < 3; ++mf) {
                const int rr = row + mf * 16; const float rs = sc[lrow + mf * 16]; const LAS float* bp = sc + 256 + cond_of_row(rr) * (32 * NFRAG) + lcol;
#pragma unroll
                for (int nf = 0; nf < NFRAG; ++nf) *(f32x4*)(Z + (size_t)rr * 256 + cb + nf * 16) = acc[mf][nf] * rs + *(const LAS f32x4*)(bp + nf * 16);
            }
        }
    }
};

constexpr double c_pi = 3.14159265358979323846;
constexpr double c_sin_poly(double x) { double t = x, s = x; for (int i = 1; i < 14; ++i) { t *= -x * x / ((2 * i) * (2 * i + 1)); s += t; } return s; }
constexpr double c_cos_poly(double x) { double t = 1, s = 1; for (int i = 1; i < 14; ++i) { t *= -x * x / ((2 * i - 1) * (2 * i)); s += t; } return s; }
constexpr int c_bitrev(int x, int n) { int r = 0; for (int b = 1; b < n; b <<= 1) { r = (r << 1) | (x & 1); x >>= 1; } return r; }
template <int N, int HALF, int BASE, int J>
__device__ __forceinline__ void fft_bf(float (&re)[N], float (&im)[N]) {
    constexpr int ia = BASE + J, ib = ia + HALF;
    constexpr float c = (float)c_cos_poly(c_pi * J / HALF), s = (float)c_sin_poly(c_pi * J / HALF);
    const float ar = re[ia], ai = im[ia], br = re[ib], bi = im[ib];
    re[ia] = ar + br; im[ia] = ai + bi;
    const float dr = ar - br, di = ai - bi;
    if constexpr (J == 0) { re[ib] = dr; im[ib] = di; }
    else if constexpr (2 * J == HALF) { re[ib] = di; im[ib] = -dr; }
    else { re[ib] = dr * c + di * s; im[ib] = di * c - dr * s; }
    if constexpr (J + 1 < HALF) fft_bf<N, HALF, BASE, J + 1>(re, im);
    else if constexpr (BASE + 2 * HALF < N) fft_bf<N, HALF, BASE + 2 * HALF, 0>(re, im);
    else if constexpr (HALF > 1) fft_bf<N, HALF / 2, 0, 0>(re, im);
}
template <int R, int P>
__device__ __forceinline__ void fa_store(const float (&zr)[R], const float (&zi)[R], float* BR, float* BI, int row0, int n2, int col, const LAS float* twN) {
    constexpr int k1 = c_bitrev(P, R);
    const int t = k1 * n2; const float c = twN[t], s = twN[R * R + t];
    const size_t o = (size_t)(row0 + k1 * R + n2) * 256 + col;
    BR[o] = c * zr[P] + s * zi[P]; BI[o] = c * zi[P] - s * zr[P];
    if constexpr (P + 1 < R) fa_store<R, P + 1>(zr, zi, BR, BI, row0, n2, col, twN);
}
template <int R>
__device__ __forceinline__ void fourier_a_item(const float* ZR, const float* ZI, float* BR, float* BI, int row0, int n2, const LAS float* twN, int col) {
    float zr[R], zi[R];
#pragma unroll
    for (int n1 = 0; n1 < R; ++n1) { const size_t o = (size_t)(row0 + R * n1 + n2) * 256 + col; zr[n1] = ZR[o]; zi[n1] = ZI[o]; }
    fft_bf<R, R / 2, 0, 0>(zr, zi);
    fa_store<R, 0>(zr, zi, BR, BI, row0, n2, col, twN);
}
template <int R, int P>
__device__ __forceinline__ void fc_store(const float (&br)[R], bf16* Y, int row0, int k1, int col) {
    constexpr int k2 = c_bitrev(P, R);
    Y[(size_t)(row0 + k1 + R * k2) * D + 768 + col] = (bf16)f2bf(br[P] * (1.0f / R));
    if constexpr (P + 1 < R) fc_store<R, P + 1>(br, Y, row0, k1, col);
}
template <int R>
__device__ __forceinline__ void fourier_c_item(const float* BR, const float* BI, bf16* Y, int row0, int k1, int col) {
    float br[R], bi[R];
#pragma unroll
    for (int n2 = 0; n2 < R; ++n2) { const size_t o = (size_t)(row0 + k1 * R + n2) * 256 + col; br[n2] = BR[o]; bi[n2] = BI[o]; }
    fft_bf<R, R / 2, 0, 0>(br, bi);
    fc_store<R, 0>(br, Y, row0, k1, col);
}
__device__ __forceinline__ void fourier_tables(LAS float* tw, int tid) {
    for (int i = tid; i < 1024; i += 512) { const float x = (float)i * (1.f / 512.f); tw[64 + i] = cospif(x); tw[64 + 1024 + i] = sinpif(x); }
    if (tid < 256) { const float x = (float)tid * (1.f / 128.f); tw[2144 + tid] = cospif(x); tw[2144 + 256 + tid] = sinpif(x); }
    if (tid < 32) { const float x = (float)tid * (1.f / 16.f); tw[tid] = cospif(x); tw[32 + tid] = sinpif(x); }
    if (tid < 16) { const float x = (float)tid * (1.f / 8.f); tw[2112 + tid] = cospif(x); tw[2112 + 16 + tid] = sinpif(x); }
}

__device__ __forceinline__ void phase_odd_mix(Frame& F, int j) {
    const CAS Args& a = *F.a;
    const bf16* G = (const bf16*)(a.ws + WS_P); bf16* Y = (bf16*)(a.ws + WS_Y);
    const float* ZR = (const float*)(a.ws + WS_ZR); const float* ZI = (const float*)(a.ws + WS_ZI);
    float* BR = (float*)(a.ws + WS_QN); float* BI = (float*)(a.ws + WS_KN);
    const float* ST = (const float*)(a.ws + WS_CTL + CTL_ST_OFF) + (size_t)j * M * 2;
    LAS unsigned char* L = F.lds;
    LAS float* tw = (LAS float*)(L + 65536);
    fourier_tables(tw, F.tid);
    __syncthreads();
    const int wave = F.wave;
    constexpr int NA_LAT = LAT_B * 32 / 2, NSGU = (M / 128) * NH, NA_CTX = CTX_B * 16 / 2;
    for (int it = F.vcu; it < NA_LAT + NSGU + NA_CTX; it += F.G) {
        int tid_ = F.tid; asm volatile("" : "+v"(tid_));
        if (it < NA_LAT) { const int q = it * 2 + (tid_ >> 8); fourier_a_item<32>(ZR, ZI, BR, BI, NCTX + (q >> 5) * LAT_L, q & 31, tw + 64, tid_ & 255); continue; }
        if (it >= NA_LAT + NSGU) { const int q = (it - NA_LAT - NSGU) * 2 + (tid_ >> 8); fourier_a_item<16>(ZR, ZI, BR, BI, (q >> 4) * CTX_L, q & 15, tw + 2144, tid_ & 255); continue; }
        const int q = it - NA_LAT, ch = q / NH, h = q % NH, r0 = ch * 128;
        const int lane = tid_ & 63, fr = lane & 15, fq = lane >> 4;
        __syncthreads();
        {
            const int s = tid_ >> 2, cq = tid_ & 3, row = r0 + s;
            const float s1 = ST[(size_t)row * 2], s2 = ST[(size_t)row * 2 + 1];
            const float mu = s1 * (1.f / 768.f), var = s2 * (1.f / 768.f) - mu * mu, rstd = rsq_f(fmaxf(var, 0.f) + EPS);
            const bf16* gp = G + (size_t)row * 1536 + 768 + h * 128 + cq * 32;
            const float* nw = a.in[I_SGUN] + j * 768 + h * 128 + cq * 32;
#pragma unroll
            for (int v8 = 0; v8 < 4; ++v8) {
                const u32x4 raw = *(const u32x4*)(gp + v8 * 8);
                const unsigned wds[4] = {raw.x, raw.y, raw.z, raw.w};
#pragma unroll
                for (int e2 = 0; e2 < 4; ++e2) {
                    const float g0 = __builtin_bit_cast(float, wds[e2] << 16), g1 = __builtin_bit_cast(float, wds[e2] & 0xffff0000u);
                    const int c0 = cq * 32 + v8 * 8 + e2 * 2;
                    const float v0 = (g0 - mu) * rstd * nw[v8 * 8 + e2 * 2], v1 = (g1 - mu) * rstd * nw[v8 * 8 + e2 * 2 + 1];
                    *(LAS bf16*)(L + c0 * 256 + (((s >> 3) ^ (c0 & 15)) << 4) + (s & 7) * 2) = (bf16)f2bf(v0);
                    *(LAS bf16*)(L + (c0 + 1) * 256 + (((s >> 3) ^ ((c0 + 1) & 15)) << 4) + (s & 7) * 2) = (bf16)f2bf(v1);
                }
            }
        }
        __syncthreads();
        {
            const bf16* Wb = (const bf16*)(a.ws + WS_SGUW) + ((size_t)j * NH + h) * 16384;
            f32x4 acc[8];
#pragma unroll
            for (int pf = 0; pf < 8; ++pf) acc[pf] = (f32x4){0.f, 0.f, 0.f, 0.f};
#pragma unroll
            for (int ks = 0; ks < 4; ++ks) {
                const bf16x8 av = *(const LAS bf16x8*)(L + (wave * 16 + fr) * 256 + (((ks * 4 + fq) ^ fr) << 4));
#pragma unroll
                for (int pf = 0; pf < 8; ++pf) {
                    const bf16x8 bw = *(const bf16x8*)(Wb + (pf * 16 + fr) * 128 + ks * 32 + fq * 8);
                    acc[pf] = MFMA16(av, bw, acc[pf]);
                }
            }
            const float* bs = a.in[I_SGUB] + ((size_t)j * NH + h) * 128;
#pragma unroll
            for (int pf = 0; pf < 8; ++pf) {
                const int p = pf * 16 + fr, row = r0 + p, c = wave * 16 + 4 * fq; const float b = bs[p];
                const u32x2 gu = *(const u32x2*)(G + (size_t)row * 1536 + h * 128 + c);
                const float u0 = __builtin_bit_cast(float, gu.x << 16), u1 = __builtin_bit_cast(float, gu.x & 0xffff0000u), u2 = __builtin_bit_cast(float, gu.y << 16), u3 = __builtin_bit_cast(float, gu.y & 0xffff0000u);
                u32x2 o; o.x = pk2(u0 * (acc[pf][0] + b), u1 * (acc[pf][1] + b)); o.y = pk2(u2 * (acc[pf][2] + b), u3 * (acc[pf][3] + b));
                *(u32x2*)(Y + (size_t)row * D + h * 128 + c) = o;
            }
        }
    }
    __syncthreads();
}
__device__ __forceinline__ void phase_odd_fc(Frame& F) {
    const CAS Args& a = *F.a;
    const float* BR = (const float*)(a.ws + WS_QN); const float* BI = (const float*)(a.ws + WS_KN); bf16* Y = (bf16*)(a.ws + WS_Y);
    constexpr int NC_LAT = LAT_B * 32 / 2, NC_CTX = CTX_B * 16 / 2;
    for (int it = F.vcu; it < NC_LAT + NC_CTX; it += F.G) {
        int tid_ = F.tid; asm volatile("" : "+v"(tid_));
        if (it < NC_LAT) { const int q = it * 2 + (tid_ >> 8); fourier_c_item<32>(BR, BI, Y, NCTX + (q >> 5) * LAT_L, q & 31, tid_ & 255); }
        else { const int q = (it - NC_LAT) * 2 + (tid_ >> 8); fourier_c_item<16>(BR, BI, Y, (q >> 4) * CTX_L, q & 15, tid_ & 255); }
    }
    __syncthreads();
}

constexpr int STEPS = 9, N_PHASES = 2 + DEPTH * STEPS + 1;
__device__ __forceinline__ bool phase_active(int ph) {
    if (ph < 2 || ph == N_PHASES - 1) return true;
    const int l = (ph - 2) / STEPS, st = (ph - 2) % STEPS;
    return !((l & 1) && st == 5);
}
__device__ __forceinline__ void run_phase(Frame& F, int ph) {
    const CAS Args& a = *F.a; unsigned char* ws = a.ws;
    if (ph == 0) { phase_setup(F); return; }
    if (ph == 1) { phase_init(F); return; }
    if (ph == N_PHASES - 1) { phase_final(F, F.grp); return; }
    const int l = (ph - 2) / STEPS, st = (ph - 2) % STEPS, e = l >> 1;
    bf16* XS = (bf16*)(ws + WS_HN); bf16* HH = (bf16*)(ws + WS_HH); float* X = (float*)(ws + WS_X); float* P = (float*)(ws + WS_P);
    const bf16* Y = (const bf16*)(ws + WS_Y); const float* mod = (const float*)(ws + WS_MOD);
    float* ssb = (float*)(ws + WS_CTL + CTL_SS_OFF); const float* biasb = (const float*)(ws + WS_BIAS);
#define PRE_OF(s_) Pre{ssb + (size_t)(s_) * M, biasb + (size_t)(s_) * 3 * NBMAX}
    switch (st) {
        case 0: { EpiUp E{HH, PRE_OF(3 * l)}; gemm_phase<11, EpiUp>(F, XS, (const bf16*)(ws + WS_WUP + (size_t)(l * 2) * WUP_SZ), D, NUP, E); } break;
        case 1: { EpiRes E{X, mod, l, 2, 0.5f, XS, ssb + (size_t)(3 * l + 1) * M, a.in[I_MIXN] + l * D, l, 1}; gemm_phase<4, EpiRes>(F, HH, (const bf16*)(ws + WS_WDN + (size_t)(l * 2) * WDN_SZ), FF, D, E); } break;
        case 2: { if ((l & 1) == 0) { EpiStore E{(bf16*)(ws + WS_P), (float*)(ws + WS_AG), PRE_OF(3 * l + 1)}; gemm_phase<7, EpiStore>(F, XS, (const bf16*)(ws + WS_EVIN + (size_t)e * EVIN_SZ), D, P_EVEN_PAD, E); }
                  else { EpiOdd EO{(bf16*)(ws + WS_P), (float*)(ws + WS_ZR), (float*)(ws + WS_ZI), (float*)(ws + WS_CTL + CTL_ST_OFF) + (size_t)e * M * 2, PRE_OF(3 * l + 1)};
                         gemm_phase<8, EpiOdd>(F, XS, (const bf16*)(ws + WS_ODIN + (size_t)e * ODIN_SZ), D, 2048, EO); } } break;
        case 3: if ((l & 1) == 0) phase_dn_prep(F, e); else phase_odd_mix(F, e); break;
        case 4: if ((l & 1) == 0) phase_dn_scan(F, e); else phase_odd_fc(F); break;
        case 5: if ((l & 1) == 0) phase_dn_fin(F, e); break;
        case 6: { EpiRes E{X, mod, l, 5, 1.0f, XS, ssb + (size_t)(3 * l + 2) * M, a.in[I_F2N] + l * D, l, 2}; gemm_phase<4, EpiRes>(F, Y, (const bf16*)(ws + ((l & 1) ? WS_ODOUT : WS_EVOUT) + (size_t)e * SQ_SZ), D, D, E); } break;
        case 7: { EpiUp E{HH, PRE_OF(3 * l + 2)}; gemm_phase<11, EpiUp>(F, XS, (const bf16*)(ws + WS_WUP + (size_t)(l * 2 + 1) * WUP_SZ), D, NUP, E); } break;
        case 8: { const bool last = (l == DEPTH - 1);
                  EpiRes E{X, mod, l, 8, 0.5f, XS, last ? nullptr : ssb + (size_t)(3 * l + 3) * M, a.in[I_F1N] + (last ? l : l + 1) * D, last ? l : l + 1, 0};
                  gemm_phase<4, EpiRes>(F, HH, (const bf16*)(ws + WS_WDN + (size_t)(l * 2 + 1) * WDN_SZ), FF, D, E); } break;
    }
#undef PRE_OF
}

__global__ void __launch_bounds__(512, 2) mk_fwd(Args args) {
    extern __shared__ __attribute__((aligned(16))) unsigned char lds_raw[];
    Frame F;
    F.lds = (LAS unsigned char*)lds_raw;
    F.tid = threadIdx.x; F.lane = F.tid & 63; F.wave = __builtin_amdgcn_readfirstlane(F.tid >> 6);
    F.G = gridDim.x; { const int bx = blockIdx.x; F.vcu = (F.G % 8 == 0) ? (bx % 8) * (F.G / 8) + bx / 8 : bx; }
    const CAS Args* ap = (const CAS Args*)__builtin_amdgcn_kernarg_segment_ptr();
    F.a = ap;
    const int ph_lo = ap->ph_lo, ph_hi = ap->ph_hi;
    unsigned char* ws0 = ap->ws;
    volatile LAS unsigned* MISC = (volatile LAS unsigned*)(F.lds + LDS_MISC);
    if (F.tid < 64) MISC[F.tid] = 0u;
    __syncthreads();
    const bool multi = (ph_hi - ph_lo) > 1;
    XcdBarrier bar; bar.bar = (unsigned*)(ws0 + WS_CTL) + CW_BAR; bar.x = 0; bar.st = MISC + 8;
    if (multi) bar = xcd_barrier_post((unsigned*)(ws0 + WS_CTL) + CW_BAR, MISC + 8);
    unsigned* ctl = (unsigned*)(ws0 + WS_CTL);
    if (F.tid == 0) __hip_atomic_store(ctl + CW_GXCC + F.vcu, xb_xcc_id() + 1u, __ATOMIC_RELAXED, __HIP_MEMORY_SCOPE_AGENT);
    F.grp = false;
    for (int ph = ph_lo; ph < ph_hi; ++ph) {
        { const CAS Args* a2 = ap; asm volatile("" : "+s"(a2)); F.a = a2; }
        { int t_ = threadIdx.x; asm volatile("" : "+v"(t_)); F.tid = t_; F.lane = t_ & 63; F.wave = __builtin_amdgcn_readfirstlane(t_ >> 6); }
        if (!phase_active(ph)) continue;
        run_phase(F, ph);
        if (ph + 1 >= ph_hi) break;
        bool local = false;
        if (ph >= 2 && ph < N_PHASES - 1) { const int st = (ph - 2) % STEPS; local = (st == 0 || st == 1 || st >= 6); }
        if (local && F.grp) group_barrier(ctl, F.vcu >> 3);
        else xcd_barrier(bar);
        if (ph == 0 && multi && F.G == 256) {
            unsigned ok = 1u;
            for (int i = F.lane; i < 256; i += 64) { const unsigned mine = xb_ld(ctl + CW_GXCC + i), first = xb_ld(ctl + CW_GXCC + (i & ~7)); if (mine == 0u || mine != first) ok = 0u; }
            F.grp = (__ballot(ok != 0u) == ~0ull);
        }
    }
}

extern "C" void kernel_launch(void* const* d_in, const int* in_sizes, int n_in, void* d_out, int out_size, void* d_ws, size_t ws_size, hipStream_t stream) {
    static int grid = 0;
    if (grid == 0) {
        if (n_in != 31 || ws_size < WS_END) { fprintf(stderr, "kernel_launch: unexpected n_in %d or ws_size %zu (need %zu)\n", n_in, ws_size, (size_t)WS_END); grid = -1; return; }
        int dev = 0, cus = 0;
        if (hipGetDevice(&dev) != hipSuccess || hipDeviceGetAttribute(&cus, hipDeviceAttributeMultiprocessorCount, dev) != hipSuccess) { grid = -1; return; }
        if (hipFuncSetAttribute((const void*)mk_fwd, hipFuncAttributeMaxDynamicSharedMemorySize, LDS_BYTES) != hipSuccess) { fprintf(stderr, "kernel_launch: hipFuncSetAttribute failed\n"); grid = -1; return; }
        (void)hipGetLastError();
        grid = cus;
    }
    if (grid < 0) return;
    (void)hipMemsetAsync((char*)d_ws + WS_CTL, 0, CTL_BYTES, stream);
    (void)hipMemsetAsync((char*)d_ws + WS_MOD, 0, (size_t)4 * 3 * 9216 * 4, stream);
    (void)hipMemsetAsync((char*)d_ws + WS_BIAS, 0, (size_t)12 * 3 * NBMAX * 4, stream);
    Args a{};
    for (int i = 0; i < 31; ++i) a.in[i] = (const float*)d_in[i];
    a.out = (float*)d_out; a.ws = (unsigned char*)d_ws;
#if ONE_LAUNCH
    a.ph_lo = 0; a.ph_hi = N_PHASES;
    hipLaunchKernelGGL(mk_fwd, dim3(grid), dim3(512), LDS_BYTES, stream, a);
#else
    for (int ph = 0; ph < N_PHASES; ++ph) {
        a.ph_lo = ph; a.ph_hi = ph + 1;
        hipLaunchKernelGGL(mk_fwd, dim3(grid), dim3(512), LDS_BYTES, stream, a);
    }
#endif
}
```

```cpp
#include <hip/hip_runtime.h>
#include <cstdio>
#include <cstdint>

#ifndef ONE_LAUNCH
#define ONE_LAUNCH 1
#endif

#define GAS __attribute__((address_space(1)))
#define LAS __attribute__((address_space(3)))
#define CAS __attribute__((address_space(4)))
typedef unsigned short bf16;
typedef float f32x4 __attribute__((ext_vector_type(4)));
typedef float f32x2 __attribute__((ext_vector_type(2)));
typedef short bf16x8 __attribute__((ext_vector_type(8)));
typedef unsigned u32x4 __attribute__((ext_vector_type(4)));
typedef unsigned u32x2 __attribute__((ext_vector_type(2)));

constexpr int D = 1024, NCTX = 4096, NLAT = 2048, M = 6144, FF = 2816, DEPTH = 4;
constexpr int CTX_B = 16, CTX_L = 256, LAT_B = 2, LAT_L = 1024;
constexpr int NUP = 2 * FF;
constexpr int P_EVEN = 3352, P_EVEN_PAD = 3584, P_ODD = 1792;
constexpr int LDP = 3584;
constexpr int NH = 6, DK = 128;
constexpr float EPS = 1e-6f;
constexpr int NSEQ = CTX_B + LAT_B;

constexpr size_t MiB = 1u << 20;
constexpr size_t WS_CTL = 0, CTL_BYTES = 1 * MiB;
constexpr size_t WS_MOD = 1 * MiB;
constexpr size_t WS_WUP = 2 * MiB, WUP_SZ = 11 * MiB;
constexpr size_t WS_WDN = 90 * MiB, WDN_SZ = 5632 * 1024;
constexpr size_t WS_EVIN = 134 * MiB, EVIN_SZ = 7 * MiB;
constexpr size_t WS_EVOUT = 148 * MiB, SQ_SZ = 2 * MiB;
constexpr size_t WS_ODIN = 152 * MiB, ODIN_SZ = 4 * MiB;
constexpr size_t WS_ODOUT = 160 * MiB;
constexpr size_t WS_X = 164 * MiB;
constexpr size_t WS_HN = 188 * MiB;
constexpr size_t WS_HH = 200 * MiB;
constexpr size_t WS_P = 233 * MiB;
constexpr size_t WS_Y = 317 * MiB;
constexpr size_t WS_QN = 329 * MiB, WS_KN = 347 * MiB, WS_VV = 365 * MiB, WS_OF = 383 * MiB, WS_OB = 401 * MiB;
constexpr size_t WS_AG = 419 * MiB, WS_BT = 420 * MiB;
constexpr size_t WS_ZR = 421 * MiB, WS_ZI = 427 * MiB, WS_SPEC = 433 * MiB;
constexpr size_t WS_DW = 439 * MiB, WS_DQ = 457 * MiB, WS_DAI = 475 * MiB, WS_DKT = 484 * MiB, WS_DUT = 502 * MiB, WS_DGL = 520 * MiB;
constexpr size_t WS_BIAS = 521 * MiB;
constexpr size_t WS_END = 522 * MiB;

constexpr size_t CTL_ST_OFF = 262144;
constexpr size_t CTL_SS_OFF = 524288;
constexpr int NBMAX = 5632;
constexpr size_t WS_SGUW = 1 * MiB + 512 * 1024;
constexpr int CW_GXCC = 8192;
constexpr int CW_GCNT = 16384;
constexpr int CW_BAR = 4096;

constexpr int LDS_MAIN = 160768;
constexpr int LDS_MISC = LDS_MAIN;
constexpr int LDS_BYTES = LDS_MAIN + 1024;

__device__ __forceinline__ float wave_sum(float v) {
#pragma unroll
    for (int o = 1; o < 64; o <<= 1) v += __shfl_xor(v, o);
    return v;
}
typedef __bf16 bf16x2_t __attribute__((ext_vector_type(2)));
__device__ __forceinline__ unsigned pk2(float lo, float hi) { const f32x2 v = {lo, hi}; const bf16x2_t b = __builtin_convertvector(v, bf16x2_t); return __builtin_bit_cast(unsigned, b); }
__device__ __forceinline__ unsigned f2bf(float f) { return pk2(f, 0.f) & 0xffffu; }
__device__ __forceinline__ float rcp_f(float x) { return __builtin_amdgcn_rcpf(x); }
__device__ __forceinline__ float rsq_f(float x) { return __builtin_amdgcn_rsqf(x); }
__device__ __forceinline__ float silu_f(float x) { return x * rcp_f(1.f + __expf(-x)); }
__device__ __forceinline__ float sigmoid_f(float x) { return rcp_f(1.f + __expf(-x)); }
__device__ __forceinline__ float gelu_tanh(float x) { const float u2 = 1.5957691216057308f * (x + 0.044715f * x * x * x); return x * rcp_f(1.f + __expf(-u2)); }
__device__ __forceinline__ float softplus_f(float x) { return x > 20.f ? x : log1pf(expf(x)); }
__device__ __forceinline__ int cond_of_row(int r) { return r < NCTX ? 0 : (r < NCTX + LAT_L ? 1 : 2); }
__device__ __forceinline__ void seq_of_row(int r, int& s0, int& L) { if (r < NCTX) { s0 = r & ~(CTX_L - 1); L = CTX_L; } else { s0 = NCTX + ((r - NCTX) & ~(LAT_L - 1)); L = LAT_L; } }

#define XB_TMO      128
#define XB_XCNT(j)  (256  + 64 * (j))
#define XB_XSUB(j)  (1280 + 64 * (j))
#define XB_XGEN(j)  (2304 + 64 * (j))
#define XB_TOP      3328
#define XB_TOPGEN   3392
#define XCD_BAR_WORDS 3456
#define XB_SPIN_CAP (1u << 18)
__device__ __forceinline__ unsigned xb_ld(unsigned* p)              { return __hip_atomic_load(p, __ATOMIC_RELAXED, __HIP_MEMORY_SCOPE_AGENT); }
__device__ __forceinline__ unsigned xb_add(unsigned* p, unsigned v) { return __hip_atomic_fetch_add(p, v, __ATOMIC_RELAXED, __HIP_MEMORY_SCOPE_AGENT); }
__device__ __forceinline__ unsigned xb_xcc_id() { return (unsigned)__builtin_amdgcn_s_getreg((3 << 11) | 20) & 0xFu; }
#define XB_SPIN(cond, bar) do { unsigned _sp = 0; while (cond) { __builtin_amdgcn_s_sleep(1); \
    if ((++_sp & 255u) == 0u) { if (xb_ld(&(bar)[XB_TMO])) break; if (_sp > XB_SPIN_CAP) { atomicAdd(&(bar)[XB_TMO], 1u); break; } } } } while (0)
struct XcdBarrier { unsigned* bar; unsigned x; volatile LAS unsigned* st; };
__device__ __forceinline__ XcdBarrier xcd_barrier_post(unsigned* bar, volatile LAS unsigned* st) {
    XcdBarrier b; b.bar = bar; b.x = xb_xcc_id(); b.st = st;
    if (threadIdx.x == 0) (void)xb_add(&bar[XB_XCNT(b.x)], 1u);
    return b;
}
__device__ __forceinline__ void xcd_barrier_complete(unsigned* bar, unsigned x, unsigned& nloc, unsigned& nx) {
    const unsigned G = gridDim.x * gridDim.y * gridDim.z;
    unsigned sum, cnt, mine, sp = 0u;
    for (;;) {
        sum = 0u; cnt = 0u; mine = 0u;
#pragma unroll
        for (unsigned j = 0; j < 16; ++j) { const unsigned c = xb_ld(&bar[XB_XCNT(j)]); sum += c; cnt += (c > 0u) ? 1u : 0u; mine = (j == x) ? c : mine; }
        if (sum == G) break;
        __builtin_amdgcn_s_sleep(1);
        if ((++sp & 255u) == 0u) { if (xb_ld(&bar[XB_TMO])) break; if (sp > XB_SPIN_CAP) { atomicAdd(&bar[XB_TMO], 1u); break; } }
    }
    nloc = mine > 0u ? mine : 1u; nx = cnt > 0u ? cnt : 1u;
}
__device__ __forceinline__ void xcd_barrier(const XcdBarrier& b) {
    asm volatile("s_waitcnt vmcnt(0)" ::: "memory");
    __syncthreads();
    if (threadIdx.x == 0) {
        unsigned* bar = b.bar;
        __builtin_amdgcn_s_waitcnt(0);
        unsigned nloc = b.st[0], nx = b.st[1];
        if (nloc == 0u) { xcd_barrier_complete(bar, b.x, nloc, nx); b.st[0] = nloc; b.st[1] = nx; }
        const unsigned old = xb_add(&bar[XB_XSUB(b.x)], 1u);
        const unsigned gen = old / nloc;
        if (old + 1u == (gen + 1u) * nloc) {
            __builtin_amdgcn_fence(__ATOMIC_RELEASE, "agent");
            asm volatile("s_waitcnt vmcnt(0)" ::: "memory");
            const unsigned og = xb_add(&bar[XB_TOP], 1u);
            const unsigned tg = og / nx;
            if (og + 1u == (tg + 1u) * nx) xb_add(&bar[XB_TOPGEN], 1u);
            else XB_SPIN(xb_ld(&bar[XB_TOPGEN]) == tg, bar);
            __builtin_amdgcn_fence(__ATOMIC_ACQUIRE, "agent");
            xb_add(&bar[XB_XGEN(b.x)], 1u);
            asm volatile("s_waitcnt vmcnt(0)" ::: "memory");
        } else {
            XB_SPIN(xb_ld(&bar[XB_XGEN(b.x)]) == gen, bar);
            __builtin_amdgcn_fence(__ATOMIC_ACQUIRE, "agent");
            asm volatile("s_waitcnt vmcnt(0)" ::: "memory");
        }
    }
    __syncthreads();
}

__device__ __forceinline__ void group_barrier(unsigned* ctl, int group) {
    asm volatile("s_waitcnt vmcnt(0)" ::: "memory");
    __syncthreads();
    if (threadIdx.x == 0) {
        unsigned* cnt = ctl + CW_GCNT + 64 * group;
        __builtin_amdgcn_s_waitcnt(0);
        const unsigned old = xb_add(cnt, 1u), target = (old / 8u + 1u) * 8u;
        unsigned sp = 0;
        while (xb_ld(cnt) < target) { __builtin_amdgcn_s_sleep(1); if (++sp > (1u << 22)) break; }
        __builtin_amdgcn_fence(__ATOMIC_ACQUIRE, "agent");
        asm volatile("s_waitcnt vmcnt(0)" ::: "memory");
    }
    __syncthreads();
}
struct Args { const float* in[31]; float* out; unsigned char* ws; int ph_lo, ph_hi; };
enum { I_XP = 0, I_XS, I_STATE, I_C, I_CCTX, I_F1N, I_F1G, I_F1U, I_F1D, I_MIXN, I_F2N, I_F2G, I_F2U, I_F2D, I_ADAW, I_ADAB, I_EVIN, I_EVOUT,
       I_POOLW, I_POOLS, I_CONVW, I_ALOG, I_DTB, I_DNNW, I_ODIN, I_ODOUT, I_SGUN, I_SGUW, I_SGUB, I_FNETW, I_FINN };

struct Frame {
    LAS unsigned char* lds;
    int tid, lane, wave, vcu, G;
    bool grp;
    const CAS Args* a;
};

#define DS_READ128(dst, addr) asm volatile("ds_read_b128 %0, %1" : "=v"(dst) : "v"((unsigned)(addr)))
__device__ __forceinline__ void lgkm_wait(int n) {
    switch (n) { case 0: asm volatile("s_waitcnt lgkmcnt(0)" ::: "memory"); break; case 1: asm volatile("s_waitcnt lgkmcnt(1)" ::: "memory"); break;
                 case 2: asm volatile("s_waitcnt lgkmcnt(2)" ::: "memory"); break; case 3: asm volatile("s_waitcnt lgkmcnt(3)" ::: "memory"); break;
                 case 4: asm volatile("s_waitcnt lgkmcnt(4)" ::: "memory"); break; case 5: asm volatile("s_waitcnt lgkmcnt(5)" ::: "memory"); break;
                 case 6: asm volatile("s_waitcnt lgkmcnt(6)" ::: "memory"); break; default: asm volatile("s_waitcnt lgkmcnt(7)" ::: "memory"); break; }
}
__device__ __forceinline__ void vm_wait(int n) {
    switch (n) { case 0: asm volatile("s_waitcnt vmcnt(0)" ::: "memory"); break; case 4: asm volatile("s_waitcnt vmcnt(4)" ::: "memory"); break;
                 case 5: asm volatile("s_waitcnt vmcnt(5)" ::: "memory"); break; case 6: asm volatile("s_waitcnt vmcnt(6)" ::: "memory"); break;
                 case 7: asm volatile("s_waitcnt vmcnt(7)" ::: "memory"); break; case 8: asm volatile("s_waitcnt vmcnt(8)" ::: "memory"); break;
                 case 9: asm volatile("s_waitcnt vmcnt(9)" ::: "memory"); break; default: asm volatile("s_waitcnt vmcnt(0)" ::: "memory"); break; }
}
template <int NFRAG, class Epi>
__device__ __forceinline__ void gemm_tile(LAS unsigned char* lds, const int tid, const bf16* A, const bf16* Bt, int K, int row0, int col0, const Epi& E) {
    constexpr int BN = 32 * NFRAG, NPB = BN / 8, A_BYTES = 192 * 128, B_BYTES = BN * 128, STAGE = A_BYTES + B_BYTES, NBI = (NPB + 7) / 8;
    constexpr int NS = (3 * STAGE <= LDS_MAIN) ? 3 : 2;
    static_assert(NS * STAGE <= LDS_MAIN, "LDS");
    const int lane = tid & 63, wid = __builtin_amdgcn_readfirstlane(tid >> 6), wm = wid >> 1, wn = wid & 1, fr = lane & 15, fq = lane >> 4;
    const int r = lane >> 3, slot = lane & 7;
    const int srow = wid * 8 + r;
    const int chunk = slot ^ ((srow >> 1) & 7);
    const char* gA = (const char*)(A + (size_t)(row0 + srow) * K) + chunk * 16;
    const char* gB = (const char*)(Bt + (size_t)(col0 + srow) * K) + chunk * 16;
    const size_t pstep = (size_t)64 * K * 2;
    const int nt = K / 64;
    const int nbw = (NPB - wid + 7) / 8;
    const unsigned ldsb = (unsigned)(uintptr_t)lds;
    const int rowA0 = wm * 48 + fr, rowB0 = wn * NFRAG * 16 + fr;
    int offA[2], offB[2];
#pragma unroll
    for (int kk = 0; kk < 2; ++kk) {
        offA[kk] = rowA0 * 128 + (((kk * 4 + fq) ^ ((rowA0 >> 1) & 7)) << 4);
        offB[kk] = A_BYTES + rowB0 * 128 + (((kk * 4 + fq) ^ ((rowB0 >> 1) & 7)) << 4);
    }
    f32x4 acc[3][NFRAG];
#pragma unroll
    for (int i = 0; i < 3; ++i)
#pragma unroll
        for (int j = 0; j < NFRAG; ++j) acc[i][j] = (f32x4){0.f, 0.f, 0.f, 0.f};
    typename Epi::template Hold<NFRAG> hold;
    E.template preload<NFRAG>(hold, row0 + wm * 48 + fr, col0 + wn * NFRAG * 16 + fq * 4, tid, row0, col0);

#define GEMM_STAGE(buf, t) do { LAS unsigned char* sA_ = lds + (buf) * STAGE + wid * 1024; \
        _Pragma("unroll") for (int i_ = 0; i_ < 3; ++i_) \
            __builtin_amdgcn_global_load_lds((const unsigned*)(gA + i_ * pstep + (size_t)(t) * 128), (LAS unsigned*)(sA_ + i_ * 8192), 16, 0, 0); \
        _Pragma("unroll") for (int i_ = 0; i_ < NBI; ++i_) if (wid + 8 * i_ < NPB) \
            __builtin_amdgcn_global_load_lds((const unsigned*)(gB + i_ * pstep + (size_t)(t) * 128), (LAS unsigned*)(sA_ + A_BYTES + i_ * 8192), 16, 0, 0); } while (0)

    GEMM_STAGE(0, 0);
    if (NS == 3) GEMM_STAGE(1, 1);
    int sbuf = 0;
    for (int t = 0; t < nt; ++t) {
        if (NS == 3) {
            if (t + 1 < nt) { if (nbw == NBI) vm_wait(3 + NBI); else vm_wait(3 + NBI - 1); } else vm_wait(0);
            __builtin_amdgcn_s_barrier();
            if (t + 2 < nt) { const int nb_ = (sbuf >= 1) ? sbuf - 1 : 2; GEMM_STAGE(nb_, t + 2); }
        } else {
            asm volatile("s_waitcnt vmcnt(0)" ::: "memory");
            __syncthreads();
            if (t + 1 < nt) GEMM_STAGE((t + 1) & 1, t + 1);
        }
        {
            const unsigned sbo = (unsigned)sbuf * STAGE;
            const unsigned aA0 = ldsb + sbo + offA[0], aA1 = ldsb + sbo + offA[1], aB0 = ldsb + sbo + offB[0], aB1 = ldsb + sbo + offB[1];
            bf16x8 af[2][3], bq[4];
#pragma unroll
            for (int mf = 0; mf < 3; ++mf) { DS_READ128(af[0][mf], aA0 + mf * 2048); }
#pragma unroll
            for (int mf = 0; mf < 3; ++mf) { DS_READ128(af[1][mf], aA1 + mf * 2048); }
            constexpr int TOT = 2 * NFRAG;
#pragma unroll
            for (int f = 0; f < 3; ++f) { DS_READ128(bq[f], aB0 + f * 2048); }
#pragma unroll
            for (int f = 0; f < TOT; ++f) {
                if (f + 3 < TOT) { const int g = f + 3; DS_READ128(bq[g & 3], ((g >= NFRAG) ? aB1 + (g - NFRAG) * 2048 : aB0 + g * 2048)); }
                const int outstanding = (f + 3 < TOT) ? 3 : (TOT - 1 - f);
                lgkm_wait(outstanding);
                asm volatile("" : "+v"(bq[f & 3]));
                __builtin_amdgcn_sched_barrier(0);
                const int kk = (f >= NFRAG) ? 1 : 0, nf = f - kk * NFRAG;
#pragma unroll
                for (int mf = 0; mf < 3; ++mf) acc[mf][nf] = __builtin_amdgcn_mfma_f32_16x16x32_bf16(bq[f & 3], af[kk][mf], acc[mf][nf], 0, 0, 0);
            }
        }
        sbuf = (sbuf + 1 == NS) ? 0 : sbuf + 1;
    }
#undef GEMM_STAGE
    __syncthreads();
    E.template stage<NFRAG>(hold, (LAS float*)lds, tid);
    __syncthreads();
    E.template operator()<NFRAG>(acc, hold, row0 + wm * 48 + fr, col0 + wn * NFRAG * 16 + fq * 4, fq, (const LAS float*)lds, wm * 48 + fr, wn * NFRAG * 16 + fq * 4);
    asm volatile("s_waitcnt vmcnt(0)" ::: "memory");
    __syncthreads();
}

template <int RB, int PITCH>
__device__ __forceinline__ void image_store(const LAS unsigned char* img, unsigned char* dst, size_t ldb, int lane) {
    constexpr int CPR = RB / 16, TOT = 48 * CPR;
#pragma unroll
    for (int j = 0; j < (TOT + 63) / 64; ++j) {
        const int ci = lane + 64 * j;
        if (ci < TOT) { const int r = ci / CPR, ch = ci - r * CPR; *(u32x4*)(dst + (size_t)r * ldb + ch * 16) = *(const LAS u32x4*)(img + r * PITCH + ch * 16); }
    }
}
struct Pre { const float* ss; const float* bias; };
struct PreHold { float rs, b[3]; };
__device__ __forceinline__ void pre_fetch(const Pre& p, PreHold& h, int tid, int row0, int col0, int BN) {
    h.rs = (tid < 192) ? p.ss[row0 + tid] : 0.f;
#pragma unroll
    for (int q = 0; q < 3; ++q) { const int i = tid + 512 * q; const int c = i / BN, j = i - c * BN; h.b[q] = (i < 3 * BN) ? p.bias[c * NBMAX + col0 + j] : 0.f; }
}
__device__ __forceinline__ void pre_write(const PreHold& h, LAS float* sc, int tid, int BN) {
    if (tid < 192) sc[tid] = rsq_f(h.rs * (1.f / D) + EPS);
#pragma unroll
    for (int q = 0; q < 3; ++q) { const int i = tid + 512 * q; if (i < 3 * BN) sc[256 + i] = h.b[q]; }
}
struct EpiUp {
    bf16* H; Pre pre;
    template <int NFRAG> struct Hold { PreHold ph; };
    template <int NFRAG> __device__ __forceinline__ void preload(Hold<NFRAG>& h, int, int, int tid, int row0, int col0) const { pre_fetch(pre, h.ph, tid, row0, col0, 32 * NFRAG); }
    template <int NFRAG> __device__ __forceinline__ void stage(const Hold<NFRAG>& h, LAS float* sc, int tid) const { pre_write(h.ph, sc, tid, 32 * NFRAG); }
    template <int NFRAG> __device__ __forceinline__ void operator()(f32x4 (&acc)[3][NFRAG], const Hold<NFRAG>&, int row, int colq, int fq, const LAS float* sc, int lrow, int lcol) const {
        constexpr int RB = 16 * NFRAG;
        const int wm = lrow / 48, wn = lcol / (16 * NFRAG), fr = lrow - wm * 48;
        LAS unsigned char* img = (LAS unsigned char*)sc + 8192 + (wm * 2 + wn) * (48 * RB);
#pragma unroll
        for (int mf = 0; mf < 3; ++mf) {
            const int rr = row + mf * 16; const float rs = sc[lrow + mf * 16];
            const LAS float* bp = sc + 256 + cond_of_row(rr) * (32 * NFRAG) + lcol;
#pragma unroll
            for (int nf = 0; nf < NFRAG; ++nf) {
                const f32x4 v = acc[mf][nf] * rs + *(const LAS f32x4*)(bp + nf * 16);
                *(LAS unsigned*)(img + (mf * 16 + fr) * RB + nf * 16 + fq * 4) = pk2(silu_f(v[0]) * v[2], silu_f(v[1]) * v[3]);
            }
        }
        const int lane = fq * 16 + fr;
        bf16* hb = H + (size_t)(row - fr) * FF + ((colq - fq * 4) >> 1);
#pragma unroll
        for (int j = 0; j < (48 * NFRAG + 63) / 64; ++j) {
            const int ci = lane + 64 * j;
            if (ci < 48 * NFRAG) { const int r = ci / NFRAG, ch = ci - r * NFRAG; *(u32x4*)(hb + (size_t)r * FF + ch * 8) = *(const LAS u32x4*)(img + r * RB + ch * 16); }
        }
    }
};
struct EpiRes {
    float* X; const float* mod; int layer, gidx; float scale;
    bf16* XS; float* ssn; const float* nwn; int ln, wn;
    template <int NFRAG> struct Hold { f32x4 xv[3][NFRAG]; float g, c; };
    template <int NFRAG> __device__ __forceinline__ void preload(Hold<NFRAG>& h, int row, int colq, int tid, int, int col0) const {
        constexpr int BN = 32 * NFRAG; static_assert(3 * BN <= 512, "one vector element per thread");
#pragma unroll
        for (int mf = 0; mf < 3; ++mf)
#pragma unroll
            for (int nf = 0; nf < NFRAG; ++nf) h.xv[mf][nf] = *(const f32x4*)(X + (size_t)(row + mf * 16) * D + colq + nf * 16);
        const int c = tid / BN, j = tid - c * BN; h.g = 0.f; h.c = 0.f;
        if (tid < 3 * BN) {
            h.g = mod[((size_t)(layer * 3 + c) * 9 + gidx) * 1024 + col0 + j] * scale;
            h.c = nwn[col0 + j] * (mod[((size_t)(ln * 3 + c) * 9 + wn * 3 + 1) * 1024 + col0 + j] + 1.0f);
        }
    }
    template <int NFRAG> __device__ __forceinline__ void stage(const Hold<NFRAG>& h, LAS float* sc, int tid) const {
        constexpr int BN = 32 * NFRAG;
        if (tid < 3 * BN) { sc[256 + tid] = h.g; sc[256 + 3 * BN + tid] = h.c; }
    }
    template <int NFRAG> __device__ __forceinline__ void operator()(f32x4 (&acc)[3][NFRAG], const Hold<NFRAG>& h, int row, int colq, int fq, const LAS float* sc, int lrow, int lcol) const {
        constexpr int BN = 32 * NFRAG, RBX = 64 * NFRAG, RBS = 32 * NFRAG, PX = RBX + 16, PS = RBS + 16;
        const int wm = lrow / 48, wn = lcol / (16 * NFRAG), fr = lrow - wm * 48, lane = fq * 16 + fr;
        LAS unsigned char* imx = (LAS unsigned char*)sc + 8192 + (wm * 2 + wn) * (48 * PX);
        u32x2 hsw[3][NFRAG];
#pragma unroll
        for (int mf = 0; mf < 3; ++mf) {
            const int rr = row + mf * 16, cnd = cond_of_row(rr);
            const LAS float* gp = sc + 256 + cnd * BN + lcol; const LAS float* cp = sc + 256 + 3 * BN + cnd * BN + lcol;
            float ssq = 0.f;
#pragma unroll
            for (int nf = 0; nf < NFRAG; ++nf) {
                const f32x4 x = h.xv[mf][nf] + acc[mf][nf] * *(const LAS f32x4*)(gp + nf * 16);
                *(LAS f32x4*)(imx + (mf * 16 + fr) * PX + nf * 64 + fq * 16) = x;
                if (ssn) {
                    const f32x4 hs = x * *(const LAS f32x4*)(cp + nf * 16);
                    hsw[mf][nf].x = pk2(hs[0], hs[1]); hsw[mf][nf].y = pk2(hs[2], hs[3]);
                    ssq += (x[0] * x[0] + x[1] * x[1]) + (x[2] * x[2] + x[3] * x[3]);
                }
            }
            if (ssn) { ssq += __shfl_xor(ssq, 16); ssq += __shfl_xor(ssq, 32); if (fq == 0) atomicAdd(ssn + rr, ssq); }
        }
        const size_t o0 = (size_t)(row - fr) * D + (colq - fq * 4);
        image_store<RBX, PX>(imx, (unsigned char*)(X + o0), (size_t)D * 4, lane);
        if (ssn) {
#pragma unroll
            for (int mf = 0; mf < 3; ++mf)
#pragma unroll
                for (int nf = 0; nf < NFRAG; ++nf) *(LAS u32x2*)(imx + (mf * 16 + fr) * PS + nf * 32 + fq * 8) = hsw[mf][nf];
            image_store<RBS, PS>(imx, (unsigned char*)(XS + o0), (size_t)D * 2, lane);
        }
    }
};
struct EpiStore {
    bf16* P; float* GT; Pre pre;
    template <int NFRAG> struct Hold { PreHold ph; };
    template <int NFRAG> __device__ __forceinline__ void preload(Hold<NFRAG>& h, int, int, int tid, int row0, int col0) const { pre_fetch(pre, h.ph, tid, row0, col0, 32 * NFRAG); }
    template <int NFRAG> __device__ __forceinline__ void stage(const Hold<NFRAG>& h, LAS float* sc, int tid) const { pre_write(h.ph, sc, tid, 32 * NFRAG); }
    template <int NFRAG> __device__ __forceinline__ void operator()(f32x4 (&acc)[3][NFRAG], const Hold<NFRAG>&, int row, int colq, int fq, const LAS float* sc, int lrow, int lcol) const {
        constexpr int RB = 32 * NFRAG, PB = RB + 16;
        const int wm = lrow / 48, wn = lcol / (16 * NFRAG), fr = lrow - wm * 48, lane = fq * 16 + fr;
        LAS unsigned char* img = (LAS unsigned char*)sc + 8192 + (wm * 2 + wn) * (48 * PB);
#pragma unroll
        for (int mf = 0; mf < 3; ++mf) {
            const int rr = row + mf * 16; const float rs = sc[lrow + mf * 16];
            const LAS float* bp = sc + 256 + cond_of_row(rr) * (32 * NFRAG) + lcol;
#pragma unroll
            for (int nf = 0; nf < NFRAG; ++nf) {
                const f32x4 v = acc[mf][nf] * rs + *(const LAS f32x4*)(bp + nf * 16);
                const int c = colq + nf * 16;
                u32x2 w; w.x = pk2(v[0], v[1]); w.y = pk2(v[2], v[3]);
                *(LAS u32x2*)(img + (mf * 16 + fr) * PB + nf * 32 + fq * 8) = w;
                if (c >= 3328 && c < 3352) *(f32x4*)(GT + (size_t)rr * 24 + (c - 3328)) = v;
            }
        }
        image_store<RB, PB>(img, (unsigned char*)(P + (size_t)(row - fr) * LDP + (colq - fq * 4)), (size_t)LDP * 2, lane);
    }
};

template <int NFRAG, class Epi>
__device__ __forceinline__ void gemm_phase(Frame& F, const bf16* A, const bf16* Bt, int K, int N, const Epi& E) {
    constexpr int BN = 32 * NFRAG;
    const int NT = N / BN, nitems = 32 * NT;
    for (int i = F.vcu; i < nitems; i += F.G) {
        const int panel = (i >> 3) & 31, ct = (i & 7) + 8 * (i >> 8);
        gemm_tile<NFRAG, Epi>(F.lds, F.tid, A, Bt, K, panel * 192, ct * BN, E);
    }
}

__device__ __forceinline__ void transpose_item(const float* W, int K, int N, int ldw, bf16* WT, int mode, LAS float* scr, int item, int lane, const float* shp, float* biasp) {
    const int nblk = (N + 63) / 64, kb = item / nblk, nb = item % nblk, k0 = 64 * kb, n0 = 64 * nb;
    const int lc = (lane & 15) * 4, lr = lane >> 4;
    f32x4 v[16];
#pragma unroll
    for (int i = 0; i < 16; ++i) v[i] = (n0 + lc < N) ? __builtin_nontemporal_load((const f32x4*)(W + (size_t)(k0 + 4 * i + lr) * ldw + n0 + lc)) : (f32x4){0.f, 0.f, 0.f, 0.f};
    float sh0 = 0.f, sh1 = 0.f, sh2 = 0.f;
    if (biasp) { sh0 = shp[k0 + lane]; sh1 = shp[9216 + k0 + lane]; sh2 = shp[2 * 9216 + k0 + lane]; }
#pragma unroll
    for (int i = 0; i < 16; ++i) { LAS float* p = scr + (4 * i + lr) * 65 + lc; p[0] = v[i][0]; p[1] = v[i][1]; p[2] = v[i][2]; p[3] = v[i][3]; }
    asm volatile("s_waitcnt lgkmcnt(0)" ::: "memory");
    const int c = lane & 7;
#pragma unroll
    for (int j = 0; j < 8; ++j) {
        const int nl = (lane >> 3) + 8 * j, n = n0 + nl; const LAS float* s = scr + (8 * c) * 65 + nl;
        u32x4 o; o.x = pk2(s[0 * 65], s[1 * 65]); o.y = pk2(s[2 * 65], s[3 * 65]); o.z = pk2(s[4 * 65], s[5 * 65]); o.w = pk2(s[6 * 65], s[7 * 65]);
        const int dr = (mode == 0) ? n : ((n >> 1) * 4 + (n & 1) + (mode == 2 ? 2 : 0));
        if (n < N) *(u32x4*)(WT + (size_t)dr * K + k0 + 8 * c) = o;
    }
    if (biasp) {
        float b0 = 0.f, b1 = 0.f, b2 = 0.f;
#pragma unroll
        for (int kk = 0; kk < 64; ++kk) {
            const float w = scr[kk * 65 + lane];
            b0 += w * __builtin_bit_cast(float, __builtin_amdgcn_readlane(__builtin_bit_cast(int, sh0), kk));
            b1 += w * __builtin_bit_cast(float, __builtin_amdgcn_readlane(__builtin_bit_cast(int, sh1), kk));
            b2 += w * __builtin_bit_cast(float, __builtin_amdgcn_readlane(__builtin_bit_cast(int, sh2), kk));
        }
        const int n = n0 + lane, dr = (mode == 0) ? n : ((n >> 1) * 4 + (n & 1) + (mode == 2 ? 2 : 0));
        if (n < N) { atomicAdd(biasp + dr, b0); atomicAdd(biasp + NBMAX + dr, b1); atomicAdd(biasp + 2 * NBMAX + dr, b2); }
    }
    asm volatile("s_waitcnt lgkmcnt(0)" ::: "memory");
}

__device__ __forceinline__ void phase_setup(Frame& F) {
    const CAS Args& a = *F.a;
    unsigned char* ws = a.ws;
    {
        LAS float* sc = (LAS float*)F.lds;
        LAS float* red = sc + 3 * 1024;
        for (int i = F.tid; i < 3 * 1024; i += 512) { const int c = i >> 10, k = i & 1023; const float v = (c == 0) ? a.in[I_CCTX][k] : a.in[I_C][(c - 1) * 1024 + k]; sc[i] = silu_f(v); }
        __syncthreads();
        float* mod = (float*)(ws + WS_MOD);
        for (int it = F.vcu; it < 4 * 288; it += F.G) {
            const int l = it / 288, r_ = it % 288, kr = r_ / 36, seg = r_ % 36;
            const int k0 = kr * 128 + F.wave * 16;
            const float* W = a.in[I_ADAW] + (size_t)l * 1024 * 9216 + (size_t)k0 * 9216 + seg * 256 + F.lane * 4;
            f32x4 w[16];
#pragma unroll
            for (int k = 0; k < 16; ++k) w[k] = __builtin_nontemporal_load((const f32x4*)(W + (size_t)k * 9216));
            f32x4 s0 = {0, 0, 0, 0}, s1 = s0, s2 = s0;
#pragma unroll
            for (int k = 0; k < 16; ++k) { s0 += w[k] * sc[k0 + k]; s1 += w[k] * sc[1024 + k0 + k]; s2 += w[k] * sc[2048 + k0 + k]; }
            LAS float* rp = red + (F.wave * 64 + F.lane) * 12;
#pragma unroll
            for (int j = 0; j < 4; ++j) { rp[j] = s0[j]; rp[4 + j] = s1[j]; rp[8 + j] = s2[j]; }
            __syncthreads();
            if (F.tid < 256) {
                const int ln = F.tid >> 2, j = F.tid & 3, n = seg * 256 + F.tid;
#pragma unroll
                for (int c = 0; c < 3; ++c) {
                    float s = 0.f;
#pragma unroll
                    for (int wv = 0; wv < 8; ++wv) s += red[(wv * 64 + ln) * 12 + c * 4 + j];
                    if (kr == 0) s += a.in[I_ADAB][l * 9216 + n];
                    atomicAdd(mod + (size_t)(l * 3 + c) * 9216 + n, s);
                }
            }
            __syncthreads();
        }
        __syncthreads();
    }
    {
        const int gw = F.vcu * 8 + F.wave, NGW = F.G * 8;
        for (int it = gw; it < 2 * NH * 16384 / 512; it += NGW) {
            const float* sp = a.in[I_SGUW] + (size_t)it * 512 + F.lane * 8;
            const f32x4 x0 = *(const f32x4*)sp, x1 = *(const f32x4*)(sp + 4);
            u32x4 o; o.x = pk2(x0[0], x0[1]); o.y = pk2(x0[2], x0[3]); o.z = pk2(x1[0], x1[1]); o.w = pk2(x1[2], x1[3]);
            *(u32x4*)((bf16*)(ws + WS_SGUW) + (size_t)it * 512 + F.lane * 8) = o;
        }
        __syncthreads();
    }
    {
        const int gw = F.vcu * 8 + F.wave, NGW = F.G * 8;
        for (int it = gw; it < 2 * (P_EVEN_PAD - P_EVEN); it += NGW) {
            const int e = it / (P_EVEN_PAD - P_EVEN), rr = P_EVEN + it % (P_EVEN_PAD - P_EVEN);
            u32x4* p = (u32x4*)((bf16*)(ws + WS_EVIN + (size_t)e * EVIN_SZ) + (size_t)rr * D);
            p[F.lane] = (u32x4){0, 0, 0, 0}; p[64 + F.lane] = (u32x4){0, 0, 0, 0};
        }
        float* X = (float*)(ws + WS_X);
        for (int row = gw; row < M; row += NGW) {
            float* xo = X + (size_t)row * D;
            if (row < NCTX) {
                const f32x4* src = (const f32x4*)(a.in[I_XP] + (size_t)row * D);
#pragma unroll
                for (int j = 0; j < 4; ++j) ((f32x4*)xo)[j * 64 + F.lane] = src[j * 64 + F.lane];
            } else {
                const int t = (row - NCTX) & (LAT_L - 1); const float pr = (float)(t >> 6), pc = (float)(t & 63);
                const float* src = a.in[I_XS] + (size_t)(row - NCTX) * D;
#pragma unroll
                for (int j = 0; j < 16; ++j) {
                    const int ch = j * 64 + F.lane, seg = ch >> 8, i = ch & 255;
                    const float freq = expf(-9.210340371976184f * (float)i * (1.0f / 256.0f));
                    const float ang = ((seg < 2) ? pr : pc) * freq;
                    const float pe = (seg & 1) ? cosf(ang) : sinf(ang);
                    xo[ch] = src[ch] + pe;
                }
            }
        }
    }
}

__device__ __forceinline__ const bf16* sub_weight(unsigned char* ws, int s, int& N) {
    const int l = s / 3, which = s % 3, e = l >> 1;
    if (which != 1) { N = NUP; return (const bf16*)(ws + WS_WUP + (size_t)(l * 2 + (which == 2 ? 1 : 0)) * WUP_SZ); }
    if ((l & 1) == 0) { N = P_EVEN_PAD; return (const bf16*)(ws + WS_EVIN + (size_t)e * EVIN_SZ); }
    N = 2048; return (const bf16*)(ws + WS_ODIN + (size_t)e * ODIN_SZ);
}
__device__ __forceinline__ void phase_init(Frame& F) {
    const CAS Args& a = *F.a; unsigned char* ws = a.ws;
    const float* mod = (const float*)(ws + WS_MOD);
    const int gw = F.vcu * 8 + F.wave, NGW = F.G * 8;
    {
        LAS float* T = (LAS float*)F.lds;
        LAS float* wt = T + 64 * 128;
        LAS float* tw = wt + 64 * 65;
        if (F.tid < 64) { tw[F.tid] = cospif((float)F.tid * (1.f / 32.f)); tw[64 + F.tid] = sinpif((float)F.tid * (1.f / 32.f)); }
        __syncthreads();
        for (int it = F.vcu; it < 2 * 4 * 16; it += F.G) {
            const int j = it >> 6, g = (it >> 4) & 3, k0 = (it & 15) * 64;
            const float* Wg = a.in[I_FNETW] + ((size_t)j * 4 + g) * 4096;
            {
                const int c = F.tid >> 3, eb = (F.tid & 7) * 8;
                float ac[8], as[8];
#pragma unroll
                for (int q = 0; q < 8; ++q) { ac[q] = 0.f; as[q] = 0.f; }
                for (int m = 0; m < 64; ++m) {
                    const int idx = (m * c) & 63; const float cs = tw[idx], sn = tw[64 + idx];
                    const f32x4 w0 = *(const f32x4*)(Wg + m * 64 + eb), w1 = *(const f32x4*)(Wg + m * 64 + eb + 4);
#pragma unroll
                    for (int q = 0; q < 4; ++q) { ac[q] += cs * w0[q]; ac[4 + q] += cs * w1[q]; as[q] -= sn * w0[q]; as[4 + q] -= sn * w1[q]; }
                }
#pragma unroll
                for (int q = 0; q < 8; ++q) { T[c * 128 + eb + q] = ac[q] * 0.125f; T[c * 128 + 64 + eb + q] = as[q] * 0.125f; }
                const int kk = F.tid >> 3, c8 = (F.tid & 7) * 8;
                const float* wp = a.in[I_ODIN] + (size_t)j * D * P_ODD + (size_t)(k0 + kk) * P_ODD + 1536 + g * 64 + c8;
                const f32x4 x0 = *(const f32x4*)wp, x1 = *(const f32x4*)(wp + 4);
#pragma unroll
                for (int q = 0; q < 4; ++q) { wt[kk * 65 + c8 + q] = x0[q]; wt[kk * 65 + c8 + 4 + q] = x1[q]; }
            }
            __syncthreads();
            {
                const int col = F.tid & 127, kq = F.tid >> 7;
                float acc[16];
#pragma unroll
                for (int q = 0; q < 16; ++q) acc[q] = 0.f;
                for (int c = 0; c < 64; ++c) {
                    const float t = T[c * 128 + col];
#pragma unroll
                    for (int q = 0; q < 16; ++q) acc[q] += wt[(kq * 16 + q) * 65 + c] * t;
                }
                const int drow = 1536 + ((col < 64) ? (g * 64 + col) : (256 + g * 64 + col - 64));
                bf16* dst = (bf16*)(ws + WS_ODIN + (size_t)j * ODIN_SZ) + (size_t)drow * D + k0 + kq * 16;
                u32x4 o0, o1;
                o0.x = pk2(acc[0], acc[1]); o0.y = pk2(acc[2], acc[3]); o0.z = pk2(acc[4], acc[5]); o0.w = pk2(acc[6], acc[7]);
                o1.x = pk2(acc[8], acc[9]); o1.y = pk2(acc[10], acc[11]); o1.z = pk2(acc[12], acc[13]); o1.w = pk2(acc[14], acc[15]);
                *(u32x4*)dst = o0; *(u32x4*)(dst + 8) = o1;
                const float* shp = (const float*)(ws + WS_MOD) + ((size_t)((2 * j + 1) * 3) * 9 + 3) * 1024 + k0 + kq * 16 + (F.lane & 15);
                const float s0v = shp[0], s1v = shp[9216], s2v = shp[2 * 9216];
                float b0 = 0.f, b1 = 0.f, b2 = 0.f;
#pragma unroll
                for (int q = 0; q < 16; ++q) {
                    b0 += acc[q] * __builtin_bit_cast(float, __builtin_amdgcn_readlane(__builtin_bit_cast(int, s0v), q));
                    b1 += acc[q] * __builtin_bit_cast(float, __builtin_amdgcn_readlane(__builtin_bit_cast(int, s1v), q));
                    b2 += acc[q] * __builtin_bit_cast(float, __builtin_amdgcn_readlane(__builtin_bit_cast(int, s2v), q));
                }
                float* bp = (float*)(ws + WS_BIAS) + (size_t)(3 * (2 * j + 1) + 1) * 3 * NBMAX + drow;
                atomicAdd(bp, b0); atomicAdd(bp + NBMAX, b1); atomicAdd(bp + 2 * NBMAX, b2);
            }
            __syncthreads();
        }
    }
    {
        LAS float* scr = (LAS float*)(F.lds + F.wave * 16640);
        const int gw = F.vcu * 8 + F.wave, NGW = F.G * 8;
        constexpr int IT_G = 16 * 44, IT_D = 44 * 16, IT_EVIN = 16 * 53, IT_SQ = 16 * 16, IT_ODIN = 16 * 24;
        static_assert(IT_G == IT_D, "decode");
        constexpr int PER_FFN = 2 * IT_G + IT_D;
        constexpr int TOT = 8 * PER_FFN + 2 * (IT_EVIN + IT_SQ + IT_ODIN + IT_SQ);
        for (int it = gw; it < TOT; it += NGW) {
            int r = it; const float* W; bf16* WT; int K, N, mode, ldw = 0, sub_s = -1;
            if (r < 8 * PER_FFN) {
                const int f = r / PER_FFN, l = f >> 1, s = f & 1; r -= f * PER_FFN;
                const int sub = r / IT_G; r -= sub * IT_G;
                const int idx = (sub == 0) ? (s ? I_F2G : I_F1G) : ((sub == 1) ? (s ? I_F2U : I_F1U) : (s ? I_F2D : I_F1D));
                W = a.in[idx] + (size_t)l * D * FF;
                WT = (sub == 2) ? (bf16*)(ws + WS_WDN + (size_t)f * WDN_SZ) : (bf16*)(ws + WS_WUP + (size_t)f * WUP_SZ);
                K = (sub == 2) ? FF : D; N = (sub == 2) ? D : FF; mode = (sub == 2) ? 0 : sub + 1;
                if (sub != 2) sub_s = 3 * l + (s ? 2 : 0);
            } else {
                r -= 8 * PER_FFN;
                constexpr int PER_E = IT_EVIN + IT_SQ + IT_ODIN + IT_SQ;
                const int e = r / PER_E; r -= e * PER_E;
                K = D; mode = 0;
                if (r < IT_EVIN) { W = a.in[I_EVIN] + (size_t)e * D * P_EVEN; N = P_EVEN; WT = (bf16*)(ws + WS_EVIN + (size_t)e * EVIN_SZ); sub_s = 3 * (2 * e) + 1; }
                else if (r < IT_EVIN + IT_SQ) { r -= IT_EVIN; W = a.in[I_EVOUT] + (size_t)e * D * D; N = D; WT = (bf16*)(ws + WS_EVOUT + (size_t)e * SQ_SZ); }
                else if (r < IT_EVIN + IT_SQ + IT_ODIN) { r -= IT_EVIN + IT_SQ; W = a.in[I_ODIN] + (size_t)e * D * P_ODD; N = 1536; ldw = P_ODD; WT = (bf16*)(ws + WS_ODIN + (size_t)e * ODIN_SZ); sub_s = 3 * (2 * e + 1) + 1; }
                else { r -= IT_EVIN + IT_SQ + IT_ODIN; W = a.in[I_ODOUT] + (size_t)e * D * D; N = D; WT = (bf16*)(ws + WS_ODOUT + (size_t)e * SQ_SZ); }
            }
            const float* shp = nullptr; float* biasp = nullptr;
            if (sub_s >= 0) { shp = (const float*)(ws + WS_MOD) + ((size_t)((sub_s / 3) * 3) * 9 + (sub_s % 3) * 3) * 1024; biasp = (float*)(ws + WS_BIAS) + (size_t)sub_s * 3 * NBMAX; }
            transpose_item(W, K, N, ldw ? ldw : N, WT, mode, scr, r, F.lane, shp, biasp);
        }
    }
    {
        const float* X = (const float*)(ws + WS_X); bf16* XS = (bf16*)(ws + WS_HN);
        float* ss = (float*)(ws + WS_CTL + CTL_SS_OFF);
        const float* nw = a.in[I_F1N];
        for (int row = gw; row < M; row += NGW) {
            const f32x4* xr = (const f32x4*)(X + (size_t)row * D) + F.lane;
            f32x4 v[4]; float s = 0.f;
#pragma unroll
            for (int j = 0; j < 4; ++j) { v[j] = xr[64 * j]; s += v[j][0] * v[j][0] + v[j][1] * v[j][1] + v[j][2] * v[j][2] + v[j][3] * v[j][3]; }
            s = wave_sum(s);
            if (F.lane == 0) ss[row] = s;
            const float* mb = mod + ((size_t)(0 * 3 + cond_of_row(row)) * 9 + 1) * 1024;
            u32x2* o = (u32x2*)(XS + (size_t)row * D) + F.lane;
#pragma unroll
            for (int j = 0; j < 4; ++j) {
                const int k = (64 * j + F.lane) * 4;
                const f32x4 h = v[j] * *(const f32x4*)(nw + k) * (*(const f32x4*)(mb + k) + 1.0f);
                u32x2 pkd; pkd.x = pk2(h[0], h[1]); pkd.y = pk2(h[2], h[3]);
                o[64 * j] = pkd;
            }
        }
    }
}

__device__ __forceinline__ void phase_final(Frame& F, bool panel_local) {
    const CAS Args& a = *F.a;
    const float* X = (const float*)(a.ws + WS_X);
    const float* nw = a.in[I_FINN];
    const int gw = panel_local ? (F.vcu & 7) * 8 + F.wave : F.vcu * 8 + F.wave, NGW = panel_local ? 64 : F.G * 8;
    const int rbeg = panel_local ? (F.vcu >> 3) * 192 : 0, rend = panel_local ? rbeg + 192 : M;
    for (int row = rbeg + gw; row < rend; row += NGW) {
        const f32x4* xr = (const f32x4*)(X + (size_t)row * D) + F.lane;
        f32x4 v[4]; float s = 0.f;
#pragma unroll
        for (int j = 0; j < 4; ++j) { v[j] = xr[64 * j]; s += v[j][0] * v[j][0] + v[j][1] * v[j][1] + v[j][2] * v[j][2] + v[j][3] * v[j][3]; }
        const float rstd = 1.0f / sqrtf(wave_sum(s) * (1.f / D) + EPS);
        f32x4* o = (f32x4*)(a.out + (size_t)row * D) + F.lane;
#pragma unroll
        for (int j = 0; j < 4; ++j) { const f32x4 w = *(const f32x4*)(nw + (64 * j + F.lane) * 4); o[64 * j] = v[j] * rstd * w; }
    }
}

__device__ __forceinline__ float wave_matvec64(float d, const float* W, int lane) {
    float y = 0.f;
#pragma unroll
    for (int c = 0; c < 64; ++c) { const float dc = __builtin_bit_cast(float, __builtin_amdgcn_readlane(__builtin_bit_cast(int, d), c)); y += dc * W[c * 64 + lane]; }
    return y;
}

__device__ __forceinline__ int perm32(int x) { return (x & ~31) | ((x & 12) << 1) | ((x & 16) >> 2) | (x & 3); }
__device__ __forceinline__ int sw256(int row, int c16) { return row * 256 + ((c16 ^ (row & 15)) << 4); }
__device__ __forceinline__ int sw128(int row, int c8) { return row * 128 + ((c8 ^ ((row >> 1) & 7)) << 4); }
__device__ __forceinline__ int e128(int row, int col) { return sw128(row, col >> 3) + (col & 7) * 2; }
__device__ __forceinline__ void dn_item_decode(int cc, int& row0, int& L, int& c) {
    if (cc < 64) { row0 = (cc >> 2) * CTX_L; L = CTX_L; c = cc & 3; } else { const int q = cc - 64; row0 = NCTX + (q >> 4) * LAT_L; L = LAT_L; c = q & 15; }
}
#define MFMA16(a, b, c) __builtin_amdgcn_mfma_f32_16x16x32_bf16((a), (b), (c), 0, 0, 0)

__device__ __forceinline__ void phase_dn_prep(Frame& F, int e) {
    const CAS Args& a = *F.a;
    const bf16* P = (const bf16*)(a.ws + WS_P); const float* GT = (const float*)(a.ws + WS_AG);
    const float* cw = a.in[I_CONVW] + (size_t)e * 3 * 2304;
    LAS unsigned char* L = F.lds;
    constexpr int CWL = 114688;
    constexpr int KB = 0, QB = 16384, VBT = 32768, KGT = 49152, KDT = 65536, AIo = 81920, MM = 90112, TT = 98304, TN = 106496, MD = 114688, XT = 118784, SM = 139264, VB16 = 140288;
    LAS float* sm = (LAS float*)(L + SM);
    const int wave = F.wave;
    for (int rec = F.vcu; rec < 1152; rec += F.G) {
        int tid_ = F.tid; asm volatile("" : "+v"(tid_));
        const int lane = tid_ & 63, fr = lane & 15, fq = lane >> 4;
        const int dir = rec & 1, h = (rec >> 1) % NH, cc = rec / (2 * NH);
        int row0, Ls, c; dn_item_decode(cc, row0, Ls, c);
        __syncthreads();
        for (int i_ = tid_; i_ < 1152; i_ += 512) { const int part = i_ / 384, r_ = i_ % 384, tap = r_ >> 7, ch = r_ & 127; ((LAS float*)(L + CWL))[i_] = cw[tap * 2304 + part * 768 + h * 128 + ch]; }
        if (wave == 0) {
            const int row = row0 + (dir ? (Ls - 1 - (c * 64 + lane)) : (c * 64 + lane));
            const float araw = GT[(size_t)row * 24 + 12 + dir * 6 + h], braw = GT[(size_t)row * 24 + dir * 6 + h];
            const float al = a.in[I_ALOG][(e * 2 + dir) * 6 + h], dtb = a.in[I_DTB][(e * 2 + dir) * 6 + h];
            float x = -expf(al) * softplus_f(araw + dtb); const float b = sigmoid_f(braw);
#pragma unroll
            for (int o = 1; o < 64; o <<= 1) { const float t = __shfl_up(x, o); if (lane >= o) x += t; }
            const float gl = __shfl(x, 63);
            sm[lane] = x; sm[64 + lane] = b; sm[128 + lane] = expf(x); sm[192 + lane] = expf(gl - x);
            if (lane == 63) ((float*)(a.ws + WS_DGL))[rec] = expf(x);
        }
        __syncthreads();
        {
            const int i = tid_ >> 3, cg = tid_ & 7;
            const int row = row0 + (dir ? (Ls - 1 - (c * 64 + i)) : (c * 64 + i));
            const int tl = row - row0; const bool hp = tl > 0, hn = tl < Ls - 1;
            float kf[16], qf[16], vf[16];
#pragma unroll
            for (int part = 0; part < 3; ++part) {
                const int pc = 256 + part * 768 + h * 128 + cg * 16;
                const bf16* p1 = P + (size_t)row * LDP + pc;
                const LAS float* wl = (const LAS float*)(L + CWL) + part * 384 + cg * 16;
                float out[16];
#pragma unroll
                for (int q8 = 0; q8 < 2; ++q8) {
                    const u32x4 r1 = *(const u32x4*)(p1 + q8 * 8);
                    const u32x4 r0 = hp ? *(const u32x4*)(p1 - LDP + q8 * 8) : (u32x4){0, 0, 0, 0};
                    const u32x4 r2 = hn ? *(const u32x4*)(p1 + LDP + q8 * 8) : (u32x4){0, 0, 0, 0};
                    const unsigned a0[4] = {r0.x, r0.y, r0.z, r0.w}, a1[4] = {r1.x, r1.y, r1.z, r1.w}, a2[4] = {r2.x, r2.y, r2.z, r2.w};
#pragma unroll
                    for (int d = 0; d < 4; ++d) {
#pragma unroll
                        for (int hh = 0; hh < 2; ++hh) {
                            const int j = q8 * 8 + d * 2 + hh;
                            const float x0 = __builtin_bit_cast(float, hh ? (a0[d] & 0xffff0000u) : (a0[d] << 16));
                            const float x1 = __builtin_bit_cast(float, hh ? (a1[d] & 0xffff0000u) : (a1[d] << 16));
                            const float x2 = __builtin_bit_cast(float, hh ? (a2[d] & 0xffff0000u) : (a2[d] << 16));
                            out[j] = silu_f(x0 * wl[j] + x1 * wl[128 + j] + x2 * wl[256 + j]);
                        }
                    }
                }
                if (part < 2) {
                    float ssq = 0.f;
#pragma unroll
                    for (int j = 0; j < 16; ++j) ssq += out[j] * out[j];
                    ssq += __shfl_xor(ssq, 1); ssq += __shfl_xor(ssq, 2); ssq += __shfl_xor(ssq, 4);
                    const float rs = rsq_f(ssq + EPS) * (part == 0 ? 0.08838834764831845f : 1.0f);
#pragma unroll
                    for (int j = 0; j < 16; ++j) { if (part == 0) qf[j] = out[j] * rs; else kf[j] = out[j] * rs; }
                } else {
#pragma unroll
                    for (int j = 0; j < 16; ++j) vf[j] = out[j];
                }
            }
            const float eg = sm[128 + i];
#pragma unroll
            for (int hf = 0; hf < 2; ++hf) {
                u32x4 kk, qq, vv;
                kk.x = pk2(kf[hf * 8 + 0], kf[hf * 8 + 1]); kk.y = pk2(kf[hf * 8 + 2], kf[hf * 8 + 3]); kk.z = pk2(kf[hf * 8 + 4], kf[hf * 8 + 5]); kk.w = pk2(kf[hf * 8 + 6], kf[hf * 8 + 7]);
                qq.x = pk2(qf[hf * 8 + 0], qf[hf * 8 + 1]); qq.y = pk2(qf[hf * 8 + 2], qf[hf * 8 + 3]); qq.z = pk2(qf[hf * 8 + 4], qf[hf * 8 + 5]); qq.w = pk2(qf[hf * 8 + 6], qf[hf * 8 + 7]);
                vv.x = pk2(vf[hf * 8 + 0], vf[hf * 8 + 1]); vv.y = pk2(vf[hf * 8 + 2], vf[hf * 8 + 3]); vv.z = pk2(vf[hf * 8 + 4], vf[hf * 8 + 5]); vv.w = pk2(vf[hf * 8 + 6], vf[hf * 8 + 7]);
                *(LAS u32x4*)(L + KB + sw256(i, cg * 2 + hf)) = kk;
                *(LAS u32x4*)(L + QB + sw256(i, cg * 2 + hf)) = qq;
                *(LAS u32x4*)(L + VB16 + sw256(i, cg * 2 + hf)) = vv;
            }
            bf16* QD = (bf16*)(a.ws + WS_DQ) + (size_t)rec * 8192 + i * 128;
#pragma unroll
            for (int qq = 0; qq < 4; ++qq) {
                const int pos = perm32(cg * 16 + 4 * qq);
                u32x2 w; w.x = pk2(qf[4 * qq] * eg, qf[4 * qq + 1] * eg); w.y = pk2(qf[4 * qq + 2] * eg, qf[4 * qq + 3] * eg);
                *(u32x2*)(QD + pos) = w;
            }
        }
        __syncthreads();
        {
            const int kdl = lane & 15, ipl = lane >> 4;
#pragma unroll 2
            for (int it8 = 0; it8 < 8; ++it8) {
                const int combo = wave * 8 + it8, kd = (combo & 7) * 16 + kdl, i0 = 2 * ((combo >> 3) * 4 + ipl);
                const int a0 = sw256(i0, kd >> 3) + (kd & 7) * 2, a1 = sw256(i0 + 1, kd >> 3) + (kd & 7) * 2;
                const float k0 = __builtin_bit_cast(float, (unsigned)(*(const LAS bf16*)(L + KB + a0)) << 16), k1 = __builtin_bit_cast(float, (unsigned)(*(const LAS bf16*)(L + KB + a1)) << 16);
                const float v0 = __builtin_bit_cast(float, (unsigned)(*(const LAS bf16*)(L + VB16 + a0)) << 16), v1 = __builtin_bit_cast(float, (unsigned)(*(const LAS bf16*)(L + VB16 + a1)) << 16);
                const float be0 = sm[64 + i0], be1 = sm[65 + i0], eg0 = sm[128 + i0], eg1 = sm[129 + i0], ek0 = sm[192 + i0], ek1 = sm[193 + i0];
                *(LAS unsigned*)(L + VBT + e128(kd, i0)) = pk2(v0 * be0, v1 * be1);
                *(LAS unsigned*)(L + KGT + e128(kd, i0)) = pk2(k0 * be0 * eg0, k1 * be1 * eg1);
                *(LAS unsigned*)(L + KDT + e128(kd, perm32(i0))) = pk2(k0 * ek0, k1 * ek1);
            }
        }
        __syncthreads();
        const int mi = wave >> 1;
#pragma unroll
        for (int f = 0; f < 2; ++f) {
            const int nj = (wave & 1) * 2 + f;
            f32x4 kkacc = {0.f, 0.f, 0.f, 0.f}, qkacc = {0.f, 0.f, 0.f, 0.f};
            if (nj <= mi) {
#pragma unroll
                for (int ks = 0; ks < 4; ++ks) {
                    const bf16x8 ak = *(const LAS bf16x8*)(L + KB + sw256(mi * 16 + fr, ks * 4 + fq));
                    const bf16x8 aq = *(const LAS bf16x8*)(L + QB + sw256(mi * 16 + fr, ks * 4 + fq));
                    const bf16x8 bk = *(const LAS bf16x8*)(L + KB + sw256(nj * 16 + fr, ks * 4 + fq));
                    kkacc = MFMA16(ak, bk, kkacc); qkacc = MFMA16(aq, bk, qkacc);
                }
            }
            const int j = nj * 16 + fr, i0 = mi * 16 + 4 * fq; const float gcj = sm[j];
#pragma unroll
            for (int r = 0; r < 4; ++r) {
                const int i = i0 + r; const float dec = (i >= j) ? __expf(sm[i] - gcj) : 0.f;
                const float mv = (i > j) ? (sm[64 + i] * kkacc[r] * dec) : 0.f;
                if (nj <= mi) *(LAS bf16*)(L + MM + e128(i, j)) = (bf16)f2bf(mv);
                if (nj == mi) *(LAS float*)(L + MD + ((mi * 16 + 4 * fq + r) * 16 + fr) * 4) = mv;
                if (nj > mi) *(LAS bf16*)(L + TN + e128(i, j)) = (bf16)0;
                *(LAS bf16*)(L + AIo + e128(i, perm32(j))) = (bf16)f2bf(qkacc[r] * dec);
            }
        }
        __syncthreads();
        if (wave == 0) {
            const int b = lane >> 4, cc_ = lane & 15;
            const LAS float* md = (const LAS float*)(L + MD) + b * 256;
            float T[16];
#pragma unroll
            for (int i = 0; i < 16; ++i) {
                float s = (i == cc_) ? 1.f : 0.f;
#pragma unroll
                for (int jj = 0; jj < i; ++jj) s -= md[i * 16 + jj] * T[jj];
                T[i] = s;
            }
#pragma unroll
            for (int i = 0; i < 16; ++i) *(LAS bf16*)(L + TN + e128(16 * b + i, 16 * b + cc_)) = (bf16)f2bf(T[i]);
#pragma unroll
            for (int hf = 0; hf < 2; ++hf) {
                u32x4 t; t.x = pk2(T[hf * 8 + 0], T[hf * 8 + 1]); t.y = pk2(T[hf * 8 + 2], T[hf * 8 + 3]); t.z = pk2(T[hf * 8 + 4], T[hf * 8 + 5]); t.w = pk2(T[hf * 8 + 6], T[hf * 8 + 7]);
                *(LAS u32x4*)(L + TT + sw128(16 * b + cc_, 2 * b + hf)) = t;
            }
        }
        __syncthreads();
#pragma unroll
        for (int lvl = 1; lvl <= 3; ++lvl) {
            if (wave < 4 - lvl) {
                const int J = wave, I = wave + lvl;
                f32x4 x = {0.f, 0.f, 0.f, 0.f};
                const bf16x8 zero8 = {0, 0, 0, 0, 0, 0, 0, 0};
#pragma unroll
                for (int ks = 0; ks < (lvl == 3 ? 2 : 1); ++ks) {
                    const bf16x8 am = *(const LAS bf16x8*)(L + MM + sw128(16 * I + fr, 2 * J + 4 * ks + fq));
                    bf16x8 bt = *(const LAS bf16x8*)(L + TT + sw128(16 * J + fr, 2 * J + 4 * ks + fq));
                    if (4 * ks + fq >= 2 * lvl) bt = zero8;
                    x = MFMA16(am, bt, x);
                }
                LAS unsigned char* xt = L + XT + wave * 512;
                { u32x2 t; t.x = pk2(x[0], x[1]); t.y = pk2(x[2], x[3]); *(LAS u32x2*)(xt + fr * 32 + fq * 8) = t; }
                const bf16x8 ad = *(const LAS bf16x8*)(L + TN + sw128(16 * I + fr, 2 * I + (fq & 1)));
                bf16x8 bx = *(const LAS bf16x8*)(xt + fr * 32 + (fq & 1) * 16);
                if (fq >= 2) bx = zero8;
                f32x4 t4 = {0.f, 0.f, 0.f, 0.f};
                t4 = MFMA16(ad, bx, t4);
#pragma unroll
                for (int r = 0; r < 4; ++r) *(LAS bf16*)(L + TN + e128(16 * I + 4 * fq + r, 16 * J + fr)) = (bf16)f2bf(-t4[r]);
                { u32x2 t; t.x = pk2(-t4[0], -t4[1]); t.y = pk2(-t4[2], -t4[3]); *(LAS u32x2*)(L + TT + e128(16 * J + fr, 16 * I + 4 * fq)) = t; }
            }
            __syncthreads();
        }
        {
            bf16* UT = (bf16*)(a.ws + WS_DUT) + (size_t)rec * 8192;
            bf16* Wn = (bf16*)(a.ws + WS_DW) + (size_t)rec * 8192;
            const int ui = wave & 3;
#pragma unroll
            for (int f = 0; f < 4; ++f) {
                const int dvf = (wave >> 2) * 4 + f;
                f32x4 acc = {0.f, 0.f, 0.f, 0.f};
#pragma unroll
                for (int ks = 0; ks < 2; ++ks) {
                    const bf16x8 ta = *(const LAS bf16x8*)(L + TN + sw128(ui * 16 + fr, ks * 4 + fq));
                    const bf16x8 vb = *(const LAS bf16x8*)(L + VBT + sw128(dvf * 16 + fr, ks * 4 + fq));
                    acc = MFMA16(ta, vb, acc);
                }
                u32x2 t; t.x = pk2(acc[0], acc[1]); t.y = pk2(acc[2], acc[3]);
                *(u32x2*)(UT + (dvf * 16 + fr) * 64 + ui * 16 + 4 * fq) = t;
            }
#pragma unroll
            for (int f = 0; f < 4; ++f) {
                f32x4 acc = {0.f, 0.f, 0.f, 0.f};
#pragma unroll
                for (int ks = 0; ks < 2; ++ks) {
                    const bf16x8 ka = *(const LAS bf16x8*)(L + KGT + sw128(wave * 16 + fr, ks * 4 + fq));
                    const bf16x8 tb = *(const LAS bf16x8*)(L + TN + sw128(f * 16 + fr, ks * 4 + fq));
                    acc = MFMA16(ka, tb, acc);
                }
                u32x2 t; t.x = pk2(-acc[0], -acc[1]); t.y = pk2(-acc[2], -acc[3]);
                *(u32x2*)(Wn + (f * 16 + fr) * 128 + perm32(wave * 16 + 4 * fq)) = t;
            }
            {
                const int rw = tid_ >> 3, c8 = tid_ & 7;
                *(u32x4*)((unsigned char*)(a.ws + WS_DAI) + (size_t)rec * 8192 + rw * 128 + c8 * 16) = *(const LAS u32x4*)(L + AIo + sw128(rw, c8));
#pragma unroll
                for (int k2 = 0; k2 < 2; ++k2) {
                    const int rr = rw + 64 * k2;
                    *(u32x4*)((unsigned char*)(a.ws + WS_DKT) + (size_t)rec * 16384 + rr * 128 + c8 * 16) = *(const LAS u32x4*)(L + KDT + sw128(rr, c8));
                }
            }
        }
    }
    __syncthreads();
}

__device__ __forceinline__ void phase_dn_scan(Frame& F, int e) {
    const CAS Args& a = *F.a;
    LAS unsigned char* L = F.lds;
    constexpr int BUF = 57344, oW = 0, oQ = 16384, oA = 32768, oK = 40960;
    const int wave = F.wave;
    const unsigned char* gW = (const unsigned char*)(a.ws + WS_DW); const unsigned char* gQ = (const unsigned char*)(a.ws + WS_DQ);
    const unsigned char* gA = (const unsigned char*)(a.ws + WS_DAI); const unsigned char* gK = (const unsigned char*)(a.ws + WS_DKT);
    const bf16* gU = (const bf16*)(a.ws + WS_DUT); const float* gGL = (const float*)(a.ws + WS_DGL);
    for (int it = F.vcu; it < (2 * LAT_B + CTX_B) * 2 * NH; it += F.G) {
        int tid_ = F.tid; asm volatile("" : "+v"(tid_));
        const int lane = tid_ & 63, fr = lane & 15, fq = lane >> 4;
        const int r4 = lane >> 4, s16 = lane & 15, r8 = lane >> 3, s8 = lane & 7;
        int seq, dir, h, half = 0;
        if (it < 2 * LAT_B * 2 * NH) { half = it & 1; const int j = it >> 1; seq = CTX_B + j / (2 * NH); dir = (j / NH) & 1; h = j % NH; }
        else { const int j = it - 2 * LAT_B * 2 * NH; seq = j / (2 * NH); dir = (j / NH) & 1; h = j % NH; }
        const bool lat = seq >= CTX_B;
        const bool active = lat ? (wave < 4) : true;
        const int dvc = (lat ? half * 64 : 0) + (wave & (lat ? 3 : 7)) * 16 + fr;
        const int Ls = lat ? LAT_L : CTX_L, row0 = lat ? NCTX + (seq - CTX_B) * LAT_L : seq * CTX_L, nch = Ls / 64;
        const int cbase = lat ? 64 + (seq - CTX_B) * 16 : seq * 4;
        f32x4 S[8];
        if (lat) {
            const float* s0 = a.in[I_STATE] + ((((size_t)(seq - CTX_B) * 2 + e) * 2 + dir) * NH + h) * 128 * 128;
#pragma unroll
            for (int mf = 0; mf < 8; ++mf)
#pragma unroll
                for (int r = 0; r < 4; ++r) S[mf][r] = s0[(size_t)(mf * 16 + 4 * fq + r) * 128 + dvc];
        } else {
#pragma unroll
            for (int mf = 0; mf < 8; ++mf) S[mf] = (f32x4){0.f, 0.f, 0.f, 0.f};
        }
        float* O = (float*)(a.ws + (dir ? WS_OB : WS_OF));
#define DN_STAGE(bufi, rec_) do { LAS unsigned char* sb_ = L + (bufi) * BUF; const size_t ro_ = (size_t)(rec_); \
        _Pragma("unroll") for (int p_ = 0; p_ < 2; ++p_) { const int pc_ = wave + 8 * p_; const int rw_ = pc_ * 4 + r4; const int so_ = rw_ * 256 + ((s16 ^ (rw_ & 15)) << 4); \
            __builtin_amdgcn_global_load_lds((const unsigned*)(gW + ro_ * 16384 + so_), (LAS unsigned*)(sb_ + oW + pc_ * 1024), 16, 0, 0); \
            __builtin_amdgcn_global_load_lds((const unsigned*)(gQ + ro_ * 16384 + so_), (LAS unsigned*)(sb_ + oQ + pc_ * 1024), 16, 0, 0); \
            const int rk_ = pc_ * 8 + r8; const int sk_ = rk_ * 128 + ((s8 ^ ((rk_ >> 1) & 7)) << 4); \
            __builtin_amdgcn_global_load_lds((const unsigned*)(gK + ro_ * 16384 + sk_), (LAS unsigned*)(sb_ + oK + pc_ * 1024), 16, 0, 0); } \
        { const int ra_ = wave * 8 + r8; const int sa_ = ra_ * 128 + ((s8 ^ ((ra_ >> 1) & 7)) << 4); \
            __builtin_amdgcn_global_load_lds((const unsigned*)(gA + ro_ * 8192 + sa_), (LAS unsigned*)(sb_ + oA + wave * 1024), 16, 0, 0); } } while (0)
        __syncthreads();
        int rec = (cbase * NH + h) * 2 + dir;
        DN_STAGE(0, rec);
        u32x2 un[4]; float gln;
#pragma unroll
        for (int mf = 0; mf < 4; ++mf) un[mf] = *(const u32x2*)(gU + (size_t)rec * 8192 + dvc * 64 + mf * 16 + 4 * fq);
        gln = gGL[rec];
        for (int c = 0; c < nch; ++c) {
            asm volatile("s_waitcnt vmcnt(0)" ::: "memory");
            __syncthreads();
            u32x2 uc[4]; const float gl = gln;
#pragma unroll
            for (int mf = 0; mf < 4; ++mf) uc[mf] = un[mf];
            if (c + 1 < nch) {
                const int rn = rec + 2 * NH;
                DN_STAGE((c + 1) & 1, rn);
#pragma unroll
                for (int mf = 0; mf < 4; ++mf) un[mf] = *(const u32x2*)(gU + (size_t)rn * 8192 + dvc * 64 + mf * 16 + 4 * fq);
                gln = gGL[rn];
            }
            if (active) {
            bf16x8 Sb[4];
#pragma unroll
            for (int ks = 0; ks < 4; ++ks) {
                u32x4 t; t.x = pk2(S[2 * ks][0], S[2 * ks][1]); t.y = pk2(S[2 * ks][2], S[2 * ks][3]); t.z = pk2(S[2 * ks + 1][0], S[2 * ks + 1][1]); t.w = pk2(S[2 * ks + 1][2], S[2 * ks + 1][3]);
                Sb[ks] = __builtin_bit_cast(bf16x8, t);
            }
#pragma unroll
            for (int mf = 0; mf < 8; ++mf) S[mf] = S[mf] * gl;
            f32x4 vn[4], o[4];
#pragma unroll
            for (int mf = 0; mf < 4; ++mf) {
                vn[mf][0] = __builtin_bit_cast(float, uc[mf].x << 16); vn[mf][1] = __builtin_bit_cast(float, uc[mf].x & 0xffff0000u);
                vn[mf][2] = __builtin_bit_cast(float, uc[mf].y << 16); vn[mf][3] = __builtin_bit_cast(float, uc[mf].y & 0xffff0000u);
                o[mf] = (f32x4){0.f, 0.f, 0.f, 0.f};
            }
            const unsigned sbb = (unsigned)(uintptr_t)L + (unsigned)(c & 1) * BUF;
            const unsigned aWQ = sbb + fr * 256, aAK = sbb + fr * 128;
            unsigned xw[4], xa[2];
#pragma unroll
            for (int ks = 0; ks < 4; ++ks) xw[ks] = (unsigned)(((ks * 4 + fq) ^ fr) << 4);
#pragma unroll
            for (int ks = 0; ks < 2; ++ks) xa[ks] = (unsigned)(((ks * 4 + fq) ^ ((fr >> 1) & 7)) << 4);
#define DN_FADDR(f) (((f) < 32) ? (aWQ + ((((f) & 7) < 4) ? oW : oQ) + ((f) >> 3) * 4096 + xw[(f) & 3]) : (((f) < 40) ? (aAK + oA + (((f) - 32) >> 1) * 2048 + xa[((f) - 32) & 1]) : (aAK + oK + (((f) - 40) >> 1) * 2048 + xa[((f) - 40) & 1])))
            bf16x8 ring[8], Vb[2];
#pragma unroll
            for (int f = 0; f < 7; ++f) { DS_READ128(ring[f], DN_FADDR(f)); }
#pragma unroll
            for (int f = 0; f < 56; ++f) {
                if (f + 7 < 56) { DS_READ128(ring[(f + 7) & 7], DN_FADDR(f + 7)); }
                lgkm_wait((f + 7 < 56) ? 7 : (55 - f));
                asm volatile("" : "+v"(ring[f & 7]));
                __builtin_amdgcn_sched_barrier(0);
                if (f == 32) {
#pragma unroll
                    for (int ks = 0; ks < 2; ++ks) {
                        u32x4 t; t.x = pk2(vn[2 * ks][0], vn[2 * ks][1]); t.y = pk2(vn[2 * ks][2], vn[2 * ks][3]); t.z = pk2(vn[2 * ks + 1][0], vn[2 * ks + 1][1]); t.w = pk2(vn[2 * ks + 1][2], vn[2 * ks + 1][3]);
                        Vb[ks] = __builtin_bit_cast(bf16x8, t);
                    }
                }
                if (f < 32) { const int mf = f >> 3, j = f & 7; if (j < 4) vn[mf] = MFMA16(ring[f & 7], Sb[j], vn[mf]); else o[mf] = MFMA16(ring[f & 7], Sb[j - 4], o[mf]); }
                else if (f < 40) { const int g = f - 32; o[g >> 1] = MFMA16(ring[f & 7], Vb[g & 1], o[g >> 1]); }
                else { const int g = f - 40; S[g >> 1] = MFMA16(ring[f & 7], Vb[g & 1], S[g >> 1]); }
            }
#undef DN_FADDR
#pragma unroll
            for (int mf = 0; mf < 4; ++mf)
#pragma unroll
                for (int r = 0; r < 4; ++r) {
                    const int step = c * 64 + mf * 16 + 4 * fq + r, row = row0 + (dir ? (Ls - 1 - step) : step);
                    O[(size_t)row * 768 + h * 128 + dvc] = o[mf][r];
                }
            }
            rec += 2 * NH;
        }
#undef DN_STAGE
        if (!lat) {
            float* so = a.out + (size_t)M * D + ((((size_t)seq * 2 + e) * 2 + dir) * NH + h) * 128 * 128;
#pragma unroll
            for (int mf = 0; mf < 8; ++mf)
#pragma unroll
                for (int r = 0; r < 4; ++r) so[(size_t)(mf * 16 + 4 * fq + r) * 128 + dvc] = S[mf][r];
        }
    }
    __syncthreads();
}

__device__ __forceinline__ void phase_dn_fin(Frame& F, int e) {
    const CAS Args& a = *F.a;
    const bf16* P = (const bf16*)(a.ws + WS_P);
    const float* OF = (const float*)(a.ws + WS_OF); const float* OB = (const float*)(a.ws + WS_OB);
    bf16* Y = (bf16*)(a.ws + WS_Y);
    const float* nw = a.in[I_DNNW] + e * 128;
    const int gw = F.vcu * 8 + F.wave, NGW = F.G * 8;
    for (int row = gw; row < M; row += NGW) {
        const int c2 = F.lane * 2;
        f32x2 v[NH]; unsigned zr[NH]; float ss[NH];
#pragma unroll
        for (int h = 0; h < NH; ++h) {
            const size_t o = (size_t)row * 768 + h * 128 + c2;
            v[h] = *(const f32x2*)(OF + o) + *(const f32x2*)(OB + o);
            zr[h] = *(const unsigned*)(P + (size_t)row * LDP + 2560 + h * 128 + c2);
            ss[h] = v[h][0] * v[h][0] + v[h][1] * v[h][1];
        }
#pragma unroll
        for (int o = 1; o < 64; o <<= 1) {
#pragma unroll
            for (int h = 0; h < NH; ++h) ss[h] += __shfl_xor(ss[h], o);
        }
        const f32x2 w = *(const f32x2*)(nw + c2);
#pragma unroll
        for (int h = 0; h < NH; ++h) {
            const float rs = rsq_f(ss[h] * (1.f / 128.f) + EPS);
            const f32x2 z = {__builtin_bit_cast(float, zr[h] << 16), __builtin_bit_cast(float, zr[h] & 0xffff0000u)};
            *(unsigned*)(Y + (size_t)row * D + 256 + h * 128 + c2) = pk2(v[h][0] * rs * w[0] * silu_f(z[0]), v[h][1] * rs * w[1] * silu_f(z[1]));
        }
    }
    const float* pw = a.in[I_POOLW] + (size_t)e * 4 * 64 * 64; const float* ps = a.in[I_POOLS] + e * 256;
    LAS float* xs = (LAS float*)F.lds;
    LAS float* dl = xs + 112 * 64;
    LAS float* wl = dl + 96 * 65;
    for (int it = F.vcu; it < (M / 96) * 4; it += F.G) {
        const int blk = it >> 2, g = it & 3, r0 = blk * 96;
        __syncthreads();
        for (int i = F.tid; i < 112 * 16; i += 512) {
            const int rr = i >> 4, c4 = (i & 15) * 4, row = r0 - 8 + rr;
            const bool in = (row >= 0) && (row < M);
            const u32x2 pr = in ? *(const u32x2*)(P + (size_t)row * LDP + g * 64 + c4) : (u32x2){0, 0};
            *(LAS f32x4*)(xs + rr * 64 + c4) = (f32x4){__builtin_bit_cast(float, pr.x << 16), __builtin_bit_cast(float, pr.x & 0xffff0000u), __builtin_bit_cast(float, pr.y << 16), __builtin_bit_cast(float, pr.y & 0xffff0000u)};
        }
        for (int i = F.tid; i < 1024; i += 512) *(LAS f32x4*)(wl + i * 4) = *(const f32x4*)(pw + g * 4096 + i * 4);
        __syncthreads();
        for (int u = F.tid; u < 96 * 8; u += 512) {
            const int t = u >> 3, c8 = (u & 7) * 8, row = r0 + t, half = 1 << g; int s0, Ls; seq_of_row(row, s0, Ls);
            const int tl = row - s0;
            const int lo = max(tl - half, 0), hi = min(tl + half, Ls);
            float sum[8];
#pragma unroll
            for (int q = 0; q < 8; ++q) sum[q] = 0.f;
            for (int p = lo; p < hi; ++p) {
                const LAS float* xr = xs + (p - tl + t + 8) * 64 + c8;
                const f32x4 a0 = *(const LAS f32x4*)xr, a1 = *(const LAS f32x4*)(xr + 4);
#pragma unroll
                for (int q = 0; q < 4; ++q) { sum[q] += a0[q]; sum[4 + q] += a1[q]; }
            }
            const float inv = rcp_f((float)(hi - lo));
            const LAS float* xc = xs + (t + 8) * 64 + c8;
#pragma unroll
            for (int q = 0; q < 8; ++q) dl[t * 65 + c8 + q] = sum[q] * inv - xc[q];
        }
        __syncthreads();
        for (int u = F.tid; u < 96 * 8; u += 512) {
            const int t = u >> 3, e8 = (u & 7) * 8;
            float y[8];
#pragma unroll
            for (int q = 0; q < 8; ++q) y[q] = 0.f;
            for (int c = 0; c < 64; ++c) {
                const float d = dl[t * 65 + c];
                const f32x4 w0 = *(const LAS f32x4*)(wl + c * 64 + e8), w1 = *(const LAS f32x4*)(wl + c * 64 + e8 + 4);
#pragma unroll
                for (int q = 0; q < 4; ++q) { y[q] += d * w0[q]; y[4 + q] += d * w1[q]; }
            }
            const f32x4 s0v = *(const f32x4*)(ps + g * 64 + e8), s1v = *(const f32x4*)(ps + g * 64 + e8 + 4);
            u32x4 o; o.x = pk2(y[0] * s0v[0], y[1] * s0v[1]); o.y = pk2(y[2] * s0v[2], y[3] * s0v[3]); o.z = pk2(y[4] * s1v[0], y[5] * s1v[1]); o.w = pk2(y[6] * s1v[2], y[7] * s1v[3]);
            *(u32x4*)(Y + (size_t)(r0 + t) * D + g * 64 + e8) = o;
        }
    }
    __syncthreads();
}

struct EpiOdd {
    bf16* G; float* ZR; float* ZI; float* ST; Pre pre;
    template <int NFRAG> struct Hold { PreHold ph; };
    template <int NFRAG> __device__ __forceinline__ void preload(Hold<NFRAG>& h, int, int, int tid, int row0, int col0) const { pre_fetch(pre, h.ph, tid, row0, col0, 32 * NFRAG); }
    template <int NFRAG> __device__ __forceinline__ void stage(const Hold<NFRAG>& h, LAS float* sc, int tid) const { pre_write(h.ph, sc, tid, 32 * NFRAG); }
    template <int NFRAG> __device__ __forceinline__ void operator()(f32x4 (&acc)[3][NFRAG], const Hold<NFRAG>&, int row, int colq, int fq, const LAS float* sc, int lrow, int lcol) const {
        const int ct = colq >> 8;
        constexpr int RB = 32 * NFRAG, PB = RB + 16;
        const int wm = lrow / 48, wn = lcol / (16 * NFRAG), fr = lrow - wm * 48, lane = fq * 16 + fr;
        LAS unsigned char* img = (LAS unsigned char*)sc + 8192 + (wm * 2 + wn) * (48 * PB);
        if (ct < 6) {
#pragma unroll
            for (int mf = 0; mf < 3; ++mf) {
                const int rr = row + mf * 16; float s1 = 0.f, s2 = 0.f;
                const float rs = sc[lrow + mf * 16]; const LAS float* bp = sc + 256 + cond_of_row(rr) * (32 * NFRAG) + lcol;
#pragma unroll
                for (int nf = 0; nf < NFRAG; ++nf) {
                    const f32x4 v = acc[mf][nf] * rs + *(const LAS f32x4*)(bp + nf * 16);
                    const float g0 = gelu_tanh(v[0]), g1 = gelu_tanh(v[1]), g2 = gelu_tanh(v[2]), g3 = gelu_tanh(v[3]);
                    u32x2 w; w.x = pk2(g0, g1); w.y = pk2(g2, g3);
                    *(LAS u32x2*)(img + (mf * 16 + fr) * PB + nf * 32 + fq * 8) = w;
                    s1 += (g0 + g1) + (g2 + g3); s2 += (g0 * g0 + g1 * g1) + (g2 * g2 + g3 * g3);
                }
                if (ct >= 3) {
                    s1 += __shfl_xor(s1, 16); s1 += __shfl_xor(s1, 32); s2 += __shfl_xor(s2, 16); s2 += __shfl_xor(s2, 32);
                    if (fq == 0) { atomicAdd(ST + (size_t)rr * 2, s1); atomicAdd(ST + (size_t)rr * 2 + 1, s2); }
                }
            }
            image_store<RB, PB>(img, (unsigned char*)(G + (size_t)(row - fr) * 1536 + (colq - fq * 4)), (size_t)1536 * 2, lane);
        } else {
            float* Z = (ct == 6) ? ZR : ZI; const int cb = colq - ct * 256;
#pragma unroll
            for (int mf = 0; mf < 3; ++mf) {
                const int rr = row + mf * 16; const float rs = sc[lrow + mf * 16]; const LAS float* bp = sc + 256 + cond_of_row(rr) * (32 * NFRAG) + lcol;
#pragma unroll
                for (int nf = 0; nf < NFRAG; ++nf) *(f32x4*)(Z + (size_t)rr * 256 + cb + nf * 16) = acc[mf][nf] * rs + *(const LAS f32x4*)(bp + nf * 16);
            }
        }
    }
};

constexpr double c_pi = 3.14159265358979323846;
constexpr double c_sin_poly(double x) { double t = x, s = x; for (int i = 1; i < 14; ++i) { t *= -x * x / ((2 * i) * (2 * i + 1)); s += t; } return s; }
constexpr double c_cos_poly(double x) { double t = 1, s = 1; for (int i = 1; i < 14; ++i) { t *= -x * x / ((2 * i - 1) * (2 * i)); s += t; } return s; }
constexpr int c_bitrev(int x, int n) { int r = 0; for (int b = 1; b < n; b <<= 1) { r = (r << 1) | (x & 1); x >>= 1; } return r; }
template <int N, int HALF, int BASE, int J>
__device__ __forceinline__ void fft_bf(float (&re)[N], float (&im)[N]) {
    constexpr int ia = BASE + J, ib = ia + HALF;
    constexpr float c = (float)c_cos_poly(c_pi * J / HALF), s = (float)c_sin_poly(c_pi * J / HALF);
    const float ar = re[ia], ai = im[ia], br = re[ib], bi = im[ib];
    re[ia] = ar + br; im[ia] = ai + bi;
    const float dr = ar - br, di = ai - bi;
    if constexpr (J == 0) { re[ib] = dr; im[ib] = di; }
    else if constexpr (2 * J == HALF) { re[ib] = di; im[ib] = -dr; }
    else { re[ib] = dr * c + di * s; im[ib] = di * c - dr * s; }
    if constexpr (J + 1 < HALF) fft_bf<N, HALF, BASE, J + 1>(re, im);
    else if constexpr (BASE + 2 * HALF < N) fft_bf<N, HALF, BASE + 2 * HALF, 0>(re, im);
    else if constexpr (HALF > 1) fft_bf<N, HALF / 2, 0, 0>(re, im);
}
template <int R, int P>
__device__ __forceinline__ void fa_store(const float (&zr)[R], const float (&zi)[R], float* BR, float* BI, int row0, int n2, int col, const LAS float* twN) {
    constexpr int k1 = c_bitrev(P, R);
    const int t = k1 * n2; const float c = twN[t], s = twN[R * R + t];
    const size_t o = (size_t)(row0 + k1 * R + n2) * 256 + col;
    BR[o] = c * zr[P] + s * zi[P]; BI[o] = c * zi[P] - s * zr[P];
    if constexpr (P + 1 < R) fa_store<R, P + 1>(zr, zi, BR, BI, row0, n2, col, twN);
}
template <int R>
__device__ __forceinline__ void fourier_a_item(const float* ZR, const float* ZI, float* BR, float* BI, int row0, int n2, const LAS float* twN, int col) {
    float zr[R], zi[R];
#pragma unroll
    for (int n1 = 0; n1 < R; ++n1) { const size_t o = (size_t)(row0 + R * n1 + n2) * 256 + col; zr[n1] = ZR[o]; zi[n1] = ZI[o]; }
    fft_bf<R, R / 2, 0, 0>(zr, zi);
    fa_store<R, 0>(zr, zi, BR, BI, row0, n2, col, twN);
}
template <int R, int P>
__device__ __forceinline__ void fc_store(const float (&br)[R], bf16* Y, int row0, int k1, int col) {
    constexpr int k2 = c_bitrev(P, R);
    Y[(size_t)(row0 + k1 + R * k2) * D + 768 + col] = (bf16)f2bf(br[P] * (1.0f / R));
    if constexpr (P + 1 < R) fc_store<R, P + 1>(br, Y, row0, k1, col);
}
template <int R>
__device__ __forceinline__ void fourier_c_item(const float* BR, const float* BI, bf16* Y, int row0, int k1, int col) {
    float br[R], bi[R];
#pragma unroll
    for (int n2 = 0; n2 < R; ++n2) { const size_t o = (size_t)(row0 + k1 * R + n2) * 256 + col; br[n2] = BR[o]; bi[n2] = BI[o]; }
    fft_bf<R, R / 2, 0, 0>(br, bi);
    fc_store<R, 0>(br, Y, row0, k1, col);
}
__device__ __forceinline__ void fourier_tables(LAS float* tw, int tid) {
    for (int i = tid; i < 1024; i += 512) { const float x = (float)i * (1.f / 512.f); tw[64 + i] = cospif(x); tw[64 + 1024 + i] = sinpif(x); }
    if (tid < 256) { const float x = (float)tid * (1.f / 128.f); tw[2144 + tid] = cospif(x); tw[2144 + 256 + tid] = sinpif(x); }
    if (tid < 32) { const float x = (float)tid * (1.f / 16.f); tw[tid] = cospif(x); tw[32 + tid] = sinpif(x); }
    if (tid < 16) { const float x = (float)tid * (1.f / 8.f); tw[2112 + tid] = cospif(x); tw[2112 + 16 + tid] = sinpif(x); }
}

__device__ __forceinline__ void phase_odd_mix(Frame& F, int j) {
    const CAS Args& a = *F.a;
    const bf16* G = (const bf16*)(a.ws + WS_P); bf16* Y = (bf16*)(a.ws + WS_Y);
    const float* ZR = (const float*)(a.ws + WS_ZR); const float* ZI = (const float*)(a.ws + WS_ZI);
    float* BR = (float*)(a.ws + WS_QN); float* BI = (float*)(a.ws + WS_KN);
    const float* ST = (const float*)(a.ws + WS_CTL + CTL_ST_OFF) + (size_t)j * M * 2;
    LAS unsigned char* L = F.lds;
    LAS float* tw = (LAS float*)(L + 65536);
    fourier_tables(tw, F.tid);
    __syncthreads();
    const int wave = F.wave;
    constexpr int NA_LAT = LAT_B * 32 / 2, NSGU = (M / 128) * NH, NA_CTX = CTX_B * 16 / 2;
    for (int it = F.vcu; it < NA_LAT + NSGU + NA_CTX; it += F.G) {
        int tid_ = F.tid; asm volatile("" : "+v"(tid_));
        if (it < NA_LAT) { const int q = it * 2 + (tid_ >> 8); fourier_a_item<32>(ZR, ZI, BR, BI, NCTX + (q >> 5) * LAT_L, q & 31, tw + 64, tid_ & 255); continue; }
        if (it >= NA_LAT + NSGU) { const int q = (it - NA_LAT - NSGU) * 2 + (tid_ >> 8); fourier_a_item<16>(ZR, ZI, BR, BI, (q >> 4) * CTX_L, q & 15, tw + 2144, tid_ & 255); continue; }
        const int q = it - NA_LAT, ch = q / NH, h = q % NH, r0 = ch * 128;
        const int lane = tid_ & 63, fr = lane & 15, fq = lane >> 4;
        __syncthreads();
        {
            const int s = tid_ >> 2, cq = tid_ & 3, row = r0 + s;
            const float s1 = ST[(size_t)row * 2], s2 = ST[(size_t)row * 2 + 1];
            const float mu = s1 * (1.f / 768.f), var = s2 * (1.f / 768.f) - mu * mu, rstd = rsq_f(fmaxf(var, 0.f) + EPS);
            const bf16* gp = G + (size_t)row * 1536 + 768 + h * 128 + cq * 32;
            const float* nw = a.in[I_SGUN] + j * 768 + h * 128 + cq * 32;
#pragma unroll
            for (int v8 = 0; v8 < 4; ++v8) {
                const u32x4 raw = *(const u32x4*)(gp + v8 * 8);
                const unsigned wds[4] = {raw.x, raw.y, raw.z, raw.w};
#pragma unroll
                for (int e2 = 0; e2 < 4; ++e2) {
                    const float g0 = __builtin_bit_cast(float, wds[e2] << 16), g1 = __builtin_bit_cast(float, wds[e2] & 0xffff0000u);
                    const int c0 = cq * 32 + v8 * 8 + e2 * 2;
                    const float v0 = (g0 - mu) * rstd * nw[v8 * 8 + e2 * 2], v1 = (g1 - mu) * rstd * nw[v8 * 8 + e2 * 2 + 1];
                    *(LAS bf16*)(L + c0 * 256 + (((s >> 3) ^ (c0 & 15)) << 4) + (s & 7) * 2) = (bf16)f2bf(v0);
                    *(LAS bf16*)(L + (c0 + 1) * 256 + (((s >> 3) ^ ((c0 + 1) & 15)) << 4) + (s & 7) * 2) = (bf16)f2bf(v1);
                }
            }
        }
        __syncthreads();
        {
            const bf16* Wb = (const bf16*)(a.ws + WS_SGUW) + ((size_t)j * NH + h) * 16384;
            f32x4 acc[8];
#pragma unroll
            for (int pf = 0; pf < 8; ++pf) acc[pf] = (f32x4){0.f, 0.f, 0.f, 0.f};
#pragma unroll
            for (int ks = 0; ks < 4; ++ks) {
                const bf16x8 av = *(const LAS bf16x8*)(L + (wave * 16 + fr) * 256 + (((ks * 4 + fq) ^ fr) << 4));
#pragma unroll
                for (int pf = 0; pf < 8; ++pf) {
                    const bf16x8 bw = *(const bf16x8*)(Wb + (pf * 16 + fr) * 128 + ks * 32 + fq * 8);
                    acc[pf] = MFMA16(av, bw, acc[pf]);
                }
            }
            const float* bs = a.in[I_SGUB] + ((size_t)j * NH + h) * 128;
#pragma unroll
            for (int pf = 0; pf < 8; ++pf) {
                const int p = pf * 16 + fr, row = r0 + p, c = wave * 16 + 4 * fq; const float b = bs[p];
                const u32x2 gu = *(const u32x2*)(G + (size_t)row * 1536 + h * 128 + c);
                const float u0 = __builtin_bit_cast(float, gu.x << 16), u1 = __builtin_bit_cast(float, gu.x & 0xffff0000u), u2 = __builtin_bit_cast(float, gu.y << 16), u3 = __builtin_bit_cast(float, gu.y & 0xffff0000u);
                u32x2 o; o.x = pk2(u0 * (acc[pf][0] + b), u1 * (acc[pf][1] + b)); o.y = pk2(u2 * (acc[pf][2] + b), u3 * (acc[pf][3] + b));
                *(u32x2*)(Y + (size_t)row * D + h * 128 + c) = o;
            }
        }
    }
    __syncthreads();
}
__device__ __forceinline__ void phase_odd_fc(Frame& F) {
    const CAS Args& a = *F.a;
    const float* BR = (const float*)(a.ws + WS_QN); const float* BI = (const float*)(a.ws + WS_KN); bf16* Y = (bf16*)(a.ws + WS_Y);
    constexpr int NC_LAT = LAT_B * 32 / 2, NC_CTX = CTX_B * 16 / 2;
    for (int it = F.vcu; it < NC_LAT + NC_CTX; it += F.G) {
        int tid_ = F.tid; asm volatile("" : "+v"(tid_));
        if (it < NC_LAT) { const int q = it * 2 + (tid_ >> 8); fourier_c_item<32>(BR, BI, Y, NCTX + (q >> 5) * LAT_L, q & 31, tid_ & 255); }
        else { const int q = (it - NC_LAT) * 2 + (tid_ >> 8); fourier_c_item<16>(BR, BI, Y, (q >> 4) * CTX_L, q & 15, tid_ & 255); }
    }
    __syncthreads();
}

constexpr int STEPS = 9, N_PHASES = 2 + DEPTH * STEPS + 1;
__device__ __forceinline__ bool phase_active(int ph) {
    if (ph < 2 || ph == N_PHASES - 1) return true;
    const int l = (ph - 2) / STEPS, st = (ph - 2) % STEPS;
    return !((l & 1) && st == 5);
}
__device__ __forceinline__ void run_phase(Frame& F, int ph) {
    const CAS Args& a = *F.a; unsigned char* ws = a.ws;
    if (ph == 0) { phase_setup(F); return; }
    if (ph == 1) { phase_init(F); return; }
    if (ph == N_PHASES - 1) { phase_final(F, F.grp); return; }
    const int l = (ph - 2) / STEPS, st = (ph - 2) % STEPS, e = l >> 1;
    bf16* XS = (bf16*)(ws + WS_HN); bf16* HH = (bf16*)(ws + WS_HH); float* X = (float*)(ws + WS_X); float* P = (float*)(ws + WS_P);
    const bf16* Y = (const bf16*)(ws + WS_Y); const float* mod = (const float*)(ws + WS_MOD);
    float* ssb = (float*)(ws + WS_CTL + CTL_SS_OFF); const float* biasb = (const float*)(ws + WS_BIAS);
#define PRE_OF(s_) Pre{ssb + (size_t)(s_) * M, biasb + (size_t)(s_) * 3 * NBMAX}
    switch (st) {
        case 0: { EpiUp E{HH, PRE_OF(3 * l)}; gemm_phase<11, EpiUp>(F, XS, (const bf16*)(ws + WS_WUP + (size_t)(l * 2) * WUP_SZ), D, NUP, E); } break;
        case 1: { EpiRes E{X, mod, l, 2, 0.5f, XS, ssb + (size_t)(3 * l + 1) * M, a.in[I_MIXN] + l * D, l, 1}; gemm_phase<4, EpiRes>(F, HH, (const bf16*)(ws + WS_WDN + (size_t)(l * 2) * WDN_SZ), FF, D, E); } break;
        case 2: { if ((l & 1) == 0) { EpiStore E{(bf16*)(ws + WS_P), (float*)(ws + WS_AG), PRE_OF(3 * l + 1)}; gemm_phase<7, EpiStore>(F, XS, (const bf16*)(ws + WS_EVIN + (size_t)e * EVIN_SZ), D, P_EVEN_PAD, E); }
                  else { EpiOdd EO{(bf16*)(ws + WS_P), (float*)(ws + WS_ZR), (float*)(ws + WS_ZI), (float*)(ws + WS_CTL + CTL_ST_OFF) + (size_t)e * M * 2, PRE_OF(3 * l + 1)};
                         gemm_phase<8, EpiOdd>(F, XS, (const bf16*)(ws + WS_ODIN + (size_t)e * ODIN_SZ), D, 2048, EO); } } break;
        case 3: if ((l & 1) == 0) phase_dn_prep(F, e); else phase_odd_mix(F, e); break;
        case 4: if ((l & 1) == 0) phase_dn_scan(F, e); else phase_odd_fc(F); break;
        case 5: if ((l & 1) == 0) phase_dn_fin(F, e); break;
        case 6: { EpiRes E{X, mod, l, 5, 1.0f, XS, ssb + (size_t)(3 * l + 2) * M, a.in[I_F2N] + l * D, l, 2}; gemm_phase<4, EpiRes>(F, Y, (const bf16*)(ws + ((l & 1) ? WS_ODOUT : WS_EVOUT) + (size_t)e * SQ_SZ), D, D, E); } break;
        case 7: { EpiUp E{HH, PRE_OF(3 * l + 2)}; gemm_phase<11, EpiUp>(F, XS, (const bf16*)(ws + WS_WUP + (size_t)(l * 2 + 1) * WUP_SZ), D, NUP, E); } break;
        case 8: { const bool last = (l == DEPTH - 1);
                  EpiRes E{X, mod, l, 8, 0.5f, XS, last ? nullptr : ssb + (size_t)(3 * l + 3) * M, a.in[I_F1N] + (last ? l : l + 1) * D, last ? l : l + 1, 0};
                  gemm_phase<4, EpiRes>(F, HH, (const bf16*)(ws + WS_WDN + (size_t)(l * 2 + 1) * WDN_SZ), FF, D, E); } break;
    }
#undef PRE_OF
}

__global__ void __launch_bounds__(512, 2) mk_fwd(Args args) {
    extern __shared__ __attribute__((aligned(16))) unsigned char lds_raw[];
    Frame F;
    F.lds = (LAS unsigned char*)lds_raw;
    F.tid = threadIdx.x; F.lane = F.tid & 63; F.wave = __builtin_amdgcn_readfirstlane(F.tid >> 6);
    F.G = gridDim.x; { const int bx = blockIdx.x; F.vcu = (F.G % 8 == 0) ? (bx % 8) * (F.G / 8) + bx / 8 : bx; }
    const CAS Args* ap = (const CAS Args*)__builtin_amdgcn_kernarg_segment_ptr();
    F.a = ap;
    const int ph_lo = ap->ph_lo, ph_hi = ap->ph_hi;
    unsigned char* ws0 = ap->ws;
    volatile LAS unsigned* MISC = (volatile LAS unsigned*)(F.lds + LDS_MISC);
    if (F.tid < 64) MISC[F.tid] = 0u;
    __syncthreads();
    const bool multi = (ph_hi - ph_lo) > 1;
    XcdBarrier bar; bar.bar = (unsigned*)(ws0 + WS_CTL) + CW_BAR; bar.x = 0; bar.st = MISC + 8;
    if (multi) bar = xcd_barrier_post((unsigned*)(ws0 + WS_CTL) + CW_BAR, MISC + 8);
    unsigned* ctl = (unsigned*)(ws0 + WS_CTL);
    if (F.tid == 0) __hip_atomic_store(ctl + CW_GXCC + F.vcu, xb_xcc_id() + 1u, __ATOMIC_RELAXED, __HIP_MEMORY_SCOPE_AGENT);
    F.grp = false;
    for (int ph = ph_lo; ph < ph_hi; ++ph) {
        { const CAS Args* a2 = ap; asm volatile("" : "+s"(a2)); F.a = a2; }
        { int t_ = threadIdx.x; asm volatile("" : "+v"(t_)); F.tid = t_; F.lane = t_ & 63; F.wave = __builtin_amdgcn_readfirstlane(t_ >> 6); }
        if (!phase_active(ph)) continue;
        run_phase(F, ph);
        if (ph + 1 >= ph_hi) break;
        bool local = false;
        if (ph >= 2 && ph < N_PHASES - 1) { const int st = (ph - 2) % STEPS; local = (st == 0 || st == 1 || st >= 6); }
        if (local && F.grp) group_barrier(ctl, F.vcu >> 3);
        else xcd_barrier(bar);
        if (ph == 0 && multi && F.G == 256) {
            unsigned ok = 1u;
            for (int i = F.lane; i < 256; i += 64) { const unsigned mine = xb_ld(ctl + CW_GXCC + i), first = xb_ld(ctl + CW_GXCC + (i & ~7)); if (mine == 0u || mine != first) ok = 0u; }
            F.grp = (__ballot(ok != 0u) == ~0ull);
        }
    }
}

extern "C" void kernel_launch(void* const* d_in, const int* in_sizes, int n_in, void* d_out, int out_size, void* d_ws, size_t ws_size, hipStream_t stream) {
    static int grid = 0;
    if (grid == 0) {
        if (n_in != 31 || ws_size < WS_END) { fprintf(stderr, "kernel_launch: unexpected n_in %d or ws_size %zu (need %zu)\n", n_in, ws_size, (size_t)WS_END); grid = -1; return; }
        int dev = 0, cus = 0;
        if (hipGetDevice(&dev) != hipSuccess || hipDeviceGetAttribute(&cus, hipDeviceAttributeMultiprocessorCount, dev) != hipSuccess) { grid = -1; return; }
        if (hipFuncSetAttribute((const void*)mk_fwd, hipFuncAttributeMaxDynamicSharedMemorySize, LDS_BYTES) != hipSuccess) { fprintf(stderr, "kernel_launch: hipFuncSetAttribute failed\n"); grid = -1; return; }
        (void)hipGetLastError();
        grid = cus;
    }
    if (grid < 0) return;
    (void)hipMemsetAsync((char*)d_ws + WS_CTL, 0, CTL_BYTES, stream);
    (void)hipMemsetAsync((char*)d_ws + WS_MOD, 0, (size_t)4 * 3 * 9216 * 4, stream);
    (void)hipMemsetAsync((char*)d_ws + WS_BIAS, 0, (size_t)12 * 3 * NBMAX * 4, stream);
    Args a{};
    for (int i = 0; i < 31; ++i) a.in[i] = (const float*)d_in[i];
    a.out = (float*)d_out; a.ws = (unsigned char*)d_ws;
#if ONE_LAUNCH
    a.ph_lo = 0; a.ph_hi = N_PHASES;
    hipLaunchKernelGGL(mk_fwd, dim3(grid), dim3(512), LDS_BYTES, stream, a);
#else
    for (int ph = 0; ph < N_PHASES; ++ph) {
        a.ph_lo = ph; a.ph_hi = ph + 1;
        hipLaunchKernelGGL(mk_fwd, dim3(grid), dim3(512), LDS_BYTES, stream, a);
    }
#endif
}
```

```cpp
#include <hip/hip_runtime.h>
#include <cstdio>
#include <cstdint>

#ifndef ONE_LAUNCH
#define ONE_LAUNCH 1
#endif

#define GAS __attribute__((address_space(1)))
#define LAS __attribute__((address_space(3)))
#define CAS __attribute__((address_space(4)))
typedef unsigned short bf16;
typedef float f32x4 __attribute__((ext_vector_type(4)));
typedef float f32x2 __attribute__((ext_vector_type(2)));
typedef short bf16x8 __attribute__((ext_vector_type(8)));
typedef unsigned u32x4 __attribute__((ext_vector_type(4)));
typedef unsigned u32x2 __attribute__((ext_vector_type(2)));

constexpr int D = 1024, NCTX = 4096, NLAT = 2048, M = 6144, FF = 2816, DEPTH = 4;
constexpr int CTX_B = 16, CTX_L = 256, LAT_B = 2, LAT_L = 1024;
constexpr int NUP = 2 * FF;
constexpr int P_EVEN = 3352, P_EVEN_PAD = 3584, P_ODD = 1792;
constexpr int LDP = 3584;
constexpr int NH = 6, DK = 128;
constexpr float EPS = 1e-6f;
constexpr int NSEQ = CTX_B + LAT_B;

constexpr size_t MiB = 1u << 20;
constexpr size_t WS_CTL = 0, CTL_BYTES = 819200;
constexpr size_t WS_MOD = 819200;
constexpr size_t WS_WUP = 2 * MiB, WUP_SZ = 11 * MiB;
constexpr size_t WS_WDN = 90 * MiB, WDN_SZ = 5632 * 1024;
constexpr size_t WS_EVIN = 134 * MiB, EVIN_SZ = 7 * MiB;
constexpr size_t WS_EVOUT = 148 * MiB, SQ_SZ = 2 * MiB;
constexpr size_t WS_ODIN = 152 * MiB, ODIN_SZ = 4 * MiB;
constexpr size_t WS_ODOUT = 160 * MiB;
constexpr size_t WS_X = 164 * MiB;
constexpr size_t WS_HN = 188 * MiB;
constexpr size_t WS_HH = 200 * MiB;
constexpr size_t WS_P = 233 * MiB;
constexpr size_t WS_Y = 317 * MiB;
constexpr size_t WS_QN = 329 * MiB, WS_KN = 347 * MiB, WS_VV = 365 * MiB, WS_OF = 383 * MiB, WS_OB = 401 * MiB;
constexpr size_t WS_AG = 419 * MiB, WS_BT = 420 * MiB;
constexpr size_t WS_ZR = 421 * MiB, WS_ZI = 427 * MiB, WS_SPEC = 433 * MiB;
constexpr size_t WS_DW = 439 * MiB, WS_DQ = 457 * MiB, WS_DAI = 475 * MiB, WS_DKT = 484 * MiB, WS_DUT = 502 * MiB, WS_DGL = 520 * MiB;
constexpr size_t WS_BIAS = 1261568;
constexpr size_t WS_END = 522 * MiB;

constexpr size_t CTL_ST_OFF = 262144;
constexpr size_t CTL_SS_OFF = 524288;
constexpr int NBMAX = 5632;
constexpr size_t WS_SGUW = 521 * MiB;
constexpr int CW_GXCC = 8192;
constexpr int CW_GCNT = 16384;
constexpr int CW_BAR = 4096;
constexpr int CW_POOLQ = 20480;

constexpr int LDS_MAIN = 160768;
constexpr int LDS_MISC = LDS_MAIN;
constexpr int LDS_BYTES = LDS_MAIN + 1024;

__device__ __forceinline__ float wave_sum(float v) {
#pragma unroll
    for (int o = 1; o < 64; o <<= 1) v += __shfl_xor(v, o);
    return v;
}
typedef __bf16 bf16x2_t __attribute__((ext_vector_type(2)));
__device__ __forceinline__ unsigned pk2(float lo, float hi) { const f32x2 v = {lo, hi}; const bf16x2_t b = __builtin_convertvector(v, bf16x2_t); return __builtin_bit_cast(unsigned, b); }
__device__ __forceinline__ unsigned f2bf(float f) { return pk2(f, 0.f) & 0xffffu; }
__device__ __forceinline__ float rcp_f(float x) { return __builtin_amdgcn_rcpf(x); }
__device__ __forceinline__ float rsq_f(float x) { return __builtin_amdgcn_rsqf(x); }
__device__ __forceinline__ float silu_f(float x) { return x * rcp_f(1.f + __expf(-x)); }
__device__ __forceinline__ float sigmoid_f(float x) { return rcp_f(1.f + __expf(-x)); }
__device__ __forceinline__ float gelu_tanh(float x) { const float u2 = 1.5957691216057308f * (x + 0.044715f * x * x * x); return x * rcp_f(1.f + __expf(-u2)); }
__device__ __forceinline__ float softplus_f(float x) { return x > 20.f ? x : log1pf(expf(x)); }
__device__ __forceinline__ int cond_of_row(int r) { return r < NCTX ? 0 : (r < NCTX + LAT_L ? 1 : 2); }
__device__ __forceinline__ void seq_of_row(int r, int& s0, int& L) { if (r < NCTX) { s0 = r & ~(CTX_L - 1); L = CTX_L; } else { s0 = NCTX + ((r - NCTX) & ~(LAT_L - 1)); L = LAT_L; } }

#define XB_TMO      128
#define XB_XCNT(j)  (256  + 64 * (j))
#define XB_XSUB(j)  (1280 + 64 * (j))
#define XB_XGEN(j)  (2304 + 64 * (j))
#define XB_TOP      3328
#define XB_TOPGEN   3392
#define XCD_BAR_WORDS 3456
#define XB_SPIN_CAP (1u << 18)
__device__ __forceinline__ unsigned xb_ld(unsigned* p)              { return __hip_atomic_load(p, __ATOMIC_RELAXED, __HIP_MEMORY_SCOPE_AGENT); }
__device__ __forceinline__ unsigned xb_add(unsigned* p, unsigned v) { return __hip_atomic_fetch_add(p, v, __ATOMIC_RELAXED, __HIP_MEMORY_SCOPE_AGENT); }
__device__ __forceinline__ unsigned xb_xcc_id() { return (unsigned)__builtin_amdgcn_s_getreg((3 << 11) | 20) & 0xFu; }
#define XB_SPIN(cond, bar) do { unsigned _sp = 0; while (cond) { __builtin_amdgcn_s_sleep(1); \
    if ((++_sp & 255u) == 0u) { if (xb_ld(&(bar)[XB_TMO])) break; if (_sp > XB_SPIN_CAP) { atomicAdd(&(bar)[XB_TMO], 1u); break; } } } } while (0)
struct XcdBarrier { unsigned* bar; unsigned x; volatile LAS unsigned* st; };
__device__ __forceinline__ XcdBarrier xcd_barrier_post(unsigned* bar, volatile LAS unsigned* st) {
    XcdBarrier b; b.bar = bar; b.x = xb_xcc_id(); b.st = st;
    if (threadIdx.x == 0) (void)xb_add(&bar[XB_XCNT(b.x)], 1u);
    return b;
}
__device__ __forceinline__ void xcd_barrier_complete(unsigned* bar, unsigned x, unsigned& nloc, unsigned& nx) {
    const unsigned G = gridDim.x * gridDim.y * gridDim.z;
    unsigned sum, cnt, mine, sp = 0u;
    for (;;) {
        sum = 0u; cnt = 0u; mine = 0u;
#pragma unroll
        for (unsigned j = 0; j < 16; ++j) { const unsigned c = xb_ld(&bar[XB_XCNT(j)]); sum += c; cnt += (c > 0u) ? 1u : 0u; mine = (j == x) ? c : mine; }
        if (sum == G) break;
        __builtin_amdgcn_s_sleep(1);
        if ((++sp & 255u) == 0u) { if (xb_ld(&bar[XB_TMO])) break; if (sp > XB_SPIN_CAP) { atomicAdd(&bar[XB_TMO], 1u); break; } }
    }
    nloc = mine > 0u ? mine : 1u; nx = cnt > 0u ? cnt : 1u;
}
__device__ __forceinline__ void xcd_barrier(const XcdBarrier& b) {
    asm volatile("s_waitcnt vmcnt(0)" ::: "memory");
    __syncthreads();
    if (threadIdx.x == 0) {
        unsigned* bar = b.bar;
        __builtin_amdgcn_s_waitcnt(0);
        unsigned nloc = b.st[0], nx = b.st[1];
        if (nloc == 0u) { xcd_barrier_complete(bar, b.x, nloc, nx); b.st[0] = nloc; b.st[1] = nx; }
        const unsigned old = xb_add(&bar[XB_XSUB(b.x)], 1u);
        const unsigned gen = old / nloc;
        if (old + 1u == (gen + 1u) * nloc) {
            __builtin_amdgcn_fence(__ATOMIC_RELEASE, "agent");
            asm volatile("s_waitcnt vmcnt(0)" ::: "memory");
            const unsigned og = xb_add(&bar[XB_TOP], 1u);
            const unsigned tg = og / nx;
            if (og + 1u == (tg + 1u) * nx) xb_add(&bar[XB_TOPGEN], 1u);
            else XB_SPIN(xb_ld(&bar[XB_TOPGEN]) == tg, bar);
            __builtin_amdgcn_fence(__ATOMIC_ACQUIRE, "agent");
            xb_add(&bar[XB_XGEN(b.x)], 1u);
            asm volatile("s_waitcnt vmcnt(0)" ::: "memory");
        } else {
            XB_SPIN(xb_ld(&bar[XB_XGEN(b.x)]) == gen, bar);
            __builtin_amdgcn_fence(__ATOMIC_ACQUIRE, "agent");
            asm volatile("s_waitcnt vmcnt(0)" ::: "memory");
        }
    }
    __syncthreads();
}

__device__ __forceinline__ void group_barrier(unsigned* ctl, int group, bool acquire, unsigned gen) {
    asm volatile("s_waitcnt vmcnt(0)" ::: "memory");
    __syncthreads();
    if (threadIdx.x == 0) {
        unsigned* cnt = ctl + CW_GCNT + 64 * group;
        __builtin_amdgcn_s_waitcnt(0);
        (void)__hip_atomic_fetch_add(cnt, 1u, __ATOMIC_RELAXED, __HIP_MEMORY_SCOPE_AGENT);
        const unsigned target = 8u * gen;
        unsigned sp = 0;
        while (xb_ld(cnt) < target) { __builtin_amdgcn_s_sleep(1); if (++sp > (1u << 22)) break; }
        if (acquire) { __builtin_amdgcn_fence(__ATOMIC_ACQUIRE, "agent"); asm volatile("s_waitcnt vmcnt(0)" ::: "memory"); }
    }
    __syncthreads();
}
struct Args { const float* in[31]; float* out; unsigned char* ws; int ph_lo, ph_hi; };
enum { I_XP = 0, I_XS, I_STATE, I_C, I_CCTX, I_F1N, I_F1G, I_F1U, I_F1D, I_MIXN, I_F2N, I_F2G, I_F2U, I_F2D, I_ADAW, I_ADAB, I_EVIN, I_EVOUT,
       I_POOLW, I_POOLS, I_CONVW, I_ALOG, I_DTB, I_DNNW, I_ODIN, I_ODOUT, I_SGUN, I_SGUW, I_SGUB, I_FNETW, I_FINN };

struct Frame {
    LAS unsigned char* lds;
    int tid, lane, wave, vcu, G;
    bool grp;
    const CAS Args* a;
};

#define DS_READ128(dst, addr) asm volatile("ds_read_b128 %0, %1" : "=v"(dst) : "v"((unsigned)(addr)))
__device__ __forceinline__ void lgkm_wait(int n) {
    switch (n) { case 0: asm volatile("s_waitcnt lgkmcnt(0)" ::: "memory"); break; case 1: asm volatile("s_waitcnt lgkmcnt(1)" ::: "memory"); break;
                 case 2: asm volatile("s_waitcnt lgkmcnt(2)" ::: "memory"); break; case 3: asm volatile("s_waitcnt lgkmcnt(3)" ::: "memory"); break;
                 case 4: asm volatile("s_waitcnt lgkmcnt(4)" ::: "memory"); break; case 5: asm volatile("s_waitcnt lgkmcnt(5)" ::: "memory"); break;
                 case 6: asm volatile("s_waitcnt lgkmcnt(6)" ::: "memory"); break; default: asm volatile("s_waitcnt lgkmcnt(7)" ::: "memory"); break; }
}
__device__ __forceinline__ void vm_wait(int n) {
    switch (n) { case 0: asm volatile("s_waitcnt vmcnt(0)" ::: "memory"); break; case 4: asm volatile("s_waitcnt vmcnt(4)" ::: "memory"); break;
                 case 5: asm volatile("s_waitcnt vmcnt(5)" ::: "memory"); break; case 6: asm volatile("s_waitcnt vmcnt(6)" ::: "memory"); break;
                 case 7: asm volatile("s_waitcnt vmcnt(7)" ::: "memory"); break; case 8: asm volatile("s_waitcnt vmcnt(8)" ::: "memory"); break;
                 case 9: asm volatile("s_waitcnt vmcnt(9)" ::: "memory"); break; default: asm volatile("s_waitcnt vmcnt(0)" ::: "memory"); break; }
}
template <int AUX>
__device__ __forceinline__ void glds_piece(const char* ubase, unsigned voff, LAS unsigned char* dst) {
    asm volatile("" : "+s"(ubase), "+v"(voff));
    __builtin_amdgcn_global_load_lds((const unsigned*)(ubase + voff), (LAS unsigned*)dst, 16, 0, AUX);
}
constexpr int AUX_ACT = 16, AUX_W = 0;
template <int NFRAG, class Epi>
__device__ __forceinline__ void gemm_tile(LAS unsigned char* lds, const int tid_in, const bf16* A, const bf16* Bt, int K, int row0, int col0, const Epi& E) {
    int tid = tid_in; asm volatile("" : "+v"(tid));
    constexpr int BN = 32 * NFRAG, NPB = BN / 8, A_BYTES = 192 * 128, B_BYTES = BN * 128, NBI = (NPB + 7) / 8;
    constexpr int NS = (3 * (A_BYTES + B_BYTES) <= LDS_MAIN) ? 3 : 2;
    constexpr bool UNI = (NS == 2);
    constexpr int STAGE = A_BYTES + (UNI ? NBI * 8192 : B_BYTES);
    constexpr bool ILV = true;
    static_assert(NS * STAGE <= LDS_MAIN, "LDS"); static_assert(2 * NFRAG >= 3 + NBI, "one staging piece per fragment step");
    const int lane = tid & 63, wid = __builtin_amdgcn_readfirstlane(tid >> 6), wm = wid >> 1, wn = wid & 1, fr = lane & 15, fq = lane >> 4;
    const int r = lane >> 3, slot = lane & 7;
    const int srow = wid * 8 + r;
    const int chunk = slot ^ ((srow >> 1) & 7);
    const unsigned voff = (unsigned)(r * K * 2 + chunk * 16);
    const char* gA = (const char*)(A + (size_t)(row0 + wid * 8) * K);
    const char* gB = (const char*)(Bt + (size_t)(col0 + wid * 8) * K);
    const size_t pstep = (size_t)64 * K * 2;
    const int nt = K / 64;
    const int nbw = (NPB - wid + 7) / 8;
    const unsigned ldsb = (unsigned)(uintptr_t)lds;
    const int rowA0 = wm * 48 + fr, rowB0 = wn * NFRAG * 16 + fr;
    int offA[2], offB[2];
#pragma unroll
    for (int kk = 0; kk < 2; ++kk) {
        offA[kk] = rowA0 * 128 + (((kk * 4 + fq) ^ ((rowA0 >> 1) & 7)) << 4);
        offB[kk] = A_BYTES + rowB0 * 128 + (((kk * 4 + fq) ^ ((rowB0 >> 1) & 7)) << 4);
    }
    f32x4 acc[3][NFRAG];
#pragma unroll
    for (int i = 0; i < 3; ++i)
#pragma unroll
        for (int j = 0; j < NFRAG; ++j) acc[i][j] = (f32x4){0.f, 0.f, 0.f, 0.f};
    typename Epi::template Hold<NFRAG> hold;
    E.template preload<NFRAG>(hold, row0 + wm * 48 + fr, col0 + wn * NFRAG * 16 + fq * 4, tid, row0, col0);

#define GEMM_STAGE(buf, t) do { LAS unsigned char* sA_ = lds + (buf) * STAGE + wid * 1024; \
        _Pragma("unroll") for (int i_ = 0; i_ < 3; ++i_) \
            glds_piece<AUX_ACT>(gA + i_ * pstep + (size_t)(t) * 128, voff, sA_ + i_ * 8192); \
        _Pragma("unroll") for (int i_ = 0; i_ < NBI; ++i_) if (UNI || wid + 8 * i_ < NPB) \
            glds_piece<AUX_W>(gB + i_ * pstep + (size_t)(t) * 128, voff, sA_ + A_BYTES + i_ * 8192); } while (0)

#define GEMM_PIECE(buf, j) do { LAS unsigned char* sP_ = lds + (buf) * STAGE + wid * 1024; \
        if ((j) < 3) glds_piece<AUX_ACT>(gA + (j) * pstep, voff, sP_ + (j) * 8192); \
        else if (UNI || wid + 8 * ((j) - 3) < NPB) glds_piece<AUX_W>(gB + ((j) - 3) * pstep, voff, sP_ + A_BYTES + ((j) - 3) * 8192); } while (0)
    GEMM_STAGE(0, 0);
    if (NS == 3) GEMM_STAGE(1, 1);
    gA += (NS == 3) ? 256 : 128; gB += (NS == 3) ? 256 : 128;
    int sbuf = 0;
    for (int t = 0; t < nt; ++t) {
        if (NS == 3) {
            if (t + 1 < nt) { if (nbw == NBI) vm_wait(3 + NBI); else vm_wait(3 + NBI - 1); } else vm_wait(0);
            __builtin_amdgcn_s_barrier();
        } else {
            asm volatile("s_waitcnt vmcnt(0)" ::: "memory");
            __syncthreads();
        }
        const int tn = (NS == 3) ? t + 2 : t + 1;
        const int nbuf = (NS == 3) ? ((sbuf >= 1) ? sbuf - 1 : 2) : (sbuf ^ 1);
        const bool do_st = tn < nt;
        if (!ILV) { if (do_st) { GEMM_STAGE(nbuf, 0); } }
        if (UNI && !do_st) { gA -= 128; gB -= 128; }
        asm volatile("" : "+s"(gA), "+s"(gB));
        if (NS == 3) {
            const unsigned sbo = (unsigned)sbuf * STAGE;
            const unsigned aA0 = ldsb + sbo + offA[0], aA1 = ldsb + sbo + offA[1], aB0 = ldsb + sbo + offB[0], aB1 = ldsb + sbo + offB[1];
            bf16x8 af[2][3], bq[4];
#pragma unroll
            for (int mf = 0; mf < 3; ++mf) { DS_READ128(af[0][mf], aA0 + mf * 2048); }
#pragma unroll
            for (int mf = 0; mf < 3; ++mf) { DS_READ128(af[1][mf], aA1 + mf * 2048); }
            constexpr int TOT = 2 * NFRAG;
#pragma unroll
            for (int f = 0; f < 3; ++f) { DS_READ128(bq[f], aB0 + f * 2048); }
#pragma unroll
            for (int f = 0; f < TOT; ++f) {
                if (f + 3 < TOT) { const int g = f + 3; DS_READ128(bq[g & 3], ((g >= NFRAG) ? aB1 + (g - NFRAG) * 2048 : aB0 + g * 2048)); }
                const int outstanding = (f + 3 < TOT) ? 3 : (TOT - 1 - f);
                lgkm_wait(outstanding);
                asm volatile("" : "+v"(bq[f & 3]));
                __builtin_amdgcn_sched_barrier(0);
                const int kk = (f >= NFRAG) ? 1 : 0, nf = f - kk * NFRAG;
#pragma unroll
                for (int mf = 0; mf < 3; ++mf) acc[mf][nf] = __builtin_amdgcn_mfma_f32_16x16x32_bf16(bq[f & 3], af[kk][mf], acc[mf][nf], 0, 0, 0);
                if (f < 3 + NBI) { if (do_st) GEMM_PIECE(nbuf, f); }
            }
        } else {
            const unsigned sbo = (unsigned)sbuf * STAGE;
            const unsigned aA0 = ldsb + sbo + offA[0], aA1 = ldsb + sbo + offA[1], aB0 = ldsb + sbo + offB[0], aB1 = ldsb + sbo + offB[1];
            bf16x8 af[3], bq[3];
#pragma unroll
            for (int mf = 0; mf < 3; ++mf) { DS_READ128(af[mf], aA0 + mf * 2048); }
            constexpr int TOT = 2 * NFRAG;
#pragma unroll
            for (int f = 0; f < 2; ++f) { DS_READ128(bq[f], aB0 + f * 2048); }
#pragma unroll
            for (int f = 0; f < TOT; ++f) {
                if (f + 2 < TOT) { const int g = f + 2; DS_READ128(bq[g % 3], ((g >= NFRAG) ? aB1 + (g - NFRAG) * 2048 : aB0 + g * 2048)); }
                const int outstanding = (f == NFRAG) ? 1 : ((f + 2 < TOT) ? 2 : (TOT - 1 - f));
                lgkm_wait(outstanding);
                asm volatile("" : "+v"(bq[f % 3]));
                if (f == NFRAG) asm volatile("" : "+v"(af[0]), "+v"(af[1]), "+v"(af[2]));
                __builtin_amdgcn_sched_barrier(0);
                const int nf = (f >= NFRAG) ? f - NFRAG : f;
#pragma unroll
                for (int mf = 0; mf < 3; ++mf) acc[mf][nf] = __builtin_amdgcn_mfma_f32_16x16x32_bf16(bq[f % 3], af[mf], acc[mf][nf], 0, 0, 0);
                if (f == NFRAG - 1) {
                    __builtin_amdgcn_sched_barrier(0);
#pragma unroll
                    for (int mf = 0; mf < 3; ++mf) { DS_READ128(af[mf], aA1 + mf * 2048); }
                }
                if (f < 3 + NBI) GEMM_PIECE(nbuf, f);
            }
        }
        sbuf = (sbuf + 1 == NS) ? 0 : sbuf + 1;
        gA += 128; gB += 128;
    }
#undef GEMM_STAGE
#undef GEMM_PIECE
    if (UNI) asm volatile("s_waitcnt vmcnt(0)" ::: "memory");
    __syncthreads();
    int te = tid; asm volatile("" : "+v"(te));
    const int fre = te & 15, fqe = (te >> 4) & 3;
    E.template stage<NFRAG>(hold, (LAS float*)lds, te);
    __syncthreads();
    E.template operator()<NFRAG>(acc, hold, row0 + wm * 48 + fre, col0 + wn * NFRAG * 16 + fqe * 4, fqe, (const LAS float*)lds, wm * 48 + fre, wn * NFRAG * 16 + fqe * 4);
    asm volatile("s_waitcnt vmcnt(0)" ::: "memory");
    __syncthreads();
}

template <int RB, int PITCH>
__device__ __forceinline__ void image_store(const LAS unsigned char* img, unsigned char* dst, size_t ldb, int lane) {
    constexpr int CPR = RB / 16, TOT = 48 * CPR;
#pragma unroll
    for (int j = 0; j < (TOT + 63) / 64; ++j) {
        const int ci = lane + 64 * j;
        if (ci < TOT) { const int r = ci / CPR, ch = ci - r * CPR; *(u32x4*)(dst + (size_t)r * ldb + ch * 16) = *(const LAS u32x4*)(img + r * PITCH + ch * 16); }
    }
}
struct Pre { const float* ss; const float* bias; };
struct PreHold { float rs, b[3]; };
__device__ __forceinline__ void pre_fetch(const Pre& p, PreHold& h, int tid, int row0, int col0, int BN) {
    h.rs = (tid < 192) ? __hip_atomic_load(p.ss + row0 + tid, __ATOMIC_RELAXED, __HIP_MEMORY_SCOPE_AGENT) : 0.f;
#pragma unroll
    for (int q = 0; q < 3; ++q) { const int i = tid + 512 * q; const int c = i / BN, j = i - c * BN; h.b[q] = (i < 3 * BN) ? p.bias[c * NBMAX + col0 + j] : 0.f; }
}
__device__ __forceinline__ void pre_write(const PreHold& h, LAS float* sc, int tid, int BN) {
    if (tid < 192) sc[tid] = rsq_f(h.rs * (1.f / D) + EPS);
#pragma unroll
    for (int q = 0; q < 3; ++q) { const int i = tid + 512 * q; if (i < 3 * BN) sc[256 + i] = h.b[q]; }
}
struct EpiUp {
    bf16* H; Pre pre;
    template <int NFRAG> struct Hold { PreHold ph; };
    template <int NFRAG> __device__ __forceinline__ void preload(Hold<NFRAG>& h, int, int, int tid, int row0, int col0) const { pre_fetch(pre, h.ph, tid, row0, col0, 32 * NFRAG); }
    template <int NFRAG> __device__ __forceinline__ void stage(const Hold<NFRAG>& h, LAS float* sc, int tid) const {
        constexpr int BN = 32 * NFRAG;
        if (tid < 192) sc[tid] = rsq_f(h.ph.rs * (1.f / D) + EPS);
#pragma unroll
        for (int q = 0; q < 3; ++q) { const int i = tid + 512 * q; if (i < 3 * BN) { const int j = i % BN; sc[256 + i] = h.ph.b[q] * ((j & 2) ? -0.6931471805599453f : -1.4426950408889634f); } }
    }
    template <int NFRAG> __device__ __forceinline__ void operator()(f32x4 (&acc)[3][NFRAG], const Hold<NFRAG>&, int row, int colq, int fq, const LAS float* sc, int lrow, int lcol) const {
        constexpr int RB = 16 * NFRAG;
        const int wm = lrow / 48, wn = lcol / (16 * NFRAG), fr = lrow - wm * 48;
        LAS unsigned char* img = (LAS unsigned char*)sc + 8192 + (wm * 2 + wn) * (48 * RB);
#pragma unroll
        for (int mf = 0; mf < 3; ++mf) {
            const int rr = row + mf * 16; const float rs = sc[lrow + mf * 16];
            const f32x4 rsv = {rs * -1.4426950408889634f, rs * -1.4426950408889634f, rs * -0.6931471805599453f, rs * -0.6931471805599453f};
            const LAS float* bp = sc + 256 + cond_of_row(rr) * (32 * NFRAG) + lcol;
#pragma unroll
            for (int nf = 0; nf < NFRAG; ++nf) {
                const f32x4 v = acc[mf][nf] * rsv + *(const LAS f32x4*)(bp + nf * 16);
                const f32x2 gs = {v[0], v[1]}, us = {v[2], v[3]};
                const f32x2 den = (f32x2){__builtin_amdgcn_exp2f(gs[0]), __builtin_amdgcn_exp2f(gs[1])} + (f32x2){1.f, 1.f};
                const f32x2 hv = (gs * (f32x2){rcp_f(den[0]), rcp_f(den[1])}) * us;
                *(LAS unsigned*)(img + (mf * 16 + fr) * RB + nf * 16 + fq * 4) = pk2(hv[0], hv[1]);
            }
        }
        const int lane = fq * 16 + fr;
        bf16* hb = H + (size_t)(row - fr) * FF + ((colq - fq * 4) >> 1);
#pragma unroll
        for (int j = 0; j < (48 * NFRAG + 63) / 64; ++j) {
            const int ci = lane + 64 * j;
            if (ci < 48 * NFRAG) { const int r = ci / NFRAG, ch = ci - r * NFRAG; *(u32x4*)(hb + (size_t)r * FF + ch * 8) = *(const LAS u32x4*)(img + r * RB + ch * 16); }
        }
    }
};
struct EpiRes {
    float* X; const float* mod; int layer, gidx; float scale;
    bf16* XS; float* ssn; const float* nwn; int ln, wn;
    template <int NFRAG> struct Hold { f32x4 xv[3][NFRAG]; float g, c; };
    template <int NFRAG> __device__ __forceinline__ void preload(Hold<NFRAG>& h, int row, int colq, int tid, int, int col0) const {
        constexpr int BN = 32 * NFRAG; static_assert(3 * BN <= 512, "one vector element per thread");
#pragma unroll
        for (int mf = 0; mf < 3; ++mf)
#pragma unroll
            for (int nf = 0; nf < NFRAG; ++nf) h.xv[mf][nf] = *(const f32x4*)(X + (size_t)(row + mf * 16) * D + colq + nf * 16);
        const int c = tid / BN, j = tid - c * BN; h.g = 0.f; h.c = 0.f;
        if (tid < 3 * BN) {
            h.g = mod[((size_t)(layer * 3 + c) * 9 + gidx) * 1024 + col0 + j] * scale;
            h.c = nwn[col0 + j] * (mod[((size_t)(ln * 3 + c) * 9 + wn * 3 + 1) * 1024 + col0 + j] + 1.0f);
        }
    }
    template <int NFRAG> __device__ __forceinline__ void stage(const Hold<NFRAG>& h, LAS float* sc, int tid) const {
        constexpr int BN = 32 * NFRAG;
        if (tid < 3 * BN) { sc[256 + tid] = h.g; sc[256 + 3 * BN + tid] = h.c; }
    }
    template <int NFRAG> __device__ __forceinline__ void operator()(f32x4 (&acc)[3][NFRAG], const Hold<NFRAG>& h, int row, int colq, int fq, const LAS float* sc, int lrow, int lcol) const {
        constexpr int BN = 32 * NFRAG, RBX = 64 * NFRAG, RBS = 32 * NFRAG, PX = RBX + 16, PS = RBS + 16;
        const int wm = lrow / 48, wn = lcol / (16 * NFRAG), fr = lrow - wm * 48, lane = fq * 16 + fr;
        LAS unsigned char* imx = (LAS unsigned char*)sc + 8192 + (wm * 2 + wn) * (48 * PX);
        u32x2 hsw[3][NFRAG];
#pragma unroll
        for (int mf = 0; mf < 3; ++mf) {
            const int rr = row + mf * 16, cnd = cond_of_row(rr);
            const LAS float* gp = sc + 256 + cnd * BN + lcol; const LAS float* cp = sc + 256 + 3 * BN + cnd * BN + lcol;
            float ssq = 0.f;
#pragma unroll
            for (int nf = 0; nf < NFRAG; ++nf) {
                const f32x4 x = h.xv[mf][nf] + acc[mf][nf] * *(const LAS f32x4*)(gp + nf * 16);
                *(LAS f32x4*)(imx + (mf * 16 + fr) * PX + nf * 64 + fq * 16) = x;
                if (ssn) {
                    const f32x4 hs = x * *(const LAS f32x4*)(cp + nf * 16);
                    hsw[mf][nf].x = pk2(hs[0], hs[1]); hsw[mf][nf].y = pk2(hs[2], hs[3]);
                    ssq += (x[0] * x[0] + x[1] * x[1]) + (x[2] * x[2] + x[3] * x[3]);
                }
            }
            if (ssn) { ssq += __shfl_xor(ssq, 16); ssq += __shfl_xor(ssq, 32); if (fq == 0) atomicAdd(ssn + rr, ssq); }
        }
        const size_t o0 = (size_t)(row - fr) * D + (colq - fq * 4);
        image_store<RBX, PX>(imx, (unsigned char*)(X + o0), (size_t)D * 4, lane);
        if (ssn) {
#pragma unroll
            for (int mf = 0; mf < 3; ++mf)
#pragma unroll
                for (int nf = 0; nf < NFRAG; ++nf) *(LAS u32x2*)(imx + (mf * 16 + fr) * PS + nf * 32 + fq * 8) = hsw[mf][nf];
            image_store<RBS, PS>(imx, (unsigned char*)(XS + o0), (size_t)D * 2, lane);
        }
    }
};
struct EpiStore {
    bf16* P; float* GT; Pre pre;
    template <int NFRAG> struct Hold { PreHold ph; };
    template <int NFRAG> __device__ __forceinline__ void preload(Hold<NFRAG>& h, int, int, int tid, int row0, int col0) const { pre_fetch(pre, h.ph, tid, row0, col0, 32 * NFRAG); }
    template <int NFRAG> __device__ __forceinline__ void stage(const Hold<NFRAG>& h, LAS float* sc, int tid) const { pre_write(h.ph, sc, tid, 32 * NFRAG); }
    template <int NFRAG> __device__ __forceinline__ void operator()(f32x4 (&acc)[3][NFRAG], const Hold<NFRAG>&, int row, int colq, int fq, const LAS float* sc, int lrow, int lcol) const {
        constexpr int RB = 32 * NFRAG, PB = RB + 16;
        const int wm = lrow / 48, wn = lcol / (16 * NFRAG), fr = lrow - wm * 48, lane = fq * 16 + fr;
        LAS unsigned char* img = (LAS unsigned char*)sc + 8192 + (wm * 2 + wn) * (48 * PB);
#pragma unroll
        for (int mf = 0; mf < 3; ++mf) {
            const int rr = row + mf * 16; const float rs = sc[lrow + mf * 16];
            const LAS float* bp = sc + 256 + cond_of_row(rr) * (32 * NFRAG) + lcol;
#pragma unroll
            for (int nf = 0; nf < NFRAG; ++nf) {
                const f32x4 v = acc[mf][nf] * rs + *(const LAS f32x4*)(bp + nf * 16);
                const int c = colq + nf * 16;
                u32x2 w; w.x = pk2(v[0], v[1]); w.y = pk2(v[2], v[3]);
                *(LAS u32x2*)(img + (mf * 16 + fr) * PB + nf * 32 + fq * 8) = w;
                if (c >= 3328 && c < 3352) *(f32x4*)(GT + (size_t)rr * 24 + (c - 3328)) = v;
            }
        }
        image_store<RB, PB>(img, (unsigned char*)(P + (size_t)(row - fr) * LDP + (colq - fq * 4)), (size_t)LDP * 2, lane);
    }
};

template <int NFRAG, class Epi>
__device__ __forceinline__ void gemm_phase(Frame& F, const bf16* A, const bf16* Bt, int K, int N, const Epi& E) {
    constexpr int BN = 32 * NFRAG;
    const int NT = N / BN, nitems = 32 * NT;
    for (int i = F.vcu; i < nitems; i += F.G) {
        const int panel = (i >> 3) & 31, ct = (i & 7) + 8 * (i >> 8);
        gemm_tile<NFRAG, Epi>(F.lds, F.tid, A, Bt, K, panel * 192, ct * BN, E);
    }
}

__device__ __forceinline__ void transpose_item(const float* W, int K, int N, int ldw, bf16* WT, int mode, LAS float* scr, int item, int lane, const float* shp, float* biasp) {
    const int nblk = (N + 63) / 64, kb = item / nblk, nb = item % nblk, k0 = 64 * kb, n0 = 64 * nb;
    const int lc = (lane & 15) * 4, lr = lane >> 4;
    f32x4 v[16];
#pragma unroll
    for (int i = 0; i < 16; ++i) v[i] = (n0 + lc < N) ? __builtin_nontemporal_load((const f32x4*)(W + (size_t)(k0 + 4 * i + lr) * ldw + n0 + lc)) : (f32x4){0.f, 0.f, 0.f, 0.f};
    float sh0 = 0.f, sh1 = 0.f, sh2 = 0.f;
    if (biasp) { sh0 = shp[k0 + lane]; sh1 = shp[9216 + k0 + lane]; sh2 = shp[2 * 9216 + k0 + lane]; }
#pragma unroll
    for (int i = 0; i < 16; ++i) { LAS float* p = scr + (4 * i + lr) * 65 + lc; p[0] = v[i][0]; p[1] = v[i][1]; p[2] = v[i][2]; p[3] = v[i][3]; }
    asm volatile("s_waitcnt lgkmcnt(0)" ::: "memory");
    const int c = lane & 7;
#pragma unroll
    for (int j = 0; j < 8; ++j) {
        const int nl = (lane >> 3) + 8 * j, n = n0 + nl; const LAS float* s = scr + (8 * c) * 65 + nl;
        u32x4 o; o.x = pk2(s[0 * 65], s[1 * 65]); o.y = pk2(s[2 * 65], s[3 * 65]); o.z = pk2(s[4 * 65], s[5 * 65]); o.w = pk2(s[6 * 65], s[7 * 65]);
        const int dr = (mode == 0) ? n : ((n >> 1) * 4 + (n & 1) + (mode == 2 ? 2 : 0));
        if (n < N) __builtin_nontemporal_store(o, (u32x4*)(WT + (size_t)dr * K + k0 + 8 * c));
    }
    if (biasp) {
        float b0 = 0.f, b1 = 0.f, b2 = 0.f;
#pragma unroll
        for (int kk = 0; kk < 64; ++kk) {
            const float w = scr[kk * 65 + lane];
            b0 += w * __builtin_bit_cast(float, __builtin_amdgcn_readlane(__builtin_bit_cast(int, sh0), kk));
            b1 += w * __builtin_bit_cast(float, __builtin_amdgcn_readlane(__builtin_bit_cast(int, sh1), kk));
            b2 += w * __builtin_bit_cast(float, __builtin_amdgcn_readlane(__builtin_bit_cast(int, sh2), kk));
        }
        const int n = n0 + lane, dr = (mode == 0) ? n : ((n >> 1) * 4 + (n & 1) + (mode == 2 ? 2 : 0));
        if (n < N) { atomicAdd(biasp + dr, b0); atomicAdd(biasp + NBMAX + dr, b1); atomicAdd(biasp + 2 * NBMAX + dr, b2); }
    }
    asm volatile("s_waitcnt lgkmcnt(0)" ::: "memory");
}

__device__ __forceinline__ void phase_setup(Frame& F) {
    const CAS Args& a = *F.a;
    unsigned char* ws = a.ws;
    {
        LAS float* sc = (LAS float*)F.lds;
        LAS float* red = sc + 3 * 1024;
        for (int i = F.tid; i < 3 * 1024; i += 512) { const int c = i >> 10, k = i & 1023; const float v = (c == 0) ? a.in[I_CCTX][k] : a.in[I_C][(c - 1) * 1024 + k]; sc[i] = silu_f(v); }
        __syncthreads();
        float* mod = (float*)(ws + WS_MOD);
        for (int it = F.vcu; it < 4 * 288; it += F.G) {
            const int l = it / 288, r_ = it % 288, kr = r_ / 36, seg = r_ % 36;
            const int k0 = kr * 128 + F.wave * 16;
            const float* W = a.in[I_ADAW] + (size_t)l * 1024 * 9216 + (size_t)k0 * 9216 + seg * 256 + F.lane * 4;
            f32x4 w[16];
#pragma unroll
            for (int k = 0; k < 16; ++k) w[k] = __builtin_nontemporal_load((const f32x4*)(W + (size_t)k * 9216));
            f32x4 s0 = {0, 0, 0, 0}, s1 = s0, s2 = s0;
#pragma unroll
            for (int k = 0; k < 16; ++k) { s0 += w[k] * sc[k0 + k]; s1 += w[k] * sc[1024 + k0 + k]; s2 += w[k] * sc[2048 + k0 + k]; }
            LAS float* rp = red + (F.wave * 64 + F.lane) * 12;
#pragma unroll
            for (int j = 0; j < 4; ++j) { rp[j] = s0[j]; rp[4 + j] = s1[j]; rp[8 + j] = s2[j]; }
            __syncthreads();
            if (F.tid < 256) {
                const int ln = F.tid >> 2, j = F.tid & 3, n = seg * 256 + F.tid;
#pragma unroll
                for (int c = 0; c < 3; ++c) {
                    float s = 0.f;
#pragma unroll
                    for (int wv = 0; wv < 8; ++wv) s += red[(wv * 64 + ln) * 12 + c * 4 + j];
                    if (kr == 0) s += a.in[I_ADAB][l * 9216 + n];
                    atomicAdd(mod + (size_t)(l * 3 + c) * 9216 + n, s);
                }
            }
            __syncthreads();
        }
        __syncthreads();
    }
}

__device__ __forceinline__ const bf16* sub_weight(unsigned char* ws, int s, int& N) {
    const int l = s / 3, which = s % 3, e = l >> 1;
    if (which != 1) { N = NUP; return (const bf16*)(ws + WS_WUP + (size_t)(l * 2 + (which == 2 ? 1 : 0)) * WUP_SZ); }
    if ((l & 1) == 0) { N = P_EVEN_PAD; return (const bf16*)(ws + WS_EVIN + (size_t)e * EVIN_SZ); }
    N = 2048; return (const bf16*)(ws + WS_ODIN + (size_t)e * ODIN_SZ);
}
__device__ __forceinline__ void phase_init(Frame& F) {
    const CAS Args& a = *F.a; unsigned char* ws = a.ws;
    const float* mod = (const float*)(ws + WS_MOD);
    const int gw = F.vcu * 8 + F.wave, NGW = F.G * 8;
    {
        for (int it = gw; it < 2 * NH * 16384 / 512; it += NGW) {
            const float* sp = a.in[I_SGUW] + (size_t)it * 512 + F.lane * 8;
            const f32x4 x0 = __builtin_nontemporal_load((const f32x4*)sp), x1 = __builtin_nontemporal_load((const f32x4*)(sp + 4));
            u32x4 o; o.x = pk2(x0[0], x0[1]); o.y = pk2(x0[2], x0[3]); o.z = pk2(x1[0], x1[1]); o.w = pk2(x1[2], x1[3]);
            *(u32x4*)((bf16*)(ws + WS_SGUW) + (size_t)it * 512 + F.lane * 8) = o;
        }
        for (int it = gw; it < 2 * (P_EVEN_PAD - P_EVEN); it += NGW) {
            const int e = it / (P_EVEN_PAD - P_EVEN), rr = P_EVEN + it % (P_EVEN_PAD - P_EVEN);
            u32x4* p = (u32x4*)((bf16*)(ws + WS_EVIN + (size_t)e * EVIN_SZ) + (size_t)rr * D);
            p[F.lane] = (u32x4){0, 0, 0, 0}; p[64 + F.lane] = (u32x4){0, 0, 0, 0};
        }
    }
    {
        float* X = (float*)(ws + WS_X); bf16* XS = (bf16*)(ws + WS_HN);
        float* ss = (float*)(ws + WS_CTL + CTL_SS_OFF);
        const float* nw = a.in[I_F1N];
        for (int row = gw; row < M; row += NGW) {
            f32x4 v[4];
            if (row < NCTX) {
                const f32x4* src = (const f32x4*)(a.in[I_XP] + (size_t)row * D);
#pragma unroll
                for (int j = 0; j < 4; ++j) v[j] = __builtin_nontemporal_load(src + j * 64 + F.lane);
            } else {
                const int t = (row - NCTX) & (LAT_L - 1); const float pr = (float)(t >> 6), pc = (float)(t & 63);
                const f32x4* src = (const f32x4*)(a.in[I_XS] + (size_t)(row - NCTX) * D);
#pragma unroll
                for (int j = 0; j < 4; ++j) {
                    const f32x4 sv = __builtin_nontemporal_load(src + j * 64 + F.lane);
#pragma unroll
                    for (int q = 0; q < 4; ++q) {
                        const int ch = (j * 64 + F.lane) * 4 + q, seg = ch >> 8, i = ch & 255;
                        const float freq = expf(-9.210340371976184f * (float)i * (1.0f / 256.0f));
                        const float ang = ((seg < 2) ? pr : pc) * freq;
                        const float pe = (seg & 1) ? cosf(ang) : sinf(ang);
                        v[j][q] = sv[q] + pe;
                    }
                }
            }
            float sq = 0.f;
#pragma unroll
            for (int j = 0; j < 4; ++j) { ((f32x4*)(X + (size_t)row * D))[j * 64 + F.lane] = v[j]; sq += v[j][0] * v[j][0] + v[j][1] * v[j][1] + v[j][2] * v[j][2] + v[j][3] * v[j][3]; }
            sq = wave_sum(sq);
            if (F.lane == 0) ss[row] = sq;
            const float* mb = mod + ((size_t)(0 * 3 + cond_of_row(row)) * 9 + 1) * 1024;
            u32x2* o = (u32x2*)(XS + (size_t)row * D) + F.lane;
#pragma unroll
            for (int j = 0; j < 4; ++j) {
                const int k = (64 * j + F.lane) * 4;
                const f32x4 h = v[j] * *(const f32x4*)(nw + k) * (*(const f32x4*)(mb + k) + 1.0f);
                u32x2 pkd; pkd.x = pk2(h[0], h[1]); pkd.y = pk2(h[2], h[3]);
                o[64 * j] = pkd;
            }
        }
    }
    {
        LAS float* T = (LAS float*)F.lds;
        LAS float* wt = T + 64 * 128;
        LAS float* tw = wt + 64 * 65;
        if (F.tid < 64) { tw[F.tid] = cospif((float)F.tid * (1.f / 32.f)); tw[64 + F.tid] = sinpif((float)F.tid * (1.f / 32.f)); }
        __syncthreads();
        for (int it = F.vcu; it < 2 * 4 * 16; it += F.G) {
            const int j = it >> 6, g = (it >> 4) & 3, k0 = (it & 15) * 64;
            const float* Wg = a.in[I_FNETW] + ((size_t)j * 4 + g) * 4096;
            LAS float* wgl = tw + 128;
            for (int i = F.tid; i < 1024; i += 512) *(LAS f32x4*)(wgl + i * 4) = *(const f32x4*)(Wg + i * 4);
            __syncthreads();
            {
                const int c = F.tid >> 3, eb = (F.tid & 7) * 8;
                float ac[8], as[8];
#pragma unroll
                for (int q = 0; q < 8; ++q) { ac[q] = 0.f; as[q] = 0.f; }
#pragma unroll 8
                for (int m = 0; m < 64; ++m) {
                    const int idx = (m * c) & 63; const float cs = tw[idx], sn = tw[64 + idx];
                    const f32x4 w0 = *(const LAS f32x4*)(wgl + m * 64 + eb), w1 = *(const LAS f32x4*)(wgl + m * 64 + eb + 4);
#pragma unroll
                    for (int q = 0; q < 4; ++q) { ac[q] += cs * w0[q]; ac[4 + q] += cs * w1[q]; as[q] -= sn * w0[q]; as[4 + q] -= sn * w1[q]; }
                }
#pragma unroll
                for (int q = 0; q < 8; ++q) { T[c * 128 + eb + q] = ac[q] * 0.125f; T[c * 128 + 64 + eb + q] = as[q] * 0.125f; }
                const int kk = F.tid >> 3, c8 = (F.tid & 7) * 8;
                const float* wp = a.in[I_ODIN] + (size_t)j * D * P_ODD + (size_t)(k0 + kk) * P_ODD + 1536 + g * 64 + c8;
                const f32x4 x0 = *(const f32x4*)wp, x1 = *(const f32x4*)(wp + 4);
#pragma unroll
                for (int q = 0; q < 4; ++q) { wt[kk * 65 + c8 + q] = x0[q]; wt[kk * 65 + c8 + 4 + q] = x1[q]; }
            }
            __syncthreads();
            {
                const int col = F.tid & 127, kq = F.tid >> 7;
                float acc[16];
#pragma unroll
                for (int q = 0; q < 16; ++q) acc[q] = 0.f;
                for (int c = 0; c < 64; ++c) {
                    const float t = T[c * 128 + col];
#pragma unroll
                    for (int q = 0; q < 16; ++q) acc[q] += wt[(kq * 16 + q) * 65 + c] * t;
                }
                const int drow = 1536 + ((col < 64) ? (g * 64 + col) : (256 + g * 64 + col - 64));
                bf16* dst = (bf16*)(ws + WS_ODIN + (size_t)j * ODIN_SZ) + (size_t)drow * D + k0 + kq * 16;
                u32x4 o0, o1;
                o0.x = pk2(acc[0], acc[1]); o0.y = pk2(acc[2], acc[3]); o0.z = pk2(acc[4], acc[5]); o0.w = pk2(acc[6], acc[7]);
                o1.x = pk2(acc[8], acc[9]); o1.y = pk2(acc[10], acc[11]); o1.z = pk2(acc[12], acc[13]); o1.w = pk2(acc[14], acc[15]);
                *(u32x4*)dst = o0; *(u32x4*)(dst + 8) = o1;
                const float* shp = (const float*)(ws + WS_MOD) + ((size_t)((2 * j + 1) * 3) * 9 + 3) * 1024 + k0 + kq * 16 + (F.lane & 15);
                const float s0v = shp[0], s1v = shp[9216], s2v = shp[2 * 9216];
                float b0 = 0.f, b1 = 0.f, b2 = 0.f;
#pragma unroll
                for (int q = 0; q < 16; ++q) {
                    b0 += acc[q] * __builtin_bit_cast(float, __builtin_amdgcn_readlane(__builtin_bit_cast(int, s0v), q));
                    b1 += acc[q] * __builtin_bit_cast(float, __builtin_amdgcn_readlane(__builtin_bit_cast(int, s1v), q));
                    b2 += acc[q] * __builtin_bit_cast(float, __builtin_amdgcn_readlane(__builtin_bit_cast(int, s2v), q));
                }
                float* bp = (float*)(ws + WS_BIAS) + (size_t)(3 * (2 * j + 1) + 1) * 3 * NBMAX + drow;
                atomicAdd(bp, b0); atomicAdd(bp + NBMAX, b1); atomicAdd(bp + 2 * NBMAX, b2);
            }
            __syncthreads();
        }
    }
    {
        LAS float* scr = (LAS float*)(F.lds + F.wave * 16640);
        const int gw = F.vcu * 8 + F.wave, NGW = F.G * 8;
        constexpr int IT_G = 16 * 44, IT_D = 44 * 16, IT_EVIN = 16 * 53, IT_SQ = 16 * 16, IT_ODIN = 16 * 24;
        static_assert(IT_G == IT_D, "decode");
        constexpr int PER_FFN = 2 * IT_G + IT_D;
        constexpr int TOT = 8 * PER_FFN + 2 * (IT_EVIN + IT_SQ + IT_ODIN + IT_SQ);
        constexpr int SPLIT = 9 * 2048;
        const bool skew = (F.G == 256);
        constexpr int TAIL_B = 1280;
        for (int pass = 0; pass < 2; ++pass) {
          int lo, hi, st;
          if (!skew) { lo = gw; hi = TOT; st = NGW; }
          else if (pass == 0) { lo = gw; hi = SPLIT; st = NGW; }
          else if (F.vcu >= 128) { lo = SPLIT + (gw - 1024); hi = SPLIT + TAIL_B; st = 1024; }
          else { lo = SPLIT + TAIL_B + gw; hi = TOT; st = 1024; }
          if (pass && !skew) break;
          for (int it = lo; it < hi; it += st) {
            int r = it; const float* W; bf16* WT; int K, N, mode, ldw = 0, sub_s = -1;
            if (r < 8 * PER_FFN) {
                const int f = r / PER_FFN, l = f >> 1, s = f & 1; r -= f * PER_FFN;
                const int sub = r / IT_G; r -= sub * IT_G;
                const int idx = (sub == 0) ? (s ? I_F2G : I_F1G) : ((sub == 1) ? (s ? I_F2U : I_F1U) : (s ? I_F2D : I_F1D));
                W = a.in[idx] + (size_t)l * D * FF;
                WT = (sub == 2) ? (bf16*)(ws + WS_WDN + (size_t)f * WDN_SZ) : (bf16*)(ws + WS_WUP + (size_t)f * WUP_SZ);
                K = (sub == 2) ? FF : D; N = (sub == 2) ? D : FF; mode = (sub == 2) ? 0 : sub + 1;
                if (sub != 2) sub_s = 3 * l + (s ? 2 : 0);
            } else {
                r -= 8 * PER_FFN;
                constexpr int PER_E = IT_EVIN + IT_SQ + IT_ODIN + IT_SQ;
                const int e = r / PER_E; r -= e * PER_E;
                K = D; mode = 0;
                if (r < IT_EVIN) { W = a.in[I_EVIN] + (size_t)e * D * P_EVEN; N = P_EVEN; WT = (bf16*)(ws + WS_EVIN + (size_t)e * EVIN_SZ); sub_s = 3 * (2 * e) + 1; }
                else if (r < IT_EVIN + IT_SQ) { r -= IT_EVIN; W = a.in[I_EVOUT] + (size_t)e * D * D; N = D; WT = (bf16*)(ws + WS_EVOUT + (size_t)e * SQ_SZ); }
                else if (r < IT_EVIN + IT_SQ + IT_ODIN) { r -= IT_EVIN + IT_SQ; W = a.in[I_ODIN] + (size_t)e * D * P_ODD; N = 1536; ldw = P_ODD; WT = (bf16*)(ws + WS_ODIN + (size_t)e * ODIN_SZ); sub_s = 3 * (2 * e + 1) + 1; }
                else { r -= IT_EVIN + IT_SQ + IT_ODIN; W = a.in[I_ODOUT] + (size_t)e * D * D; N = D; WT = (bf16*)(ws + WS_ODOUT + (size_t)e * SQ_SZ); }
            }
            const float* shp = nullptr; float* biasp = nullptr;
            if (sub_s >= 0) { shp = (const float*)(ws + WS_MOD) + ((size_t)((sub_s / 3) * 3) * 9 + (sub_s % 3) * 3) * 1024; biasp = (float*)(ws + WS_BIAS) + (size_t)sub_s * 3 * NBMAX; }
            transpose_item(W, K, N, ldw ? ldw : N, WT, mode, scr, r, F.lane, shp, biasp);
          }
        }
    }
}

__device__ __forceinline__ void phase_final(Frame& F, bool panel_local) {
    const CAS Args& a = *F.a;
    const float* X = (const float*)(a.ws + WS_X);
    const float* nw = a.in[I_FINN];
    const int gw = panel_local ? (F.vcu & 7) * 8 + F.wave : F.vcu * 8 + F.wave, NGW = panel_local ? 64 : F.G * 8;
    const int rbeg = panel_local ? (F.vcu >> 3) * 192 : 0, rend = panel_local ? rbeg + 192 : M;
    for (int row = rbeg + gw; row < rend; row += NGW) {
        const f32x4* xr = (const f32x4*)(X + (size_t)row * D) + F.lane;
        f32x4 v[4]; float s = 0.f;
#pragma unroll
        for (int j = 0; j < 4; ++j) { v[j] = xr[64 * j]; s += v[j][0] * v[j][0] + v[j][1] * v[j][1] + v[j][2] * v[j][2] + v[j][3] * v[j][3]; }
        const float rstd = 1.0f / sqrtf(wave_sum(s) * (1.f / D) + EPS);
        f32x4* o = (f32x4*)(a.out + (size_t)row * D) + F.lane;
#pragma unroll
        for (int j = 0; j < 4; ++j) { const f32x4 w = *(const f32x4*)(nw + (64 * j + F.lane) * 4); o[64 * j] = v[j] * rstd * w; }
    }
}

__device__ __forceinline__ float wave_matvec64(float d, const float* W, int lane) {
    float y = 0.f;
#pragma unroll
    for (int c = 0; c < 64; ++c) { const float dc = __builtin_bit_cast(float, __builtin_amdgcn_readlane(__builtin_bit_cast(int, d), c)); y += dc * W[c * 64 + lane]; }
    return y;
}

__device__ __forceinline__ int perm32(int x) { return (x & ~31) | ((x & 12) << 1) | ((x & 16) >> 2) | (x & 3); }
__device__ __forceinline__ int sw256(int row, int c16) { return row * 256 + ((c16 ^ (row & 15)) << 4); }
__device__ __forceinline__ int sw128(int row, int c8) { return row * 128 + ((c8 ^ ((row >> 1) & 7)) << 4); }
__device__ __forceinline__ int e128(int row, int col) { return sw128(row, col >> 3) + (col & 7) * 2; }
__device__ __forceinline__ void dn_item_decode(int cc, int& row0, int& L, int& c) {
    if (cc < 64) { row0 = (cc >> 2) * CTX_L; L = CTX_L; c = cc & 3; } else { const int q = cc - 64; row0 = NCTX + (q >> 4) * LAT_L; L = LAT_L; c = q & 15; }
}
#define MFMA16(a, b, c) __builtin_amdgcn_mfma_f32_16x16x32_bf16((a), (b), (c), 0, 0, 0)

__device__ __forceinline__ bool prep_task(int vcu, int G, int t, int& rec, bool& reuse) {
    if (G != 256) { rec = vcu + G * t; reuse = false; return rec < 1152; }
    int p, d;
    if (t < 4) { p = vcu + 256 * (t >> 1); d = t & 1; reuse = (d != 0); }
    else if (t == 4 && vcu < 128) { p = 512 + (vcu >> 1); d = vcu & 1; reuse = false; }
    else { rec = 0; reuse = false; return false; }
    int cc = p / NH; const int h = p - cc * NH;
    if (d) cc = (cc < 64) ? ((cc & ~3) | (3 - (cc & 3))) : (64 + (((cc - 64) & ~15) | (15 - ((cc - 64) & 15))));
    rec = (cc * NH + h) * 2 + d;
    return true;
}
__device__ __forceinline__ void phase_dn_prep(Frame& F, int e) {
    const CAS Args& a = *F.a;
    const bf16* P = (const bf16*)(a.ws + WS_P); const float* GT = (const float*)(a.ws + WS_AG);
    const float* cw = a.in[I_CONVW] + (size_t)e * 3 * 2304;
    LAS unsigned char* L = F.lds;
    constexpr int CWL = 114688;
    constexpr int KB = 0, QB = 16384, VBT = 32768, KGT = 49152, KDT = 65536, AIo = 81920, MM = 90112, TT = 98304, TN = 106496, MD = 114688, XT = 118784, SM = 139264, VB16 = 140288;
    LAS float* sm = (LAS float*)(L + SM);
    const int wave = F.wave;
    float cwp[3], arawp = 0.f, brawp = 0.f;
#define PREP_FETCH(rec_) do { const int t_ = F.tid, dir_ = (rec_) & 1, h_ = ((rec_) >> 1) % NH, cc_ = (rec_) / (2 * NH); int r0_, L_, c_; dn_item_decode(cc_, r0_, L_, c_); \
        _Pragma("unroll") for (int q_ = 0; q_ < 3; ++q_) { const int i_ = t_ + 512 * q_; const int part = i_ / 384, r_ = i_ % 384, tap = r_ >> 7, ch = r_ & 127; cwp[q_] = (i_ < 1152) ? cw[tap * 2304 + part * 768 + h_ * 128 + ch] : 0.f; } \
        if (wave == 0) { const int ln_ = t_ & 63; const int row_ = r0_ + (dir_ ? (L_ - 1 - (c_ * 64 + ln_)) : (c_ * 64 + ln_)); arawp = GT[(size_t)row_ * 24 + 12 + dir_ * 6 + h_]; brawp = GT[(size_t)row_ * 24 + dir_ * 6 + h_]; } } while (0)
    { int rec0; bool ru0; if (prep_task(F.vcu, F.G, 0, rec0, ru0)) PREP_FETCH(rec0); }
    for (int tk = 0; ; ++tk) {
        int rec; bool reuse;
        if (!prep_task(F.vcu, F.G, tk, rec, reuse)) break;
        int tid_ = F.tid; asm volatile("" : "+v"(tid_));
        const int lane = tid_ & 63, fr = lane & 15, fq = lane >> 4;
        const int dir = rec & 1, h = (rec >> 1) % NH, cc = rec / (2 * NH);
        int row0, Ls, c; dn_item_decode(cc, row0, Ls, c);
        __syncthreads();
#pragma unroll
        for (int q_ = 0; q_ < 3; ++q_) { const int i_ = tid_ + 512 * q_; if (i_ < 1152) ((LAS float*)(L + CWL))[i_] = cwp[q_]; }
        if (wave == 0) {
            const float araw = arawp, braw = brawp;
            const float al = a.in[I_ALOG][(e * 2 + dir) * 6 + h], dtb = a.in[I_DTB][(e * 2 + dir) * 6 + h];
            const float sx = araw + dtb;
            float x = -__expf(al) * (sx > 20.f ? sx : __logf(1.f + __expf(sx))); const float b = sigmoid_f(braw);
#pragma unroll
            for (int o = 1; o < 64; o <<= 1) { const float t = __shfl_up(x, o); if (lane >= o) x += t; }
            const float gl = __shfl(x, 63);
            const float ex = __expf(x);
            sm[lane] = x; sm[64 + lane] = b; sm[128 + lane] = ex; sm[192 + lane] = __expf(gl - x);
            if (lane == 63) ((float*)(a.ws + WS_DGL))[rec] = ex;
        }
        __syncthreads();
        {
            const int i = tid_ >> 3, cg = tid_ & 7;
            const int row = row0 + (dir ? (Ls - 1 - (c * 64 + i)) : (c * 64 + i));
            const int tl = row - row0; const bool hp = tl > 0, hn = tl < Ls - 1;
            float kf[16], qf[16], vf[16];
            if (reuse) {
#pragma unroll
                for (int hf = 0; hf < 2; ++hf) {
                    const u32x4 qq = *(const LAS u32x4*)(L + QB + sw256(63 - i, cg * 2 + hf));
                    const unsigned qa[4] = {qq.x, qq.y, qq.z, qq.w};
#pragma unroll
                    for (int d = 0; d < 4; ++d) { qf[hf * 8 + 2 * d] = __builtin_bit_cast(float, qa[d] << 16); qf[hf * 8 + 2 * d + 1] = __builtin_bit_cast(float, qa[d] & 0xffff0000u); }
                }
            } else {
#pragma unroll
            for (int part = 0; part < 3; ++part) {
                const int pc = 256 + part * 768 + h * 128 + cg * 16;
                const bf16* p1 = P + (size_t)row * LDP + pc;
                const LAS float* wl = (const LAS float*)(L + CWL) + part * 384 + cg * 16;
                float out[16];
#pragma unroll
                for (int q8 = 0; q8 < 2; ++q8) {
                    const u32x4 r1 = *(const u32x4*)(p1 + q8 * 8);
                    const u32x4 r0 = hp ? *(const u32x4*)(p1 - LDP + q8 * 8) : (u32x4){0, 0, 0, 0};
                    const u32x4 r2 = hn ? *(const u32x4*)(p1 + LDP + q8 * 8) : (u32x4){0, 0, 0, 0};
                    const unsigned a0[4] = {r0.x, r0.y, r0.z, r0.w}, a1[4] = {r1.x, r1.y, r1.z, r1.w}, a2[4] = {r2.x, r2.y, r2.z, r2.w};
                    f32x4 w0[2], w1[2], w2[2];
#pragma unroll
                    for (int hv = 0; hv < 2; ++hv) { w0[hv] = *(const LAS f32x4*)(wl + q8 * 8 + hv * 4); w1[hv] = *(const LAS f32x4*)(wl + 128 + q8 * 8 + hv * 4); w2[hv] = *(const LAS f32x4*)(wl + 256 + q8 * 8 + hv * 4); }
#pragma unroll
                    for (int d = 0; d < 4; ++d) {
#pragma unroll
                        for (int hh = 0; hh < 2; ++hh) {
                            const int jj = d * 2 + hh, j = q8 * 8 + jj;
                            const float x0 = __builtin_bit_cast(float, hh ? (a0[d] & 0xffff0000u) : (a0[d] << 16));
                            const float x1 = __builtin_bit_cast(float, hh ? (a1[d] & 0xffff0000u) : (a1[d] << 16));
                            const float x2 = __builtin_bit_cast(float, hh ? (a2[d] & 0xffff0000u) : (a2[d] << 16));
                            out[j] = silu_f(x0 * w0[jj >> 2][jj & 3] + x1 * w1[jj >> 2][jj & 3] + x2 * w2[jj >> 2][jj & 3]);
                        }
                    }
                }
                if (part < 2) {
                    float ssq = 0.f;
#pragma unroll
                    for (int j = 0; j < 16; ++j) ssq += out[j] * out[j];
                    ssq += __shfl_xor(ssq, 1); ssq += __shfl_xor(ssq, 2); ssq += __shfl_xor(ssq, 4);
                    const float rs = rsq_f(ssq + EPS) * (part == 0 ? 0.08838834764831845f : 1.0f);
#pragma unroll
                    for (int j = 0; j < 16; ++j) { if (part == 0) qf[j] = out[j] * rs; else kf[j] = out[j] * rs; }
                } else {
#pragma unroll
                    for (int j = 0; j < 16; ++j) vf[j] = out[j];
                }
            }
            }
            const float eg = sm[128 + i];
            if (!reuse) {
#pragma unroll
            for (int hf = 0; hf < 2; ++hf) {
                u32x4 kk, qq, vv;
                kk.x = pk2(kf[hf * 8 + 0], kf[hf * 8 + 1]); kk.y = pk2(kf[hf * 8 + 2], kf[hf * 8 + 3]); kk.z = pk2(kf[hf * 8 + 4], kf[hf * 8 + 5]); kk.w = pk2(kf[hf * 8 + 6], kf[hf * 8 + 7]);
                qq.x = pk2(qf[hf * 8 + 0], qf[hf * 8 + 1]); qq.y = pk2(qf[hf * 8 + 2], qf[hf * 8 + 3]); qq.z = pk2(qf[hf * 8 + 4], qf[hf * 8 + 5]); qq.w = pk2(qf[hf * 8 + 6], qf[hf * 8 + 7]);
                vv.x = pk2(vf[hf * 8 + 0], vf[hf * 8 + 1]); vv.y = pk2(vf[hf * 8 + 2], vf[hf * 8 + 3]); vv.z = pk2(vf[hf * 8 + 4], vf[hf * 8 + 5]); vv.w = pk2(vf[hf * 8 + 6], vf[hf * 8 + 7]);
                *(LAS u32x4*)(L + KB + sw256(i, cg * 2 + hf)) = kk;
                *(LAS u32x4*)(L + QB + sw256(i, cg * 2 + hf)) = qq;
                *(LAS u32x4*)(L + VB16 + sw256(i, cg * 2 + hf)) = vv;
            }
            }
            bf16* QD = (bf16*)(a.ws + WS_DQ) + (size_t)rec * 8192 + i * 128;
#pragma unroll
            for (int qq = 0; qq < 4; ++qq) {
                const int pos = perm32(cg * 16 + 4 * qq);
                u32x2 w; w.x = pk2(qf[4 * qq] * eg, qf[4 * qq + 1] * eg); w.y = pk2(qf[4 * qq + 2] * eg, qf[4 * qq + 3] * eg);
                *(u32x2*)(QD + pos) = w;
            }
        }
        __syncthreads();
        {
            const int kdl = lane & 15, ipl = lane >> 4;
            const int i0h = 2 * (wave * 4 + ipl);
            const float be0 = sm[64 + i0h], be1 = sm[65 + i0h], eg0 = sm[128 + i0h], eg1 = sm[129 + i0h], ek0 = sm[192 + i0h], ek1 = sm[193 + i0h];
#pragma unroll 2
            for (int it8 = 0; it8 < 8; ++it8) {
                const int combo = wave * 8 + it8, kd = (combo & 7) * 16 + kdl, i0 = i0h;
                const int a0 = sw256(reuse ? 63 - i0 : i0, kd >> 3) + (kd & 7) * 2, a1 = sw256(reuse ? 62 - i0 : i0 + 1, kd >> 3) + (kd & 7) * 2;
                const float k0 = __builtin_bit_cast(float, (unsigned)(*(const LAS bf16*)(L + KB + a0)) << 16), k1 = __builtin_bit_cast(float, (unsigned)(*(const LAS bf16*)(L + KB + a1)) << 16);
                const float v0 = __builtin_bit_cast(float, (unsigned)(*(const LAS bf16*)(L + VB16 + a0)) << 16), v1 = __builtin_bit_cast(float, (unsigned)(*(const LAS bf16*)(L + VB16 + a1)) << 16);
                *(LAS unsigned*)(L + VBT + e128(kd, i0)) = pk2(v0 * be0, v1 * be1);
                *(LAS unsigned*)(L + KGT + e128(kd, i0)) = pk2(k0 * be0 * eg0, k1 * be1 * eg1);
                *(LAS unsigned*)(L + KDT + e128(kd, perm32(i0))) = pk2(k0 * ek0, k1 * ek1);
            }
        }
        __syncthreads();
        const int mi = wave >> 1;
#pragma unroll
        for (int f = 0; f < 2; ++f) {
            const int nj = (wave & 1) * 2 + f;
            f32x4 kkacc = {0.f, 0.f, 0.f, 0.f}, qkacc = {0.f, 0.f, 0.f, 0.f};
            if (nj <= mi) {
#pragma unroll
                for (int ks = 0; ks < 4; ++ks) {
                    const int ra = reuse ? 63 - (mi * 16 + fr) : mi * 16 + fr, rb = reuse ? 63 - (nj * 16 + fr) : nj * 16 + fr;
                    const bf16x8 ak = *(const LAS bf16x8*)(L + KB + sw256(ra, ks * 4 + fq));
                    const bf16x8 aq = *(const LAS bf16x8*)(L + QB + sw256(ra, ks * 4 + fq));
                    const bf16x8 bk = *(const LAS bf16x8*)(L + KB + sw256(rb, ks * 4 + fq));
                    kkacc = MFMA16(ak, bk, kkacc); qkacc = MFMA16(aq, bk, qkacc);
                }
            }
            const int j = nj * 16 + fr, i0 = mi * 16 + 4 * fq; const float gcj = sm[j];
#pragma unroll
            for (int r = 0; r < 4; ++r) {
                const int i = i0 + r; const float dec = (i >= j) ? __expf(sm[i] - gcj) : 0.f;
                const float mv = (i > j) ? (sm[64 + i] * kkacc[r] * dec) : 0.f;
                if (nj <= mi) *(LAS bf16*)(L + MM + e128(i, j)) = (bf16)f2bf(mv);
                if (nj == mi) *(LAS float*)(L + MD + ((mi * 16 + 4 * fq + r) * 16 + fr) * 4) = mv;
                if (nj > mi) *(LAS bf16*)(L + TN + e128(i, j)) = (bf16)0;
                *(LAS bf16*)(L + AIo + e128(i, perm32(j))) = (bf16)f2bf(qkacc[r] * dec);
            }
        }
        __syncthreads();
        if (wave == 0) {
            const int b = lane >> 4, cc_ = lane & 15;
            const LAS float* md = (const LAS float*)(L + MD) + b * 256;
            float T[16];
#pragma unroll
            for (int i = 0; i < 16; ++i) {
                float s = (i == cc_) ? 1.f : 0.f;
#pragma unroll
                for (int jj = 0; jj < i; ++jj) s -= md[i * 16 + jj] * T[jj];
                T[i] = s;
            }
#pragma unroll
            for (int i = 0; i < 16; ++i) *(LAS bf16*)(L + TN + e128(16 * b + i, 16 * b + cc_)) = (bf16)f2bf(T[i]);
#pragma unroll
            for (int hf = 0; hf < 2; ++hf) {
                u32x4 t; t.x = pk2(T[hf * 8 + 0], T[hf * 8 + 1]); t.y = pk2(T[hf * 8 + 2], T[hf * 8 + 3]); t.z = pk2(T[hf * 8 + 4], T[hf * 8 + 5]); t.w = pk2(T[hf * 8 + 6], T[hf * 8 + 7]);
                *(LAS u32x4*)(L + TT + sw128(16 * b + cc_, 2 * b + hf)) = t;
            }
        }
        __syncthreads();
#pragma unroll
        for (int lvl = 1; lvl <= 3; ++lvl) {
            if (wave < 4 - lvl) {
                const int J = wave, I = wave + lvl;
                f32x4 x = {0.f, 0.f, 0.f, 0.f};
                const bf16x8 zero8 = {0, 0, 0, 0, 0, 0, 0, 0};
#pragma unroll
                for (int ks = 0; ks < (lvl == 3 ? 2 : 1); ++ks) {
                    const bf16x8 am = *(const LAS bf16x8*)(L + MM + sw128(16 * I + fr, 2 * J + 4 * ks + fq));
                    bf16x8 bt = *(const LAS bf16x8*)(L + TT + sw128(16 * J + fr, 2 * J + 4 * ks + fq));
                    if (4 * ks + fq >= 2 * lvl) bt = zero8;
                    x = MFMA16(am, bt, x);
                }
                LAS unsigned char* xt = L + XT + wave * 512;
                { u32x2 t; t.x = pk2(x[0], x[1]); t.y = pk2(x[2], x[3]); *(LAS u32x2*)(xt + fr * 32 + fq * 8) = t; }
                const bf16x8 ad = *(const LAS bf16x8*)(L + TN + sw128(16 * I + fr, 2 * I + (fq & 1)));
                bf16x8 bx = *(const LAS bf16x8*)(xt + fr * 32 + (fq & 1) * 16);
                if (fq >= 2) bx = zero8;
                f32x4 t4 = {0.f, 0.f, 0.f, 0.f};
                t4 = MFMA16(ad, bx, t4);
#pragma unroll
                for (int r = 0; r < 4; ++r) *(LAS bf16*)(L + TN + e128(16 * I + 4 * fq + r, 16 * J + fr)) = (bf16)f2bf(-t4[r]);
                { u32x2 t; t.x = pk2(-t4[0], -t4[1]); t.y = pk2(-t4[2], -t4[3]); *(LAS u32x2*)(L + TT + e128(16 * J + fr, 16 * I + 4 * fq)) = t; }
            }
            __syncthreads();
        }
        { int recn; bool run; if (prep_task(F.vcu, F.G, tk + 1, recn, run)) PREP_FETCH(recn); }
        {
            bf16* UT = (bf16*)(a.ws + WS_DUT) + (size_t)rec * 8192;
            bf16* Wn = (bf16*)(a.ws + WS_DW) + (size_t)rec * 8192;
            const int ui = wave & 3;
#pragma unroll
            for (int f = 0; f < 4; ++f) {
                const int dvf = (wave >> 2) * 4 + f;
                f32x4 acc = {0.f, 0.f, 0.f, 0.f};
#pragma unroll
                for (int ks = 0; ks < 2; ++ks) {
                    const bf16x8 ta = *(const LAS bf16x8*)(L + TN + sw128(ui * 16 + fr, ks * 4 + fq));
                    const bf16x8 vb = *(const LAS bf16x8*)(L + VBT + sw128(dvf * 16 + fr, ks * 4 + fq));
                    acc = MFMA16(ta, vb, acc);
                }
                u32x2 t; t.x = pk2(acc[0], acc[1]); t.y = pk2(acc[2], acc[3]);
                *(u32x2*)(UT + (dvf * 16 + fr) * 64 + ui * 16 + 4 * fq) = t;
            }
#pragma unroll
            for (int f = 0; f < 4; ++f) {
                f32x4 acc = {0.f, 0.f, 0.f, 0.f};
#pragma unroll
                for (int ks = 0; ks < 2; ++ks) {
                    const bf16x8 ka = *(const LAS bf16x8*)(L + KGT + sw128(wave * 16 + fr, ks * 4 + fq));
                    const bf16x8 tb = *(const LAS bf16x8*)(L + TN + sw128(f * 16 + fr, ks * 4 + fq));
                    acc = MFMA16(ka, tb, acc);
                }
                u32x2 t; t.x = pk2(-acc[0], -acc[1]); t.y = pk2(-acc[2], -acc[3]);
                *(u32x2*)(Wn + (f * 16 + fr) * 128 + perm32(wave * 16 + 4 * fq)) = t;
            }
            {
                const int rw = tid_ >> 3, c8 = tid_ & 7;
                *(u32x4*)((unsigned char*)(a.ws + WS_DAI) + (size_t)rec * 8192 + rw * 128 + c8 * 16) = *(const LAS u32x4*)(L + AIo + sw128(rw, c8));
#pragma unroll
                for (int k2 = 0; k2 < 2; ++k2) {
                    const int rr = rw + 64 * k2;
                    *(u32x4*)((unsigned char*)(a.ws + WS_DKT) + (size_t)rec * 16384 + rr * 128 + c8 * 16) = *(const LAS u32x4*)(L + KDT + sw128(rr, c8));
                }
            }
        }
    }
#undef PREP_FETCH
    __syncthreads();
}

__device__ __forceinline__ void pool_items(Frame& F, int e, int first_cu, int max_items) {
    const CAS Args& a = *F.a;
    const bf16* P = (const bf16*)(a.ws + WS_P); bf16* Y = (bf16*)(a.ws + WS_Y);
    if (F.vcu < first_cu) return;
    constexpr int PB = 48, NIT = (M / PB) * 4;
    const float* pw = a.in[I_POOLW] + (size_t)e * 4 * 64 * 64; const float* ps = a.in[I_POOLS] + e * 256;
    unsigned* qcnt = (unsigned*)(a.ws + WS_CTL) + CW_POOLQ + 64 * e;
    LAS float* xs = (LAS float*)F.lds;
    LAS float* dl = xs + (PB + 16) * 64;
    LAS float* wl = dl + PB * 65;
    LAS int* nxt = (LAS int*)(wl + 64 * 64);
    __syncthreads();
    if (F.tid == 0) *nxt = (int)xb_add(qcnt, 1u);
    __syncthreads();
    int it = *nxt, done = 0;
    while (it < NIT && done < max_items) {
        const int blk = it >> 2, g = it & 3, r0 = blk * PB;
        int nx = NIT;
        if (F.tid == 0 && done + 1 < max_items) nx = (int)xb_add(qcnt, 1u);
        ++done;
        __syncthreads();
        for (int i = F.tid; i < (PB + 16) * 16; i += 512) {
            const int rr = i >> 4, c4 = (i & 15) * 4, row = r0 - 8 + rr;
            const bool in = (row >= 0) && (row < M);
            const u32x2 pr = in ? *(const u32x2*)(P + (size_t)row * LDP + g * 64 + c4) : (u32x2){0, 0};
            *(LAS f32x4*)(xs + rr * 64 + c4) = (f32x4){__builtin_bit_cast(float, pr.x << 16), __builtin_bit_cast(float, pr.x & 0xffff0000u), __builtin_bit_cast(float, pr.y << 16), __builtin_bit_cast(float, pr.y & 0xffff0000u)};
        }
        for (int i = F.tid; i < 1024; i += 512) *(LAS f32x4*)(wl + i * 4) = *(const f32x4*)(pw + g * 4096 + i * 4);
        __syncthreads();
        for (int u = F.tid; u < PB * 8; u += 512) {
            const int t = u >> 3, c8 = (u & 7) * 8, row = r0 + t, half = 1 << g; int s0, Ls; seq_of_row(row, s0, Ls);
            const int tl = row - s0;
            const int lo = max(tl - half, 0), hi = min(tl + half, Ls);
            float sum[8];
#pragma unroll
            for (int q = 0; q < 8; ++q) sum[q] = 0.f;
            for (int p = lo; p < hi; ++p) {
                const LAS float* xr = xs + (p - tl + t + 8) * 64 + c8;
                const f32x4 a0 = *(const LAS f32x4*)xr, a1 = *(const LAS f32x4*)(xr + 4);
#pragma unroll
                for (int q = 0; q < 4; ++q) { sum[q] += a0[q]; sum[4 + q] += a1[q]; }
            }
            const float inv = rcp_f((float)(hi - lo));
            const LAS float* xc = xs + (t + 8) * 64 + c8;
#pragma unroll
            for (int q = 0; q < 8; ++q) dl[t * 65 + c8 + q] = sum[q] * inv - xc[q];
        }
        __syncthreads();
        for (int u = F.tid; u < PB * 8; u += 512) {
            const int t = u >> 3, e8 = (u & 7) * 8;
            float y[8];
#pragma unroll
            for (int q = 0; q < 8; ++q) y[q] = 0.f;
            for (int c = 0; c < 64; ++c) {
                const float d = dl[t * 65 + c];
                const f32x4 w0 = *(const LAS f32x4*)(wl + c * 64 + e8), w1 = *(const LAS f32x4*)(wl + c * 64 + e8 + 4);
#pragma unroll
                for (int q = 0; q < 4; ++q) { y[q] += d * w0[q]; y[4 + q] += d * w1[q]; }
            }
            const f32x4 s0v = *(const f32x4*)(ps + g * 64 + e8), s1v = *(const f32x4*)(ps + g * 64 + e8 + 4);
            u32x4 o; o.x = pk2(y[0] * s0v[0], y[1] * s0v[1]); o.y = pk2(y[2] * s0v[2], y[3] * s0v[3]); o.z = pk2(y[4] * s1v[0], y[5] * s1v[1]); o.w = pk2(y[6] * s1v[2], y[7] * s1v[3]);
            *(u32x4*)(Y + (size_t)(r0 + t) * D + g * 64 + e8) = o;
        }
        if (F.tid == 0) *nxt = nx;
        __syncthreads();
        it = *nxt;
    }
    __syncthreads();
}

__device__ __forceinline__ void phase_dn_scan(Frame& F, int e) {
    const CAS Args& a = *F.a;
    LAS unsigned char* L = F.lds;
    constexpr int BUF = 57344 + 16384 + 256, oW = 0, oQ = 16384, oA = 32768, oK = 40960, oU = 57344, oG = 73728;
    static_assert(2 * BUF <= LDS_MAIN, "scan LDS");
    const int wave = F.wave;
    const unsigned char* gW = (const unsigned char*)(a.ws + WS_DW); const unsigned char* gQ = (const unsigned char*)(a.ws + WS_DQ);
    const unsigned char* gA = (const unsigned char*)(a.ws + WS_DAI); const unsigned char* gK = (const unsigned char*)(a.ws + WS_DKT);
    const bf16* gU = (const bf16*)(a.ws + WS_DUT); const float* gGL = (const float*)(a.ws + WS_DGL);
    for (int it = F.vcu; it < (2 * LAT_B + CTX_B) * 2 * NH; it += F.G) {
        int tid_ = F.tid; asm volatile("" : "+v"(tid_));
        const int lane = tid_ & 63, fr = lane & 15, fq = lane >> 4;
        const int r4 = lane >> 4, s16 = lane & 15, r8 = lane >> 3, s8 = lane & 7;
        int seq, dir, h, half = 0;
        if (it < 2 * LAT_B * 2 * NH) { half = it & 1; const int j = it >> 1; seq = CTX_B + j / (2 * NH); dir = (j / NH) & 1; h = j % NH; }
        else { const int j = it - 2 * LAT_B * 2 * NH; seq = j / (2 * NH); dir = (j / NH) & 1; h = j % NH; }
        const bool lat = seq >= CTX_B;
        const bool active = lat ? (wave < 4) : true;
        const bool ldr = lat ? (wave >= 4) : true; const int lw = lat ? wave - 4 : wave, nw = lat ? 4 : 8;
        const int dvc = (lat ? half * 64 : 0) + (wave & (lat ? 3 : 7)) * 16 + fr;
        const int Ls = lat ? LAT_L : CTX_L, row0 = lat ? NCTX + (seq - CTX_B) * LAT_L : seq * CTX_L, nch = Ls / 64;
        const int cbase = lat ? 64 + (seq - CTX_B) * 16 : seq * 4;
        f32x4 S[8];
        if (lat) {
            const float* s0 = a.in[I_STATE] + ((((size_t)(seq - CTX_B) * 2 + e) * 2 + dir) * NH + h) * 128 * 128;
#pragma unroll
            for (int mf = 0; mf < 8; ++mf)
#pragma unroll
                for (int r = 0; r < 4; ++r) S[mf][r] = s0[(size_t)(mf * 16 + 4 * fq + r) * 128 + dvc];
        } else {
#pragma unroll
            for (int mf = 0; mf < 8; ++mf) S[mf] = (f32x4){0.f, 0.f, 0.f, 0.f};
        }
        bf16* O = (bf16*)(a.ws + (dir ? WS_OB : WS_OF));
#define DN_STAGE(bufi, rec_) do { if (ldr) { LAS unsigned char* sb_ = L + (bufi) * BUF; const size_t ro_ = (size_t)(rec_); \
        _Pragma("unroll") for (int p_ = 0; p_ < 4; ++p_) { const int pc_ = lw + nw * p_; if (pc_ < 16) { const int rw_ = pc_ * 4 + r4; const int so_ = rw_ * 256 + ((s16 ^ (rw_ & 15)) << 4); \
            __builtin_amdgcn_global_load_lds((const unsigned*)(gW + ro_ * 16384 + so_), (LAS unsigned*)(sb_ + oW + pc_ * 1024), 16, 0, 0); \
            __builtin_amdgcn_global_load_lds((const unsigned*)(gQ + ro_ * 16384 + so_), (LAS unsigned*)(sb_ + oQ + pc_ * 1024), 16, 0, 0); \
            const int rk_ = pc_ * 8 + r8; const int sk_ = rk_ * 128 + ((s8 ^ ((rk_ >> 1) & 7)) << 4); \
            __builtin_amdgcn_global_load_lds((const unsigned*)(gK + ro_ * 16384 + sk_), (LAS unsigned*)(sb_ + oK + pc_ * 1024), 16, 0, 0); \
            if (!lat || (pc_ >> 3) == half) __builtin_amdgcn_global_load_lds((const unsigned*)((const unsigned char*)gU + ro_ * 16384 + sk_), (LAS unsigned*)(sb_ + oU + pc_ * 1024), 16, 0, 0); } } \
        _Pragma("unroll") for (int p_ = 0; p_ < 2; ++p_) { const int pa_ = lw + nw * p_; if (pa_ < 8) { const int ra_ = pa_ * 8 + r8; const int sa_ = ra_ * 128 + ((s8 ^ ((ra_ >> 1) & 7)) << 4); \
            __builtin_amdgcn_global_load_lds((const unsigned*)(gA + ro_ * 8192 + sa_), (LAS unsigned*)(sb_ + oA + pa_ * 1024), 16, 0, 0); } } \
        if (lw == 0) __builtin_amdgcn_global_load_lds((const unsigned*)(gGL + ro_), (LAS unsigned*)(sb_ + oG), 4, 0, 0); } } while (0)
        __syncthreads();
        int rec = (cbase * NH + h) * 2 + dir;
        DN_STAGE(0, rec);
        for (int c = 0; c < nch; ++c) {
            if (c == 0 || !active) asm volatile("s_waitcnt vmcnt(0)" ::: "memory"); else asm volatile("s_waitcnt vmcnt(16)" ::: "memory");
            asm volatile("s_waitcnt lgkmcnt(0)" ::: "memory");
            __builtin_amdgcn_s_barrier();
            u32x4 oimg[2];
            const bool drain = lat && ldr && c >= 1;
            if (drain) {
                const LAS unsigned char* ib = L + ((c - 1) & 1) * BUF + oU + (half ? 0 : 8192);
#pragma unroll
                for (int j_ = 0; j_ < 2; ++j_) oimg[j_] = *(const LAS u32x4*)(ib + (lw + 4 * j_) * 1024 + lane * 16);
            }
            if (c + 1 < nch) { const int rn = rec + 2 * NH; DN_STAGE((c + 1) & 1, rn); }
            if (drain) {
#pragma unroll
                for (int j_ = 0; j_ < 2; ++j_) {
                    const int irow = 8 * (lw + 4 * j_) + (lane >> 3), step = (c - 1) * 64 + irow, row = row0 + (dir ? (Ls - 1 - step) : step);
                    *(u32x4*)(O + (size_t)row * 768 + h * 128 + half * 64 + (lane & 7) * 8) = oimg[j_];
                }
            }
            if (active) {
            const unsigned sbb = (unsigned)(uintptr_t)L + (unsigned)(c & 1) * BUF;
            u32x2 uc[4]; float gl;
            {
                const unsigned aU = sbb + oU + dvc * 128 + (fq & 1) * 8;
#pragma unroll
                for (int mf = 0; mf < 4; ++mf) asm volatile("ds_read_b64 %0, %1" : "=v"(uc[mf]) : "v"(aU + (unsigned)(((mf * 2 + (fq >> 1)) ^ ((dvc >> 1) & 7)) << 4)));
                asm volatile("ds_read_b32 %0, %1" : "=v"(gl) : "v"(sbb + oG));
                asm volatile("s_waitcnt lgkmcnt(0)" ::: "memory");
#pragma unroll
                for (int mf = 0; mf < 4; ++mf) asm volatile("" : "+v"(uc[mf]));
                asm volatile("" : "+v"(gl));
            }
            bf16x8 Sb[4];
#pragma unroll
            for (int ks = 0; ks < 4; ++ks) {
                u32x4 t; t.x = pk2(S[2 * ks][0], S[2 * ks][1]); t.y = pk2(S[2 * ks][2], S[2 * ks][3]); t.z = pk2(S[2 * ks + 1][0], S[2 * ks + 1][1]); t.w = pk2(S[2 * ks + 1][2], S[2 * ks + 1][3]);
                Sb[ks] = __builtin_bit_cast(bf16x8, t);
            }
#pragma unroll
            for (int mf = 0; mf < 8; ++mf) S[mf] = S[mf] * gl;
            f32x4 vn[4], o[4];
#pragma unroll
            for (int mf = 0; mf < 4; ++mf) {
                vn[mf][0] = __builtin_bit_cast(float, uc[mf].x << 16); vn[mf][1] = __builtin_bit_cast(float, uc[mf].x & 0xffff0000u);
                vn[mf][2] = __builtin_bit_cast(float, uc[mf].y << 16); vn[mf][3] = __builtin_bit_cast(float, uc[mf].y & 0xffff0000u);
                o[mf] = (f32x4){0.f, 0.f, 0.f, 0.f};
            }
            const unsigned aWQ = sbb + fr * 256, aAK = sbb + fr * 128;
            unsigned xw[4], xa[2];
#pragma unroll
            for (int ks = 0; ks < 4; ++ks) xw[ks] = (unsigned)(((ks * 4 + fq) ^ fr) << 4);
#pragma unroll
            for (int ks = 0; ks < 2; ++ks) xa[ks] = (unsigned)(((ks * 4 + fq) ^ ((fr >> 1) & 7)) << 4);
#define DN_FADDR(f) (((f) < 32) ? (aWQ + ((((f) >> 2) < 4) ? oW : oQ) + ((f) & 3) * 4096 + xw[((f) >> 2) & 3]) : (((f) < 40) ? (aAK + oA + (((f) - 32) & 3) * 2048 + xa[((f) - 32) >> 2]) : (aAK + oK + (((f) - 40) & 7) * 2048 + xa[((f) - 40) >> 3])))
            bf16x8 ring[8], Vb[2];
#pragma unroll
            for (int f = 0; f < 7; ++f) { DS_READ128(ring[f], DN_FADDR(f)); }
#pragma unroll
            for (int f = 0; f < 56; ++f) {
                if (f + 7 < 56) { DS_READ128(ring[(f + 7) & 7], DN_FADDR(f + 7)); }
                lgkm_wait((f + 7 < 56) ? 7 : (55 - f));
                asm volatile("" : "+v"(ring[f & 7]));
                __builtin_amdgcn_sched_barrier(0);
                if (f == 32) {
#pragma unroll
                    for (int ks = 0; ks < 2; ++ks) {
                        u32x4 t; t.x = pk2(vn[2 * ks][0], vn[2 * ks][1]); t.y = pk2(vn[2 * ks][2], vn[2 * ks][3]); t.z = pk2(vn[2 * ks + 1][0], vn[2 * ks + 1][1]); t.w = pk2(vn[2 * ks + 1][2], vn[2 * ks + 1][3]);
                        Vb[ks] = __builtin_bit_cast(bf16x8, t);
                    }
                }
                if (f < 32) { const int mf = f & 3, j = f >> 2; if (j < 4) vn[mf] = MFMA16(ring[f & 7], Sb[j], vn[mf]); else o[mf] = MFMA16(ring[f & 7], Sb[j - 4], o[mf]); }
                else if (f < 40) { const int g = f - 32; o[g & 3] = MFMA16(ring[f & 7], Vb[g >> 2], o[g & 3]); }
                else { const int g = f - 40; S[g & 7] = MFMA16(ring[f & 7], Vb[g >> 3], S[g & 7]); }
            }
#undef DN_FADDR
            if (lat) {
                LAS unsigned char* ib = L + (c & 1) * BUF + oU + (half ? 0 : 8192) + ((wave & 3) * 16 + fr) * 2;
#pragma unroll
                for (int mf = 0; mf < 4; ++mf)
#pragma unroll
                    for (int r = 0; r < 4; ++r) *(LAS bf16*)(ib + (mf * 16 + 4 * fq + r) * 128) = (bf16)f2bf(o[mf][r]);
            } else
#pragma unroll
            for (int mf = 0; mf < 4; ++mf)
#pragma unroll
                for (int r = 0; r < 4; ++r) {
                    const int step = c * 64 + mf * 16 + 4 * fq + r, row = row0 + (dir ? (Ls - 1 - step) : step);
                    asm volatile("global_store_short %0, %1, off" :: "v"(O + (size_t)row * 768 + h * 128 + dvc), "v"(pk2(o[mf][r], 0.f)) : "memory");
                }
            }
            rec += 2 * NH;
        }
#undef DN_STAGE
        if (lat) {
            asm volatile("s_waitcnt lgkmcnt(0)" ::: "memory");
            __builtin_amdgcn_s_barrier();
            if (ldr) {
                const LAS unsigned char* ib = L + ((nch - 1) & 1) * BUF + oU + (half ? 0 : 8192);
#pragma unroll
                for (int j_ = 0; j_ < 2; ++j_) {
                    const u32x4 v_ = *(const LAS u32x4*)(ib + (lw + 4 * j_) * 1024 + lane * 16);
                    const int irow = 8 * (lw + 4 * j_) + (lane >> 3), step = (nch - 1) * 64 + irow, row = row0 + (dir ? (Ls - 1 - step) : step);
                    *(u32x4*)(O + (size_t)row * 768 + h * 128 + half * 64 + (lane & 7) * 8) = v_;
                }
            }
        }
        if (!lat) {
            float* so = a.out + (size_t)M * D + ((((size_t)seq * 2 + e) * 2 + dir) * NH + h) * 128 * 128;
#pragma unroll
            for (int mf = 0; mf < 8; ++mf)
#pragma unroll
                for (int r = 0; r < 4; ++r) so[(size_t)(mf * 16 + 4 * fq + r) * 128 + dvc] = S[mf][r];
        }
    }
    __syncthreads();
}

__device__ __forceinline__ void phase_dn_fin(Frame& F, int e, bool panel_local) {
    const CAS Args& a = *F.a;
    const bf16* P = (const bf16*)(a.ws + WS_P);
    const bf16* OF = (const bf16*)(a.ws + WS_OF); const bf16* OB = (const bf16*)(a.ws + WS_OB);
    bf16* Y = (bf16*)(a.ws + WS_Y);
    const float* nw = a.in[I_DNNW] + e * 128;
    const int gw = panel_local ? (F.vcu & 7) * 8 + F.wave : F.vcu * 8 + F.wave, NGW = panel_local ? 64 : F.G * 8;
    const int rbeg = panel_local ? (F.vcu >> 3) * 192 : 0, rend = panel_local ? rbeg + 192 : M;
    for (int row = rbeg + gw; row < rend; row += NGW) {
        const int c2 = F.lane * 2;
        f32x2 v[NH]; unsigned zr[NH]; float ss[NH];
#pragma unroll
        for (int h = 0; h < NH; ++h) {
            const size_t o = (size_t)row * 768 + h * 128 + c2;
            const unsigned uf = *(const unsigned*)(OF + o), ub = *(const unsigned*)(OB + o);
            v[h] = (f32x2){__builtin_bit_cast(float, uf << 16) + __builtin_bit_cast(float, ub << 16), __builtin_bit_cast(float, uf & 0xffff0000u) + __builtin_bit_cast(float, ub & 0xffff0000u)};
            zr[h] = *(const unsigned*)(P + (size_t)row * LDP + 2560 + h * 128 + c2);
            ss[h] = v[h][0] * v[h][0] + v[h][1] * v[h][1];
        }
#pragma unroll
        for (int o = 1; o < 64; o <<= 1) {
#pragma unroll
            for (int h = 0; h < NH; ++h) ss[h] += __shfl_xor(ss[h], o);
        }
        const f32x2 w = *(const f32x2*)(nw + c2);
#pragma unroll
        for (int h = 0; h < NH; ++h) {
            const float rs = rsq_f(ss[h] * (1.f / 128.f) + EPS);
            const f32x2 z = {__builtin_bit_cast(float, zr[h] << 16), __builtin_bit_cast(float, zr[h] & 0xffff0000u)};
            *(unsigned*)(Y + (size_t)row * D + 256 + h * 128 + c2) = pk2(v[h][0] * rs * w[0] * silu_f(z[0]), v[h][1] * rs * w[1] * silu_f(z[1]));
        }
    }
}

struct EpiOdd {
    bf16* G; float* ZR; float* ZI; float* ST; Pre pre;
    template <int NFRAG> struct Hold { PreHold ph; };
    template <int NFRAG> __device__ __forceinline__ void preload(Hold<NFRAG>& h, int, int, int tid, int row0, int col0) const { pre_fetch(pre, h.ph, tid, row0, col0, 32 * NFRAG); }
    template <int NFRAG> __device__ __forceinline__ void stage(const Hold<NFRAG>& h, LAS float* sc, int tid) const { pre_write(h.ph, sc, tid, 32 * NFRAG); }
    template <int NFRAG> __device__ __forceinline__ void operator()(f32x4 (&acc)[3][NFRAG], const Hold<NFRAG>&, int row, int colq, int fq, const LAS float* sc, int lrow, int lcol) const {
        const int ct = colq >> 8;
        constexpr int RB = 32 * NFRAG, PB = RB + 16;
        const int wm = lrow / 48, wn = lcol / (16 * NFRAG), fr = lrow - wm * 48, lane = fq * 16 + fr;
        LAS unsigned char* img = (LAS unsigned char*)sc + 8192 + (wm * 2 + wn) * (48 * PB);
        if (ct < 6) {
#pragma unroll
            for (int mf = 0; mf < 3; ++mf) {
                const int rr = row + mf * 16; float s1 = 0.f, s2 = 0.f;
                const float rs = sc[lrow + mf * 16]; const LAS float* bp = sc + 256 + cond_of_row(rr) * (32 * NFRAG) + lcol;
#pragma unroll
                for (int nf = 0; nf < NFRAG; ++nf) {
                    const f32x4 v = acc[mf][nf] * rs + *(const LAS f32x4*)(bp + nf * 16);
                    const float g0 = gelu_tanh(v[0]), g1 = gelu_tanh(v[1]), g2 = gelu_tanh(v[2]), g3 = gelu_tanh(v[3]);
                    u32x2 w; w.x = pk2(g0, g1); w.y = pk2(g2, g3);
                    *(LAS u32x2*)(img + (mf * 16 + fr) * PB + nf * 32 + fq * 8) = w;
                    s1 += (g0 + g1) + (g2 + g3); s2 += (g0 * g0 + g1 * g1) + (g2 * g2 + g3 * g3);
                }
                if (ct >= 3) {
                    s1 += __shfl_xor(s1, 16); s1 += __shfl_xor(s1, 32); s2 += __shfl_xor(s2, 16); s2 += __shfl_xor(s2, 32);
                    if (fq == 0) { atomicAdd(ST + (size_t)rr * 2, s1); atomicAdd(ST + (size_t)rr * 2 + 1, s2); }
                }
            }
            image_store<RB, PB>(img, (unsigned char*)(G + (size_t)(row - fr) * 1536 + (colq - fq * 4)), (size_t)1536 * 2, lane);
        } else {
            float* Z = (ct == 6) ? ZR : ZI; const int cb = colq - ct * 256;
#pragma unroll
            for (int mf = 0; mf < 3; ++mf) {
                const int rr = row + mf * 16; const float rs = sc[lrow + mf * 16]; const LAS float* bp = sc + 256 + cond_of_row(rr) * (32 * NFRAG) + lcol;
#pragma unroll
                for (int nf = 0; nf < NFRAG; ++nf) *(f32x4*)(Z + (size_t)rr * 256 + cb + nf * 16) = acc[mf][nf] * rs + *(const LAS f32x4*)(bp + nf * 16);
            }
        }
    }
};

constexpr double c_pi = 3.14159265358979323846;
constexpr double c_sin_poly(double x) { double t = x, s = x; for (int i = 1; i < 14; ++i) { t *= -x * x / ((2 * i) * (2 * i + 1)); s += t; } return s; }
constexpr double c_cos_poly(double x) { double t = 1, s = 1; for (int i = 1; i < 14; ++i) { t *= -x * x / ((2 * i - 1) * (2 * i)); s += t; } return s; }
constexpr int c_bitrev(int x, int n) { int r = 0; for (int b = 1; b < n; b <<= 1) { r = (r << 1) | (x & 1); x >>= 1; } return r; }
template <int N, int HALF, int BASE, int J>
__device__ __forceinline__ void fft_bf(float (&re)[N], float (&im)[N]) {
    constexpr int ia = BASE + J, ib = ia + HALF;
    constexpr float c = (float)c_cos_poly(c_pi * J / HALF), s = (float)c_sin_poly(c_pi * J / HALF);
    const float ar = re[ia], ai = im[ia], br = re[ib], bi = im[ib];
    re[ia] = ar + br; im[ia] = ai + bi;
    const float dr = ar - br, di = ai - bi;
    if constexpr (J == 0) { re[ib] = dr; im[ib] = di; }
    else if constexpr (2 * J == HALF) { re[ib] = di; im[ib] = -dr; }
    else { re[ib] = dr * c + di * s; im[ib] = di * c - dr * s; }
    if constexpr (J + 1 < HALF) fft_bf<N, HALF, BASE, J + 1>(re, im);
    else if constexpr (BASE + 2 * HALF < N) fft_bf<N, HALF, BASE + 2 * HALF, 0>(re, im);
    else if constexpr (HALF > 1) fft_bf<N, HALF / 2, 0, 0>(re, im);
}
template <int R, int P>
__device__ __forceinline__ void fa_store(const float (&zr)[R], const float (&zi)[R], float* BR, float* BI, int row0, int n2, int col, const LAS float* twN) {
    constexpr int k1 = c_bitrev(P, R);
    const int t = k1 * n2; const float c = twN[t], s = twN[R * R + t];
    const size_t o = (size_t)(row0 + k1 * R + n2) * 256 + col;
    BR[o] = c * zr[P] + s * zi[P]; BI[o] = c * zi[P] - s * zr[P];
    if constexpr (P + 1 < R) fa_store<R, P + 1>(zr, zi, BR, BI, row0, n2, col, twN);
}
template <int R>
__device__ __forceinline__ void fourier_a_item(const float* ZR, const float* ZI, float* BR, float* BI, int row0, int n2, const LAS float* twN, int col) {
    float zr[R], zi[R];
#pragma unroll
    for (int n1 = 0; n1 < R; ++n1) { const size_t o = (size_t)(row0 + R * n1 + n2) * 256 + col; zr[n1] = ZR[o]; zi[n1] = ZI[o]; }
    fft_bf<R, R / 2, 0, 0>(zr, zi);
    fa_store<R, 0>(zr, zi, BR, BI, row0, n2, col, twN);
}
template <int R, int P>
__device__ __forceinline__ void fc_store(const float (&br)[R], bf16* Y, int row0, int k1, int col) {
    constexpr int k2 = c_bitrev(P, R);
    Y[(size_t)(row0 + k1 + R * k2) * D + 768 + col] = (bf16)f2bf(br[P] * (1.0f / R));
    if constexpr (P + 1 < R) fc_store<R, P + 1>(br, Y, row0, k1, col);
}
template <int R>
__device__ __forceinline__ void fourier_c_item(const float* BR, const float* BI, bf16* Y, int row0, int k1, int col) {
    float br[R], bi[R];
#pragma unroll
    for (int n2 = 0; n2 < R; ++n2) { const size_t o = (size_t)(row0 + k1 * R + n2) * 256 + col; br[n2] = BR[o]; bi[n2] = BI[o]; }
    fft_bf<R, R / 2, 0, 0>(br, bi);
    fc_store<R, 0>(br, Y, row0, k1, col);
}
__device__ __forceinline__ void fourier_tables(LAS float* tw, int tid) {
    for (int i = tid; i < 1024; i += 512) { const float x = (float)i * (1.f / 512.f); tw[64 + i] = cospif(x); tw[64 + 1024 + i] = sinpif(x); }
    if (tid < 256) { const float x = (float)tid * (1.f / 128.f); tw[2144 + tid] = cospif(x); tw[2144 + 256 + tid] = sinpif(x); }
    if (tid < 32) { const float x = (float)tid * (1.f / 16.f); tw[tid] = cospif(x); tw[32 + tid] = sinpif(x); }
    if (tid < 16) { const float x = (float)tid * (1.f / 8.f); tw[2112 + tid] = cospif(x); tw[2112 + 16 + tid] = sinpif(x); }
}

__device__ __forceinline__ void phase_odd_mix(Frame& F, int j) {
    const CAS Args& a = *F.a;
    const bf16* G = (const bf16*)(a.ws + WS_P); bf16* Y = (bf16*)(a.ws + WS_Y);
    const float* ZR = (const float*)(a.ws + WS_ZR); const float* ZI = (const float*)(a.ws + WS_ZI);
    float* BR = (float*)(a.ws + WS_QN); float* BI = (float*)(a.ws + WS_KN);
    const float* ST = (const float*)(a.ws + WS_CTL + CTL_ST_OFF) + (size_t)j * M * 2;
    LAS unsigned char* L = F.lds;
    LAS float* tw = (LAS float*)(L + 65536);
    fourier_tables(tw, F.tid);
    __syncthreads();
    const int wave = F.wave;
    constexpr int NA_LAT = LAT_B * 32 / 2, NSGU = (M / 128) * NH, NA_CTX = CTX_B * 16 / 2;
    for (int it = F.vcu; it < NA_LAT + NSGU + NA_CTX; it += F.G) {
        int tid_ = F.tid; asm volatile("" : "+v"(tid_));
        if (it < NA_LAT) { const int q = it * 2 + (tid_ >> 8); fourier_a_item<32>(ZR, ZI, BR, BI, NCTX + (q >> 5) * LAT_L, q & 31, tw + 64, tid_ & 255); continue; }
        if (it >= NA_LAT + NSGU) { const int q = (it - NA_LAT - NSGU) * 2 + (tid_ >> 8); fourier_a_item<16>(ZR, ZI, BR, BI, (q >> 4) * CTX_L, q & 15, tw + 2144, tid_ & 255); continue; }
        const int q = it - NA_LAT, ch = q / NH, h = q % NH, r0 = ch * 128;
        const int lane = tid_ & 63, fr = lane & 15, fq = lane >> 4;
        __syncthreads();
        u32x4 wreg[4];
        {
            const bf16* Wb = (const bf16*)(a.ws + WS_SGUW) + ((size_t)j * NH + h) * 16384;
#pragma unroll
            for (int q = 0; q < 4; ++q) { const int i = tid_ + 512 * q; wreg[q] = *(const u32x4*)(Wb + (i >> 4) * 128 + (i & 15) * 8); }
        }
        {
            const int s = tid_ >> 2, cq = tid_ & 3, row = r0 + s;
            const float s1 = ST[(size_t)row * 2], s2 = ST[(size_t)row * 2 + 1];
            const float mu = s1 * (1.f / 768.f), var = s2 * (1.f / 768.f) - mu * mu, rstd = rsq_f(fmaxf(var, 0.f) + EPS);
            const bf16* gp = G + (size_t)row * 1536 + 768 + h * 128 + cq * 32;
            const float* nw = a.in[I_SGUN] + j * 768 + h * 128 + cq * 32;
#pragma unroll
            for (int v8 = 0; v8 < 4; ++v8) {
                const u32x4 raw = *(const u32x4*)(gp + v8 * 8);
                const unsigned wds[4] = {raw.x, raw.y, raw.z, raw.w};
#pragma unroll
                for (int e2 = 0; e2 < 4; ++e2) {
                    const float g0 = __builtin_bit_cast(float, wds[e2] << 16), g1 = __builtin_bit_cast(float, wds[e2] & 0xffff0000u);
                    const int c0 = cq * 32 + v8 * 8 + e2 * 2;
                    const float v0 = (g0 - mu) * rstd * nw[v8 * 8 + e2 * 2], v1 = (g1 - mu) * rstd * nw[v8 * 8 + e2 * 2 + 1];
                    *(LAS bf16*)(L + c0 * 256 + (((s >> 3) ^ (c0 & 15)) << 4) + (s & 7) * 2) = (bf16)f2bf(v0);
                    *(LAS bf16*)(L + (c0 + 1) * 256 + (((s >> 3) ^ ((c0 + 1) & 15)) << 4) + (s & 7) * 2) = (bf16)f2bf(v1);
                }
            }
        }
#pragma unroll
        for (int q = 0; q < 4; ++q) { const int i = tid_ + 512 * q, p = i >> 4, c16 = i & 15; *(LAS u32x4*)(L + 32768 + p * 256 + ((c16 ^ (p & 15)) << 4)) = wreg[q]; }
        __syncthreads();
        {
            f32x4 acc[8];
#pragma unroll
            for (int pf = 0; pf < 8; ++pf) acc[pf] = (f32x4){0.f, 0.f, 0.f, 0.f};
#pragma unroll
            for (int ks = 0; ks < 4; ++ks) {
                const bf16x8 av = *(const LAS bf16x8*)(L + (wave * 16 + fr) * 256 + (((ks * 4 + fq) ^ fr) << 4));
                bf16x8 bw[8];
#pragma unroll
                for (int pf = 0; pf < 8; ++pf) bw[pf] = *(const LAS bf16x8*)(L + 32768 + (pf * 16 + fr) * 256 + (((ks * 4 + fq) ^ fr) << 4));
#pragma unroll
                for (int pf = 0; pf < 8; ++pf) acc[pf] = MFMA16(av, bw[pf], acc[pf]);
            }
            const float* bs = a.in[I_SGUB] + ((size_t)j * NH + h) * 128;
#pragma unroll
            for (int pf = 0; pf < 8; ++pf) {
                const int p = pf * 16 + fr, row = r0 + p, c = wave * 16 + 4 * fq; const float b = bs[p];
                const u32x2 gu = *(const u32x2*)(G + (size_t)row * 1536 + h * 128 + c);
                const float u0 = __builtin_bit_cast(float, gu.x << 16), u1 = __builtin_bit_cast(float, gu.x & 0xffff0000u), u2 = __builtin_bit_cast(float, gu.y << 16), u3 = __builtin_bit_cast(float, gu.y & 0xffff0000u);
                u32x2 o; o.x = pk2(u0 * (acc[pf][0] + b), u1 * (acc[pf][1] + b)); o.y = pk2(u2 * (acc[pf][2] + b), u3 * (acc[pf][3] + b));
                *(u32x2*)(Y + (size_t)row * D + h * 128 + c) = o;
            }
        }
    }
    __syncthreads();
}
__device__ __forceinline__ void phase_odd_fc(Frame& F) {
    const CAS Args& a = *F.a;
    const float* BR = (const float*)(a.ws + WS_QN); const float* BI = (const float*)(a.ws + WS_KN); bf16* Y = (bf16*)(a.ws + WS_Y);
    constexpr int NC_LAT = LAT_B * 32 / 2, NC_CTX = CTX_B * 16 / 2;
    for (int it = F.vcu; it < NC_LAT + NC_CTX; it += F.G) {
        int tid_ = F.tid; asm volatile("" : "+v"(tid_));
        if (it < NC_LAT) { const int q = it * 2 + (tid_ >> 8); fourier_c_item<32>(BR, BI, Y, NCTX + (q >> 5) * LAT_L, q & 31, tid_ & 255); }
        else { const int q = (it - NC_LAT) * 2 + (tid_ >> 8); fourier_c_item<16>(BR, BI, Y, (q >> 4) * CTX_L, q & 15, tid_ & 255); }
    }
    __syncthreads();
}

constexpr int STEPS = 9, N_PHASES = 2 + DEPTH * STEPS + 1;
__device__ __forceinline__ bool phase_active(int ph) {
    if (ph < 2 || ph == N_PHASES - 1) return true;
    const int l = (ph - 2) / STEPS, st = (ph - 2) % STEPS;
    return !((l & 1) && st == 5);
}
__device__ __forceinline__ void run_phase(Frame& F, int ph) {
    const CAS Args& a = *F.a; unsigned char* ws = a.ws;
    if (ph == 0) { phase_setup(F); return; }
    if (ph == 1) { phase_init(F); return; }
    if (ph == N_PHASES - 1) { phase_final(F, F.grp); return; }
    const int l = (ph - 2) / STEPS, st = (ph - 2) % STEPS, e = l >> 1;
    bf16* XS = (bf16*)(ws + WS_HN); bf16* HH = (bf16*)(ws + WS_HH); float* X = (float*)(ws + WS_X); float* P = (float*)(ws + WS_P);
    const bf16* Y = (const bf16*)(ws + WS_Y); const float* mod = (const float*)(ws + WS_MOD);
    float* ssb = (float*)(ws + WS_CTL + CTL_SS_OFF); const float* biasb = (const float*)(ws + WS_BIAS);
#define PRE_OF(s_) Pre{ssb + (size_t)(s_) * M, biasb + (size_t)(s_) * 3 * NBMAX}
    switch (st) {
        case 0: { EpiUp E{HH, PRE_OF(3 * l)}; gemm_phase<11, EpiUp>(F, XS, (const bf16*)(ws + WS_WUP + (size_t)(l * 2) * WUP_SZ), D, NUP, E); } break;
        case 1: { EpiRes E{X, mod, l, 2, 0.5f, XS, ssb + (size_t)(3 * l + 1) * M, a.in[I_MIXN] + l * D, l, 1}; gemm_phase<4, EpiRes>(F, HH, (const bf16*)(ws + WS_WDN + (size_t)(l * 2) * WDN_SZ), FF, D, E); } break;
        case 2: { if ((l & 1) == 0) { EpiStore E{(bf16*)(ws + WS_P), (float*)(ws + WS_AG), PRE_OF(3 * l + 1)}; gemm_phase<7, EpiStore>(F, XS, (const bf16*)(ws + WS_EVIN + (size_t)e * EVIN_SZ), D, P_EVEN_PAD, E); }
                  else { EpiOdd EO{(bf16*)(ws + WS_P), (float*)(ws + WS_ZR), (float*)(ws + WS_ZI), (float*)(ws + WS_CTL + CTL_ST_OFF) + (size_t)e * M * 2, PRE_OF(3 * l + 1)};
                         gemm_phase<8, EpiOdd>(F, XS, (const bf16*)(ws + WS_ODIN + (size_t)e * ODIN_SZ), D, 2048, EO); } } break;
        case 3: if ((l & 1) == 0) { phase_dn_prep(F, e); if (F.G == 256) pool_items(F, e, 128, 2); } else phase_odd_mix(F, e); break;
        case 4: if ((l & 1) == 0) { phase_dn_scan(F, e); pool_items(F, e, (F.G > 96) ? 48 : 0, 1 << 20); } else phase_odd_fc(F); break;
        case 5: if ((l & 1) == 0) phase_dn_fin(F, e, F.grp); break;
        case 6: { EpiRes E{X, mod, l, 5, 1.0f, XS, ssb + (size_t)(3 * l + 2) * M, a.in[I_F2N] + l * D, l, 2}; gemm_phase<4, EpiRes>(F, Y, (const bf16*)(ws + ((l & 1) ? WS_ODOUT : WS_EVOUT) + (size_t)e * SQ_SZ), D, D, E); } break;
        case 7: { EpiUp E{HH, PRE_OF(3 * l + 2)}; gemm_phase<11, EpiUp>(F, XS, (const bf16*)(ws + WS_WUP + (size_t)(l * 2 + 1) * WUP_SZ), D, NUP, E); } break;
        case 8: { const bool last = (l == DEPTH - 1);
                  EpiRes E{X, mod, l, 8, 0.5f, XS, last ? nullptr : ssb + (size_t)(3 * l + 3) * M, a.in[I_F1N] + (last ? l : l + 1) * D, last ? l : l + 1, 0};
                  gemm_phase<4, EpiRes>(F, HH, (const bf16*)(ws + WS_WDN + (size_t)(l * 2 + 1) * WDN_SZ), FF, D, E); } break;
    }
#undef PRE_OF
}

__global__ void __launch_bounds__(512, 2) mk_fwd(Args args) {
    extern __shared__ __attribute__((aligned(16))) unsigned char lds_raw[];
    Frame F;
    F.lds = (LAS unsigned char*)lds_raw;
    F.tid = threadIdx.x; F.lane = F.tid & 63; F.wave = __builtin_amdgcn_readfirstlane(F.tid >> 6);
    F.G = gridDim.x; { const int bx = blockIdx.x; F.vcu = (F.G % 8 == 0) ? (bx % 8) * (F.G / 8) + bx / 8 : bx; }
    const CAS Args* ap = (const CAS Args*)__builtin_amdgcn_kernarg_segment_ptr();
    F.a = ap;
    const int ph_lo = ap->ph_lo, ph_hi = ap->ph_hi;
    unsigned char* ws0 = ap->ws;
    volatile LAS unsigned* MISC = (volatile LAS unsigned*)(F.lds + LDS_MISC);
    if (F.tid < 64) MISC[F.tid] = 0u;
    __syncthreads();
    const bool multi = (ph_hi - ph_lo) > 1;
    XcdBarrier bar; bar.bar = (unsigned*)(ws0 + WS_CTL) + CW_BAR; bar.x = 0; bar.st = MISC + 8;
    if (multi) bar = xcd_barrier_post((unsigned*)(ws0 + WS_CTL) + CW_BAR, MISC + 8);
    unsigned* ctl = (unsigned*)(ws0 + WS_CTL);
    if (F.tid == 0) __hip_atomic_store(ctl + CW_GXCC + F.vcu, xb_xcc_id() + 1u, __ATOMIC_RELAXED, __HIP_MEMORY_SCOPE_AGENT);
    F.grp = false;
    unsigned gb_gen = 0u;
    for (int ph = ph_lo; ph < ph_hi; ++ph) {
        { const CAS Args* a2 = ap; asm volatile("" : "+s"(a2)); F.a = a2; }
        { int t_ = threadIdx.x; asm volatile("" : "+v"(t_)); F.tid = t_; F.lane = t_ & 63; F.wave = __builtin_amdgcn_readfirstlane(t_ >> 6); }
        if (!phase_active(ph)) continue;
        run_phase(F, ph);
        if (ph + 1 >= ph_hi) break;
        bool local = false;
        if (ph >= 2 && ph < N_PHASES - 1) { const int st = (ph - 2) % STEPS, l_ = (ph - 2) / STEPS; local = (st == 0 || st == 1 || st >= 6 || (st == 5 && (l_ & 1) == 0)); }
        if (local && F.grp) group_barrier(ctl, F.vcu >> 3, ph + 2 >= N_PHASES, ++gb_gen);
        else xcd_barrier(bar);
        if (ph == 0 && multi && F.G == 256) {
            unsigned ok = 1u;
            for (int i = F.lane; i < 256; i += 64) { const unsigned mine = xb_ld(ctl + CW_GXCC + i), first = xb_ld(ctl + CW_GXCC + (i & ~7)); if (mine == 0u || mine != first) ok = 0u; }
            F.grp = (__ballot(ok != 0u) == ~0ull);
        }
    }
}

extern "C" void kernel_launch(void* const* d_in, const int* in_sizes, int n_in, void* d_out, int out_size, void* d_ws, size_t ws_size, hipStream_t stream) {
    static int grid = 0;
    if (grid == 0) {
        if (n_in != 31 || ws_size < WS_END) { fprintf(stderr, "kernel_launch: unexpected n_in %d or ws_size %zu (need %zu)\n", n_in, ws_size, (size_t)WS_END); grid = -1; return; }
        int dev = 0, cus = 0;
        if (hipGetDevice(&dev) != hipSuccess || hipDeviceGetAttribute(&cus, hipDeviceAttributeMultiprocessorCount, dev) != hipSuccess) { grid = -1; return; }
        if (hipFuncSetAttribute((const void*)mk_fwd, hipFuncAttributeMaxDynamicSharedMemorySize, LDS_BYTES) != hipSuccess) { fprintf(stderr, "kernel_launch: hipFuncSetAttribute failed\n"); grid = -1; return; }
        (void)hipGetLastError();
        grid = cus;
    }
    if (grid < 0) return;
    static_assert(WS_MOD == WS_CTL + CTL_BYTES && WS_BIAS == WS_MOD + (size_t)4 * 3 * 9216 * 4 && WS_BIAS + (size_t)12 * 3 * NBMAX * 4 <= 2 * MiB, "zeroed block layout");
    (void)hipMemsetAsync((char*)d_ws + WS_CTL, 0, WS_BIAS + (size_t)12 * 3 * NBMAX * 4 - WS_CTL, stream);
    Args a{};
    for (int i = 0; i < 31; ++i) a.in[i] = (const float*)d_in[i];
    a.out = (float*)d_out; a.ws = (unsigned char*)d_ws;
#if ONE_LAUNCH
    a.ph_lo = 0; a.ph_hi = N_PHASES;
    hipLaunchKernelGGL(mk_fwd, dim3(grid), dim3(512), LDS_BYTES, stream, a);
#else
    for (int ph = 0; ph < N_PHASES; ++ph) {
        a.ph_lo = ph; a.ph_hi = ph + 1;
        hipLaunchKernelGGL(mk_fwd, dim3(grid), dim3(512), LDS_BYTES, stream, a);
    }
#endif
}
```
